# Optimizing an MI355X kernel written in HIP

```python
import jax, jax.numpy as jnp
from jax import lax
import numpy as np

D_MODEL = 1024
BATCH = 1
SEQ = 16384
DEPTH = 4

CHUNK = 64
Q_BLOCK = 128
SGU_CHUNK = 128
HEAD_DIM = 64
D_ATTN = D_MODEL // 2
N_ATTN_HEADS = D_ATTN // HEAD_DIM
D_SGU = D_MODEL // 2
SGU_GROUP_DIM = 64
N_SGU_GROUPS = D_SGU // SGU_GROUP_DIM
D_MIX = D_ATTN + D_SGU
D_IN = 3 * D_ATTN + N_ATTN_HEADS + 2 * D_SGU
D_FF = -(-8 * D_MODEL // (3 * 256)) * 256
EPS = 1e-6

kernel_name = 'fox_gmlp_hybrid_trunk'


def rms_norm(x, g):
    xf = x.astype(jnp.float32)
    y = xf * lax.rsqrt(jnp.mean(xf * xf, axis=-1, keepdims=True) + EPS)
    return (y * g.astype(jnp.float32)).astype(x.dtype)


def layer_norm(x, g, b):
    xf = x.astype(jnp.float32)
    mu = jnp.mean(xf, axis=-1, keepdims=True)
    xc = xf - mu
    y = xc * lax.rsqrt(jnp.mean(xc * xc, axis=-1, keepdims=True) + EPS)
    return (y * g.astype(jnp.float32) + b.astype(jnp.float32)).astype(x.dtype)


def forgetting_attention(q, k, v, log_f):
    B, S, H, Dh = q.shape
    nb = S // Q_BLOCK
    c_bhs = jnp.cumsum(log_f, axis=1).transpose(0, 2, 1)
    q_blocks = q.reshape(B, nb, Q_BLOCK, H, Dh).transpose(1, 0, 2, 3, 4)
    cq_blocks = c_bhs.reshape(B, H, nb, Q_BLOCK).transpose(2, 0, 1, 3)
    starts = jnp.arange(nb, dtype=jnp.int32) * Q_BLOCK
    key_pos = jnp.arange(S, dtype=jnp.int32)
    scale = Dh ** -0.5

    def one_block(args):
        qb, cqb, start = args
        s = jnp.einsum('bqhd,bkhd->bhqk', qb, k).astype(jnp.float32) * scale
        s = s + cqb[..., :, None] - c_bhs[..., None, :]
        q_pos = start + jnp.arange(Q_BLOCK, dtype=jnp.int32)
        causal = key_pos[None, :] <= q_pos[:, None]
        s = jnp.where(causal, s, -jnp.inf)
        p = jax.nn.softmax(s, axis=-1).astype(v.dtype)
        return jnp.einsum('bhqk,bkhd->bqhd', p, v)

    out = lax.map(one_block, (q_blocks, cq_blocks, starts))
    return out.transpose(1, 0, 2, 3, 4).reshape(B, S, H * Dh)


def spatial_gating(z, ln_g, ln_b, w_s, b_s):
    B, S, _ = z.shape
    zu, zv = jnp.split(z, 2, axis=-1)
    zv = layer_norm(zv, ln_g, ln_b)
    nc = S // SGU_CHUNK
    zv = zv.reshape(B, nc, SGU_CHUNK, N_SGU_GROUPS, SGU_GROUP_DIM)
    pos = jnp.arange(SGU_CHUNK, dtype=jnp.int32) // CHUNK
    mask = (pos[None, :] <= pos[:, None]).astype(w_s.dtype)
    w = w_s * mask[None]
    mixed = jnp.einsum('gij,bcjgd->bcigd', w, zv) + b_s.T[None, None, :, :, None]
    return zu * mixed.reshape(B, S, D_SGU)


def setup_inputs(seed: int = 0) -> dict:
    key = jax.random.key(seed)
    ks = jax.random.split(key, 14)
    f32 = jnp.float32
    nrm = lambda k, shape, s: jax.random.normal(k, shape, f32) * s
    head_bias = jnp.linspace(1.0, 5.0, N_ATTN_HEADS, dtype=f32)
    return {
        'x': jax.random.normal(ks[0], (BATCH, SEQ, D_MODEL), f32),
        'mix_norm_g': 1.0 + nrm(ks[1], (DEPTH, D_MODEL), 0.05),
        'w_in': nrm(ks[2], (DEPTH, D_MODEL, D_IN), D_MODEL ** -0.5),
        'b_f': head_bias[None, :] + nrm(ks[3], (DEPTH, N_ATTN_HEADS), 0.1),
        'sgu_ln_g': 1.0 + nrm(ks[4], (DEPTH, D_SGU), 0.05),
        'sgu_ln_b': nrm(ks[5], (DEPTH, D_SGU), 0.02),
        'w_s': nrm(ks[6], (DEPTH, N_SGU_GROUPS, SGU_CHUNK, SGU_CHUNK), 0.5 * SGU_CHUNK ** -0.5),
        'b_s': 1.0 + nrm(ks[7], (DEPTH, N_SGU_GROUPS, SGU_CHUNK), 0.1),
        'out_norm_g': 1.0 + nrm(ks[8], (DEPTH, D_MIX), 0.05),
        'w_out': nrm(ks[9], (DEPTH, D_MIX, D_MODEL), D_MIX ** -0.5),
        'ffn_norm_g': 1.0 + nrm(ks[10], (DEPTH, D_MODEL), 0.05),
        'w_gate_up': nrm(ks[11], (DEPTH, D_MODEL, 2 * D_FF), D_MODEL ** -0.5),
        'w_down': nrm(ks[12], (DEPTH, D_FF, D_MODEL), D_FF ** -0.5),
        'final_norm_g': 1.0 + nrm(ks[13], (D_MODEL,), 0.05),
    }


def reference(x, mix_norm_g, w_in, b_f, sgu_ln_g, sgu_ln_b, w_s, b_s, out_norm_g, w_out,
              ffn_norm_g, w_gate_up, w_down, final_norm_g):
    B, S, _ = x.shape
    for l in range(DEPTH):
        xn = rms_norm(x, mix_norm_g[l])
        h = xn @ w_in[l]
        q, k, v, f_logit, z = jnp.split(
            h, [D_ATTN, 2 * D_ATTN, 3 * D_ATTN, 3 * D_ATTN + N_ATTN_HEADS], axis=-1)
        q = q.reshape(B, S, N_ATTN_HEADS, HEAD_DIM)
        k = k.reshape(B, S, N_ATTN_HEADS, HEAD_DIM)
        v = v.reshape(B, S, N_ATTN_HEADS, HEAD_DIM)
        log_f = jax.nn.log_sigmoid(f_logit.astype(jnp.float32) + b_f[l].astype(jnp.float32))
        attn = forgetting_attention(q, k, v, log_f)
        sgu = spatial_gating(jax.nn.gelu(z, approximate=False),
                             sgu_ln_g[l], sgu_ln_b[l], w_s[l], b_s[l])
        merged = jnp.concatenate(
            [rms_norm(attn, out_norm_g[l, :D_ATTN]), rms_norm(sgu, out_norm_g[l, D_ATTN:])], axis=-1)
        x = x + merged @ w_out[l]
        xn = rms_norm(x, ffn_norm_g[l])
        gate, up = jnp.split(xn @ w_gate_up[l], 2, axis=-1)
        x = x + (jax.nn.silu(gate) * up) @ w_down[l]
    return rms_norm(x, final_norm_g)
```

```cpp
#define MK_MULTI 1
#include <hip/hip_runtime.h>
#include <hip/hip_cooperative_groups.h>
#include <cstdio>
#include <cstdint>
namespace pg8 {
#define PG8_LAS __attribute__((address_space(3)))
typedef unsigned short bf16_t;
typedef short bf16x8 __attribute__((ext_vector_type(8)));
typedef float f32x4 __attribute__((ext_vector_type(4)));
typedef unsigned u32x4 __attribute__((ext_vector_type(4)));
constexpr int BM = 256, BK = 64, HALF = 128, HTB = HALF * BK * 2  , STAGE_BYTES = 8 * HTB, NXCD = 8, WGM = 8;

__host__ __device__ __forceinline__ int lds_byte(int r, int c) { const int st = (r >> 4) * 2 + (c >> 5), rr = r & 15, cc = c & 31, ob = rr * 64 + cc * 2; return st * 1024 + (ob ^ (((ob >> 9) & 1) << 5)); }
__host__ __device__ __forceinline__ void stage_rc(int b, int& R, int& C) { const int st = b / 1024, sb = b % 1024, swz = sb ^ (((sb >> 9) & 1) << 5); R = (st >> 1) * 16 + swz / 64; C = (st & 1) * 32 + (swz % 64) / 2; }
__host__ __device__ __forceinline__ int perm32(int rho) { const int n = rho >> 4, i = rho & 15; return 8 * (i >> 2) + 4 * n + (i & 3); }

struct Unit { int pm, pn; };
struct Gemm { const bf16_t* A; const bf16_t* Bt; int M, N, K; };

struct StaticOrder {
    int nM, nN, nwg, G, c;
    __host__ __device__ void init(int M, int N, int G_, int c_) { nM = M / BM; nN = N / BM; nwg = nM * nN; G = G_; c = c_; }
    __host__ __device__ bool next(int i, Unit& u) const {
        const long L = (long)i * G + c; if (L >= nwg) return false;
        int wgid = (int)L; { const int q = nwg / NXCD, r = nwg % NXCD, xcd = wgid % NXCD, off = wgid / NXCD; wgid = (xcd < r ? xcd * (q + 1) : r * (q + 1) + (xcd - r) * q) + off; }
        const int nig = WGM * nN, gid = wgid / nig, fm = gid * WGM, gsz = (nM - fm) < WGM ? (nM - fm) : WGM;
        u.pm = fm + ((wgid % nig) % gsz); u.pn = (wgid % nig) / gsz; return true;
    }
    __device__ __forceinline__ void a_ready(const Unit&) const {}
    __device__ __forceinline__ void done(const Unit&) const {}
};

__device__ __forceinline__ unsigned cvt_pk_bf16(float lo, float hi) { unsigned r; asm volatile("v_cvt_pk_bf16_f32 %0, %1, %2" : "=v"(r) : "v"(lo), "v"(hi)); return r; }
typedef float f32x2 __attribute__((ext_vector_type(2)));
__device__ __forceinline__ f32x2 gelu_pk(f32x2 v) {
    const f32x2 av = __builtin_elementwise_abs(v), d = av * 0.2316418882f + 1.0f;
    f32x2 t; t.x = __builtin_amdgcn_rcpf(d.x); t.y = __builtin_amdgcn_rcpf(d.y);
    f32x2 q = t * 0.5307027145f + (-0.7265760135f); q = q * t + 0.7107068705f; q = q * t + (-0.142248368f); q = q * t + 0.127414796f; q = q * t;
    const f32x2 s = (v * v) * (-0.72134752044f);
    f32x2 e; e.x = __builtin_amdgcn_exp2f(s.x); e.y = __builtin_amdgcn_exp2f(s.y);
    const f32x2 m = v * (q * e), r = v - m;
    f32x2 o; o.x = v.x < 0.f ? m.x : r.x; o.y = v.y < 0.f ? m.y : r.y; return o;
}
constexpr float C2Q = 0.125f * 1.4426950408889634f;
struct EpiInProj {
    static constexpr bool PERM = true, AFTER_DRAIN = false;
    bf16_t* O; size_t split_stride; const float* rstd;
    __device__ __forceinline__ void operator()(const f32x4 (&acc)[2][2][4][2], const Unit& u, int wr, int wc, int fr, int fq) const {
        const int t = u.pn >> 1; bf16_t* base = O + (size_t)t * split_stride;
        const int row0 = u.pm * BM + wr * 64 + fr, col0 = (u.pn & 1) * 256 + wc * 32 + 8 * fq;
        const float s0 = (t == 0) ? C2Q : 1.0f;
#pragma unroll
        for (int ai = 0; ai < 2; ++ai)
#pragma unroll
            for (int m = 0; m < 4; ++m) { const int row = row0 + ai * HALF + m * 16; const float rs = rstd[row] * s0; bf16_t* rowp = base + (size_t)row * 512 + col0;
#pragma unroll
                for (int bj = 0; bj < 2; ++bj) { f32x4 v0 = acc[ai][bj][m][0] * rs, v1 = acc[ai][bj][m][1] * rs;
                    if (t >= 3) { f32x2 a = gelu_pk((f32x2){v0[0], v0[1]}), b = gelu_pk((f32x2){v0[2], v0[3]}), c = gelu_pk((f32x2){v1[0], v1[1]}), d = gelu_pk((f32x2){v1[2], v1[3]});
                        v0 = (f32x4){a.x, a.y, b.x, b.y}; v1 = (f32x4){c.x, c.y, d.x, d.y}; }
                    u32x4 w; w.x = cvt_pk_bf16(v0[0], v0[1]); w.y = cvt_pk_bf16(v0[2], v0[3]); w.z = cvt_pk_bf16(v1[0], v1[1]); w.w = cvt_pk_bf16(v1[2], v1[3]);
                    *(u32x4*)(rowp + bj * HALF) = w; } }
    }
};
struct EpiResid {
    static constexpr bool PERM = false, AFTER_DRAIN = false;
    const float* base; float* out;
    __device__ __forceinline__ void operator()(const f32x4 (&acc)[2][2][4][2], const Unit& u, int wr, int wc, int fr, int fq) const {
        const int col0 = u.pn * BM + wc * 32 + 4 * fq;
#pragma unroll
        for (int ai = 0; ai < 2; ++ai)
#pragma unroll
            for (int m = 0; m < 4; ++m) { const size_t off = (size_t)(u.pm * BM + ai * HALF + wr * 64 + m * 16 + fr) * 1024 + col0;
#pragma unroll
                for (int bj = 0; bj < 2; ++bj)
#pragma unroll
                    for (int n = 0; n < 2; ++n) { const f32x4 b = *(const f32x4*)(base + off + bj * HALF + n * 16); *(f32x4*)(out + off + bj * HALF + n * 16) = b + acc[ai][bj][m][n]; } }
    }
};
struct EpiSwiGLU {
    static constexpr bool PERM = true, AFTER_DRAIN = false;
    bf16_t* H; const float* rstd;
    __device__ __forceinline__ void operator()(const f32x4 (&acc)[2][2][4][2], const Unit& u, int wr, int wc, int fr, int fq) const {
        const int row0 = u.pm * BM + wr * 64 + fr, col0 = u.pn * 128 + wc * 32 + 8 * fq;
#pragma unroll
        for (int ai = 0; ai < 2; ++ai)
#pragma unroll
            for (int m = 0; m < 4; ++m) { const int row = row0 + ai * HALF + m * 16; const float rs = rstd[row];
                float hv[8];
#pragma unroll
                for (int n = 0; n < 2; ++n)
#pragma unroll
                    for (int e = 0; e < 4; ++e) { const float g = acc[ai][0][m][n][e] * rs, up = acc[ai][1][m][n][e] * rs;
                        const float sg = __builtin_amdgcn_rcpf(1.0f + __builtin_amdgcn_exp2f(-1.4426950408889634f * g)); hv[n * 4 + e] = g * sg * up; }
                u32x4 w; w.x = cvt_pk_bf16(hv[0], hv[1]); w.y = cvt_pk_bf16(hv[2], hv[3]); w.z = cvt_pk_bf16(hv[4], hv[5]); w.w = cvt_pk_bf16(hv[6], hv[7]);
                *(u32x4*)(H + (size_t)row * 2816 + col0) = w; }
    }
};
template <class Epi, class Sched, bool ALIGN_EPI = false, bool SP2 = false>
__device__ __forceinline__ void gemm_phase(PG8_LAS unsigned char* lds, const Gemm g, const Sched& S, const Epi& E) {
    int tid = threadIdx.x; asm volatile("" : "+v"(tid));
    const int wid = __builtin_amdgcn_readfirstlane(tid >> 6), lane = tid & 63, wr = wid >> 2, wc = wid & 3, fr = lane & 15, fq = lane >> 4;
    const int K = g.K, nt = K / BK;
    unsigned voffA[2], voffB[2];
#pragma unroll
    for (int i = 0; i < 2; ++i) { int R, C; stage_rc(tid * 16 + i * 8192, R, C); const int Rb = Epi::PERM ? ((R & ~31) + perm32(R & 31)) : R;
        voffA[i] = (unsigned)(R * K + C) * 2u; voffB[i] = (unsigned)(Rb * K + C) * 2u; }
    const size_t kstep = (size_t)(BK * 2);
    const size_t hstep = (size_t)HALF * K * 2;
    const size_t tstep = 2 * hstep;
    const unsigned ldsw = (unsigned)wid * 1024u;
    const int aoff = lds_byte(wr * 64 + fr, fq * 8), boff = lds_byte(wc * 32 + fr, fq * 8);
#define PG8_SA(b, h) (((b) * 2 + (h)) * HTB)
#define PG8_SB(b, h) ((4 + (b) * 2 + (h)) * HTB)
#define PG8_STAGE(bufoff, gbase, voff) do { _Pragma("unroll") for (int _i = 0; _i < 2; ++_i) \
        __builtin_amdgcn_global_load_lds((const unsigned*)((const char*)(gbase) + (voff)[_i]), (PG8_LAS unsigned*)(lds + (bufoff) + ldsw + _i * 8192), 16, 0, 0); } while (0)
#define PG8_LDA(dst, b, h) do { _Pragma("unroll") for (int m = 0; m < 4; ++m) _Pragma("unroll") for (int k = 0; k < 2; ++k) dst[m][k] = *(const PG8_LAS bf16x8*)(lds + PG8_SA(b, h) + aoff + m * 2048 + k * 1024); } while (0)
#define PG8_LDB(dst, b, h) do { _Pragma("unroll") for (int n = 0; n < 2; ++n) _Pragma("unroll") for (int k = 0; k < 2; ++k) dst[n][k] = *(const PG8_LAS bf16x8*)(lds + PG8_SB(b, h) + boff + n * 2048 + k * 1024); } while (0)
#define PG8_MMA(ai, bj, At, Bt) do { __builtin_amdgcn_s_setprio(1); _Pragma("unroll") for (int m = 0; m < 4; ++m) _Pragma("unroll") for (int n = 0; n < 2; ++n) _Pragma("unroll") for (int k = 0; k < 2; ++k) \
        acc[ai][bj][m][n] = __builtin_amdgcn_mfma_f32_16x16x32_bf16(Bt[n][k], At[m][k], acc[ai][bj][m][n], 0, 0, 0); __builtin_amdgcn_s_setprio(0); } while (0)
#define PG8_WAIT_V(n) asm volatile("s_waitcnt vmcnt(" #n ")" ::: "memory")
#define PG8_WAIT_L(n) asm volatile("s_waitcnt lgkmcnt(" #n ")" ::: "memory")
#define PG8_BAR __builtin_amdgcn_s_barrier()
#define PG8_SCHED __builtin_amdgcn_sched_barrier(0)
    Unit cur, nxt; int ui = 0;
    if (!S.next(0, cur)) return;
    f32x4 acc[2][2][4][2];
#pragma unroll
    for (int a = 0; a < 2; ++a)
#pragma unroll
        for (int b = 0; b < 2; ++b)
#pragma unroll
            for (int m = 0; m < 4; ++m)
#pragma unroll
                for (int n = 0; n < 2; ++n) acc[a][b][m][n] = (f32x4){0.f, 0.f, 0.f, 0.f};
    bf16x8 At[4][2], B0[2][2], B1[2][2];
    const char* cA = (const char*)g.A + (size_t)cur.pm * tstep; const char* cB = (const char*)g.Bt + (size_t)cur.pn * tstep;
    S.a_ready(cur);
    if constexpr (SP2) {
        PG8_STAGE(PG8_SB(0, 0), cB, voffB); PG8_STAGE(PG8_SB(0, 1), cB + hstep, voffB); PG8_STAGE(PG8_SA(0, 0), cA, voffA); PG8_STAGE(PG8_SA(0, 1), cA + hstep, voffA);
        if (wr == 1) PG8_BAR;
        PG8_WAIT_V(2); PG8_BAR;
        PG8_STAGE(PG8_SB(1, 0), cB + kstep, voffB); PG8_STAGE(PG8_SA(1, 0), cA + kstep, voffA); PG8_STAGE(PG8_SB(1, 1), cB + hstep + kstep, voffB);
        PG8_WAIT_V(6); PG8_BAR;
    } else {
        PG8_STAGE(PG8_SB(0, 0), cB, voffB); PG8_STAGE(PG8_SA(0, 0), cA, voffA); PG8_STAGE(PG8_SB(0, 1), cB + hstep, voffB); PG8_STAGE(PG8_SA(0, 1), cA + hstep, voffA);
        if (wr == 1) PG8_BAR;
        PG8_WAIT_V(4); PG8_BAR;
        PG8_STAGE(PG8_SB(1, 0), cB + kstep, voffB); PG8_STAGE(PG8_SA(1, 0), cA + kstep, voffA); PG8_STAGE(PG8_SB(1, 1), cB + hstep + kstep, voffB);
        PG8_WAIT_V(6); PG8_BAR;
    }
    for (;;) {
        const bool has_next = S.next(ui + 1, nxt);
        const char* nA = has_next ? (const char*)g.A + (size_t)nxt.pm * tstep : cA; const char* nB = has_next ? (const char*)g.Bt + (size_t)nxt.pn * tstep : cB;
        for (int t = 0; t < nt; t += 2) {
            const bool last = (t == nt - 2);
            const char* a1 = cA + (size_t)(t + 1) * kstep;
            const char* a2 = last ? nA : cA + (size_t)(t + 2) * kstep; const char* b2 = last ? nB : cB + (size_t)(t + 2) * kstep;
            const char* a3 = a2 + kstep; const char* b3 = b2 + kstep;
            if (last && has_next) S.a_ready(nxt);
            if constexpr (SP2) {
            PG8_LDB(B0, 0, 0); PG8_LDB(B1, 0, 1); PG8_SCHED; PG8_LDA(At, 0, 0); PG8_STAGE(PG8_SA(1, 1), a1 + hstep, voffA);
            PG8_WAIT_V(8); PG8_WAIT_L(0); PG8_BAR; PG8_MMA(0, 0, At, B0); PG8_MMA(0, 1, At, B1); PG8_BAR; PG8_SCHED;
            PG8_LDA(At, 0, 1); PG8_STAGE(PG8_SB(0, 0), b2, voffB); PG8_STAGE(PG8_SB(0, 1), b2 + hstep, voffB); PG8_STAGE(PG8_SA(0, 0), a2, voffA);
            PG8_WAIT_V(8); PG8_WAIT_L(0); PG8_BAR; PG8_MMA(1, 0, At, B0); PG8_MMA(1, 1, At, B1); PG8_BAR; PG8_SCHED;
            PG8_LDB(B0, 1, 0); PG8_LDB(B1, 1, 1); PG8_SCHED; PG8_LDA(At, 1, 0); PG8_STAGE(PG8_SA(0, 1), a2 + hstep, voffA);
            PG8_WAIT_V(8); PG8_WAIT_L(0); PG8_BAR; PG8_MMA(0, 0, At, B0); PG8_MMA(0, 1, At, B1); PG8_BAR; PG8_SCHED;
            PG8_LDA(At, 1, 1); PG8_STAGE(PG8_SB(1, 0), b3, voffB); PG8_STAGE(PG8_SB(1, 1), b3 + hstep, voffB); PG8_STAGE(PG8_SA(1, 0), a3, voffA);
            PG8_WAIT_V(8); PG8_WAIT_L(0); PG8_BAR; PG8_MMA(1, 0, At, B0); PG8_MMA(1, 1, At, B1); PG8_BAR; PG8_SCHED;
            } else {
            PG8_LDB(B0, 0, 0); PG8_SCHED; PG8_LDA(At, 0, 0); PG8_STAGE(PG8_SA(1, 1), a1 + hstep, voffA);
            PG8_WAIT_L(8); PG8_BAR; PG8_WAIT_L(0); PG8_MMA(0, 0, At, B0); PG8_BAR; PG8_SCHED;
            PG8_LDB(B1, 0, 1); PG8_STAGE(PG8_SB(0, 0), b2, voffB);
            PG8_BAR; PG8_WAIT_L(0); PG8_MMA(0, 1, At, B1); PG8_BAR;
            PG8_LDA(At, 0, 1); PG8_STAGE(PG8_SA(0, 0), a2, voffA);
            PG8_BAR; PG8_WAIT_L(0); PG8_MMA(1, 0, At, B0); PG8_BAR; PG8_SCHED;
            PG8_STAGE(PG8_SB(0, 1), b2 + hstep, voffB);
            PG8_WAIT_V(6); PG8_BAR; PG8_MMA(1, 1, At, B1); PG8_BAR;
            PG8_LDB(B0, 1, 0); PG8_SCHED; PG8_LDA(At, 1, 0); PG8_STAGE(PG8_SA(0, 1), a2 + hstep, voffA);
            PG8_WAIT_L(8); PG8_BAR; PG8_WAIT_L(0); PG8_MMA(0, 0, At, B0); PG8_BAR; PG8_SCHED;
            PG8_LDB(B1, 1, 1); PG8_STAGE(PG8_SB(1, 0), b3, voffB);
            PG8_BAR; PG8_WAIT_L(0); PG8_MMA(0, 1, At, B1); PG8_BAR;
            PG8_LDA(At, 1, 1); PG8_STAGE(PG8_SA(1, 0), a3, voffA);
            PG8_BAR; PG8_WAIT_L(0); PG8_MMA(1, 0, At, B0); PG8_BAR; PG8_SCHED;
            PG8_STAGE(PG8_SB(1, 1), b3 + hstep, voffB);
            PG8_WAIT_V(6); PG8_BAR; PG8_MMA(1, 1, At, B1); PG8_BAR;
            }
        }
        if constexpr (ALIGN_EPI) { if (wr == 0) PG8_BAR; }
        if constexpr (!Epi::AFTER_DRAIN) { E(acc, cur, wr, wc, fr, fq); S.done(cur); }
        if (!has_next) break;
#pragma unroll
        for (int a = 0; a < 2; ++a)
#pragma unroll
            for (int b = 0; b < 2; ++b)
#pragma unroll
                for (int m = 0; m < 4; ++m)
#pragma unroll
                    for (int n = 0; n < 2; ++n) acc[a][b][m][n] = (f32x4){0.f, 0.f, 0.f, 0.f};
        cur = nxt; cA = nA; cB = nB; ++ui;
        if constexpr (ALIGN_EPI) { if (wr == 1) PG8_BAR; }
    }
    PG8_WAIT_V(0);
    if constexpr (!ALIGN_EPI) { if (wr == 0) PG8_BAR; }
    PG8_BAR;
    if constexpr (Epi::AFTER_DRAIN) { E.fused(acc, cur, wr, wc, fr, fq, lds, wid, lane); S.done(cur); }
#undef PG8_SA
#undef PG8_SB
#undef PG8_STAGE
#undef PG8_LDA
#undef PG8_LDB
#undef PG8_MMA
#undef PG8_WAIT_V
#undef PG8_WAIT_L
#undef PG8_BAR
#undef PG8_SCHED
}
}
#include <hip/hip_bf16.h>
#include <cmath>
namespace attn_body {
using bf16=__hip_bfloat16;
using bf16x8=__attribute__((ext_vector_type(8)))short;
using s16x4=__attribute__((ext_vector_type(4)))short;
using f32x16=__attribute__((ext_vector_type(16)))float;
using u32x4=__attribute__((ext_vector_type(4)))unsigned;
constexpr int BATCH=1,NHEAD=8,SEQ=16384,D=64,DM=NHEAD*D;
constexpr int NW=8,QBLK=32,QB=QBLK*NW,KVBLK=64,NQB=SEQ/QB;
constexpr int ATTN_PITCH=DM, ATTN_UNIT_ROWS=QB;
__device__ __forceinline__ int crow(int r,int hi){return (r&3)+8*(r>>2)+4*hi;}
#define SBAR() __builtin_amdgcn_sched_barrier(0)
__device__ __forceinline__ void cmask(f32x16&p0,f32x16&p1,int jb,int qrel,int hi){
  const float NEG=-INFINITY; int kb=64*jb+4*hi;
  #pragma unroll
  for(int r=0;r<16;++r){int kv=kb+(r&3)+8*(r>>2); if(kv>qrel)p0[r]=NEG; if(kv+32>qrel)p1[r]=NEG;}
}

constexpr int NSLOT=3, SLOTB=8192;
constexpr int LDS_K=0, LDS_V=NSLOT*SLOTB, LDS_WS=2*NSLOT*SLOTB, LDS_OST=LDS_WS+NW*64*4, LDS_BYTES=LDS_OST+NW*4096;
constexpr float C2=0.125f*1.4426950408889634f;
__device__ __forceinline__ void glds16(const void*gsrc,unsigned lds_dst){unsigned keep;
  asm volatile("s_mov_b32 %0, m0\n\ts_mov_b32 m0, %2\n\ts_nop 0\n\tglobal_load_lds_dwordx4 %1, off\n\ts_mov_b32 m0, %0":"=&s"(keep):"v"(gsrc),"s"(lds_dst):"memory");}
__device__ __forceinline__ float max3f(float a,float b,float c){float r;asm("v_max3_f32 %0, %1, %2, %3":"=v"(r):"v"(a),"v"(b),"v"(c));return r;}
__device__ __forceinline__ float max2f(float a,float b){float r;asm("v_max_f32_e32 %0, %1, %2":"=v"(r):"v"(a),"v"(b));return r;}
__device__ __forceinline__ float fadd_s(float a,float b){float r;asm("v_add_f32_e32 %0, %1, %2":"=v"(r):"v"(a),"v"(b));return r;}
__device__ __forceinline__ float fsub_s(float a,float b){float r;asm("v_sub_f32_e32 %0, %1, %2":"=v"(r):"v"(a),"v"(b));return r;}
typedef float f32x2_t __attribute__((ext_vector_type(2))); typedef __bf16 bf16x2_t __attribute__((ext_vector_type(2)));
__device__ __forceinline__ unsigned cvtpk_s(float lo,float hi){f32x2_t v={lo,hi};bf16x2_t b=__builtin_convertvector(v,bf16x2_t);return __builtin_bit_cast(unsigned,b);}
#define WAIT_BAR(N) asm volatile("s_waitcnt vmcnt(" #N ") lgkmcnt(0)\n\ts_barrier":::"memory")

__device__ __forceinline__ void qkt(f32x16&p0,f32x16&p1,const char*Kslot,const bf16x8*qr,const f32x16&negm,int r32,int hi){
  const char*kb=Kslot+hi*1024+r32*16;
  #pragma unroll
  for(int d0=0;d0<4;++d0){
    const bf16x8 b0=*reinterpret_cast<const bf16x8*>(kb+d0*2048);
    const bf16x8 b1=*reinterpret_cast<const bf16x8*>(kb+d0*2048+512);
    if(d0==0){p0=__builtin_amdgcn_mfma_f32_32x32x16_bf16(b0,qr[0],negm,0,0,0);p1=__builtin_amdgcn_mfma_f32_32x32x16_bf16(b1,qr[0],negm,0,0,0);}
    else{p0=__builtin_amdgcn_mfma_f32_32x32x16_bf16(b0,qr[d0],p0,0,0,0);p1=__builtin_amdgcn_mfma_f32_32x32x16_bf16(b1,qr[d0],p1,0,0,0);}}
}
typedef __attribute__((address_space(3))) const char* lds_cptr;
typedef short v4i16_t __attribute__((ext_vector_type(4)));
__device__ __forceinline__ void kload8(bf16x8*kf,lds_cptr kp){
  kf[0]=*(const __attribute__((address_space(3))) bf16x8*)(kp);      kf[1]=*(const __attribute__((address_space(3))) bf16x8*)(kp+512);
  kf[2]=*(const __attribute__((address_space(3))) bf16x8*)(kp+2048); kf[3]=*(const __attribute__((address_space(3))) bf16x8*)(kp+2560);
  kf[4]=*(const __attribute__((address_space(3))) bf16x8*)(kp+4096); kf[5]=*(const __attribute__((address_space(3))) bf16x8*)(kp+4608);
  kf[6]=*(const __attribute__((address_space(3))) bf16x8*)(kp+6144); kf[7]=*(const __attribute__((address_space(3))) bf16x8*)(kp+6656);
}
__device__ __forceinline__ void kload2(bf16x8*kf,lds_cptr kp,int j){ kf[2*j]=*(const __attribute__((address_space(3))) bf16x8*)(kp+j*2048); kf[2*j+1]=*(const __attribute__((address_space(3))) bf16x8*)(kp+j*2048+512); }
__device__ __forceinline__ s16x4 vtr(lds_cptr p){ return __builtin_bit_cast(s16x4,__builtin_amdgcn_ds_read_tr16_b64_v4i16((__attribute__((address_space(3))) v4i16_t*)p)); }
__device__ __forceinline__ float rowmax(const f32x16&p0,const f32x16&p1){
  float a=max3f(p0[0],p0[1],p1[0]),b=max3f(p0[2],p0[3],p1[1]);a=max3f(a,p1[2],p1[3]);
  #pragma unroll
  for(int r=4;r<16;r+=4){a=max3f(a,p0[r],p0[r+1]);b=max3f(b,p0[r+2],p0[r+3]);a=max3f(a,p1[r],p1[r+1]);b=max3f(b,p1[r+2],p1[r+3]);}
  const float m=max2f(a,b);
  auto rr=__builtin_amdgcn_permlane32_swap(__float_as_uint(m),__float_as_uint(m),false,false);
  return max2f(__uint_as_float(rr[0]),__uint_as_float(rr[1]));
}
__device__ __forceinline__ void pv(f32x16*o,int vb,bf16x8 pa0,bf16x8 pa1,bf16x8 pa2,bf16x8 pa3){
  #pragma unroll
  for(int d0=0;d0<2;++d0){s16x4 lo[4],hi[4];
    #pragma unroll
    for(int ks=0;ks<4;++ks){
      asm volatile("ds_read_b64_tr_b16 %0,%1 offset:%c2":"=&v"(lo[ks]):"v"(vb),"i"(d0*4096+ks*1024):"memory");
      asm volatile("ds_read_b64_tr_b16 %0,%1 offset:%c2":"=&v"(hi[ks]):"v"(vb),"i"(d0*4096+ks*1024+512):"memory");}
    asm volatile("s_waitcnt lgkmcnt(0)":::"memory");SBAR();
    #define PK(k) (bf16x8){lo[k][0],lo[k][1],lo[k][2],lo[k][3],hi[k][0],hi[k][1],hi[k][2],hi[k][3]}
    o[d0]=__builtin_amdgcn_mfma_f32_32x32x16_bf16(pa0,PK(0),o[d0],0,0,0);
    o[d0]=__builtin_amdgcn_mfma_f32_32x32x16_bf16(pa1,PK(1),o[d0],0,0,0);
    o[d0]=__builtin_amdgcn_mfma_f32_32x32x16_bf16(pa2,PK(2),o[d0],0,0,0);
    o[d0]=__builtin_amdgcn_mfma_f32_32x32x16_bf16(pa3,PK(3),o[d0],0,0,0);
    #undef PK
  }
}
typedef float f32x4_t __attribute__((ext_vector_type(4)));
constexpr int FLDS_WS=2*NSLOT*SLOTB, FLDS_CK=FLDS_WS+2048, FOX_LDS_BYTES=FLDS_CK+65536;
__device__ __forceinline__ void fox_unit(int h,int qb,int ts,const bf16*Q,const bf16*__restrict__ K,const bf16*__restrict__ V,bf16*O,const float*__restrict__ c2h,char*shm){
  int tid=threadIdx.x; asm volatile("":"+v"(tid)); const int lane=tid&63,r32=lane&31,hi=lane>>5; const int wid=__builtin_amdgcn_readfirstlane(tid>>6);
  const int q0=qb*QB;
  const bf16*Qw=Q+(long)(q0+wid*QBLK)*DM+h*D;
  const bf16*Kh=K+h*D,*Vh=V+h*D;
  const unsigned lds0=(unsigned)(uintptr_t)shm;
  float*wsf=(float*)(shm+FLDS_WS)+wid*64;
  float*ckl=(float*)(shm+FLDS_CK);
  const bf16*ksrc=Kh+(long)lane*DM+wid*8;
  const bf16*vsrc=Vh+(long)(16*(wid&3)+(lane>>2))*DM+(wid>>2)*32+(lane&3)*8;
  const unsigned kdst=lds0+LDS_K+wid*1024, vdst=lds0+LDS_V+wid*1024;
  #define DMA_K(t,slot) glds16(ksrc+(long)(t)*KVBLK*DM,(unsigned)__builtin_amdgcn_readfirstlane(kdst+(slot)))
  #define DMA_V(t,slot) glds16(vsrc+(long)(t)*KVBLK*DM,(unsigned)__builtin_amdgcn_readfirstlane(vdst+(slot)))
  const int vb0=(int)(lds0+LDS_V)+((lane>>4)&1)*32+(lane&3)*8+(4*hi+((lane&15)>>2))*64;
  const int NT=(q0+QB)/KVBLK;
  { const float cref=c2h[q0]; const int nck=(NT-ts)*64;
    for(int i=tid*4;i<nck;i+=2048){ f32x4_t v=*(const f32x4_t*)(c2h+ts*64+i); v=v-cref; *(f32x4_t*)(ckl+i)=v; } }
  asm volatile("s_waitcnt vmcnt(0)":::"memory");
  DMA_K(ts,0);DMA_V(ts,0);DMA_K(ts+1,SLOTB);DMA_V(ts+1,SLOTB);
  bf16x8 qr[4];
  #pragma unroll
  for(int d0=0;d0<4;++d0)qr[d0]=*reinterpret_cast<const bf16x8*>(&Qw[(long)r32*DM+d0*16+hi*8]);
  float mhat=-1.0e30f,l_reg=0.f;f32x16 o[2];o[0]=f32x16{};o[1]=f32x16{};
  const f32x16 zero16=f32x16{};
  const int qrel=wid*QBLK+r32;
  int slot=0;
  for(int t=ts;t<NT;++t){
    if(t+1<NT){WAIT_BAR(2);}else{WAIT_BAR(0);}
    if(t+2<NT){ const int s2=(slot>=SLOTB)?slot-SLOTB:slot+2*SLOTB; DMA_K(t+2,s2);DMA_V(t+2,s2); }
    f32x16 p0,p1;
    qkt(p0,p1,shm+LDS_K+slot,qr,zero16,r32,hi);
    { const float*cb=ckl+(t-ts)*64+4*hi;
      #pragma unroll
      for(int g=0;g<4;++g){ const f32x4_t a=*(const f32x4_t*)(cb+8*g), b=*(const f32x4_t*)(cb+32+8*g);
        #pragma unroll
        for(int e=0;e<4;++e){p0[4*g+e]-=a[e];p1[4*g+e]-=b[e];} } }
    { const int jb=t-(NT-4); if(jb>=0)cmask(p0,p1,jb,qrel,hi); }
    float rm;
    { float a=__builtin_fmaxf(__builtin_fmaxf(p0[0],p0[1]),p1[0]),b=__builtin_fmaxf(__builtin_fmaxf(p0[2],p0[3]),p1[1]); a=__builtin_fmaxf(__builtin_fmaxf(a,p1[2]),p1[3]);
      #pragma unroll
      for(int r=4;r<16;r+=4){a=__builtin_fmaxf(__builtin_fmaxf(a,p0[r]),p0[r+1]);b=__builtin_fmaxf(__builtin_fmaxf(b,p0[r+2]),p0[r+3]);a=__builtin_fmaxf(__builtin_fmaxf(a,p1[r]),p1[r+1]);b=__builtin_fmaxf(__builtin_fmaxf(b,p1[r+2]),p1[r+3]);}
      rm=__builtin_fmaxf(a,b); auto rr=__builtin_amdgcn_permlane32_swap(__float_as_uint(rm),__float_as_uint(rm),false,false); rm=__builtin_fmaxf(__uint_as_float(rr[0]),__uint_as_float(rr[1])); }
    const float mnew=__builtin_fmaxf(mhat,rm);
    if(__any(mnew>mhat)){ const float f=__builtin_amdgcn_exp2f(mhat-mnew); l_reg*=f; if(hi==0)wsf[r32]=f; asm volatile("s_waitcnt lgkmcnt(0)":::"memory");
      #pragma unroll
      for(int d_=0;d_<2;++d_)
        #pragma unroll
        for(int r=0;r<16;++r)o[d_][r]*=wsf[crow(r,hi)];
      mhat=mnew; }
    float sacc=0.f;
    #pragma unroll
    for(int r=0;r<16;++r){p0[r]=__builtin_amdgcn_exp2f(p0[r]-mhat);p1[r]=__builtin_amdgcn_exp2f(p1[r]-mhat);sacc+=p0[r]+p1[r];}
    l_reg+=sacc;
    #define PKW(P,B) cvtpk_s(P[B],P[B+1])
    const u32x4 pw0=(u32x4){PKW(p0,0),PKW(p0,2),PKW(p0,4),PKW(p0,6)},pw1=(u32x4){PKW(p0,8),PKW(p0,10),PKW(p0,12),PKW(p0,14)},pw2=(u32x4){PKW(p1,0),PKW(p1,2),PKW(p1,4),PKW(p1,6)},pw3=(u32x4){PKW(p1,8),PKW(p1,10),PKW(p1,12),PKW(p1,14)};
    #undef PKW
    pv(o,vb0+slot,__builtin_bit_cast(bf16x8,pw0),__builtin_bit_cast(bf16x8,pw1),__builtin_bit_cast(bf16x8,pw2),__builtin_bit_cast(bf16x8,pw3));
    slot=(slot==(NSLOT-1)*SLOTB)?0:slot+SLOTB;
  }
  {auto rr=__builtin_amdgcn_permlane32_swap(__float_as_uint(l_reg),__float_as_uint(l_reg),false,false);l_reg=__uint_as_float(rr[0])+__uint_as_float(rr[1]);}
  if(hi==0)wsf[32+r32]=l_reg;
  asm volatile("s_waitcnt lgkmcnt(0)\n\ts_barrier":::"memory");
  float rli[16];
  #pragma unroll
  for(int r=0;r<16;++r)rli[r]=__builtin_amdgcn_rcpf(wsf[32+crow(r,hi)]);
  bf16*Ow=O+(long)(q0+wid*QBLK)*DM+h*D;
  { bf16*stg=(bf16*)(shm+LDS_K)+wid*2048;
    #pragma unroll
    for(int r=0;r<16;++r){const int orow=crow(r,hi);
      #pragma unroll
      for(int d0=0;d0<2;++d0)stg[orow*64+d0*32+r32]=__float2bfloat16(o[d0][r]*rli[r]);}
    asm volatile("s_waitcnt lgkmcnt(0)":::"memory");
    #pragma unroll
    for(int i=0;i<4;++i){const int row=i*8+(lane>>3),ch=lane&7; const u32x4 v=*(const u32x4*)(stg+row*64+ch*8); *(u32x4*)(Ow+(long)row*DM+ch*8)=v;} }
  asm volatile("s_waitcnt lgkmcnt(0)\n\ts_barrier":::"memory");
  #undef DMA_K
  #undef DMA_V
}
#undef SBAR
#undef WAIT_BAR
}
namespace cg = cooperative_groups;
constexpr int S_ = 16384, DMOD = 1024, NL = 4, DIN = 2568, NIN = 2560, DFF = 2816, NGU = 5632, NHD = 8;
constexpr float EPSN = 1e-6f;
constexpr size_t MiB = 1u << 20;
constexpr size_t WS_CTL = 0, CTL_BYTES = 65536;
constexpr size_t WS_WF = 1 * MiB;
constexpr size_t WS_WIN = 2 * MiB;
constexpr size_t WS_WOUT = 22 * MiB;
constexpr size_t WS_WGU = 30 * MiB;
constexpr size_t WS_WD = 74 * MiB;
constexpr size_t WS_XB = 96 * MiB;
constexpr size_t WS_RSTD = 128 * MiB;
constexpr size_t WS_LOGF = 128 * MiB + 256 * 1024;
constexpr size_t WS_C2 = 129 * MiB;
constexpr size_t WS_QKVZ = 130 * MiB;
constexpr size_t WS_O = 210 * MiB;
constexpr size_t WS_MG = 226 * MiB;
constexpr size_t WS_H = 130 * MiB;
constexpr size_t WS_END = 258 * MiB;
static_assert(WS_H + (size_t)S_ * DFF * 2 <= WS_MG, "h overlay");
constexpr int LDS_BYTES = 147456;
constexpr int NPHASE = 2 + 8 * NL;

#define LAS __attribute__((address_space(3)))
typedef unsigned short bf16r;
typedef unsigned v4u __attribute__((ext_vector_type(4)));
typedef float f32x4 __attribute__((ext_vector_type(4)));
typedef float f32x16 __attribute__((ext_vector_type(16)));
typedef short bf16x8 __attribute__((ext_vector_type(8)));
#define LDS_WAIT() asm volatile("s_waitcnt lgkmcnt(0)" ::: "memory")
__device__ __forceinline__ unsigned f2bf(float f) { unsigned u = __builtin_bit_cast(unsigned, f); return (u + 0x7fffu + ((u >> 16) & 1u)) >> 16; }
__device__ __forceinline__ unsigned pk2(float lo, float hi) { return f2bf(lo) | (f2bf(hi) << 16); }
__device__ __forceinline__ float bflo(unsigned w) { return __builtin_bit_cast(float, w << 16); }
__device__ __forceinline__ float bfhi(unsigned w) { return __builtin_bit_cast(float, w & 0xffff0000u); }
__device__ __forceinline__ float bf1(bf16r w) { return __builtin_bit_cast(float, (unsigned)w << 16); }
__device__ __forceinline__ float wave_sum(float v) {
#pragma unroll
    for (int o = 1; o < 64; o <<= 1) v += __shfl_xor(v, o);
    return v;
}
__device__ __forceinline__ void prep_item(const float* W, int ldw, int srccol, const float* gs, bf16r* WT, int K, int dstrow, int k0, LAS float* scr, int lane) {
#pragma unroll 8
    for (int i = 0; i < 32; ++i) { const int kk = 2 * i + (lane >> 5); float w = W[(size_t)(k0 + kk) * ldw + srccol + (lane & 31)]; if (gs) w *= gs[k0 + kk]; scr[kk * 33 + (lane & 31)] = w; }
    LDS_WAIT(); asm volatile("" ::: "memory");
    const int c = lane & 7;
#pragma unroll
    for (int j = 0; j < 4; ++j) { const int n = (lane >> 3) + 8 * j; const LAS float* s = scr + (8 * c) * 33 + n;
        v4u o; o.x = pk2(s[0 * 33], s[1 * 33]); o.y = pk2(s[2 * 33], s[3 * 33]); o.z = pk2(s[4 * 33], s[5 * 33]); o.w = pk2(s[6 * 33], s[7 * 33]);
        *(v4u*)(WT + (size_t)(dstrow + n) * K + k0 + 8 * c) = o; }
    LDS_WAIT(); asm volatile("" ::: "memory");
}
struct Ptrs {
    const float *x, *mixg, *w_in, *b_f, *lng, *lnb, *w_s, *b_s, *outg, *w_out, *ffng, *w_gu, *w_d, *fing;
    float* out; unsigned char* ws;
};
__device__ __forceinline__ void phase_prep(const Ptrs& P, LAS unsigned char* lds, int gw, int NGW, int wave, int lane) {
    LAS float* scr = (LAS float*)(lds + wave * 16384);
    bf16r* WinT = (bf16r*)(P.ws + WS_WIN); bf16r* WoutT = (bf16r*)(P.ws + WS_WOUT); bf16r* WguT = (bf16r*)(P.ws + WS_WGU); bf16r* WdT = (bf16r*)(P.ws + WS_WD);
    constexpr int I_IN = 16 * 80, I_OUT = 16 * 32, I_GU = 16 * 176, I_D = 44 * 32, I_L = I_IN + I_OUT + I_GU + I_D;
    for (int it = gw; it < NL * I_L; it += NGW) {
        const int l = it / I_L; int r = it % I_L;
        if (r < I_IN) { const int kb = r / 80, nb = r % 80, n0 = 32 * nb, src = n0 < 1536 ? n0 : n0 + 8;
            prep_item(P.w_in + (size_t)l * DMOD * DIN, DIN, src, P.mixg + l * DMOD, WinT + (size_t)l * NIN * DMOD, DMOD, n0, 64 * kb, scr, lane); continue; }
        r -= I_IN;
        if (r < I_OUT) { const int kb = r / 32, nb = r % 32;
            prep_item(P.w_out + (size_t)l * DMOD * DMOD, DMOD, 32 * nb, P.outg + l * DMOD, WoutT + (size_t)l * DMOD * DMOD, DMOD, 32 * nb, 64 * kb, scr, lane); continue; }
        r -= I_OUT;
        if (r < I_GU) { const int kb = r / 176, nb = r % 176, n0 = 32 * nb, pn = n0 >> 8, j = n0 & 255, src = j < 128 ? 128 * pn + j : DFF + 128 * pn + (j - 128);
            prep_item(P.w_gu + (size_t)l * DMOD * NGU, NGU, src, P.ffng + l * DMOD, WguT + (size_t)l * NGU * DMOD, DMOD, n0, 64 * kb, scr, lane); continue; }
        r -= I_GU;
        { const int kb = r / 32, nb = r % 32;
            prep_item(P.w_d + (size_t)l * DFF * DMOD, DMOD, 32 * nb, nullptr, WdT + (size_t)l * DMOD * DFF, DFF, 32 * nb, 64 * kb, scr, lane); }
    }
    float* wf = (float*)(P.ws + WS_WF);
    for (int idx = gw * 64 + lane; idx < NL * 8 * DMOD; idx += NGW * 64) { const int l = idx >> 13, h = (idx >> 10) & 7, k = idx & 1023;
        wf[idx] = P.w_in[((size_t)l * DMOD + k) * DIN + 1536 + h] * P.mixg[l * DMOD + k]; }
}
template <int MODE>
__device__ __forceinline__ void phase_rowstats(const float* xin, bf16r* xb, float* rstd_out, const float* wf, const float* bfv, float* logf, const float* gfin, float* outp, int gw, int NGW, int lane) {
    for (int m = gw; m < S_; m += NGW) {
        const f32x4* xr = (const f32x4*)(xin + (size_t)m * DMOD) + lane;
        f32x4 v[4]; float s = 0.f;
#pragma unroll
        for (int j = 0; j < 4; ++j) { v[j] = xr[64 * j]; s += (v[j].x * v[j].x + v[j].y * v[j].y) + (v[j].z * v[j].z + v[j].w * v[j].w); }
        const float rs = 1.0f / sqrtf(wave_sum(s) * (1.0f / DMOD) + EPSN);
        if (MODE == 2) {
            f32x4* orow = (f32x4*)(outp + (size_t)m * DMOD) + lane; const f32x4* gr = (const f32x4*)gfin + lane;
#pragma unroll
            for (int j = 0; j < 4; ++j) orow[64 * j] = v[j] * rs * gr[64 * j];
        } else {
            unsigned long long* o8 = (unsigned long long*)(xb + (size_t)m * DMOD) + lane;
#pragma unroll
            for (int j = 0; j < 4; ++j) o8[64 * j] = (unsigned long long)pk2(v[j].x, v[j].y) | ((unsigned long long)pk2(v[j].z, v[j].w) << 32);
            if (lane == 0) rstd_out[m] = rs;
            if (MODE == 0) {
                float mine = 0.f;
#pragma unroll
                for (int h = 0; h < 8; ++h) { const f32x4* wr = (const f32x4*)(wf + h * DMOD) + lane; float d = 0.f;
#pragma unroll
                    for (int j = 0; j < 4; ++j) { const f32x4 w = wr[64 * j]; d += (v[j].x * w.x + v[j].y * w.y) + (v[j].z * w.z + v[j].w * w.w); }
                    d = wave_sum(d); if (lane == h) mine = d; }
                if (lane < 8) { const float z = mine * rs + bfv[lane]; logf[(size_t)m * 8 + lane] = fminf(z, 0.f) - log1pf(expf(-fabsf(z))); }
            }
        }
    }
}
__device__ __forceinline__ void cumsum_head(const float* logf, float* c2, int h, LAS unsigned char* lds, int tid) {
    LAS double* scr = (LAS double*)lds;
    const int base = tid * 32; double sum = 0.0;
    for (int e = 0; e < 32; ++e) sum += (double)logf[(size_t)(base + e) * 8 + h];
    scr[tid] = sum; __syncthreads();
    double pre = 0.0; for (int i = 0; i < tid; ++i) pre += scr[i];
    for (int e = 0; e < 32; ++e) { pre += (double)logf[(size_t)(base + e) * 8 + h]; c2[(size_t)h * S_ + base + e] = (float)(pre * 1.4426950408889634); }
    __syncthreads();
}
__device__ __forceinline__ void merge_item(int c, const bf16r* ZU, const bf16r* ZV, const bf16r* O, bf16r* MG, const float* lng, const float* lnb, const float* wsl, const float* bsl,
                                           LAS unsigned char* lds, int wid, int lane) {
    LAS float* bsb = (LAS float*)lds;
    LAS bf16r* zt = (LAS bf16r*)(lds + 4096);
    const int r32 = lane & 31, hi = lane >> 5, g = wid, tid = wid * 64 + lane;
    bsb[tid] = bsl[tid]; bsb[tid + 512] = bsl[tid + 512];
    float gl[8], bl[8];
    { const f32x4 g0 = *(const f32x4*)(lng + 8 * lane), g1 = *(const f32x4*)(lng + 8 * lane + 4), b0 = *(const f32x4*)(lnb + 8 * lane), b1 = *(const f32x4*)(lnb + 8 * lane + 4);
      gl[0] = g0.x; gl[1] = g0.y; gl[2] = g0.z; gl[3] = g0.w; gl[4] = g1.x; gl[5] = g1.y; gl[6] = g1.z; gl[7] = g1.w;
      bl[0] = b0.x; bl[1] = b0.y; bl[2] = b0.z; bl[3] = b0.w; bl[4] = b1.x; bl[5] = b1.y; bl[6] = b1.z; bl[7] = b1.w; }
#pragma unroll 2
    for (int rr = 0; rr < 16; ++rr) { const int i = 16 * wid + rr; const size_t row = (size_t)c * 128 + i;
        const v4u zr = *(const v4u*)(ZV + row * 512 + 8 * lane);
        const v4u orr = *(const v4u*)(O + row * 512 + 8 * lane);
        float z[8] = {bflo(zr.x), bfhi(zr.x), bflo(zr.y), bfhi(zr.y), bflo(zr.z), bfhi(zr.z), bflo(zr.w), bfhi(zr.w)};
        float s = 0.f;
#pragma unroll
        for (int e = 0; e < 8; ++e) s += z[e];
        const float mean = wave_sum(s) * (1.0f / 512.0f); float q = 0.f;
#pragma unroll
        for (int e = 0; e < 8; ++e) { z[e] -= mean; q += z[e] * z[e]; }
        const float rstd = 1.0f / sqrtf(wave_sum(q) * (1.0f / 512.0f) + EPSN);
#pragma unroll
        for (int e = 0; e < 8; ++e) z[e] = z[e] * rstd * gl[e] + bl[e];
        v4u zw; zw.x = pk2(z[0], z[1]); zw.y = pk2(z[2], z[3]); zw.z = pk2(z[4], z[5]); zw.w = pk2(z[6], z[7]);
        *(LAS v4u*)(zt + i * 512 + 8 * lane) = zw;
        float a[8] = {bflo(orr.x), bfhi(orr.x), bflo(orr.y), bfhi(orr.y), bflo(orr.z), bfhi(orr.z), bflo(orr.w), bfhi(orr.w)};
        float ss = 0.f;
#pragma unroll
        for (int e = 0; e < 8; ++e) ss += a[e] * a[e];
        const float ra = 1.0f / sqrtf(wave_sum(ss) * (1.0f / 512.0f) + EPSN);
        v4u w; w.x = pk2(a[0] * ra, a[1] * ra); w.y = pk2(a[2] * ra, a[3] * ra); w.z = pk2(a[4] * ra, a[5] * ra); w.w = pk2(a[6] * ra, a[7] * ra);
        *(v4u*)(MG + row * 1024 + 8 * lane) = w;
    }
    LDS_WAIT(); __syncthreads();
#pragma unroll 1
    for (int ni = 0; ni < 2; ++ni) {
        const int d = 64 * g + 32 * ni + r32;
        bf16x8 bfr[8];
#pragma unroll
        for (int ks = 0; ks < 8; ++ks) { const LAS bf16r* zp = zt + (16 * ks + 8 * hi) * 512 + d;
            v4u w; w.x = (unsigned)zp[0] | ((unsigned)zp[512] << 16); w.y = (unsigned)zp[1024] | ((unsigned)zp[1536] << 16); w.z = (unsigned)zp[2048] | ((unsigned)zp[2560] << 16); w.w = (unsigned)zp[3072] | ((unsigned)zp[3584] << 16);
            bfr[ks] = __builtin_bit_cast(bf16x8, w); }
        LDS_WAIT(); asm volatile("" ::: "memory");
        f32x16 acc[4];
#pragma unroll
        for (int mi = 0; mi < 4; ++mi) { acc[mi] = f32x16{};
#pragma unroll
            for (int ks = 0; ks < 8; ++ks) { if (mi < 2 && ks >= 4) continue;
                const float* wp = wsl + ((size_t)g * 128 + 32 * mi + r32) * 128 + 16 * ks + 8 * hi; const f32x4 a0 = *(const f32x4*)wp, a1 = *(const f32x4*)(wp + 4);
                v4u w; w.x = pk2(a0.x, a0.y); w.y = pk2(a0.z, a0.w); w.z = pk2(a1.x, a1.y); w.w = pk2(a1.z, a1.w);
                acc[mi] = __builtin_amdgcn_mfma_f32_32x32x16_bf16(__builtin_bit_cast(bf16x8, w), bfr[ks], acc[mi], 0, 0, 0); }
            asm volatile("" ::: "memory"); }
#pragma unroll
        for (int mi = 0; mi < 4; ++mi)
#pragma unroll
            for (int r = 0; r < 16; ++r) { const int i = 32 * mi + (r & 3) + 8 * (r >> 2) + 4 * hi;
                zt[i * 512 + d] = (bf16r)f2bf(acc[mi][r] + bsb[g * 128 + i]); }
        LDS_WAIT(); asm volatile("" ::: "memory");
    }
    __syncthreads();
#pragma unroll 2
    for (int rr = 0; rr < 16; ++rr) { const int i = 16 * wid + rr; const size_t row = (size_t)c * 128 + i;
        const v4u tr = *(const LAS v4u*)(zt + i * 512 + 8 * lane);
        const v4u ur = *(const v4u*)(ZU + row * 512 + 8 * lane);
        float a[8] = {bflo(tr.x) * bflo(ur.x), bfhi(tr.x) * bfhi(ur.x), bflo(tr.y) * bflo(ur.y), bfhi(tr.y) * bfhi(ur.y), bflo(tr.z) * bflo(ur.z), bfhi(tr.z) * bfhi(ur.z), bflo(tr.w) * bflo(ur.w), bfhi(tr.w) * bfhi(ur.w)};
        float ss = 0.f;
#pragma unroll
        for (int e = 0; e < 8; ++e) ss += a[e] * a[e];
        const float ra = 1.0f / sqrtf(wave_sum(ss) * (1.0f / 512.0f) + EPSN);
        v4u w; w.x = pk2(a[0] * ra, a[1] * ra); w.y = pk2(a[2] * ra, a[3] * ra); w.z = pk2(a[4] * ra, a[5] * ra); w.w = pk2(a[6] * ra, a[7] * ra);
        *(v4u*)(MG + row * 1024 + 512 + 8 * lane) = w;
    }
    LDS_WAIT(); __syncthreads();
}
#ifndef MK_MULTI
#define MK_MULTI 0
#endif
struct Args { const float* in[14]; float* out; unsigned char* ws; int ph_lo, ph_hi; };
__global__ void __launch_bounds__(512, 2) fox_fwd(Args args) {
    extern __shared__ __attribute__((aligned(16))) unsigned char lds[];
    cg::grid_group grid = cg::this_grid();
    LAS unsigned char* L = (LAS unsigned char*)lds;
    const int G = gridDim.x, bx = blockIdx.x;
    const int vcu = (G % 8 == 0) ? (bx % 8) * (G / 8) + bx / 8 : bx;
    const int NGW = G * 8;
#define IDS() int tid = threadIdx.x; asm volatile("" : "+v"(tid)); const int lane = tid & 63, wave = __builtin_amdgcn_readfirstlane(tid >> 6), gw = vcu * 8 + wave; (void)lane; (void)gw
    Ptrs P;
    P.x = args.in[0]; P.mixg = args.in[1]; P.w_in = args.in[2]; P.b_f = args.in[3]; P.lng = args.in[4]; P.lnb = args.in[5]; P.w_s = args.in[6]; P.b_s = args.in[7];
    P.outg = args.in[8]; P.w_out = args.in[9]; P.ffng = args.in[10]; P.w_gu = args.in[11]; P.w_d = args.in[12]; P.fing = args.in[13]; P.out = args.out; P.ws = args.ws;
    unsigned char* ws = args.ws;
    unsigned* ctl = (unsigned*)(ws + WS_CTL);
    float* wf = (float*)(ws + WS_WF);
    bf16r* WinT = (bf16r*)(ws + WS_WIN); bf16r* WoutT = (bf16r*)(ws + WS_WOUT); bf16r* WguT = (bf16r*)(ws + WS_WGU); bf16r* WdT = (bf16r*)(ws + WS_WD);
    bf16r* XB = (bf16r*)(ws + WS_XB); float* RSTD = (float*)(ws + WS_RSTD); float* LOGF = (float*)(ws + WS_LOGF); float* C2A = (float*)(ws + WS_C2);
    bf16r* QKVZ = (bf16r*)(ws + WS_QKVZ); bf16r* OB = (bf16r*)(ws + WS_O); bf16r* MG = (bf16r*)(ws + WS_MG); bf16r* HB = (bf16r*)(ws + WS_H);
    constexpr size_t QS = (size_t)S_ * 512;
    const int lo = args.ph_lo, hi = args.ph_hi;
    int ph = 0;
#define RUN() (ph >= lo && ph < hi)
#define SEAM() do { ++ph; if (ph > lo && ph < hi) grid.sync(); } while (0)

#ifndef NO_P0
    if (RUN()) { IDS(); phase_prep(P, L, gw, NGW, wave, lane); }
#endif
    SEAM();
#ifndef NO_P0
    if (RUN()) { IDS(); phase_rowstats<0>(P.x, XB, RSTD, wf, P.b_f, LOGF, nullptr, nullptr, gw, NGW, lane); }
#endif
    SEAM();
    for (int l = 0; l < NL; ++l) {
#ifndef NO_INPROJ
        if (RUN()) {
            if (bx < NHD) { IDS(); cumsum_head(LOGF, C2A, bx, L, tid); }
            pg8::Gemm g{XB, WinT + (size_t)l * NIN * DMOD, S_, NIN, DMOD}; pg8::StaticOrder So; So.init(S_, NIN, G, bx);
            pg8::EpiInProj E{QKVZ, QS, RSTD};
            pg8::gemm_phase<pg8::EpiInProj, pg8::StaticOrder, true, true>(L, g, So, E);
        }
#endif
        SEAM();
#ifndef NO_ATTN
        if (RUN()) {
            IDS(); LAS unsigned* bc = (LAS unsigned*)(L + 147456 - 64);
            for (int qi = 0; qi < NHD; ++qi) { const int h = (bx + qi) & 7;
                for (;;) {
                    if (tid == 0) bc[0] = atomicAdd(ctl + (l * NHD + h) * 64, 1u);
                    __syncthreads(); const unsigned u = bc[0]; __syncthreads();
                    if (u >= 64u) break;
                    attn_body::fox_unit(h, 63 - (int)u, 0, (const attn_body::bf16*)QKVZ, (const attn_body::bf16*)(QKVZ + QS), (const attn_body::bf16*)(QKVZ + 2 * QS), (attn_body::bf16*)OB, C2A + (size_t)h * S_, (char*)lds);
                } }
        }
#endif
        SEAM();
#ifndef NO_MERGE
        if (RUN()) {
            IDS(); for (int c = vcu; c < S_ / 128; c += G)
                merge_item(c, QKVZ + 3 * QS, QKVZ + 4 * QS, OB, MG, P.lng + l * 512, P.lnb + l * 512, P.w_s + (size_t)l * 8 * 128 * 128, P.b_s + l * 8 * 128, L, wave, lane);
        }
#endif
        SEAM();
#ifndef NO_OUTPROJ
        if (RUN()) {
            pg8::Gemm g{MG, WoutT + (size_t)l * DMOD * DMOD, S_, DMOD, DMOD}; pg8::StaticOrder So; So.init(S_, DMOD, G, bx);
            pg8::EpiResid E{l == 0 ? P.x : P.out, P.out};
            pg8::gemm_phase<pg8::EpiResid, pg8::StaticOrder, true, true>(L, g, So, E);
        }
#endif
        SEAM();
#ifndef NO_RS1
        if (RUN()) { IDS(); phase_rowstats<1>(P.out, XB, RSTD, nullptr, nullptr, nullptr, nullptr, nullptr, gw, NGW, lane); }
#endif
        SEAM();
#ifndef NO_GU
        if (RUN()) {
            pg8::Gemm g{XB, WguT + (size_t)l * NGU * DMOD, S_, NGU, DMOD}; pg8::StaticOrder So; So.init(S_, NGU, G, bx);
            pg8::EpiSwiGLU E{HB, RSTD};
            pg8::gemm_phase<pg8::EpiSwiGLU, pg8::StaticOrder, true, true>(L, g, So, E);
        }
#endif
        SEAM();
#ifndef NO_DOWN
        if (RUN()) {
            pg8::Gemm g{HB, WdT + (size_t)l * DMOD * DFF, S_, DMOD, DFF}; pg8::StaticOrder So; So.init(S_, DMOD, G, bx);
            pg8::EpiResid E{P.out, P.out};
            pg8::gemm_phase<pg8::EpiResid, pg8::StaticOrder, true, true>(L, g, So, E);
        }
#endif
        SEAM();
#ifndef NO_RSN
        if (RUN()) { IDS();
            if (l + 1 < NL) phase_rowstats<0>(P.out, XB, RSTD, wf + (size_t)(l + 1) * 8 * DMOD, P.b_f + (l + 1) * 8, LOGF, nullptr, nullptr, gw, NGW, lane);
            else phase_rowstats<2>(P.out, nullptr, nullptr, nullptr, nullptr, nullptr, P.fing, P.out, gw, NGW, lane);
        }
#endif
        SEAM();
    }
#undef RUN
#undef SEAM
}

extern "C" void kernel_launch(void* const* d_in, const int* in_sizes, int n_in, void* d_out, int out_size, void* d_ws, size_t ws_size, hipStream_t stream) {
    static int grid = 0;
    if (grid == 0) {
        if (n_in != 14 || out_size != S_ * DMOD || ws_size < WS_END) { fprintf(stderr, "kernel_launch: unexpected shapes (n_in %d out %d ws %zu)\n", n_in, out_size, ws_size); grid = -1; return; }
        int dev = 0, cus = 0, per_cu = 0;
        hipGetDevice(&dev); hipDeviceGetAttribute(&cus, hipDeviceAttributeMultiprocessorCount, dev);
        if (hipFuncSetAttribute((const void*)fox_fwd, hipFuncAttributeMaxDynamicSharedMemorySize, LDS_BYTES) != hipSuccess) { fprintf(stderr, "kernel_launch: hipFuncSetAttribute failed\n"); grid = -1; return; }
        if (hipOccupancyMaxActiveBlocksPerMultiprocessor(&per_cu, (const void*)fox_fwd, 512, LDS_BYTES) != hipSuccess || per_cu < 1) { fprintf(stderr, "kernel_launch: occupancy query says %d\n", per_cu); per_cu = 1; }
        (void)hipGetLastError();
        grid = cus * per_cu;
        fprintf(stderr, "kernel_launch: grid %d (cus %d x %d)\n", grid, cus, per_cu);
    }
    if (grid < 0) return;
    hipMemsetAsync((char*)d_ws + WS_CTL, 0, CTL_BYTES, stream);
    Args a{};
    for (int i = 0; i < 14; ++i) a.in[i] = (const float*)d_in[i];
    a.out = (float*)d_out; a.ws = (unsigned char*)d_ws;
#if MK_MULTI
    for (int p = 0; p < NPHASE; ++p) { a.ph_lo = p; a.ph_hi = p + 1; hipLaunchKernelGGL(fox_fwd, dim3(grid), dim3(512), LDS_BYTES, stream, a); }
#else
    a.ph_lo = 0; a.ph_hi = NPHASE;
    void* kargs[] = {&a};
    hipError_t e = hipLaunchCooperativeKernel((const void*)fox_fwd, dim3(grid), dim3(512), kargs, LDS_BYTES, stream);
    if (e != hipSuccess) fprintf(stderr, "kernel_launch: cooperative launch failed: %s (grid %d)\n", hipGetErrorString(e), grid);
#endif
}
```

```cpp
#define MK_MULTI 0
#include <hip/hip_runtime.h>
#include <hip/hip_cooperative_groups.h>
#include <cstdio>
#include <cstdint>
namespace pg8 {
#define PG8_LAS __attribute__((address_space(3)))
typedef unsigned short bf16_t;
typedef short bf16x8 __attribute__((ext_vector_type(8)));
typedef float f32x4 __attribute__((ext_vector_type(4)));
typedef unsigned u32x4 __attribute__((ext_vector_type(4)));
constexpr int BM = 256, BK = 64, HALF = 128, HTB = HALF * BK * 2  , STAGE_BYTES = 8 * HTB, NXCD = 8, WGM = 8;

__host__ __device__ __forceinline__ int lds_byte(int r, int c) { const int st = (r >> 4) * 2 + (c >> 5), rr = r & 15, cc = c & 31, ob = rr * 64 + cc * 2; return st * 1024 + (ob ^ (((ob >> 9) & 1) << 5)); }
__host__ __device__ __forceinline__ void stage_rc(int b, int& R, int& C) { const int st = b / 1024, sb = b % 1024, swz = sb ^ (((sb >> 9) & 1) << 5); R = (st >> 1) * 16 + swz / 64; C = (st & 1) * 32 + (swz % 64) / 2; }
__host__ __device__ __forceinline__ int perm32(int rho) { const int n = rho >> 4, i = rho & 15; return 8 * (i >> 2) + 4 * n + (i & 3); }

struct Unit { int pm, pn; };
struct Gemm { const bf16_t* A; const bf16_t* Bt; int M, N, K; };

struct StaticOrder {
    int nM, nN, nwg, G, c;
    __host__ __device__ void init(int M, int N, int G_, int c_) { nM = M / BM; nN = N / BM; nwg = nM * nN; G = G_; c = c_; }
    __host__ __device__ bool next(int i, Unit& u) const {
        const long L = (long)i * G + c; if (L >= nwg) return false;
        int wgid = (int)L; { const int q = nwg / NXCD, r = nwg % NXCD, xcd = wgid % NXCD, off = wgid / NXCD; wgid = (xcd < r ? xcd * (q + 1) : r * (q + 1) + (xcd - r) * q) + off; }
        const int nig = WGM * nN, gid = wgid / nig, fm = gid * WGM, gsz = (nM - fm) < WGM ? (nM - fm) : WGM;
        u.pm = fm + ((wgid % nig) % gsz); u.pn = (wgid % nig) / gsz; return true;
    }
    __device__ __forceinline__ void a_ready(const Unit&) const {}
    __device__ __forceinline__ void done(const Unit&) const {}
};

__device__ __forceinline__ unsigned cvt_pk_bf16(float lo, float hi) { unsigned r; asm volatile("v_cvt_pk_bf16_f32 %0, %1, %2" : "=v"(r) : "v"(lo), "v"(hi)); return r; }
typedef float f32x2 __attribute__((ext_vector_type(2)));
__device__ __forceinline__ f32x2 gelu_pk(f32x2 v) {
    const f32x2 av = __builtin_elementwise_abs(v), d = av * 0.2316418882f + 1.0f;
    f32x2 t; t.x = __builtin_amdgcn_rcpf(d.x); t.y = __builtin_amdgcn_rcpf(d.y);
    f32x2 q = t * 0.5307027145f + (-0.7265760135f); q = q * t + 0.7107068705f; q = q * t + (-0.142248368f); q = q * t + 0.127414796f; q = q * t;
    const f32x2 s = (v * v) * (-0.72134752044f);
    f32x2 e; e.x = __builtin_amdgcn_exp2f(s.x); e.y = __builtin_amdgcn_exp2f(s.y);
    const f32x2 m = v * (q * e), r = v - m;
    f32x2 o; o.x = v.x < 0.f ? m.x : r.x; o.y = v.y < 0.f ? m.y : r.y; return o;
}
constexpr float C2Q = 0.125f * 1.4426950408889634f;
struct EpiInProj {
    static constexpr bool PERM = true, AFTER_DRAIN = false;
    bf16_t* O; size_t split_stride; const float* rstd;
    __device__ __forceinline__ void operator()(const f32x4 (&acc)[2][2][4][2], const Unit& u, int wr, int wc, int fr, int fq) const {
        const int t = u.pn >> 1; bf16_t* base = O + (size_t)t * split_stride;
        const int row0 = u.pm * BM + wr * 64 + fr, col0 = (u.pn & 1) * 256 + wc * 32 + 8 * fq;
        const float s0 = (t == 0) ? C2Q : 1.0f;
#pragma unroll
        for (int ai = 0; ai < 2; ++ai)
#pragma unroll
            for (int m = 0; m < 4; ++m) { const int row = row0 + ai * HALF + m * 16; const float rs = rstd[row] * s0; bf16_t* rowp = base + (size_t)row * 512 + col0;
#pragma unroll
                for (int bj = 0; bj < 2; ++bj) { f32x4 v0 = acc[ai][bj][m][0] * rs, v1 = acc[ai][bj][m][1] * rs;
                    if (t >= 3) { f32x2 a = gelu_pk((f32x2){v0[0], v0[1]}), b = gelu_pk((f32x2){v0[2], v0[3]}), c = gelu_pk((f32x2){v1[0], v1[1]}), d = gelu_pk((f32x2){v1[2], v1[3]});
                        v0 = (f32x4){a.x, a.y, b.x, b.y}; v1 = (f32x4){c.x, c.y, d.x, d.y}; }
                    u32x4 w; w.x = cvt_pk_bf16(v0[0], v0[1]); w.y = cvt_pk_bf16(v0[2], v0[3]); w.z = cvt_pk_bf16(v1[0], v1[1]); w.w = cvt_pk_bf16(v1[2], v1[3]);
                    *(u32x4*)(rowp + bj * HALF) = w; } }
    }
};
struct EpiResid {
    static constexpr bool PERM = false, AFTER_DRAIN = false;
    const float* base; float* out;
    __device__ __forceinline__ void operator()(const f32x4 (&acc)[2][2][4][2], const Unit& u, int wr, int wc, int fr, int fq) const {
        const int col0 = u.pn * BM + wc * 32 + 4 * fq;
#pragma unroll
        for (int ai = 0; ai < 2; ++ai)
#pragma unroll
            for (int m = 0; m < 4; ++m) { const size_t off = (size_t)(u.pm * BM + ai * HALF + wr * 64 + m * 16 + fr) * 1024 + col0;
#pragma unroll
                for (int bj = 0; bj < 2; ++bj)
#pragma unroll
                    for (int n = 0; n < 2; ++n) { const f32x4 b = *(const f32x4*)(base + off + bj * HALF + n * 16); *(f32x4*)(out + off + bj * HALF + n * 16) = b + acc[ai][bj][m][n]; } }
    }
};
struct EpiSwiGLU {
    static constexpr bool PERM = true, AFTER_DRAIN = false;
    bf16_t* H; const float* rstd;
    __device__ __forceinline__ void operator()(const f32x4 (&acc)[2][2][4][2], const Unit& u, int wr, int wc, int fr, int fq) const {
        const int row0 = u.pm * BM + wr * 64 + fr, col0 = u.pn * 128 + wc * 32 + 8 * fq;
#pragma unroll
        for (int ai = 0; ai < 2; ++ai)
#pragma unroll
            for (int m = 0; m < 4; ++m) { const int row = row0 + ai * HALF + m * 16; const float rs = rstd[row];
                float hv[8];
#pragma unroll
                for (int n = 0; n < 2; ++n)
#pragma unroll
                    for (int e = 0; e < 4; ++e) { const float g = acc[ai][0][m][n][e] * rs, up = acc[ai][1][m][n][e] * rs;
                        const float sg = __builtin_amdgcn_rcpf(1.0f + __builtin_amdgcn_exp2f(-1.4426950408889634f * g)); hv[n * 4 + e] = g * sg * up; }
                u32x4 w; w.x = cvt_pk_bf16(hv[0], hv[1]); w.y = cvt_pk_bf16(hv[2], hv[3]); w.z = cvt_pk_bf16(hv[4], hv[5]); w.w = cvt_pk_bf16(hv[6], hv[7]);
                *(u32x4*)(H + (size_t)row * 2816 + col0) = w; }
    }
};
template <class Epi, class Sched, bool ALIGN_EPI = false, bool SP2 = false>
__device__ __forceinline__ void gemm_phase(PG8_LAS unsigned char* lds, const Gemm g, const Sched& S, const Epi& E) {
    int tid = threadIdx.x; asm volatile("" : "+v"(tid));
    const int wid = __builtin_amdgcn_readfirstlane(tid >> 6), lane = tid & 63, wr = wid >> 2, wc = wid & 3, fr = lane & 15, fq = lane >> 4;
    const int K = g.K, nt = K / BK;
    unsigned voffA[2], voffB[2];
#pragma unroll
    for (int i = 0; i < 2; ++i) { int R, C; stage_rc(tid * 16 + i * 8192, R, C); const int Rb = Epi::PERM ? ((R & ~31) + perm32(R & 31)) : R;
        voffA[i] = (unsigned)(R * K + C) * 2u; voffB[i] = (unsigned)(Rb * K + C) * 2u; }
    const size_t kstep = (size_t)(BK * 2);
    const size_t hstep = (size_t)HALF * K * 2;
    const size_t tstep = 2 * hstep;
    const unsigned ldsw = (unsigned)wid * 1024u;
    const int aoff = lds_byte(wr * 64 + fr, fq * 8), boff = lds_byte(wc * 32 + fr, fq * 8);
#define PG8_SA(b, h) (((b) * 2 + (h)) * HTB)
#define PG8_SB(b, h) ((4 + (b) * 2 + (h)) * HTB)
#define PG8_STAGE(bufoff, gbase, voff) do { _Pragma("unroll") for (int _i = 0; _i < 2; ++_i) \
        __builtin_amdgcn_global_load_lds((const unsigned*)((const char*)(gbase) + (voff)[_i]), (PG8_LAS unsigned*)(lds + (bufoff) + ldsw + _i * 8192), 16, 0, 0); } while (0)
#define PG8_LDA(dst, b, h) do { _Pragma("unroll") for (int m = 0; m < 4; ++m) _Pragma("unroll") for (int k = 0; k < 2; ++k) dst[m][k] = *(const PG8_LAS bf16x8*)(lds + PG8_SA(b, h) + aoff + m * 2048 + k * 1024); } while (0)
#define PG8_LDB(dst, b, h) do { _Pragma("unroll") for (int n = 0; n < 2; ++n) _Pragma("unroll") for (int k = 0; k < 2; ++k) dst[n][k] = *(const PG8_LAS bf16x8*)(lds + PG8_SB(b, h) + boff + n * 2048 + k * 1024); } while (0)
#define PG8_MMA(ai, bj, At, Bt) do { __builtin_amdgcn_s_setprio(1); _Pragma("unroll") for (int m = 0; m < 4; ++m) _Pragma("unroll") for (int n = 0; n < 2; ++n) _Pragma("unroll") for (int k = 0; k < 2; ++k) \
        acc[ai][bj][m][n] = __builtin_amdgcn_mfma_f32_16x16x32_bf16(Bt[n][k], At[m][k], acc[ai][bj][m][n], 0, 0, 0); __builtin_amdgcn_s_setprio(0); } while (0)
#define PG8_WAIT_V(n) asm volatile("s_waitcnt vmcnt(" #n ")" ::: "memory")
#define PG8_WAIT_L(n) asm volatile("s_waitcnt lgkmcnt(" #n ")" ::: "memory")
#define PG8_BAR __builtin_amdgcn_s_barrier()
#define PG8_SCHED __builtin_amdgcn_sched_barrier(0)
    Unit cur, nxt; int ui = 0;
    if (!S.next(0, cur)) return;
    f32x4 acc[2][2][4][2];
#pragma unroll
    for (int a = 0; a < 2; ++a)
#pragma unroll
        for (int b = 0; b < 2; ++b)
#pragma unroll
            for (int m = 0; m < 4; ++m)
#pragma unroll
                for (int n = 0; n < 2; ++n) acc[a][b][m][n] = (f32x4){0.f, 0.f, 0.f, 0.f};
    bf16x8 At[4][2], B0[2][2], B1[2][2];
    const char* cA = (const char*)g.A + (size_t)cur.pm * tstep; const char* cB = (const char*)g.Bt + (size_t)cur.pn * tstep;
    S.a_ready(cur);
    if constexpr (SP2) {
        PG8_STAGE(PG8_SB(0, 0), cB, voffB); PG8_STAGE(PG8_SB(0, 1), cB + hstep, voffB); PG8_STAGE(PG8_SA(0, 0), cA, voffA); PG8_STAGE(PG8_SA(0, 1), cA + hstep, voffA);
        if (wr == 1) PG8_BAR;
        PG8_WAIT_V(2); PG8_BAR;
        PG8_STAGE(PG8_SB(1, 0), cB + kstep, voffB); PG8_STAGE(PG8_SA(1, 0), cA + kstep, voffA); PG8_STAGE(PG8_SB(1, 1), cB + hstep + kstep, voffB);
        PG8_WAIT_V(6); PG8_BAR;
    } else {
        PG8_STAGE(PG8_SB(0, 0), cB, voffB); PG8_STAGE(PG8_SA(0, 0), cA, voffA); PG8_STAGE(PG8_SB(0, 1), cB + hstep, voffB); PG8_STAGE(PG8_SA(0, 1), cA + hstep, voffA);
        if (wr == 1) PG8_BAR;
        PG8_WAIT_V(4); PG8_BAR;
        PG8_STAGE(PG8_SB(1, 0), cB + kstep, voffB); PG8_STAGE(PG8_SA(1, 0), cA + kstep, voffA); PG8_STAGE(PG8_SB(1, 1), cB + hstep + kstep, voffB);
        PG8_WAIT_V(6); PG8_BAR;
    }
    for (;;) {
        const bool has_next = S.next(ui + 1, nxt);
        const char* nA = has_next ? (const char*)g.A + (size_t)nxt.pm * tstep : cA; const char* nB = has_next ? (const char*)g.Bt + (size_t)nxt.pn * tstep : cB;
        for (int t = 0; t < nt; t += 2) {
            const bool last = (t == nt - 2);
            const char* a1 = cA + (size_t)(t + 1) * kstep;
            const char* a2 = last ? nA : cA + (size_t)(t + 2) * kstep; const char* b2 = last ? nB : cB + (size_t)(t + 2) * kstep;
            const char* a3 = a2 + kstep; const char* b3 = b2 + kstep;
            if (last && has_next) S.a_ready(nxt);
            if constexpr (SP2) {
            PG8_LDB(B0, 0, 0); PG8_LDB(B1, 0, 1); PG8_SCHED; PG8_LDA(At, 0, 0); PG8_STAGE(PG8_SA(1, 1), a1 + hstep, voffA);
            PG8_WAIT_V(8); PG8_WAIT_L(0); PG8_BAR; PG8_MMA(0, 0, At, B0); PG8_MMA(0, 1, At, B1); PG8_BAR; PG8_SCHED;
            PG8_LDA(At, 0, 1); PG8_STAGE(PG8_SB(0, 0), b2, voffB); PG8_STAGE(PG8_SB(0, 1), b2 + hstep, voffB); PG8_STAGE(PG8_SA(0, 0), a2, voffA);
            PG8_WAIT_V(8); PG8_WAIT_L(0); PG8_BAR; PG8_MMA(1, 0, At, B0); PG8_MMA(1, 1, At, B1); PG8_BAR; PG8_SCHED;
            PG8_LDB(B0, 1, 0); PG8_LDB(B1, 1, 1); PG8_SCHED; PG8_LDA(At, 1, 0); PG8_STAGE(PG8_SA(0, 1), a2 + hstep, voffA);
            PG8_WAIT_V(8); PG8_WAIT_L(0); PG8_BAR; PG8_MMA(0, 0, At, B0); PG8_MMA(0, 1, At, B1); PG8_BAR; PG8_SCHED;
            PG8_LDA(At, 1, 1); PG8_STAGE(PG8_SB(1, 0), b3, voffB); PG8_STAGE(PG8_SB(1, 1), b3 + hstep, voffB); PG8_STAGE(PG8_SA(1, 0), a3, voffA);
            PG8_WAIT_V(8); PG8_WAIT_L(0); PG8_BAR; PG8_MMA(1, 0, At, B0); PG8_MMA(1, 1, At, B1); PG8_BAR; PG8_SCHED;
            } else {
            PG8_LDB(B0, 0, 0); PG8_SCHED; PG8_LDA(At, 0, 0); PG8_STAGE(PG8_SA(1, 1), a1 + hstep, voffA);
            PG8_WAIT_L(8); PG8_BAR; PG8_WAIT_L(0); PG8_MMA(0, 0, At, B0); PG8_BAR; PG8_SCHED;
            PG8_LDB(B1, 0, 1); PG8_STAGE(PG8_SB(0, 0), b2, voffB);
            PG8_BAR; PG8_WAIT_L(0); PG8_MMA(0, 1, At, B1); PG8_BAR;
            PG8_LDA(At, 0, 1); PG8_STAGE(PG8_SA(0, 0), a2, voffA);
            PG8_BAR; PG8_WAIT_L(0); PG8_MMA(1, 0, At, B0); PG8_BAR; PG8_SCHED;
            PG8_STAGE(PG8_SB(0, 1), b2 + hstep, voffB);
            PG8_WAIT_V(6); PG8_BAR; PG8_MMA(1, 1, At, B1); PG8_BAR;
            PG8_LDB(B0, 1, 0); PG8_SCHED; PG8_LDA(At, 1, 0); PG8_STAGE(PG8_SA(0, 1), a2 + hstep, voffA);
            PG8_WAIT_L(8); PG8_BAR; PG8_WAIT_L(0); PG8_MMA(0, 0, At, B0); PG8_BAR; PG8_SCHED;
            PG8_LDB(B1, 1, 1); PG8_STAGE(PG8_SB(1, 0), b3, voffB);
            PG8_BAR; PG8_WAIT_L(0); PG8_MMA(0, 1, At, B1); PG8_BAR;
            PG8_LDA(At, 1, 1); PG8_STAGE(PG8_SA(1, 0), a3, voffA);
            PG8_BAR; PG8_WAIT_L(0); PG8_MMA(1, 0, At, B0); PG8_BAR; PG8_SCHED;
            PG8_STAGE(PG8_SB(1, 1), b3 + hstep, voffB);
            PG8_WAIT_V(6); PG8_BAR; PG8_MMA(1, 1, At, B1); PG8_BAR;
            }
        }
        if constexpr (ALIGN_EPI) { if (wr == 0) PG8_BAR; }
        if constexpr (!Epi::AFTER_DRAIN) { E(acc, cur, wr, wc, fr, fq); S.done(cur); }
        if (!has_next) break;
#pragma unroll
        for (int a = 0; a < 2; ++a)
#pragma unroll
            for (int b = 0; b < 2; ++b)
#pragma unroll
                for (int m = 0; m < 4; ++m)
#pragma unroll
                    for (int n = 0; n < 2; ++n) acc[a][b][m][n] = (f32x4){0.f, 0.f, 0.f, 0.f};
        cur = nxt; cA = nA; cB = nB; ++ui;
        if constexpr (ALIGN_EPI) { if (wr == 1) PG8_BAR; }
    }
    PG8_WAIT_V(0);
    if constexpr (!ALIGN_EPI) { if (wr == 0) PG8_BAR; }
    PG8_BAR;
    if constexpr (Epi::AFTER_DRAIN) { E.fused(acc, cur, wr, wc, fr, fq, lds, wid, lane); S.done(cur); }
#undef PG8_SA
#undef PG8_SB
#undef PG8_STAGE
#undef PG8_LDA
#undef PG8_LDB
#undef PG8_MMA
#undef PG8_WAIT_V
#undef PG8_WAIT_L
#undef PG8_BAR
#undef PG8_SCHED
}
}
#include <hip/hip_bf16.h>
#include <cmath>
namespace attn_body {
using bf16=__hip_bfloat16;
using bf16x8=__attribute__((ext_vector_type(8)))short;
using s16x4=__attribute__((ext_vector_type(4)))short;
using f32x16=__attribute__((ext_vector_type(16)))float;
using u32x4=__attribute__((ext_vector_type(4)))unsigned;
constexpr int BATCH=1,NHEAD=8,SEQ=16384,D=64,DM=NHEAD*D;
constexpr int NW=8,QBLK=32,QB=QBLK*NW,KVBLK=64,NQB=SEQ/QB;
constexpr int ATTN_PITCH=DM, ATTN_UNIT_ROWS=QB;
__device__ __forceinline__ int crow(int r,int hi){return (r&3)+8*(r>>2)+4*hi;}
#define SBAR() __builtin_amdgcn_sched_barrier(0)
__device__ __forceinline__ void cmask(f32x16&p0,f32x16&p1,int jb,int qrel,int hi){
  const float NEG=-INFINITY; int kb=64*jb+4*hi;
  #pragma unroll
  for(int r=0;r<16;++r){int kv=kb+(r&3)+8*(r>>2); if(kv>qrel)p0[r]=NEG; if(kv+32>qrel)p1[r]=NEG;}
}

constexpr int NSLOT=3, SLOTB=8192;
constexpr int LDS_K=0, LDS_V=NSLOT*SLOTB, LDS_WS=2*NSLOT*SLOTB, LDS_OST=LDS_WS+NW*64*4, LDS_BYTES=LDS_OST+NW*4096;
constexpr float C2=0.125f*1.4426950408889634f;
__device__ __forceinline__ void glds16(const void*gsrc,unsigned lds_dst){unsigned keep;
  asm volatile("s_mov_b32 %0, m0\n\ts_mov_b32 m0, %2\n\ts_nop 0\n\tglobal_load_lds_dwordx4 %1, off\n\ts_mov_b32 m0, %0":"=&s"(keep):"v"(gsrc),"s"(lds_dst):"memory");}
__device__ __forceinline__ float max3f(float a,float b,float c){float r;asm("v_max3_f32 %0, %1, %2, %3":"=v"(r):"v"(a),"v"(b),"v"(c));return r;}
__device__ __forceinline__ float max2f(float a,float b){float r;asm("v_max_f32_e32 %0, %1, %2":"=v"(r):"v"(a),"v"(b));return r;}
__device__ __forceinline__ float fadd_s(float a,float b){float r;asm("v_add_f32_e32 %0, %1, %2":"=v"(r):"v"(a),"v"(b));return r;}
__device__ __forceinline__ float fsub_s(float a,float b){float r;asm("v_sub_f32_e32 %0, %1, %2":"=v"(r):"v"(a),"v"(b));return r;}
typedef float f32x2_t __attribute__((ext_vector_type(2))); typedef __bf16 bf16x2_t __attribute__((ext_vector_type(2)));
__device__ __forceinline__ unsigned cvtpk_s(float lo,float hi){f32x2_t v={lo,hi};bf16x2_t b=__builtin_convertvector(v,bf16x2_t);return __builtin_bit_cast(unsigned,b);}
#define WAIT_BAR(N) asm volatile("s_waitcnt vmcnt(" #N ") lgkmcnt(0)\n\ts_barrier":::"memory")

__device__ __forceinline__ void qkt(f32x16&p0,f32x16&p1,const char*Kslot,const bf16x8*qr,const f32x16&negm,int r32,int hi){
  const char*kb=Kslot+hi*1024+r32*16;
  #pragma unroll
  for(int d0=0;d0<4;++d0){
    const bf16x8 b0=*reinterpret_cast<const bf16x8*>(kb+d0*2048);
    const bf16x8 b1=*reinterpret_cast<const bf16x8*>(kb+d0*2048+512);
    if(d0==0){p0=__builtin_amdgcn_mfma_f32_32x32x16_bf16(b0,qr[0],negm,0,0,0);p1=__builtin_amdgcn_mfma_f32_32x32x16_bf16(b1,qr[0],negm,0,0,0);}
    else{p0=__builtin_amdgcn_mfma_f32_32x32x16_bf16(b0,qr[d0],p0,0,0,0);p1=__builtin_amdgcn_mfma_f32_32x32x16_bf16(b1,qr[d0],p1,0,0,0);}}
}
typedef __attribute__((address_space(3))) const char* lds_cptr;
typedef short v4i16_t __attribute__((ext_vector_type(4)));
__device__ __forceinline__ void kload8(bf16x8*kf,lds_cptr kp){
  kf[0]=*(const __attribute__((address_space(3))) bf16x8*)(kp);      kf[1]=*(const __attribute__((address_space(3))) bf16x8*)(kp+512);
  kf[2]=*(const __attribute__((address_space(3))) bf16x8*)(kp+2048); kf[3]=*(const __attribute__((address_space(3))) bf16x8*)(kp+2560);
  kf[4]=*(const __attribute__((address_space(3))) bf16x8*)(kp+4096); kf[5]=*(const __attribute__((address_space(3))) bf16x8*)(kp+4608);
  kf[6]=*(const __attribute__((address_space(3))) bf16x8*)(kp+6144); kf[7]=*(const __attribute__((address_space(3))) bf16x8*)(kp+6656);
}
__device__ __forceinline__ void kload2(bf16x8*kf,lds_cptr kp,int j){ kf[2*j]=*(const __attribute__((address_space(3))) bf16x8*)(kp+j*2048); kf[2*j+1]=*(const __attribute__((address_space(3))) bf16x8*)(kp+j*2048+512); }
__device__ __forceinline__ s16x4 vtr(lds_cptr p){ return __builtin_bit_cast(s16x4,__builtin_amdgcn_ds_read_tr16_b64_v4i16((__attribute__((address_space(3))) v4i16_t*)p)); }
__device__ __forceinline__ float rowmax(const f32x16&p0,const f32x16&p1){
  float a=max3f(p0[0],p0[1],p1[0]),b=max3f(p0[2],p0[3],p1[1]);a=max3f(a,p1[2],p1[3]);
  #pragma unroll
  for(int r=4;r<16;r+=4){a=max3f(a,p0[r],p0[r+1]);b=max3f(b,p0[r+2],p0[r+3]);a=max3f(a,p1[r],p1[r+1]);b=max3f(b,p1[r+2],p1[r+3]);}
  const float m=max2f(a,b);
  auto rr=__builtin_amdgcn_permlane32_swap(__float_as_uint(m),__float_as_uint(m),false,false);
  return max2f(__uint_as_float(rr[0]),__uint_as_float(rr[1]));
}
__device__ __forceinline__ void pv(f32x16*o,int vb,bf16x8 pa0,bf16x8 pa1,bf16x8 pa2,bf16x8 pa3){
  #pragma unroll
  for(int d0=0;d0<2;++d0){s16x4 lo[4],hi[4];
    #pragma unroll
    for(int ks=0;ks<4;++ks){
      asm volatile("ds_read_b64_tr_b16 %0,%1 offset:%c2":"=&v"(lo[ks]):"v"(vb),"i"(d0*4096+ks*1024):"memory");
      asm volatile("ds_read_b64_tr_b16 %0,%1 offset:%c2":"=&v"(hi[ks]):"v"(vb),"i"(d0*4096+ks*1024+512):"memory");}
    asm volatile("s_waitcnt lgkmcnt(0)":::"memory");SBAR();
    #define PK(k) (bf16x8){lo[k][0],lo[k][1],lo[k][2],lo[k][3],hi[k][0],hi[k][1],hi[k][2],hi[k][3]}
    o[d0]=__builtin_amdgcn_mfma_f32_32x32x16_bf16(pa0,PK(0),o[d0],0,0,0);
    o[d0]=__builtin_amdgcn_mfma_f32_32x32x16_bf16(pa1,PK(1),o[d0],0,0,0);
    o[d0]=__builtin_amdgcn_mfma_f32_32x32x16_bf16(pa2,PK(2),o[d0],0,0,0);
    o[d0]=__builtin_amdgcn_mfma_f32_32x32x16_bf16(pa3,PK(3),o[d0],0,0,0);
    #undef PK
  }
}
typedef float f32x4_t __attribute__((ext_vector_type(4)));
constexpr int FLDS_WS=2*NSLOT*SLOTB, FLDS_CK=FLDS_WS+2048, FOX_LDS_BYTES=FLDS_CK+65536;
__device__ __forceinline__ void fox_unit(int h,int qb,int ts,const bf16*Q,const bf16*__restrict__ K,const bf16*__restrict__ V,bf16*O,const float*__restrict__ c2h,char*shm){
  int tid=threadIdx.x; asm volatile("":"+v"(tid)); const int lane=tid&63,r32=lane&31,hi=lane>>5; const int wid=__builtin_amdgcn_readfirstlane(tid>>6);
  const int q0=qb*QB;
  const bf16*Qw=Q+(long)(q0+wid*QBLK)*DM+h*D;
  const bf16*Kh=K+h*D,*Vh=V+h*D;
  const unsigned lds0=(unsigned)(uintptr_t)shm;
  float*wsf=(float*)(shm+FLDS_WS)+wid*64;
  float*ckl=(float*)(shm+FLDS_CK);
  const bf16*ksrc=Kh+(long)lane*DM+wid*8;
  const bf16*vsrc=Vh+(long)(16*(wid&3)+(lane>>2))*DM+(wid>>2)*32+(lane&3)*8;
  const unsigned kdst=lds0+LDS_K+wid*1024, vdst=lds0+LDS_V+wid*1024;
  #define DMA_K(t,slot) glds16(ksrc+(long)(t)*KVBLK*DM,(unsigned)__builtin_amdgcn_readfirstlane(kdst+(slot)))
  #define DMA_V(t,slot) glds16(vsrc+(long)(t)*KVBLK*DM,(unsigned)__builtin_amdgcn_readfirstlane(vdst+(slot)))
  const int vb0=(int)(lds0+LDS_V)+((lane>>4)&1)*32+(lane&3)*8+(4*hi+((lane&15)>>2))*64;
  const int NT=(q0+QB)/KVBLK;
  { const float cref=c2h[q0]; const int nck=(NT-ts)*64;
    for(int i=tid*4;i<nck;i+=2048){ f32x4_t v=*(const f32x4_t*)(c2h+ts*64+i); v=v-cref; *(f32x4_t*)(ckl+i)=v; } }
  asm volatile("s_waitcnt vmcnt(0)":::"memory");
  DMA_K(ts,0);DMA_V(ts,0);DMA_K(ts+1,SLOTB);DMA_V(ts+1,SLOTB);
  bf16x8 qr[4];
  #pragma unroll
  for(int d0=0;d0<4;++d0)qr[d0]=*reinterpret_cast<const bf16x8*>(&Qw[(long)r32*DM+d0*16+hi*8]);
  float mhat=-1.0e30f,l_reg=0.f;f32x16 o[2];o[0]=f32x16{};o[1]=f32x16{};
  const f32x16 zero16=f32x16{};
  const int qrel=wid*QBLK+r32;
  int slot=0;
  for(int t=ts;t<NT;++t){
    if(t+1<NT){WAIT_BAR(2);}else{WAIT_BAR(0);}
    if(t+2<NT){ const int s2=(slot>=SLOTB)?slot-SLOTB:slot+2*SLOTB; DMA_K(t+2,s2);DMA_V(t+2,s2); }
    f32x16 p0,p1;
    qkt(p0,p1,shm+LDS_K+slot,qr,zero16,r32,hi);
    { const float*cb=ckl+(t-ts)*64+4*hi;
      #pragma unroll
      for(int g=0;g<4;++g){ const f32x4_t a=*(const f32x4_t*)(cb+8*g), b=*(const f32x4_t*)(cb+32+8*g);
        #pragma unroll
        for(int e=0;e<4;++e){p0[4*g+e]-=a[e];p1[4*g+e]-=b[e];} } }
    { const int jb=t-(NT-4); if(jb>=0)cmask(p0,p1,jb,qrel,hi); }
    float rm;
    { float a=__builtin_fmaxf(__builtin_fmaxf(p0[0],p0[1]),p1[0]),b=__builtin_fmaxf(__builtin_fmaxf(p0[2],p0[3]),p1[1]); a=__builtin_fmaxf(__builtin_fmaxf(a,p1[2]),p1[3]);
      #pragma unroll
      for(int r=4;r<16;r+=4){a=__builtin_fmaxf(__builtin_fmaxf(a,p0[r]),p0[r+1]);b=__builtin_fmaxf(__builtin_fmaxf(b,p0[r+2]),p0[r+3]);a=__builtin_fmaxf(__builtin_fmaxf(a,p1[r]),p1[r+1]);b=__builtin_fmaxf(__builtin_fmaxf(b,p1[r+2]),p1[r+3]);}
      rm=__builtin_fmaxf(a,b); auto rr=__builtin_amdgcn_permlane32_swap(__float_as_uint(rm),__float_as_uint(rm),false,false); rm=__builtin_fmaxf(__uint_as_float(rr[0]),__uint_as_float(rr[1])); }
    const float mnew=__builtin_fmaxf(mhat,rm);
    if(__any(mnew>mhat)){ const float f=__builtin_amdgcn_exp2f(mhat-mnew); l_reg*=f; if(hi==0)wsf[r32]=f; asm volatile("s_waitcnt lgkmcnt(0)":::"memory");
      #pragma unroll
      for(int d_=0;d_<2;++d_)
        #pragma unroll
        for(int r=0;r<16;++r)o[d_][r]*=wsf[crow(r,hi)];
      mhat=mnew; }
    float sacc=0.f;
    #pragma unroll
    for(int r=0;r<16;++r){p0[r]=__builtin_amdgcn_exp2f(p0[r]-mhat);p1[r]=__builtin_amdgcn_exp2f(p1[r]-mhat);sacc+=p0[r]+p1[r];}
    l_reg+=sacc;
    #define PKW(P,B) cvtpk_s(P[B],P[B+1])
    const u32x4 pw0=(u32x4){PKW(p0,0),PKW(p0,2),PKW(p0,4),PKW(p0,6)},pw1=(u32x4){PKW(p0,8),PKW(p0,10),PKW(p0,12),PKW(p0,14)},pw2=(u32x4){PKW(p1,0),PKW(p1,2),PKW(p1,4),PKW(p1,6)},pw3=(u32x4){PKW(p1,8),PKW(p1,10),PKW(p1,12),PKW(p1,14)};
    #undef PKW
    pv(o,vb0+slot,__builtin_bit_cast(bf16x8,pw0),__builtin_bit_cast(bf16x8,pw1),__builtin_bit_cast(bf16x8,pw2),__builtin_bit_cast(bf16x8,pw3));
    slot=(slot==(NSLOT-1)*SLOTB)?0:slot+SLOTB;
  }
  {auto rr=__builtin_amdgcn_permlane32_swap(__float_as_uint(l_reg),__float_as_uint(l_reg),false,false);l_reg=__uint_as_float(rr[0])+__uint_as_float(rr[1]);}
  if(hi==0)wsf[32+r32]=l_reg;
  asm volatile("s_waitcnt lgkmcnt(0)\n\ts_barrier":::"memory");
  float rli[16];
  #pragma unroll
  for(int r=0;r<16;++r)rli[r]=__builtin_amdgcn_rcpf(wsf[32+crow(r,hi)]);
  bf16*Ow=O+(long)(q0+wid*QBLK)*DM+h*D;
  { bf16*stg=(bf16*)(shm+LDS_K)+wid*2048;
    #pragma unroll
    for(int r=0;r<16;++r){const int orow=crow(r,hi);
      #pragma unroll
      for(int d0=0;d0<2;++d0)stg[orow*64+d0*32+r32]=__float2bfloat16(o[d0][r]*rli[r]);}
    asm volatile("s_waitcnt lgkmcnt(0)":::"memory");
    #pragma unroll
    for(int i=0;i<4;++i){const int row=i*8+(lane>>3),ch=lane&7; const u32x4 v=*(const u32x4*)(stg+row*64+ch*8); *(u32x4*)(Ow+(long)row*DM+ch*8)=v;} }
  asm volatile("s_waitcnt lgkmcnt(0)\n\ts_barrier":::"memory");
  #undef DMA_K
  #undef DMA_V
}
#undef SBAR
#undef WAIT_BAR
}
namespace cg = cooperative_groups;
constexpr int S_ = 16384, DMOD = 1024, NL = 4, DIN = 2568, NIN = 2560, DFF = 2816, NGU = 5632, NHD = 8;
constexpr float EPSN = 1e-6f;
constexpr size_t MiB = 1u << 20;
constexpr size_t WS_CTL = 0, CTL_BYTES = 65536;
constexpr size_t WS_WF = 1 * MiB;
constexpr size_t WS_WIN = 2 * MiB;
constexpr size_t WS_WOUT = 22 * MiB;
constexpr size_t WS_WGU = 30 * MiB;
constexpr size_t WS_WD = 74 * MiB;
constexpr size_t WS_XB = 96 * MiB;
constexpr size_t WS_RSTD = 128 * MiB;
constexpr size_t WS_LOGF = 128 * MiB + 256 * 1024;
constexpr size_t WS_C2 = 129 * MiB;
constexpr size_t WS_QKVZ = 130 * MiB;
constexpr size_t WS_O = 210 * MiB;
constexpr size_t WS_MG = 226 * MiB;
constexpr size_t WS_H = 130 * MiB;
constexpr size_t WS_END = 258 * MiB;
static_assert(WS_H + (size_t)S_ * DFF * 2 <= WS_MG, "h overlay");
constexpr int LDS_BYTES = 147456;
constexpr int NPHASE = 2 + 8 * NL;

#define LAS __attribute__((address_space(3)))
typedef unsigned short bf16r;
typedef unsigned v4u __attribute__((ext_vector_type(4)));
typedef float f32x4 __attribute__((ext_vector_type(4)));
typedef float f32x16 __attribute__((ext_vector_type(16)));
typedef short bf16x8 __attribute__((ext_vector_type(8)));
#define LDS_WAIT() asm volatile("s_waitcnt lgkmcnt(0)" ::: "memory")
__device__ __forceinline__ unsigned f2bf(float f) { unsigned u = __builtin_bit_cast(unsigned, f); return (u + 0x7fffu + ((u >> 16) & 1u)) >> 16; }
__device__ __forceinline__ unsigned pk2(float lo, float hi) { return f2bf(lo) | (f2bf(hi) << 16); }
__device__ __forceinline__ float bflo(unsigned w) { return __builtin_bit_cast(float, w << 16); }
__device__ __forceinline__ float bfhi(unsigned w) { return __builtin_bit_cast(float, w & 0xffff0000u); }
__device__ __forceinline__ float bf1(bf16r w) { return __builtin_bit_cast(float, (unsigned)w << 16); }
__device__ __forceinline__ float wave_sum(float v) {
#pragma unroll
    for (int o = 1; o < 64; o <<= 1) v += __shfl_xor(v, o);
    return v;
}
__device__ __forceinline__ void prep_item(const float* W, int ldw, int srccol, const float* gs, bf16r* WT, int K, int dstrow, int k0, LAS float* scr, int lane) {
#pragma unroll 8
    for (int i = 0; i < 32; ++i) { const int kk = 2 * i + (lane >> 5); float w = W[(size_t)(k0 + kk) * ldw + srccol + (lane & 31)]; if (gs) w *= gs[k0 + kk]; scr[kk * 33 + (lane & 31)] = w; }
    LDS_WAIT(); asm volatile("" ::: "memory");
    const int c = lane & 7;
#pragma unroll
    for (int j = 0; j < 4; ++j) { const int n = (lane >> 3) + 8 * j; const LAS float* s = scr + (8 * c) * 33 + n;
        v4u o; o.x = pk2(s[0 * 33], s[1 * 33]); o.y = pk2(s[2 * 33], s[3 * 33]); o.z = pk2(s[4 * 33], s[5 * 33]); o.w = pk2(s[6 * 33], s[7 * 33]);
        *(v4u*)(WT + (size_t)(dstrow + n) * K + k0 + 8 * c) = o; }
    LDS_WAIT(); asm volatile("" ::: "memory");
}
struct Ptrs {
    const float *x, *mixg, *w_in, *b_f, *lng, *lnb, *w_s, *b_s, *outg, *w_out, *ffng, *w_gu, *w_d, *fing;
    float* out; unsigned char* ws;
};
__device__ __forceinline__ void phase_prep(const Ptrs& P, LAS unsigned char* lds, int gw, int NGW, int wave, int lane) {
    LAS float* scr = (LAS float*)(lds + wave * 16384);
    bf16r* WinT = (bf16r*)(P.ws + WS_WIN); bf16r* WoutT = (bf16r*)(P.ws + WS_WOUT); bf16r* WguT = (bf16r*)(P.ws + WS_WGU); bf16r* WdT = (bf16r*)(P.ws + WS_WD);
    constexpr int I_IN = 16 * 80, I_OUT = 16 * 32, I_GU = 16 * 176, I_D = 44 * 32, I_L = I_IN + I_OUT + I_GU + I_D;
    for (int it = gw; it < NL * I_L; it += NGW) {
        const int l = it / I_L; int r = it % I_L;
        if (r < I_IN) { const int kb = r / 80, nb = r % 80, n0 = 32 * nb, src = n0 < 1536 ? n0 : n0 + 8;
            prep_item(P.w_in + (size_t)l * DMOD * DIN, DIN, src, P.mixg + l * DMOD, WinT + (size_t)l * NIN * DMOD, DMOD, n0, 64 * kb, scr, lane); continue; }
        r -= I_IN;
        if (r < I_OUT) { const int kb = r / 32, nb = r % 32;
            prep_item(P.w_out + (size_t)l * DMOD * DMOD, DMOD, 32 * nb, P.outg + l * DMOD, WoutT + (size_t)l * DMOD * DMOD, DMOD, 32 * nb, 64 * kb, scr, lane); continue; }
        r -= I_OUT;
        if (r < I_GU) { const int kb = r / 176, nb = r % 176, n0 = 32 * nb, pn = n0 >> 8, j = n0 & 255, src = j < 128 ? 128 * pn + j : DFF + 128 * pn + (j - 128);
            prep_item(P.w_gu + (size_t)l * DMOD * NGU, NGU, src, P.ffng + l * DMOD, WguT + (size_t)l * NGU * DMOD, DMOD, n0, 64 * kb, scr, lane); continue; }
        r -= I_GU;
        { const int kb = r / 32, nb = r % 32;
            prep_item(P.w_d + (size_t)l * DFF * DMOD, DMOD, 32 * nb, nullptr, WdT + (size_t)l * DMOD * DFF, DFF, 32 * nb, 64 * kb, scr, lane); }
    }
    float* wf = (float*)(P.ws + WS_WF);
    for (int idx = gw * 64 + lane; idx < NL * 8 * DMOD; idx += NGW * 64) { const int l = idx >> 13, h = (idx >> 10) & 7, k = idx & 1023;
        wf[idx] = P.w_in[((size_t)l * DMOD + k) * DIN + 1536 + h] * P.mixg[l * DMOD + k]; }
}
template <int MODE>
__device__ __forceinline__ void phase_rowstats(const float* xin, bf16r* xb, float* rstd_out, const float* wf, const float* bfv, float* logf, const float* gfin, float* outp, int gw, int NGW, int lane) {
    for (int m = gw; m < S_; m += NGW) {
        const f32x4* xr = (const f32x4*)(xin + (size_t)m * DMOD) + lane;
        f32x4 v[4]; float s = 0.f;
#pragma unroll
        for (int j = 0; j < 4; ++j) { v[j] = xr[64 * j]; s += (v[j].x * v[j].x + v[j].y * v[j].y) + (v[j].z * v[j].z + v[j].w * v[j].w); }
        const float rs = 1.0f / sqrtf(wave_sum(s) * (1.0f / DMOD) + EPSN);
        if (MODE == 2) {
            f32x4* orow = (f32x4*)(outp + (size_t)m * DMOD) + lane; const f32x4* gr = (const f32x4*)gfin + lane;
#pragma unroll
            for (int j = 0; j < 4; ++j) orow[64 * j] = v[j] * rs * gr[64 * j];
        } else {
            unsigned long long* o8 = (unsigned long long*)(xb + (size_t)m * DMOD) + lane;
#pragma unroll
            for (int j = 0; j < 4; ++j) o8[64 * j] = (unsigned long long)pk2(v[j].x, v[j].y) | ((unsigned long long)pk2(v[j].z, v[j].w) << 32);
            if (lane == 0) rstd_out[m] = rs;
            if (MODE == 0) {
                float mine = 0.f;
#pragma unroll
                for (int h = 0; h < 8; ++h) { const f32x4* wr = (const f32x4*)(wf + h * DMOD) + lane; float d = 0.f;
#pragma unroll
                    for (int j = 0; j < 4; ++j) { const f32x4 w = wr[64 * j]; d += (v[j].x * w.x + v[j].y * w.y) + (v[j].z * w.z + v[j].w * w.w); }
                    d = wave_sum(d); if (lane == h) mine = d; }
                if (lane < 8) { const float z = mine * rs + bfv[lane]; logf[(size_t)m * 8 + lane] = fminf(z, 0.f) - log1pf(expf(-fabsf(z))); }
            }
        }
    }
}
__device__ __forceinline__ void cumsum_head(const float* logf, float* c2, int h, LAS unsigned char* lds, int tid) {
    LAS double* scr = (LAS double*)lds;
    const int base = tid * 32; double sum = 0.0;
    for (int e = 0; e < 32; ++e) sum += (double)logf[(size_t)(base + e) * 8 + h];
    scr[tid] = sum; __syncthreads();
    double pre = 0.0; for (int i = 0; i < tid; ++i) pre += scr[i];
    for (int e = 0; e < 32; ++e) { pre += (double)logf[(size_t)(base + e) * 8 + h]; c2[(size_t)h * S_ + base + e] = (float)(pre * 1.4426950408889634); }
    __syncthreads();
}
__device__ __forceinline__ void merge_item(int c, const bf16r* ZU, const bf16r* ZV, const bf16r* O, bf16r* MG, const float* lng, const float* lnb, const float* wsl, const float* bsl,
                                           LAS unsigned char* lds, int wid, int lane) {
    LAS float* bsb = (LAS float*)lds;
    LAS bf16r* zt = (LAS bf16r*)(lds + 4096);
    const int r32 = lane & 31, hi = lane >> 5, g = wid, tid = wid * 64 + lane;
    bsb[tid] = bsl[tid]; bsb[tid + 512] = bsl[tid + 512];
    float gl[8], bl[8];
    { const f32x4 g0 = *(const f32x4*)(lng + 8 * lane), g1 = *(const f32x4*)(lng + 8 * lane + 4), b0 = *(const f32x4*)(lnb + 8 * lane), b1 = *(const f32x4*)(lnb + 8 * lane + 4);
      gl[0] = g0.x; gl[1] = g0.y; gl[2] = g0.z; gl[3] = g0.w; gl[4] = g1.x; gl[5] = g1.y; gl[6] = g1.z; gl[7] = g1.w;
      bl[0] = b0.x; bl[1] = b0.y; bl[2] = b0.z; bl[3] = b0.w; bl[4] = b1.x; bl[5] = b1.y; bl[6] = b1.z; bl[7] = b1.w; }
#pragma unroll 2
    for (int rr = 0; rr < 16; ++rr) { const int i = 16 * wid + rr; const size_t row = (size_t)c * 128 + i;
        const v4u zr = *(const v4u*)(ZV + row * 512 + 8 * lane);
        const v4u orr = *(const v4u*)(O + row * 512 + 8 * lane);
        float z[8] = {bflo(zr.x), bfhi(zr.x), bflo(zr.y), bfhi(zr.y), bflo(zr.z), bfhi(zr.z), bflo(zr.w), bfhi(zr.w)};
        float s = 0.f;
#pragma unroll
        for (int e = 0; e < 8; ++e) s += z[e];
        const float mean = wave_sum(s) * (1.0f / 512.0f); float q = 0.f;
#pragma unroll
        for (int e = 0; e < 8; ++e) { z[e] -= mean; q += z[e] * z[e]; }
        const float rstd = 1.0f / sqrtf(wave_sum(q) * (1.0f / 512.0f) + EPSN);
#pragma unroll
        for (int e = 0; e < 8; ++e) z[e] = z[e] * rstd * gl[e] + bl[e];
        v4u zw; zw.x = pk2(z[0], z[1]); zw.y = pk2(z[2], z[3]); zw.z = pk2(z[4], z[5]); zw.w = pk2(z[6], z[7]);
        *(LAS v4u*)(zt + i * 512 + 8 * lane) = zw;
        float a[8] = {bflo(orr.x), bfhi(orr.x), bflo(orr.y), bfhi(orr.y), bflo(orr.z), bfhi(orr.z), bflo(orr.w), bfhi(orr.w)};
        float ss = 0.f;
#pragma unroll
        for (int e = 0; e < 8; ++e) ss += a[e] * a[e];
        const float ra = 1.0f / sqrtf(wave_sum(ss) * (1.0f / 512.0f) + EPSN);
        v4u w; w.x = pk2(a[0] * ra, a[1] * ra); w.y = pk2(a[2] * ra, a[3] * ra); w.z = pk2(a[4] * ra, a[5] * ra); w.w = pk2(a[6] * ra, a[7] * ra);
        *(v4u*)(MG + row * 1024 + 8 * lane) = w;
    }
    LDS_WAIT(); __syncthreads();
#pragma unroll 1
    for (int ni = 0; ni < 2; ++ni) {
        const int d = 64 * g + 32 * ni + r32;
        bf16x8 bfr[8];
#pragma unroll
        for (int ks = 0; ks < 8; ++ks) { const LAS bf16r* zp = zt + (16 * ks + 8 * hi) * 512 + d;
            v4u w; w.x = (unsigned)zp[0] | ((unsigned)zp[512] << 16); w.y = (unsigned)zp[1024] | ((unsigned)zp[1536] << 16); w.z = (unsigned)zp[2048] | ((unsigned)zp[2560] << 16); w.w = (unsigned)zp[3072] | ((unsigned)zp[3584] << 16);
            bfr[ks] = __builtin_bit_cast(bf16x8, w); }
        LDS_WAIT(); asm volatile("" ::: "memory");
        f32x16 acc[4];
#pragma unroll
        for (int mi = 0; mi < 4; ++mi) { acc[mi] = f32x16{};
#pragma unroll
            for (int ks = 0; ks < 8; ++ks) { if (mi < 2 && ks >= 4) continue;
                const float* wp = wsl + ((size_t)g * 128 + 32 * mi + r32) * 128 + 16 * ks + 8 * hi; const f32x4 a0 = *(const f32x4*)wp, a1 = *(const f32x4*)(wp + 4);
                v4u w; w.x = pk2(a0.x, a0.y); w.y = pk2(a0.z, a0.w); w.z = pk2(a1.x, a1.y); w.w = pk2(a1.z, a1.w);
                acc[mi] = __builtin_amdgcn_mfma_f32_32x32x16_bf16(__builtin_bit_cast(bf16x8, w), bfr[ks], acc[mi], 0, 0, 0); }
            asm volatile("" ::: "memory"); }
#pragma unroll
        for (int mi = 0; mi < 4; ++mi)
#pragma unroll
            for (int r = 0; r < 16; ++r) { const int i = 32 * mi + (r & 3) + 8 * (r >> 2) + 4 * hi;
                zt[i * 512 + d] = (bf16r)f2bf(acc[mi][r] + bsb[g * 128 + i]); }
        LDS_WAIT(); asm volatile("" ::: "memory");
    }
    __syncthreads();
#pragma unroll 2
    for (int rr = 0; rr < 16; ++rr) { const int i = 16 * wid + rr; const size_t row = (size_t)c * 128 + i;
        const v4u tr = *(const LAS v4u*)(zt + i * 512 + 8 * lane);
        const v4u ur = *(const v4u*)(ZU + row * 512 + 8 * lane);
        float a[8] = {bflo(tr.x) * bflo(ur.x), bfhi(tr.x) * bfhi(ur.x), bflo(tr.y) * bflo(ur.y), bfhi(tr.y) * bfhi(ur.y), bflo(tr.z) * bflo(ur.z), bfhi(tr.z) * bfhi(ur.z), bflo(tr.w) * bflo(ur.w), bfhi(tr.w) * bfhi(ur.w)};
        float ss = 0.f;
#pragma unroll
        for (int e = 0; e < 8; ++e) ss += a[e] * a[e];
        const float ra = 1.0f / sqrtf(wave_sum(ss) * (1.0f / 512.0f) + EPSN);
        v4u w; w.x = pk2(a[0] * ra, a[1] * ra); w.y = pk2(a[2] * ra, a[3] * ra); w.z = pk2(a[4] * ra, a[5] * ra); w.w = pk2(a[6] * ra, a[7] * ra);
        *(v4u*)(MG + row * 1024 + 512 + 8 * lane) = w;
    }
    LDS_WAIT(); __syncthreads();
}
#ifndef MK_MULTI
#define MK_MULTI 0
#endif
struct Args { const float* in[14]; float* out; unsigned char* ws; int ph_lo, ph_hi; };
__global__ void __launch_bounds__(512, 2) fox_fwd(Args args) {
    extern __shared__ __attribute__((aligned(16))) unsigned char lds[];
    cg::grid_group grid = cg::this_grid();
    LAS unsigned char* L = (LAS unsigned char*)lds;
    const int G = gridDim.x, bx = blockIdx.x;
    const int vcu = (G % 8 == 0) ? (bx % 8) * (G / 8) + bx / 8 : bx;
    const int NGW = G * 8;
#define IDS() int tid = threadIdx.x; asm volatile("" : "+v"(tid)); const int lane = tid & 63, wave = __builtin_amdgcn_readfirstlane(tid >> 6), gw = vcu * 8 + wave; (void)lane; (void)gw
    Ptrs P;
    P.x = args.in[0]; P.mixg = args.in[1]; P.w_in = args.in[2]; P.b_f = args.in[3]; P.lng = args.in[4]; P.lnb = args.in[5]; P.w_s = args.in[6]; P.b_s = args.in[7];
    P.outg = args.in[8]; P.w_out = args.in[9]; P.ffng = args.in[10]; P.w_gu = args.in[11]; P.w_d = args.in[12]; P.fing = args.in[13]; P.out = args.out; P.ws = args.ws;
    unsigned char* ws = args.ws;
    unsigned* ctl = (unsigned*)(ws + WS_CTL);
    float* wf = (float*)(ws + WS_WF);
    bf16r* WinT = (bf16r*)(ws + WS_WIN); bf16r* WoutT = (bf16r*)(ws + WS_WOUT); bf16r* WguT = (bf16r*)(ws + WS_WGU); bf16r* WdT = (bf16r*)(ws + WS_WD);
    bf16r* XB = (bf16r*)(ws + WS_XB); float* RSTD = (float*)(ws + WS_RSTD); float* LOGF = (float*)(ws + WS_LOGF); float* C2A = (float*)(ws + WS_C2);
    bf16r* QKVZ = (bf16r*)(ws + WS_QKVZ); bf16r* OB = (bf16r*)(ws + WS_O); bf16r* MG = (bf16r*)(ws + WS_MG); bf16r* HB = (bf16r*)(ws + WS_H);
    constexpr size_t QS = (size_t)S_ * 512;
    const int lo = args.ph_lo, hi = args.ph_hi;
    int ph = 0;
#define RUN() (ph >= lo && ph < hi)
#define SEAM() do { ++ph; if (ph > lo && ph < hi) grid.sync(); } while (0)

#ifndef NO_P0
    if (RUN()) { IDS(); phase_prep(P, L, gw, NGW, wave, lane); }
#endif
    SEAM();
#ifndef NO_P0
    if (RUN()) { IDS(); phase_rowstats<0>(P.x, XB, RSTD, wf, P.b_f, LOGF, nullptr, nullptr, gw, NGW, lane); }
#endif
    SEAM();
    for (int l = 0; l < NL; ++l) {
#ifndef NO_INPROJ
        if (RUN()) {
            if (bx < NHD) { IDS(); cumsum_head(LOGF, C2A, bx, L, tid); }
            pg8::Gemm g{XB, WinT + (size_t)l * NIN * DMOD, S_, NIN, DMOD}; pg8::StaticOrder So; So.init(S_, NIN, G, bx);
            pg8::EpiInProj E{QKVZ, QS, RSTD};
            pg8::gemm_phase<pg8::EpiInProj, pg8::StaticOrder, true, true>(L, g, So, E);
        }
#endif
        SEAM();
#ifndef NO_ATTN
        if (RUN()) {
            IDS(); LAS unsigned* bc = (LAS unsigned*)(L + 147456 - 64);
            for (int qi = 0; qi < NHD; ++qi) { const int h = (bx + qi) & 7;
                for (;;) {
                    if (tid == 0) bc[0] = atomicAdd(ctl + (l * NHD + h) * 64, 1u);
                    __syncthreads(); const unsigned u = bc[0]; __syncthreads();
                    if (u >= 64u) break;
                    attn_body::fox_unit(h, 63 - (int)u, 0, (const attn_body::bf16*)QKVZ, (const attn_body::bf16*)(QKVZ + QS), (const attn_body::bf16*)(QKVZ + 2 * QS), (attn_body::bf16*)OB, C2A + (size_t)h * S_, (char*)lds);
                } }
        }
#endif
        SEAM();
#ifndef NO_MERGE
        if (RUN()) {
            IDS(); for (int c = vcu; c < S_ / 128; c += G)
                merge_item(c, QKVZ + 3 * QS, QKVZ + 4 * QS, OB, MG, P.lng + l * 512, P.lnb + l * 512, P.w_s + (size_t)l * 8 * 128 * 128, P.b_s + l * 8 * 128, L, wave, lane);
        }
#endif
        SEAM();
#ifndef NO_OUTPROJ
        if (RUN()) {
            pg8::Gemm g{MG, WoutT + (size_t)l * DMOD * DMOD, S_, DMOD, DMOD}; pg8::StaticOrder So; So.init(S_, DMOD, G, bx);
            pg8::EpiResid E{l == 0 ? P.x : P.out, P.out};
            pg8::gemm_phase<pg8::EpiResid, pg8::StaticOrder, true, true>(L, g, So, E);
        }
#endif
        SEAM();
#ifndef NO_RS1
        if (RUN()) { IDS(); phase_rowstats<1>(P.out, XB, RSTD, nullptr, nullptr, nullptr, nullptr, nullptr, gw, NGW, lane); }
#endif
        SEAM();
#ifndef NO_GU
        if (RUN()) {
            pg8::Gemm g{XB, WguT + (size_t)l * NGU * DMOD, S_, NGU, DMOD}; pg8::StaticOrder So; So.init(S_, NGU, G, bx);
            pg8::EpiSwiGLU E{HB, RSTD};
            pg8::gemm_phase<pg8::EpiSwiGLU, pg8::StaticOrder, true, true>(L, g, So, E);
        }
#endif
        SEAM();
#ifndef NO_DOWN
        if (RUN()) {
            pg8::Gemm g{HB, WdT + (size_t)l * DMOD * DFF, S_, DMOD, DFF}; pg8::StaticOrder So; So.init(S_, DMOD, G, bx);
            pg8::EpiResid E{P.out, P.out};
            pg8::gemm_phase<pg8::EpiResid, pg8::StaticOrder, true, true>(L, g, So, E);
        }
#endif
        SEAM();
#ifndef NO_RSN
        if (RUN()) { IDS();
            if (l + 1 < NL) phase_rowstats<0>(P.out, XB, RSTD, wf + (size_t)(l + 1) * 8 * DMOD, P.b_f + (l + 1) * 8, LOGF, nullptr, nullptr, gw, NGW, lane);
            else phase_rowstats<2>(P.out, nullptr, nullptr, nullptr, nullptr, nullptr, P.fing, P.out, gw, NGW, lane);
        }
#endif
        SEAM();
    }
#undef RUN
#undef SEAM
}

extern "C" void kernel_launch(void* const* d_in, const int* in_sizes, int n_in, void* d_out, int out_size, void* d_ws, size_t ws_size, hipStream_t stream) {
    static int grid = 0;
    if (grid == 0) {
        if (n_in != 14 || out_size != S_ * DMOD || ws_size < WS_END) { fprintf(stderr, "kernel_launch: unexpected shapes (n_in %d out %d ws %zu)\n", n_in, out_size, ws_size); grid = -1; return; }
        int dev = 0, cus = 0, per_cu = 0;
        hipGetDevice(&dev); hipDeviceGetAttribute(&cus, hipDeviceAttributeMultiprocessorCount, dev);
        if (hipFuncSetAttribute((const void*)fox_fwd, hipFuncAttributeMaxDynamicSharedMemorySize, LDS_BYTES) != hipSuccess) { fprintf(stderr, "kernel_launch: hipFuncSetAttribute failed\n"); grid = -1; return; }
        if (hipOccupancyMaxActiveBlocksPerMultiprocessor(&per_cu, (const void*)fox_fwd, 512, LDS_BYTES) != hipSuccess || per_cu < 1) { fprintf(stderr, "kernel_launch: occupancy query says %d\n", per_cu); per_cu = 1; }
        (void)hipGetLastError();
        grid = cus * per_cu;
        fprintf(stderr, "kernel_launch: grid %d (cus %d x %d)\n", grid, cus, per_cu);
    }
    if (grid < 0) return;
    hipMemsetAsync((char*)d_ws + WS_CTL, 0, CTL_BYTES, stream);
    Args a{};
    for (int i = 0; i < 14; ++i) a.in[i] = (const float*)d_in[i];
    a.out = (float*)d_out; a.ws = (unsigned char*)d_ws;
#if MK_MULTI
    for (int p = 0; p < NPHASE; ++p) { a.ph_lo = p; a.ph_hi = p + 1; hipLaunchKernelGGL(fox_fwd, dim3(grid), dim3(512), LDS_BYTES, stream, a); }
#else
    a.ph_lo = 0; a.ph_hi = NPHASE;
    void* kargs[] = {&a};
    hipError_t e = hipLaunchCooperativeKernel((const void*)fox_fwd, dim3(grid), dim3(512), kargs, LDS_BYTES, stream);
    if (e != hipSuccess) fprintf(stderr, "kernel_launch: cooperative launch failed: %s (grid %d)\n", hipGetErrorString(e), grid);
#endif
}
```

```cpp
#define MK_MULTI 0
#include <hip/hip_runtime.h>
#include <hip/hip_cooperative_groups.h>
#include <cstdio>
#include <cstdint>
namespace pg8 {
#define PG8_LAS __attribute__((address_space(3)))
typedef unsigned short bf16_t;
typedef short bf16x8 __attribute__((ext_vector_type(8)));
typedef float f32x4 __attribute__((ext_vector_type(4)));
typedef unsigned u32x4 __attribute__((ext_vector_type(4)));
constexpr int BM = 256, BK = 64, HALF = 128, HTB = HALF * BK * 2  , STAGE_BYTES = 8 * HTB, NXCD = 8, WGM = 8;

__host__ __device__ __forceinline__ int lds_byte(int r, int c) { const int st = (r >> 4) * 2 + (c >> 5), rr = r & 15, cc = c & 31, ob = rr * 64 + cc * 2; return st * 1024 + (ob ^ (((ob >> 9) & 1) << 5)); }
__host__ __device__ __forceinline__ void stage_rc(int b, int& R, int& C) { const int st = b / 1024, sb = b % 1024, swz = sb ^ (((sb >> 9) & 1) << 5); R = (st >> 1) * 16 + swz / 64; C = (st & 1) * 32 + (swz % 64) / 2; }
__host__ __device__ __forceinline__ int perm32(int rho) { const int n = rho >> 4, i = rho & 15; return 8 * (i >> 2) + 4 * n + (i & 3); }

struct Unit { int pm, pn; };
struct Gemm { const bf16_t* A; const bf16_t* Bt; int M, N, K; };

struct StaticOrder {
    int nM, nN, nwg, G, c;
    __host__ __device__ void init(int M, int N, int G_, int c_) { nM = M / BM; nN = N / BM; nwg = nM * nN; G = G_; c = c_; }
    __host__ __device__ bool next(int i, Unit& u) const {
        const long L = (long)i * G + c; if (L >= nwg) return false;
        int wgid = (int)L; { const int q = nwg / NXCD, r = nwg % NXCD, xcd = wgid % NXCD, off = wgid / NXCD; wgid = (xcd < r ? xcd * (q + 1) : r * (q + 1) + (xcd - r) * q) + off; }
        const int nig = WGM * nN, gid = wgid / nig, fm = gid * WGM, gsz = (nM - fm) < WGM ? (nM - fm) : WGM;
        u.pm = fm + ((wgid % nig) % gsz); u.pn = (wgid % nig) / gsz; return true;
    }
    __device__ __forceinline__ void a_ready(const Unit&) const {}
    __device__ __forceinline__ void done(const Unit&) const {}
};

__device__ __forceinline__ unsigned cvt_pk_bf16(float lo, float hi) { unsigned r; asm volatile("v_cvt_pk_bf16_f32 %0, %1, %2" : "=v"(r) : "v"(lo), "v"(hi)); return r; }
typedef float f32x2 __attribute__((ext_vector_type(2)));
__device__ __forceinline__ f32x2 gelu_pk(f32x2 v) {
    const f32x2 av = __builtin_elementwise_abs(v), d = av * 0.2316418882f + 1.0f;
    f32x2 t; t.x = __builtin_amdgcn_rcpf(d.x); t.y = __builtin_amdgcn_rcpf(d.y);
    f32x2 q = t * 0.5307027145f + (-0.7265760135f); q = q * t + 0.7107068705f; q = q * t + (-0.142248368f); q = q * t + 0.127414796f; q = q * t;
    const f32x2 s = (v * v) * (-0.72134752044f);
    f32x2 e; e.x = __builtin_amdgcn_exp2f(s.x); e.y = __builtin_amdgcn_exp2f(s.y);
    const f32x2 m = v * (q * e), r = v - m;
    f32x2 o; o.x = v.x < 0.f ? m.x : r.x; o.y = v.y < 0.f ? m.y : r.y; return o;
}
constexpr float C2Q = 0.125f * 1.4426950408889634f;
struct EpiInProj {
    static constexpr bool PERM = true, AFTER_DRAIN = false;
    bf16_t* O; size_t split_stride; const float* rstd; unsigned* kmax;
    __device__ __forceinline__ void operator()(const f32x4 (&acc)[2][2][4][2], const Unit& u, int wr, int wc, int fr, int fq) const {
        const int t = u.pn >> 1; float kmx[2] = {0.f, 0.f}; bf16_t* base = O + (size_t)t * split_stride;
        const int row0 = u.pm * BM + wr * 64 + fr, col0 = (u.pn & 1) * 256 + wc * 32 + 8 * fq;
        const float s0 = (t == 0) ? C2Q : 1.0f;
#pragma unroll
        for (int ai = 0; ai < 2; ++ai)
#pragma unroll
            for (int m = 0; m < 4; ++m) { const int row = row0 + ai * HALF + m * 16; const float rs = rstd[row] * s0; bf16_t* rowp = base + (size_t)row * 512 + col0;
#pragma unroll
                for (int bj = 0; bj < 2; ++bj) { f32x4 v0 = acc[ai][bj][m][0] * rs, v1 = acc[ai][bj][m][1] * rs;
                    if (t == 1) { const f32x4 q0 = v0 * v0, q1 = v1 * v1; float sq = ((q0[0] + q0[1]) + (q0[2] + q0[3])) + ((q1[0] + q1[1]) + (q1[2] + q1[3])); sq += __shfl_xor(sq, 16); sq += __shfl_xor(sq, 32); kmx[bj] = fmaxf(kmx[bj], sq); }
                    if (t >= 3) { f32x2 a = gelu_pk((f32x2){v0[0], v0[1]}), b = gelu_pk((f32x2){v0[2], v0[3]}), c = gelu_pk((f32x2){v1[0], v1[1]}), d = gelu_pk((f32x2){v1[2], v1[3]});
                        v0 = (f32x4){a.x, a.y, b.x, b.y}; v1 = (f32x4){c.x, c.y, d.x, d.y}; }
                    u32x4 w; w.x = cvt_pk_bf16(v0[0], v0[1]); w.y = cvt_pk_bf16(v0[2], v0[3]); w.z = cvt_pk_bf16(v1[0], v1[1]); w.w = cvt_pk_bf16(v1[2], v1[3]);
                    *(u32x4*)(rowp + bj * HALF) = w; } }
        if (t == 1) {
#pragma unroll
            for (int bj = 0; bj < 2; ++bj) { float v = kmx[bj]; v = fmaxf(v, __shfl_xor(v, 1)); v = fmaxf(v, __shfl_xor(v, 2)); v = fmaxf(v, __shfl_xor(v, 4)); v = fmaxf(v, __shfl_xor(v, 8));
                if (fr == 0 && fq == 0) atomicMax(kmax + ((u.pn & 1) * 4 + bj * 2 + (wc >> 1)) * 2 + (wc & 1), __float_as_uint(v)); } }
    }
};
struct EpiResid {
    static constexpr bool PERM = false, AFTER_DRAIN = false;
    const float* base; float* out;
    __device__ __forceinline__ void operator()(const f32x4 (&acc)[2][2][4][2], const Unit& u, int wr, int wc, int fr, int fq) const {
        const int col0 = u.pn * BM + wc * 32 + 4 * fq;
#pragma unroll
        for (int ai = 0; ai < 2; ++ai)
#pragma unroll
            for (int m = 0; m < 4; ++m) { const size_t off = (size_t)(u.pm * BM + ai * HALF + wr * 64 + m * 16 + fr) * 1024 + col0;
#pragma unroll
                for (int bj = 0; bj < 2; ++bj)
#pragma unroll
                    for (int n = 0; n < 2; ++n) { const f32x4 b = *(const f32x4*)(base + off + bj * HALF + n * 16); *(f32x4*)(out + off + bj * HALF + n * 16) = b + acc[ai][bj][m][n]; } }
    }
};
struct EpiSwiGLU {
    static constexpr bool PERM = true, AFTER_DRAIN = false;
    bf16_t* H; const float* rstd;
    __device__ __forceinline__ void operator()(const f32x4 (&acc)[2][2][4][2], const Unit& u, int wr, int wc, int fr, int fq) const {
        const int row0 = u.pm * BM + wr * 64 + fr, col0 = u.pn * 128 + wc * 32 + 8 * fq;
#pragma unroll
        for (int ai = 0; ai < 2; ++ai)
#pragma unroll
            for (int m = 0; m < 4; ++m) { const int row = row0 + ai * HALF + m * 16; const float rs = rstd[row];
                float hv[8];
#pragma unroll
                for (int n = 0; n < 2; ++n)
#pragma unroll
                    for (int e = 0; e < 4; ++e) { const float g = acc[ai][0][m][n][e] * rs, up = acc[ai][1][m][n][e] * rs;
                        const float sg = __builtin_amdgcn_rcpf(1.0f + __builtin_amdgcn_exp2f(-1.4426950408889634f * g)); hv[n * 4 + e] = g * sg * up; }
                u32x4 w; w.x = cvt_pk_bf16(hv[0], hv[1]); w.y = cvt_pk_bf16(hv[2], hv[3]); w.z = cvt_pk_bf16(hv[4], hv[5]); w.w = cvt_pk_bf16(hv[6], hv[7]);
                *(u32x4*)(H + (size_t)row * 2816 + col0) = w; }
    }
};
template <class Epi, class Sched, bool ALIGN_EPI = false, bool SP2 = false>
__device__ __forceinline__ void gemm_phase(PG8_LAS unsigned char* lds, const Gemm g, const Sched& S, const Epi& E) {
    int tid = threadIdx.x; asm volatile("" : "+v"(tid));
    const int wid = __builtin_amdgcn_readfirstlane(tid >> 6), lane = tid & 63, wr = wid >> 2, wc = wid & 3, fr = lane & 15, fq = lane >> 4;
    const int K = g.K, nt = K / BK;
    unsigned voffA[2], voffB[2];
#pragma unroll
    for (int i = 0; i < 2; ++i) { int R, C; stage_rc(tid * 16 + i * 8192, R, C); const int Rb = Epi::PERM ? ((R & ~31) + perm32(R & 31)) : R;
        voffA[i] = (unsigned)(R * K + C) * 2u; voffB[i] = (unsigned)(Rb * K + C) * 2u; }
    const size_t kstep = (size_t)(BK * 2);
    const size_t hstep = (size_t)HALF * K * 2;
    const size_t tstep = 2 * hstep;
    const unsigned ldsw = (unsigned)wid * 1024u;
    const int aoff = lds_byte(wr * 64 + fr, fq * 8), boff = lds_byte(wc * 32 + fr, fq * 8);
#define PG8_SA(b, h) (((b) * 2 + (h)) * HTB)
#define PG8_SB(b, h) ((4 + (b) * 2 + (h)) * HTB)
#define PG8_STAGE(bufoff, gbase, voff) do { _Pragma("unroll") for (int _i = 0; _i < 2; ++_i) \
        __builtin_amdgcn_global_load_lds((const unsigned*)((const char*)(gbase) + (voff)[_i]), (PG8_LAS unsigned*)(lds + (bufoff) + ldsw + _i * 8192), 16, 0, 0); } while (0)
#define PG8_LDA(dst, b, h) do { _Pragma("unroll") for (int m = 0; m < 4; ++m) _Pragma("unroll") for (int k = 0; k < 2; ++k) dst[m][k] = *(const PG8_LAS bf16x8*)(lds + PG8_SA(b, h) + aoff + m * 2048 + k * 1024); } while (0)
#define PG8_LDB(dst, b, h) do { _Pragma("unroll") for (int n = 0; n < 2; ++n) _Pragma("unroll") for (int k = 0; k < 2; ++k) dst[n][k] = *(const PG8_LAS bf16x8*)(lds + PG8_SB(b, h) + boff + n * 2048 + k * 1024); } while (0)
#define PG8_MMA(ai, bj, At, Bt) do { __builtin_amdgcn_s_setprio(1); _Pragma("unroll") for (int m = 0; m < 4; ++m) _Pragma("unroll") for (int n = 0; n < 2; ++n) _Pragma("unroll") for (int k = 0; k < 2; ++k) \
        acc[ai][bj][m][n] = __builtin_amdgcn_mfma_f32_16x16x32_bf16(Bt[n][k], At[m][k], acc[ai][bj][m][n], 0, 0, 0); __builtin_amdgcn_s_setprio(0); } while (0)
#define PG8_WAIT_V(n) asm volatile("s_waitcnt vmcnt(" #n ")" ::: "memory")
#define PG8_WAIT_L(n) asm volatile("s_waitcnt lgkmcnt(" #n ")" ::: "memory")
#define PG8_BAR __builtin_amdgcn_s_barrier()
#define PG8_SCHED __builtin_amdgcn_sched_barrier(0)
    Unit cur, nxt; int ui = 0;
    if (!S.next(0, cur)) return;
    f32x4 acc[2][2][4][2];
#pragma unroll
    for (int a = 0; a < 2; ++a)
#pragma unroll
        for (int b = 0; b < 2; ++b)
#pragma unroll
            for (int m = 0; m < 4; ++m)
#pragma unroll
                for (int n = 0; n < 2; ++n) acc[a][b][m][n] = (f32x4){0.f, 0.f, 0.f, 0.f};
    bf16x8 At[4][2], B0[2][2], B1[2][2];
    const char* cA = (const char*)g.A + (size_t)cur.pm * tstep; const char* cB = (const char*)g.Bt + (size_t)cur.pn * tstep;
    S.a_ready(cur);
    if constexpr (SP2) {
        PG8_STAGE(PG8_SB(0, 0), cB, voffB); PG8_STAGE(PG8_SB(0, 1), cB + hstep, voffB); PG8_STAGE(PG8_SA(0, 0), cA, voffA); PG8_STAGE(PG8_SA(0, 1), cA + hstep, voffA);
        if (wr == 1) PG8_BAR;
        PG8_WAIT_V(2); PG8_BAR;
        PG8_STAGE(PG8_SB(1, 0), cB + kstep, voffB); PG8_STAGE(PG8_SA(1, 0), cA + kstep, voffA); PG8_STAGE(PG8_SB(1, 1), cB + hstep + kstep, voffB);
        PG8_WAIT_V(6); PG8_BAR;
    } else {
        PG8_STAGE(PG8_SB(0, 0), cB, voffB); PG8_STAGE(PG8_SA(0, 0), cA, voffA); PG8_STAGE(PG8_SB(0, 1), cB + hstep, voffB); PG8_STAGE(PG8_SA(0, 1), cA + hstep, voffA);
        if (wr == 1) PG8_BAR;
        PG8_WAIT_V(4); PG8_BAR;
        PG8_STAGE(PG8_SB(1, 0), cB + kstep, voffB); PG8_STAGE(PG8_SA(1, 0), cA + kstep, voffA); PG8_STAGE(PG8_SB(1, 1), cB + hstep + kstep, voffB);
        PG8_WAIT_V(6); PG8_BAR;
    }
    for (;;) {
        const bool has_next = S.next(ui + 1, nxt);
        const char* nA = has_next ? (const char*)g.A + (size_t)nxt.pm * tstep : cA; const char* nB = has_next ? (const char*)g.Bt + (size_t)nxt.pn * tstep : cB;
        for (int t = 0; t < nt; t += 2) {
            const bool last = (t == nt - 2);
            const char* a1 = cA + (size_t)(t + 1) * kstep;
            const char* a2 = last ? nA : cA + (size_t)(t + 2) * kstep; const char* b2 = last ? nB : cB + (size_t)(t + 2) * kstep;
            const char* a3 = a2 + kstep; const char* b3 = b2 + kstep;
            if (last && has_next) S.a_ready(nxt);
            if constexpr (SP2) {
            PG8_LDB(B0, 0, 0); PG8_LDB(B1, 0, 1); PG8_SCHED; PG8_LDA(At, 0, 0); PG8_STAGE(PG8_SA(1, 1), a1 + hstep, voffA);
            PG8_WAIT_V(8); PG8_WAIT_L(0); PG8_BAR; PG8_MMA(0, 0, At, B0); PG8_MMA(0, 1, At, B1); PG8_BAR; PG8_SCHED;
            PG8_LDA(At, 0, 1); PG8_STAGE(PG8_SB(0, 0), b2, voffB); PG8_STAGE(PG8_SB(0, 1), b2 + hstep, voffB); PG8_STAGE(PG8_SA(0, 0), a2, voffA);
            PG8_WAIT_V(8); PG8_WAIT_L(0); PG8_BAR; PG8_MMA(1, 0, At, B0); PG8_MMA(1, 1, At, B1); PG8_BAR; PG8_SCHED;
            PG8_LDB(B0, 1, 0); PG8_LDB(B1, 1, 1); PG8_SCHED; PG8_LDA(At, 1, 0); PG8_STAGE(PG8_SA(0, 1), a2 + hstep, voffA);
            PG8_WAIT_V(8); PG8_WAIT_L(0); PG8_BAR; PG8_MMA(0, 0, At, B0); PG8_MMA(0, 1, At, B1); PG8_BAR; PG8_SCHED;
            PG8_LDA(At, 1, 1); PG8_STAGE(PG8_SB(1, 0), b3, voffB); PG8_STAGE(PG8_SB(1, 1), b3 + hstep, voffB); PG8_STAGE(PG8_SA(1, 0), a3, voffA);
            PG8_WAIT_V(8); PG8_WAIT_L(0); PG8_BAR; PG8_MMA(1, 0, At, B0); PG8_MMA(1, 1, At, B1); PG8_BAR; PG8_SCHED;
            } else {
            PG8_LDB(B0, 0, 0); PG8_SCHED; PG8_LDA(At, 0, 0); PG8_STAGE(PG8_SA(1, 1), a1 + hstep, voffA);
            PG8_WAIT_L(8); PG8_BAR; PG8_WAIT_L(0); PG8_MMA(0, 0, At, B0); PG8_BAR; PG8_SCHED;
            PG8_LDB(B1, 0, 1); PG8_STAGE(PG8_SB(0, 0), b2, voffB);
            PG8_BAR; PG8_WAIT_L(0); PG8_MMA(0, 1, At, B1); PG8_BAR;
            PG8_LDA(At, 0, 1); PG8_STAGE(PG8_SA(0, 0), a2, voffA);
            PG8_BAR; PG8_WAIT_L(0); PG8_MMA(1, 0, At, B0); PG8_BAR; PG8_SCHED;
            PG8_STAGE(PG8_SB(0, 1), b2 + hstep, voffB);
            PG8_WAIT_V(6); PG8_BAR; PG8_MMA(1, 1, At, B1); PG8_BAR;
            PG8_LDB(B0, 1, 0); PG8_SCHED; PG8_LDA(At, 1, 0); PG8_STAGE(PG8_SA(0, 1), a2 + hstep, voffA);
            PG8_WAIT_L(8); PG8_BAR; PG8_WAIT_L(0); PG8_MMA(0, 0, At, B0); PG8_BAR; PG8_SCHED;
            PG8_LDB(B1, 1, 1); PG8_STAGE(PG8_SB(1, 0), b3, voffB);
            PG8_BAR; PG8_WAIT_L(0); PG8_MMA(0, 1, At, B1); PG8_BAR;
            PG8_LDA(At, 1, 1); PG8_STAGE(PG8_SA(1, 0), a3, voffA);
            PG8_BAR; PG8_WAIT_L(0); PG8_MMA(1, 0, At, B0); PG8_BAR; PG8_SCHED;
            PG8_STAGE(PG8_SB(1, 1), b3 + hstep, voffB);
            PG8_WAIT_V(6); PG8_BAR; PG8_MMA(1, 1, At, B1); PG8_BAR;
            }
        }
        if constexpr (ALIGN_EPI) { if (wr == 0) PG8_BAR; }
        if constexpr (!Epi::AFTER_DRAIN) { E(acc, cur, wr, wc, fr, fq); S.done(cur); }
        if (!has_next) break;
#pragma unroll
        for (int a = 0; a < 2; ++a)
#pragma unroll
            for (int b = 0; b < 2; ++b)
#pragma unroll
                for (int m = 0; m < 4; ++m)
#pragma unroll
                    for (int n = 0; n < 2; ++n) acc[a][b][m][n] = (f32x4){0.f, 0.f, 0.f, 0.f};
        cur = nxt; cA = nA; cB = nB; ++ui;
        if constexpr (ALIGN_EPI) { if (wr == 1) PG8_BAR; }
    }
    PG8_WAIT_V(0);
    if constexpr (!ALIGN_EPI) { if (wr == 0) PG8_BAR; }
    PG8_BAR;
    if constexpr (Epi::AFTER_DRAIN) { E.fused(acc, cur, wr, wc, fr, fq, lds, wid, lane); S.done(cur); }
#undef PG8_SA
#undef PG8_SB
#undef PG8_STAGE
#undef PG8_LDA
#undef PG8_LDB
#undef PG8_MMA
#undef PG8_WAIT_V
#undef PG8_WAIT_L
#undef PG8_BAR
#undef PG8_SCHED
}
}
#include <hip/hip_bf16.h>
#include <cmath>
namespace attn_body {
using bf16=__hip_bfloat16;
using bf16x8=__attribute__((ext_vector_type(8)))short;
using s16x4=__attribute__((ext_vector_type(4)))short;
using f32x16=__attribute__((ext_vector_type(16)))float;
using u32x4=__attribute__((ext_vector_type(4)))unsigned;
constexpr int BATCH=1,NHEAD=8,SEQ=16384,D=64,DM=NHEAD*D;
constexpr int NW=8,QBLK=32,QB=QBLK*NW,KVBLK=64,NQB=SEQ/QB;
constexpr int ATTN_PITCH=DM, ATTN_UNIT_ROWS=QB;
__device__ __forceinline__ int crow(int r,int hi){return (r&3)+8*(r>>2)+4*hi;}
#define SBAR() __builtin_amdgcn_sched_barrier(0)
__device__ __forceinline__ void cmask(f32x16&p0,f32x16&p1,int jb,int qrel,int hi){
  const float NEG=-INFINITY; int kb=64*jb+4*hi;
  #pragma unroll
  for(int r=0;r<16;++r){int kv=kb+(r&3)+8*(r>>2); if(kv>qrel)p0[r]=NEG; if(kv+32>qrel)p1[r]=NEG;}
}

constexpr int NSLOT=3, SLOTB=8192;
constexpr int LDS_K=0, LDS_V=NSLOT*SLOTB, LDS_WS=2*NSLOT*SLOTB, LDS_OST=LDS_WS+NW*64*4, LDS_BYTES=LDS_OST+NW*4096;
constexpr float C2=0.125f*1.4426950408889634f;
__device__ __forceinline__ void glds16(const void*gsrc,unsigned lds_dst){unsigned keep;
  asm volatile("s_mov_b32 %0, m0\n\ts_mov_b32 m0, %2\n\ts_nop 0\n\tglobal_load_lds_dwordx4 %1, off\n\ts_mov_b32 m0, %0":"=&s"(keep):"v"(gsrc),"s"(lds_dst):"memory");}
__device__ __forceinline__ float max3f(float a,float b,float c){float r;asm("v_max3_f32 %0, %1, %2, %3":"=v"(r):"v"(a),"v"(b),"v"(c));return r;}
__device__ __forceinline__ float max2f(float a,float b){float r;asm("v_max_f32_e32 %0, %1, %2":"=v"(r):"v"(a),"v"(b));return r;}
__device__ __forceinline__ float fadd_s(float a,float b){float r;asm("v_add_f32_e32 %0, %1, %2":"=v"(r):"v"(a),"v"(b));return r;}
__device__ __forceinline__ float fsub_s(float a,float b){float r;asm("v_sub_f32_e32 %0, %1, %2":"=v"(r):"v"(a),"v"(b));return r;}
typedef float f32x2_t __attribute__((ext_vector_type(2))); typedef __bf16 bf16x2_t __attribute__((ext_vector_type(2)));
__device__ __forceinline__ unsigned cvtpk_s(float lo,float hi){f32x2_t v={lo,hi};bf16x2_t b=__builtin_convertvector(v,bf16x2_t);return __builtin_bit_cast(unsigned,b);}
#define WAIT_BAR(N) asm volatile("s_waitcnt vmcnt(" #N ") lgkmcnt(0)\n\ts_barrier":::"memory")

__device__ __forceinline__ void qkt(f32x16&p0,f32x16&p1,const char*Kslot,const bf16x8*qr,const f32x16&negm,int r32,int hi){
  const char*kb=Kslot+hi*1024+r32*16;
  #pragma unroll
  for(int d0=0;d0<4;++d0){
    const bf16x8 b0=*reinterpret_cast<const bf16x8*>(kb+d0*2048);
    const bf16x8 b1=*reinterpret_cast<const bf16x8*>(kb+d0*2048+512);
    if(d0==0){p0=__builtin_amdgcn_mfma_f32_32x32x16_bf16(b0,qr[0],negm,0,0,0);p1=__builtin_amdgcn_mfma_f32_32x32x16_bf16(b1,qr[0],negm,0,0,0);}
    else{p0=__builtin_amdgcn_mfma_f32_32x32x16_bf16(b0,qr[d0],p0,0,0,0);p1=__builtin_amdgcn_mfma_f32_32x32x16_bf16(b1,qr[d0],p1,0,0,0);}}
}
typedef __attribute__((address_space(3))) const char* lds_cptr;
typedef short v4i16_t __attribute__((ext_vector_type(4)));
__device__ __forceinline__ void kload8(bf16x8*kf,lds_cptr kp){
  kf[0]=*(const __attribute__((address_space(3))) bf16x8*)(kp);      kf[1]=*(const __attribute__((address_space(3))) bf16x8*)(kp+512);
  kf[2]=*(const __attribute__((address_space(3))) bf16x8*)(kp+2048); kf[3]=*(const __attribute__((address_space(3))) bf16x8*)(kp+2560);
  kf[4]=*(const __attribute__((address_space(3))) bf16x8*)(kp+4096); kf[5]=*(const __attribute__((address_space(3))) bf16x8*)(kp+4608);
  kf[6]=*(const __attribute__((address_space(3))) bf16x8*)(kp+6144); kf[7]=*(const __attribute__((address_space(3))) bf16x8*)(kp+6656);
}
__device__ __forceinline__ void kload2(bf16x8*kf,lds_cptr kp,int j){ kf[2*j]=*(const __attribute__((address_space(3))) bf16x8*)(kp+j*2048); kf[2*j+1]=*(const __attribute__((address_space(3))) bf16x8*)(kp+j*2048+512); }
__device__ __forceinline__ s16x4 vtr(lds_cptr p){ return __builtin_bit_cast(s16x4,__builtin_amdgcn_ds_read_tr16_b64_v4i16((__attribute__((address_space(3))) v4i16_t*)p)); }
__device__ __forceinline__ float rowmax(const f32x16&p0,const f32x16&p1){
  float a=max3f(p0[0],p0[1],p1[0]),b=max3f(p0[2],p0[3],p1[1]);a=max3f(a,p1[2],p1[3]);
  #pragma unroll
  for(int r=4;r<16;r+=4){a=max3f(a,p0[r],p0[r+1]);b=max3f(b,p0[r+2],p0[r+3]);a=max3f(a,p1[r],p1[r+1]);b=max3f(b,p1[r+2],p1[r+3]);}
  const float m=max2f(a,b);
  auto rr=__builtin_amdgcn_permlane32_swap(__float_as_uint(m),__float_as_uint(m),false,false);
  return max2f(__uint_as_float(rr[0]),__uint_as_float(rr[1]));
}
__device__ __forceinline__ void pv(f32x16*o,int vb,bf16x8 pa0,bf16x8 pa1,bf16x8 pa2,bf16x8 pa3){
  #pragma unroll
  for(int d0=0;d0<2;++d0){s16x4 lo[4],hi[4];
    #pragma unroll
    for(int ks=0;ks<4;++ks){
      asm volatile("ds_read_b64_tr_b16 %0,%1 offset:%c2":"=&v"(lo[ks]):"v"(vb),"i"(d0*4096+ks*1024):"memory");
      asm volatile("ds_read_b64_tr_b16 %0,%1 offset:%c2":"=&v"(hi[ks]):"v"(vb),"i"(d0*4096+ks*1024+512):"memory");}
    asm volatile("s_waitcnt lgkmcnt(0)":::"memory");SBAR();
    #define PK(k) (bf16x8){lo[k][0],lo[k][1],lo[k][2],lo[k][3],hi[k][0],hi[k][1],hi[k][2],hi[k][3]}
    o[d0]=__builtin_amdgcn_mfma_f32_32x32x16_bf16(pa0,PK(0),o[d0],0,0,0);
    o[d0]=__builtin_amdgcn_mfma_f32_32x32x16_bf16(pa1,PK(1),o[d0],0,0,0);
    o[d0]=__builtin_amdgcn_mfma_f32_32x32x16_bf16(pa2,PK(2),o[d0],0,0,0);
    o[d0]=__builtin_amdgcn_mfma_f32_32x32x16_bf16(pa3,PK(3),o[d0],0,0,0);
    #undef PK
  }
}
typedef float f32x4_t __attribute__((ext_vector_type(4)));

#ifndef ATTN_STORE16
#define ATTN_STORE16(p,v) (*(u32x4*)(p)=(v))
#endif
constexpr int FCH=64;
constexpr int F2_CK=LDS_BYTES, FOX2_LDS_BYTES=F2_CK+FCH*64*4;
template<int THRL> __device__ __forceinline__ void fox_unit2(int h,int qb,int jc,float kn,const bf16*Q,const bf16*__restrict__ K,const bf16*__restrict__ V,bf16*O,float*ML,const float*__restrict__ c2h,char*shm,float*qmx){
  int tid=threadIdx.x; asm volatile("":"+v"(tid)); const int lane=tid&63,r32=lane&31,hi=lane>>5; const int wid=__builtin_amdgcn_readfirstlane(tid>>6);
  const long rowbase=0; const int q0=qb*QB;
  const bf16*Qw=Q+(rowbase+q0+wid*QBLK)*DM+h*D;
  const bf16*Kh=K+rowbase*DM+h*D,*Vh=V+rowbase*DM+h*D;
  const unsigned lds0=(unsigned)(uintptr_t)shm;
  float*wsf=(float*)(shm+LDS_WS)+wid*64;
  float*ckl=(float*)(shm+F2_CK);
  const int NTg=(q0+QB)/KVBLK;
  bf16x8 qr[4];
  #pragma unroll
  for(int d0=0;d0<4;++d0)qr[d0]=*reinterpret_cast<const bf16x8*>(&Qw[(long)r32*DM+d0*16+hi*8]);
  int ts;
  { float qs=0.f;
    #pragma unroll
    for(int d0=0;d0<4;++d0)
      #pragma unroll
      for(int e=0;e<8;++e){ const float v=__builtin_bit_cast(float,(unsigned)(unsigned short)qr[d0][e]<<16); qs+=v*v; }
    { auto rr=__builtin_amdgcn_permlane32_swap(__float_as_uint(qs),__float_as_uint(qs),false,false); qs=__uint_as_float(rr[0])+__uint_as_float(rr[1]); }
    #pragma unroll
    for(int o_=1;o_<32;o_<<=1) qs=__builtin_fmaxf(qs,__shfl_xor(qs,o_));
    if(lane==0)qmx[wid]=qs;
    __syncthreads();
    float q2=qmx[0];
    #pragma unroll
    for(int w_=1;w_<8;++w_)q2=__builtin_fmaxf(q2,qmx[w_]);
    const float lim=c2h[q0]+152.0f+2.0f*sqrtf(q2)*kn;
    ts=__syncthreads_count((tid<NTg-4)&&(c2h[64*tid+63]>lim)); ts&=~3; }
  const int t1=NTg-FCH*jc; int t0=t1-FCH; t0=t0<0?0:t0; t0=t0<ts?ts:t0;
  if(t0>=t1){ if(hi==0){ float*mlp=ML+((long)(q0+wid*QBLK+r32)*NHEAD+h)*2; mlp[0]=-1.0e30f; mlp[1]=0.f; } return; }
  const int NT=t1-t0;
  const int NTm=(jc==0)?NT:(1<<20);
  { const float cref=c2h[q0]; const int nck=NT*64;
    for(int i=tid*4;i<nck;i+=2048){ f32x4_t v=*(const f32x4_t*)(c2h+t0*64+i); v=v-cref; *(f32x4_t*)(ckl+i)=v; } }
  asm volatile("s_waitcnt vmcnt(0)":::"memory");
  const bf16*ksrc=Kh+(long)(t0*KVBLK+lane)*DM+wid*8;
  const bf16*vsrc=Vh+(long)(t0*KVBLK+16*(wid&3)+(lane>>2))*DM+(wid>>2)*32+(lane&3)*8;
  const unsigned kdst=lds0+LDS_K+wid*1024, vdst=lds0+LDS_V+wid*1024;
  #define DMA_K(t,slot) glds16(ksrc+(long)(t)*KVBLK*DM,(unsigned)__builtin_amdgcn_readfirstlane(kdst+(slot)))
  #define DMA_V(t,slot) glds16(vsrc+(long)(t)*KVBLK*DM,(unsigned)__builtin_amdgcn_readfirstlane(vdst+(slot)))
  const int vb0=(int)(lds0+LDS_V)+((lane>>4)&1)*32+(lane&3)*8+(4*hi+((lane&15)>>2))*64;
  const char*Kbase=shm+LDS_K; bf16x8 kf[8];
  const lds_cptr shm3=(lds_cptr)shm; const lds_cptr kp0=shm3+LDS_K+hi*1024+r32*16; const lds_cptr vp0=shm3+LDS_V+((lane>>4)&1)*32+(lane&3)*8+(4*hi+((lane&15)>>2))*64;
  DMA_K(0,0);DMA_V(0,0);DMA_K(1,SLOTB);
  float mhat=0.f,l_reg=0.f;f32x16 o[2];o[0]=f32x16{};o[1]=f32x16{};f32x16 negm=f32x16{};asm volatile("":"+v"(negm));
  const int qrel=wid*QBLK+r32;
  #define CMASK(P0,P1,t) do{int jb_=(t)-(NTm-4); if(jb_>=0)cmask(P0,P1,jb_,qrel,hi);}while(0)
  #define BIAS(P0,P1,t) do{ const float*cb_=ckl+(t)*64+4*hi; _Pragma("unroll") for(int g_=0;g_<4;++g_){ const f32x4_t a_=*(const f32x4_t*)(cb_+8*g_), b_=*(const f32x4_t*)(cb_+32+8*g_); _Pragma("unroll") for(int e_=0;e_<4;++e_){P0[4*g_+e_]-=a_[e_];P1[4*g_+e_]-=b_[e_];} SBAR(); } }while(0)
  bool resc=false;
  #define START(P0,P1) do{ const float rm=rowmax(P0,P1); resc=false; \
    { const float dl=rm; mhat=fadd_s(mhat,dl); \
      _Pragma("unroll") for(int r=0;r<16;++r){P0[r]=fsub_s(P0[r],dl);P1[r]=fsub_s(P1[r],dl);} \
      _Pragma("unroll") for(int r=0;r<16;++r)negm[r]=-mhat; asm volatile("":"+v"(negm)); } \
    _Pragma("unroll") for(int r=0;r<16;++r)P0[r]=__builtin_amdgcn_exp2f(P0[r]); }while(0)
  #define RESC() do{ if(resc){ asm volatile("s_waitcnt lgkmcnt(0)":::"memory"); \
      _Pragma("unroll") for(int d_=0;d_<2;++d_) _Pragma("unroll") for(int r=0;r<16;++r)o[d_][r]*=wsf[crow(r,hi)]; } }while(0)
  f32x16 pA0,pA1,pB0,pB1;
  int sl_prev=0,sl_cur=0,sl_next=SLOTB;
  #define ROT() do{sl_prev=sl_cur;sl_cur=sl_next;sl_next=(sl_next==(NSLOT-1)*SLOTB)?0:sl_next+SLOTB;}while(0)
  DMA_K(2,2*SLOTB);
  WAIT_BAR(3);
  qkt(pA0,pA1,Kbase,qr,negm,r32,hi);asm volatile("s_nop 15\n\ts_nop 7":"+v"(pA0),"+v"(pA1));BIAS(pA0,pA1,0);CMASK(pA0,pA1,0);
  START(pA0,pA1);
  _Pragma("unroll") for(int r=0;r<16;++r)pA1[r]=__builtin_amdgcn_exp2f(pA1[r]);
  WAIT_BAR(0);
  DMA_K(3,0);DMA_V(1,SLOTB);
  ROT();
  kload8(kf,kp0+sl_cur);
  WAIT_BAR(2);
  s16x4 vlo[8],vhi[8]; u32x4 pw0,pw1,pw2,pw3;
  #define PKW(P,B) cvtpk_s(P[B],P[B+1])
  #define PAF(k) __builtin_bit_cast(bf16x8,pw##k)
  #define VFR(i) (bf16x8){vlo[i][0],vlo[i][1],vlo[i][2],vlo[i][3],vhi[i][0],vhi[i][1],vhi[i][2],vhi[i][3]}
  #define PIN(x) asm volatile("":"+v"(x))
  #define MX3(a,b,c) __builtin_fmaxf(__builtin_fmaxf((a),(b)),(c))
  #define GAPA(MF,A0,A1,A2,A3,W0,W1,PW) do{ MF; sacc+=A0; sacc+=A1; sacc+=A2; sacc+=A3; PIN(sacc); W0; W1; PIN(PW); SBAR(); }while(0)
  #define EX(v) __builtin_amdgcn_exp2f(v)
  #define GAPB(MF,X,B) do{ MF; X[B]=EX(X[B]); X[B+1]=EX(X[B+1]); X[B+2]=EX(X[B+2]); X[B+3]=EX(X[B+3]); PIN(X); SBAR(); }while(0)
  #define VRD(i) do{ vlo[i]=vtr(vp_+(((i)>>2)*4096+((i)&3)*1024)); vhi[i]=vtr(vp_+(((i)>>2)*4096+((i)&3)*1024+512)); }while(0)
  #define KRD(G,j) do{ if(G){ kload2(kf,kp0+sl_next,j); SBAR(); } }while(0)
  #define STEP(C0,C1,P0,P1,t,GK,GV,GL) do{ SBAR(); \
    const lds_cptr vp_=vp0+sl_prev; \
    VRD(0); SBAR(); float sacc=(P0[0]+P0[1]); \
    GAPA(C0=__builtin_amdgcn_mfma_f32_32x32x16_bf16(kf[0],qr[0],negm,0,0,0), P0[2],P0[3],P0[4],P0[5],     pw0[0]=PKW(P0,0), pw0[1]=PKW(P0,2), pw0); \
    VRD(4); SBAR(); GAPA(C1=__builtin_amdgcn_mfma_f32_32x32x16_bf16(kf[1],qr[0],negm,0,0,0), P0[6],P0[7],P0[8],P0[9],     pw0[2]=PKW(P0,4), pw0[3]=PKW(P0,6), pw0); \
    VRD(1); SBAR(); GAPA(C0=__builtin_amdgcn_mfma_f32_32x32x16_bf16(kf[2],qr[1],C0,0,0,0),   P0[10],P0[11],P0[12],P0[13], pw1[0]=PKW(P0,8), pw1[1]=PKW(P0,10), pw1); \
    VRD(5); SBAR(); GAPA(C1=__builtin_amdgcn_mfma_f32_32x32x16_bf16(kf[3],qr[1],C1,0,0,0),   P0[14],P0[15],P1[0],P1[1],   pw1[2]=PKW(P0,12),pw1[3]=PKW(P0,14), pw1); \
    VRD(2); SBAR(); GAPA(C0=__builtin_amdgcn_mfma_f32_32x32x16_bf16(kf[4],qr[2],C0,0,0,0),   P1[2],P1[3],P1[4],P1[5],     pw2[0]=PKW(P1,0), pw2[1]=PKW(P1,2), pw2); \
    VRD(6); SBAR(); GAPA(C1=__builtin_amdgcn_mfma_f32_32x32x16_bf16(kf[5],qr[2],C1,0,0,0),   P1[6],P1[7],P1[8],P1[9],     pw2[2]=PKW(P1,4), pw2[3]=PKW(P1,6), pw2); \
    VRD(3); SBAR(); GAPA(C0=__builtin_amdgcn_mfma_f32_32x32x16_bf16(kf[6],qr[3],C0,0,0,0),   P1[10],P1[11],P1[12],P1[13], pw3[0]=PKW(P1,8), pw3[1]=PKW(P1,10), pw3); \
    VRD(7); SBAR(); GAPA(C1=__builtin_amdgcn_mfma_f32_32x32x16_bf16(kf[7],qr[3],C1,0,0,0),   P1[14],P1[15],0.f,0.f,       pw3[2]=PKW(P1,12),pw3[3]=PKW(P1,14), pw3); \
    l_reg+=sacc; \
    if(GK){DMA_K((t)+3,sl_cur);} if(GV){DMA_V((t)+1,sl_next);} \
    BIAS(C0,C1,t); CMASK(C0,C1,t); \
    { float a=MX3(C0[0],C0[1],C1[0]),b=MX3(C0[2],C0[3],C1[1]); a=MX3(a,C1[2],C1[3]); \
      _Pragma("unroll") for(int r=4;r<16;r+=4){a=MX3(a,C0[r],C0[r+1]);b=MX3(b,C0[r+2],C0[r+3]);a=MX3(a,C1[r],C1[r+1]);b=MX3(b,C1[r+2],C1[r+3]);} \
      float rm=__builtin_fmaxf(a,b); { auto rr=__builtin_amdgcn_permlane32_swap(__float_as_uint(rm),__float_as_uint(rm),false,false); rm=__builtin_fmaxf(__uint_as_float(rr[0]),__uint_as_float(rr[1])); } \
      resc=false; \
      if(__builtin_expect(__any(rm>(float)THRL),0)){ const float dl=__builtin_fmaxf(rm,0.f); mhat+=dl; \
        _Pragma("unroll") for(int r=0;r<16;++r){C0[r]-=dl;C1[r]-=dl;} \
        _Pragma("unroll") for(int r=0;r<16;++r)negm[r]=-mhat; asm volatile("":"+v"(negm)); \
        const float f=__builtin_amdgcn_exp2f(-dl); l_reg*=f; if(hi==0)wsf[r32]=f; resc=true; } } \
    SBAR(); \
    GAPB(o[0]=__builtin_amdgcn_mfma_f32_32x32x16_bf16(PAF(0),VFR(0),o[0],0,0,0), C0,0); \
    GAPB(o[1]=__builtin_amdgcn_mfma_f32_32x32x16_bf16(PAF(0),VFR(4),o[1],0,0,0), C0,4); \
    KRD(GL,0); GAPB(o[0]=__builtin_amdgcn_mfma_f32_32x32x16_bf16(PAF(1),VFR(1),o[0],0,0,0), C0,8); \
    KRD(GL,1); GAPB(o[1]=__builtin_amdgcn_mfma_f32_32x32x16_bf16(PAF(1),VFR(5),o[1],0,0,0), C0,12); \
    KRD(GL,2); GAPB(o[0]=__builtin_amdgcn_mfma_f32_32x32x16_bf16(PAF(2),VFR(2),o[0],0,0,0), C1,0); \
    KRD(GL,3); GAPB(o[1]=__builtin_amdgcn_mfma_f32_32x32x16_bf16(PAF(2),VFR(6),o[1],0,0,0), C1,4); \
    GAPB(o[0]=__builtin_amdgcn_mfma_f32_32x32x16_bf16(PAF(3),VFR(3),o[0],0,0,0), C1,8); \
    GAPB(o[1]=__builtin_amdgcn_mfma_f32_32x32x16_bf16(PAF(3),VFR(7),o[1],0,0,0), C1,12); \
    }while(0)
  int t=1;
  #undef CMASK
  #define CMASK(P0,P1,t) do{}while(0)
  for(;t+5<NT;t+=2){
    STEP(pB0,pB1,pA0,pA1,t,true,true,true);     WAIT_BAR(2); RESC(); ROT();
    STEP(pA0,pA1,pB0,pB1,t+1,true,true,true);   WAIT_BAR(2); RESC(); ROT();
  }
  #undef CMASK
  #define CMASK(P0,P1,t) do{int jb_=(t)-(NTm-4); if(jb_>=0)cmask(P0,P1,jb_,qrel,hi);}while(0)
  #define ENDW(tt) do{ if((tt)+3<NT){WAIT_BAR(2);} else if((tt)+2<NT){WAIT_BAR(1);} else {WAIT_BAR(0);} }while(0)
  for(;t+1<NT;t+=2){
    STEP(pB0,pB1,pA0,pA1,t,(t+3<NT),(t+1<NT),(t+1<NT));       ENDW(t);   RESC(); ROT();
    STEP(pA0,pA1,pB0,pB1,t+1,(t+4<NT),(t+2<NT),(t+2<NT));     ENDW(t+1); RESC(); ROT();
  }
  STEP(pB0,pB1,pA0,pA1,NT-1,false,false,false); RESC();
  { float sacc=pB0[0]+pB0[1]; _Pragma("unroll") for(int r=2;r<16;++r)sacc+=pB0[r]; _Pragma("unroll") for(int r=0;r<16;++r)sacc+=pB1[r]; l_reg+=sacc;
    pw0=(u32x4){PKW(pB0,0),PKW(pB0,2),PKW(pB0,4),PKW(pB0,6)};pw1=(u32x4){PKW(pB0,8),PKW(pB0,10),PKW(pB0,12),PKW(pB0,14)};pw2=(u32x4){PKW(pB1,0),PKW(pB1,2),PKW(pB1,4),PKW(pB1,6)};pw3=(u32x4){PKW(pB1,8),PKW(pB1,10),PKW(pB1,12),PKW(pB1,14)};
    SBAR(); pv(o,vb0+sl_cur,PAF(0),PAF(1),PAF(2),PAF(3)); }
  #undef PKW
  #undef PAF
  #undef VFR
  #undef PIN
  #undef MX3
  #undef GAPA
  #undef GAPB
  #undef EX
  #undef VRD
  #undef KRD
  #undef STEP
  #undef ENDW
  {auto rr=__builtin_amdgcn_permlane32_swap(__float_as_uint(l_reg),__float_as_uint(l_reg),false,false);l_reg=__uint_as_float(rr[0])+__uint_as_float(rr[1]);}
  if(hi==0){ wsf[32+r32]=l_reg; float*mlp=ML+((long)(q0+wid*QBLK+r32)*NHEAD+h)*2; mlp[0]=mhat; mlp[1]=l_reg; } asm volatile("s_waitcnt lgkmcnt(0)":::"memory");
  float rli[16];
  #pragma unroll
  for(int r=0;r<16;++r)rli[r]=__builtin_amdgcn_rcpf(wsf[32+crow(r,hi)]);
  bf16*Ow=O+(rowbase+q0+wid*QBLK)*DM+h*D;
  { bf16*stg=(bf16*)(shm+LDS_OST)+wid*2048;
    #pragma unroll
    for(int r=0;r<16;++r){const int orow=crow(r,hi);
      #pragma unroll
      for(int d0=0;d0<2;++d0)stg[orow*64+d0*32+r32]=__float2bfloat16(o[d0][r]*rli[r]);}
    asm volatile("s_waitcnt lgkmcnt(0)":::"memory");
    #pragma unroll
    for(int i=0;i<4;++i){const int row=i*8+(lane>>3),ch=lane&7; const u32x4 v=*(const u32x4*)(stg+row*64+ch*8); ATTN_STORE16(Ow+(long)row*DM+ch*8,v);} }
  asm volatile("s_waitcnt lgkmcnt(0)\n\ts_barrier":::"memory");
  #undef DMA_K
  #undef DMA_V
  #undef CMASK
  #undef BIAS
  #undef START
  #undef RESC
  #undef ROT
}

#undef SBAR
#undef WAIT_BAR
}
namespace cg = cooperative_groups;
constexpr int S_ = 16384, DMOD = 1024, NL = 4, DIN = 2568, NIN = 2560, DFF = 2816, NGU = 5632, NHD = 8;
constexpr float EPSN = 1e-6f;
constexpr size_t MiB = 1u << 20;
constexpr size_t WS_CTL = 0, CTL_BYTES = 65536;
constexpr size_t WS_WF = 1 * MiB;
constexpr size_t WS_WIN = 2 * MiB;
constexpr size_t WS_WOUT = 22 * MiB;
constexpr size_t WS_WGU = 30 * MiB;
constexpr size_t WS_WD = 74 * MiB;
constexpr size_t WS_XB = 96 * MiB;
constexpr size_t WS_RSTD = 128 * MiB;
constexpr size_t WS_LOGF = 128 * MiB + 256 * 1024;
constexpr size_t WS_C2 = 129 * MiB;
constexpr size_t WS_QKVZ = 130 * MiB;
constexpr size_t WS_O = 210 * MiB;
constexpr size_t WS_MG = 226 * MiB;
constexpr size_t WS_H = 130 * MiB;
constexpr size_t WS_OP = 258 * MiB;
constexpr size_t WS_ML = 306 * MiB;
constexpr size_t WS_END = 310 * MiB;
static_assert(WS_H + (size_t)S_ * DFF * 2 <= WS_MG, "h overlay");
constexpr int LDS_BYTES = 147456;
constexpr int CW_KMAX = 8192, CW_BAR = 9216;
constexpr int NPHASE = 2 + 8 * NL;

#define LAS __attribute__((address_space(3)))
typedef unsigned short bf16r;
typedef unsigned v4u __attribute__((ext_vector_type(4)));
typedef float f32x4 __attribute__((ext_vector_type(4)));
typedef float f32x16 __attribute__((ext_vector_type(16)));
typedef short bf16x8 __attribute__((ext_vector_type(8)));
#define LDS_WAIT() asm volatile("s_waitcnt lgkmcnt(0)" ::: "memory")
__device__ __forceinline__ unsigned f2bf(float f) { unsigned u = __builtin_bit_cast(unsigned, f); return (u + 0x7fffu + ((u >> 16) & 1u)) >> 16; }
__device__ __forceinline__ unsigned pk2(float lo, float hi) { return f2bf(lo) | (f2bf(hi) << 16); }
__device__ __forceinline__ float bflo(unsigned w) { return __builtin_bit_cast(float, w << 16); }
__device__ __forceinline__ float bfhi(unsigned w) { return __builtin_bit_cast(float, w & 0xffff0000u); }
__device__ __forceinline__ float bf1(bf16r w) { return __builtin_bit_cast(float, (unsigned)w << 16); }
#define DPPF(v, ctrl) __builtin_bit_cast(float, __builtin_amdgcn_update_dpp(0, __builtin_bit_cast(int, (v)), (ctrl), 0xf, 0xf, true))
__device__ __forceinline__ float wave_sum(float v) {
    v += DPPF(v, 0xB1); v += DPPF(v, 0x4E); v += DPPF(v, 0x141); v += DPPF(v, 0x140);
    const int iv = __builtin_bit_cast(int, v);
    const float s0 = __builtin_bit_cast(float, __builtin_amdgcn_readlane(iv, 0)), s1 = __builtin_bit_cast(float, __builtin_amdgcn_readlane(iv, 16)),
                s2 = __builtin_bit_cast(float, __builtin_amdgcn_readlane(iv, 32)), s3 = __builtin_bit_cast(float, __builtin_amdgcn_readlane(iv, 48));
    return (s0 + s1) + (s2 + s3);
}
constexpr int PREP_P = 132;
__device__ __forceinline__ void prep_item(const float* W, int ldw, int srccol, const float* gs, bf16r* WT, int K, int dstrow, int k0, LAS float* scr, int lane) {
#pragma unroll 8
    for (int i = 0; i < 16; ++i) { const int kk = 2 * i + (lane >> 5); f32x4 w = *(const f32x4*)(W + (size_t)(k0 + kk) * ldw + srccol + 4 * (lane & 31)); if (gs) w = w * gs[k0 + kk];
        *(LAS f32x4*)(scr + kk * PREP_P + 4 * (lane & 31)) = w; }
    LDS_WAIT(); asm volatile("" ::: "memory");
    const int c = lane & 3;
#pragma unroll
    for (int j = 0; j < 8; ++j) { const int n = (lane >> 2) + 16 * j; const LAS float* s = scr + (8 * c) * PREP_P + n;
        v4u o; o.x = pk2(s[0 * PREP_P], s[1 * PREP_P]); o.y = pk2(s[2 * PREP_P], s[3 * PREP_P]); o.z = pk2(s[4 * PREP_P], s[5 * PREP_P]); o.w = pk2(s[6 * PREP_P], s[7 * PREP_P]);
        *(v4u*)(WT + (size_t)(dstrow + n) * K + k0 + 8 * c) = o; }
    LDS_WAIT(); asm volatile("" ::: "memory");
}
struct Ptrs {
    const float *x, *mixg, *w_in, *b_f, *lng, *lnb, *w_s, *b_s, *outg, *w_out, *ffng, *w_gu, *w_d, *fing;
    float* out; unsigned char* ws;
};
__device__ __forceinline__ void phase_prep(const Ptrs& P, LAS unsigned char* lds, int gw, int NGW, int wave, int lane) {
    LAS float* scr = (LAS float*)(lds + wave * (32 * PREP_P * 4));
    bf16r* WinT = (bf16r*)(P.ws + WS_WIN); bf16r* WoutT = (bf16r*)(P.ws + WS_WOUT); bf16r* WguT = (bf16r*)(P.ws + WS_WGU); bf16r* WdT = (bf16r*)(P.ws + WS_WD);
    constexpr int I_IN = 32 * 20, I_OUT = 32 * 8, I_GU = 32 * 44, I_D = 88 * 8, I_L = I_IN + I_OUT + I_GU + I_D;
    for (int it = gw; it < NL * I_L; it += NGW) {
        const int l = it / I_L; int r = it % I_L;
        if (r < I_IN) { const int kb = r / 20, nb = r % 20, n0 = 128 * nb, src = n0 < 1536 ? n0 : n0 + 8;
            prep_item(P.w_in + (size_t)l * DMOD * DIN, DIN, src, P.mixg + l * DMOD, WinT + (size_t)l * NIN * DMOD, DMOD, n0, 32 * kb, scr, lane); continue; }
        r -= I_IN;
        if (r < I_OUT) { const int kb = r / 8, nb = r % 8;
            prep_item(P.w_out + (size_t)l * DMOD * DMOD, DMOD, 128 * nb, P.outg + l * DMOD, WoutT + (size_t)l * DMOD * DMOD, DMOD, 128 * nb, 32 * kb, scr, lane); continue; }
        r -= I_OUT;
        if (r < I_GU) { const int kb = r / 44, nb = r % 44, n0 = 128 * nb, pn = n0 >> 8, src = (n0 & 255) == 0 ? 128 * pn : DFF + 128 * pn;
            prep_item(P.w_gu + (size_t)l * DMOD * NGU, NGU, src, P.ffng + l * DMOD, WguT + (size_t)l * NGU * DMOD, DMOD, n0, 32 * kb, scr, lane); continue; }
        r -= I_GU;
        { const int kb = r / 8, nb = r % 8;
            prep_item(P.w_d + (size_t)l * DFF * DMOD, DMOD, 128 * nb, nullptr, WdT + (size_t)l * DMOD * DFF, DFF, 128 * nb, 32 * kb, scr, lane); }
    }
    float* wf = (float*)(P.ws + WS_WF);
    for (int idx = gw * 64 + lane; idx < NL * 8 * DMOD; idx += NGW * 64) { const int l = idx >> 13, h = (idx >> 10) & 7, k = idx & 1023;
        wf[idx] = P.w_in[((size_t)l * DMOD + k) * DIN + 1536 + h] * P.mixg[l * DMOD + k]; }
}
template <int MODE>
__device__ __forceinline__ void phase_rowstats(const float* xin, bf16r* xb, float* rstd_out, const float* wf, const float* bfv, float* logf, const float* gfin, float* outp, int gw, int NGW, int lane) {
#pragma unroll 2
    for (int m = gw; m < S_; m += NGW) {
        const f32x4* xr = (const f32x4*)(xin + (size_t)m * DMOD) + lane;
        f32x4 v[4]; float s = 0.f;
#pragma unroll
        for (int j = 0; j < 4; ++j) { v[j] = xr[64 * j]; s += (v[j].x * v[j].x + v[j].y * v[j].y) + (v[j].z * v[j].z + v[j].w * v[j].w); }
        const float rs = 1.0f / sqrtf(wave_sum(s) * (1.0f / DMOD) + EPSN);
        if (MODE == 2) {
            f32x4* orow = (f32x4*)(outp + (size_t)m * DMOD) + lane; const f32x4* gr = (const f32x4*)gfin + lane;
#pragma unroll
            for (int j = 0; j < 4; ++j) orow[64 * j] = v[j] * rs * gr[64 * j];
        } else {
            unsigned long long* o8 = (unsigned long long*)(xb + (size_t)m * DMOD) + lane;
#pragma unroll
            for (int j = 0; j < 4; ++j) o8[64 * j] = (unsigned long long)pk2(v[j].x, v[j].y) | ((unsigned long long)pk2(v[j].z, v[j].w) << 32);
            if (lane == 0) rstd_out[m] = rs;
            if (MODE == 0) {
                float mine = 0.f;
#pragma unroll
                for (int h = 0; h < 8; ++h) { const f32x4* wr = (const f32x4*)(wf + h * DMOD) + lane; float d = 0.f;
#pragma unroll
                    for (int j = 0; j < 4; ++j) { const f32x4 w = wr[64 * j]; d += (v[j].x * w.x + v[j].y * w.y) + (v[j].z * w.z + v[j].w * w.w); }
                    d = wave_sum(d); if (lane == h) mine = d; }
                if (lane < 8) { const float z = mine * rs + bfv[lane]; logf[(size_t)lane * S_ + m] = fminf(z, 0.f) - log1pf(expf(-fabsf(z))); }
            }
        }
    }
}
__device__ __forceinline__ void cumsum_head(const float* logf, float* c2, int h, LAS unsigned char* lds, int tid) {
    LAS double* scr = (LAS double*)lds;
    const f32x4* src = (const f32x4*)(logf + (size_t)h * S_ + tid * 32);
    f32x4 v[8]; double sum = 0.0;
#pragma unroll
    for (int e = 0; e < 8; ++e) { v[e] = src[e]; sum += ((double)v[e].x + (double)v[e].y) + ((double)v[e].z + (double)v[e].w); }
    scr[tid] = sum; __syncthreads();
    double pre = 0.0; for (int i = 0; i < tid; ++i) pre += scr[i];
    f32x4* dst = (f32x4*)(c2 + (size_t)h * S_ + tid * 32);
#pragma unroll
    for (int e = 0; e < 8; ++e) { f32x4 o; pre += (double)v[e].x; o.x = (float)(pre * 1.4426950408889634); pre += (double)v[e].y; o.y = (float)(pre * 1.4426950408889634);
        pre += (double)v[e].z; o.z = (float)(pre * 1.4426950408889634); pre += (double)v[e].w; o.w = (float)(pre * 1.4426950408889634); dst[e] = o; }
    __syncthreads();
}
__device__ __forceinline__ void sgu_item(int c, const bf16r* ZU, const bf16r* ZV, bf16r* MG, const float* lng, const float* lnb, const float* wsl, const float* bsl,
                                         LAS unsigned char* lds, int wid, int lane) {
    LAS float* bsb = (LAS float*)lds;
    LAS bf16r* zt = (LAS bf16r*)(lds + 4096);
    const int r32 = lane & 31, hi = lane >> 5, g = wid, tid = wid * 64 + lane;
    bsb[tid] = bsl[tid]; bsb[tid + 512] = bsl[tid + 512];
    float gl[8], bl[8];
    { const f32x4 g0 = *(const f32x4*)(lng + 8 * lane), g1 = *(const f32x4*)(lng + 8 * lane + 4), b0 = *(const f32x4*)(lnb + 8 * lane), b1 = *(const f32x4*)(lnb + 8 * lane + 4);
      gl[0] = g0.x; gl[1] = g0.y; gl[2] = g0.z; gl[3] = g0.w; gl[4] = g1.x; gl[5] = g1.y; gl[6] = g1.z; gl[7] = g1.w;
      bl[0] = b0.x; bl[1] = b0.y; bl[2] = b0.z; bl[3] = b0.w; bl[4] = b1.x; bl[5] = b1.y; bl[6] = b1.z; bl[7] = b1.w; }
#pragma unroll 4
    for (int rr = 0; rr < 16; ++rr) { const int i = 16 * wid + rr; const size_t row = (size_t)c * 128 + i;
        const v4u zr = *(const v4u*)(ZV + row * 512 + 8 * lane);
        float z[8] = {bflo(zr.x), bfhi(zr.x), bflo(zr.y), bfhi(zr.y), bflo(zr.z), bfhi(zr.z), bflo(zr.w), bfhi(zr.w)};
        float s = 0.f;
#pragma unroll
        for (int e = 0; e < 8; ++e) s += z[e];
        const float mean = wave_sum(s) * (1.0f / 512.0f); float q = 0.f;
#pragma unroll
        for (int e = 0; e < 8; ++e) { z[e] -= mean; q += z[e] * z[e]; }
        const float rstd = 1.0f / sqrtf(wave_sum(q) * (1.0f / 512.0f) + EPSN);
#pragma unroll
        for (int e = 0; e < 8; ++e) z[e] = z[e] * rstd * gl[e] + bl[e];
        v4u zw; zw.x = pk2(z[0], z[1]); zw.y = pk2(z[2], z[3]); zw.z = pk2(z[4], z[5]); zw.w = pk2(z[6], z[7]);
        *(LAS v4u*)(zt + i * 512 + 8 * lane) = zw;
    }
    LDS_WAIT(); __syncthreads();
#pragma unroll 1
    for (int ni = 0; ni < 2; ++ni) {
        const int d = 64 * g + 32 * ni + r32;
        bf16x8 bfr[8];
#pragma unroll
        for (int ks = 0; ks < 8; ++ks) { const LAS bf16r* zp = zt + (16 * ks + 8 * hi) * 512 + d;
            v4u w; w.x = (unsigned)zp[0] | ((unsigned)zp[512] << 16); w.y = (unsigned)zp[1024] | ((unsigned)zp[1536] << 16); w.z = (unsigned)zp[2048] | ((unsigned)zp[2560] << 16); w.w = (unsigned)zp[3072] | ((unsigned)zp[3584] << 16);
            bfr[ks] = __builtin_bit_cast(bf16x8, w); }
        LDS_WAIT(); asm volatile("" ::: "memory");
        f32x16 acc[4];
#pragma unroll
        for (int mi = 0; mi < 4; ++mi) { acc[mi] = f32x16{};
#pragma unroll
            for (int ks = 0; ks < 8; ++ks) { if (mi < 2 && ks >= 4) continue;
                const float* wp = wsl + ((size_t)g * 128 + 32 * mi + r32) * 128 + 16 * ks + 8 * hi; const f32x4 a0 = *(const f32x4*)wp, a1 = *(const f32x4*)(wp + 4);
                v4u w; w.x = pk2(a0.x, a0.y); w.y = pk2(a0.z, a0.w); w.z = pk2(a1.x, a1.y); w.w = pk2(a1.z, a1.w);
                acc[mi] = __builtin_amdgcn_mfma_f32_32x32x16_bf16(__builtin_bit_cast(bf16x8, w), bfr[ks], acc[mi], 0, 0, 0); }
            asm volatile("" ::: "memory"); }
#pragma unroll
        for (int mi = 0; mi < 4; ++mi)
#pragma unroll
            for (int r = 0; r < 16; ++r) { const int i = 32 * mi + (r & 3) + 8 * (r >> 2) + 4 * hi;
                zt[i * 512 + d] = (bf16r)f2bf(acc[mi][r] + bsb[g * 128 + i]); }
        LDS_WAIT(); asm volatile("" ::: "memory");
    }
    __syncthreads();
#pragma unroll 4
    for (int rr = 0; rr < 16; ++rr) { const int i = 16 * wid + rr; const size_t row = (size_t)c * 128 + i;
        const v4u tr = *(const LAS v4u*)(zt + i * 512 + 8 * lane);
        const v4u ur = *(const v4u*)(ZU + row * 512 + 8 * lane);
        float a[8] = {bflo(tr.x) * bflo(ur.x), bfhi(tr.x) * bfhi(ur.x), bflo(tr.y) * bflo(ur.y), bfhi(tr.y) * bfhi(ur.y), bflo(tr.z) * bflo(ur.z), bfhi(tr.z) * bfhi(ur.z), bflo(tr.w) * bflo(ur.w), bfhi(tr.w) * bfhi(ur.w)};
        float ss = 0.f;
#pragma unroll
        for (int e = 0; e < 8; ++e) ss += a[e] * a[e];
        const float ra = 1.0f / sqrtf(wave_sum(ss) * (1.0f / 512.0f) + EPSN);
        v4u w; w.x = pk2(a[0] * ra, a[1] * ra); w.y = pk2(a[2] * ra, a[3] * ra); w.z = pk2(a[4] * ra, a[5] * ra); w.w = pk2(a[6] * ra, a[7] * ra);
        *(v4u*)(MG + row * 1024 + 512 + 8 * lane) = w;
    }
    LDS_WAIT(); __syncthreads();
}
__device__ __forceinline__ void combine_item(int c, const bf16r* O, const bf16r* OP1, const float* ML, bf16r* MG, int wid, int lane) {
#pragma unroll 4
    for (int rr = 0; rr < 16; ++rr) { const size_t row = (size_t)c * 128 + 16 * wid + rr;
        float a[8];
        { const int nch = ((int)(row >> 12)) + 1, hh = lane >> 3; float Mj[4], lj[4]; v4u oj[4];
#pragma unroll
          for (int j = 0; j < 4; ++j) { if (j < nch) { const float* mlp = ML + (size_t)j * S_ * 16 + (row * 8 + hh) * 2; Mj[j] = mlp[0]; lj[j] = mlp[1];
                  oj[j] = *(const v4u*)((j == 0 ? O : OP1 + (size_t)(j - 1) * S_ * 512) + row * 512 + 8 * lane); } else { Mj[j] = -1.0e30f; lj[j] = 0.f; oj[j] = (v4u){0u, 0u, 0u, 0u}; } }
          const float Mmax = fmaxf(fmaxf(Mj[0], Mj[1]), fmaxf(Mj[2], Mj[3])); float wsum = 0.f;
#pragma unroll
          for (int e = 0; e < 8; ++e) a[e] = 0.f;
#pragma unroll
          for (int j = 0; j < 4; ++j) { const float w = lj[j] > 0.f ? lj[j] * __builtin_amdgcn_exp2f(Mj[j] - Mmax) : 0.f; wsum += w;
              if (w > 0.f) { a[0] += w * bflo(oj[j].x); a[1] += w * bfhi(oj[j].x); a[2] += w * bflo(oj[j].y); a[3] += w * bfhi(oj[j].y); a[4] += w * bflo(oj[j].z); a[5] += w * bfhi(oj[j].z); a[6] += w * bflo(oj[j].w); a[7] += w * bfhi(oj[j].w); } }
          const float iw = 1.0f / wsum;
#pragma unroll
          for (int e = 0; e < 8; ++e) a[e] *= iw; }
        float ss = 0.f;
#pragma unroll
        for (int e = 0; e < 8; ++e) ss += a[e] * a[e];
        const float ra = 1.0f / sqrtf(wave_sum(ss) * (1.0f / 512.0f) + EPSN);
        v4u w; w.x = pk2(a[0] * ra, a[1] * ra); w.y = pk2(a[2] * ra, a[3] * ra); w.z = pk2(a[4] * ra, a[5] * ra); w.w = pk2(a[6] * ra, a[7] * ra);
        *(v4u*)(MG + row * 1024 + 8 * lane) = w;
    }
}
#define XB_TMO      128
#define XB_XCNT(j)  (256  + 64 * (j))
#define XB_XSUB(j)  (1280 + 64 * (j))
#define XB_XGEN(j)  (2304 + 64 * (j))
#define XB_TOP      3328
#define XB_TOPGEN   3392
#define XCD_BAR_WORDS 3456
#define XB_SPIN_CAP (1u << 18)

__device__ __forceinline__ unsigned xb_ld(unsigned* p)              { return __hip_atomic_load(p, __ATOMIC_RELAXED, __HIP_MEMORY_SCOPE_AGENT); }
__device__ __forceinline__ unsigned xb_add(unsigned* p, unsigned v) { return __hip_atomic_fetch_add(p, v, __ATOMIC_RELAXED, __HIP_MEMORY_SCOPE_AGENT); }
__device__ __forceinline__ unsigned xb_xcc_id() { return (unsigned)__builtin_amdgcn_s_getreg((3 << 11) | 20) & 0xFu; }
#define XB_SPIN(cond, bar) do { unsigned _sp = 0; while (cond) { __builtin_amdgcn_s_sleep(1); \
    if ((++_sp & 255u) == 0u) { if (xb_ld(&(bar)[XB_TMO])) break; if (_sp > XB_SPIN_CAP) { atomicAdd(&(bar)[XB_TMO], 1u); break; } } } } while (0)

struct XcdBarrier {
    unsigned* bar; unsigned x;
    volatile LAS unsigned* st;
};

__device__ __forceinline__ XcdBarrier xcd_barrier_post(unsigned* bar, volatile LAS unsigned* st) {
    XcdBarrier b; b.bar = bar; b.x = xb_xcc_id(); b.st = st;
    if (threadIdx.x == 0) (void)xb_add(&bar[XB_XCNT(b.x)], 1u);
    return b;
}
__device__ __forceinline__ void xcd_barrier_complete(unsigned* bar, unsigned x, unsigned& nloc, unsigned& nx) {
    const unsigned G = gridDim.x * gridDim.y * gridDim.z;
    unsigned sum, cnt, mine, sp = 0u;
    for (;;) {
        sum = 0u; cnt = 0u; mine = 0u;
#pragma unroll
        for (unsigned j = 0; j < 16; ++j) { const unsigned c = xb_ld(&bar[XB_XCNT(j)]); sum += c; cnt += (c > 0u) ? 1u : 0u; mine = (j == x) ? c : mine; }
        if (sum == G) break;
        __builtin_amdgcn_s_sleep(1);
        if ((++sp & 255u) == 0u) { if (xb_ld(&bar[XB_TMO])) break; if (sp > XB_SPIN_CAP) { atomicAdd(&bar[XB_TMO], 1u); break; } }
    }
    nloc = mine > 0u ? mine : 1u; nx = cnt > 0u ? cnt : 1u;
}

__device__ __forceinline__ void xcd_barrier(const XcdBarrier& b) {
    asm volatile("s_waitcnt vmcnt(0)" ::: "memory");
    __syncthreads();
    if (threadIdx.x == 0) {
        unsigned* bar = b.bar;
        __builtin_amdgcn_s_waitcnt(0);
        unsigned nloc = b.st[0], nx = b.st[1];
        if (nloc == 0u) { xcd_barrier_complete(bar, b.x, nloc, nx); b.st[0] = nloc; b.st[1] = nx; }
        const unsigned old = xb_add(&bar[XB_XSUB(b.x)], 1u);
        const unsigned gen = old / nloc;
        if (old + 1u == (gen + 1u) * nloc) {
            __builtin_amdgcn_fence(__ATOMIC_RELEASE, "agent");
            asm volatile("s_waitcnt vmcnt(0)" ::: "memory");
            const unsigned og = xb_add(&bar[XB_TOP], 1u);
            const unsigned tg = og / nx;
            if (og + 1u == (tg + 1u) * nx) xb_add(&bar[XB_TOPGEN], 1u);
            else XB_SPIN(xb_ld(&bar[XB_TOPGEN]) == tg, bar);
            __builtin_amdgcn_fence(__ATOMIC_ACQUIRE, "agent");
            xb_add(&bar[XB_XGEN(b.x)], 1u);
            asm volatile("s_waitcnt vmcnt(0)" ::: "memory");
        } else {
            XB_SPIN(xb_ld(&bar[XB_XGEN(b.x)]) == gen, bar);
            __builtin_amdgcn_fence(__ATOMIC_ACQUIRE, "agent");
            asm volatile("s_waitcnt vmcnt(0)" ::: "memory");
        }
    }
    __syncthreads();
}
#ifndef MK_MULTI
#define MK_MULTI 0
#endif
struct Args { const float* in[14]; float* out; unsigned char* ws; int ph_lo, ph_hi; };
__global__ void __launch_bounds__(512, 2) fox_fwd(Args args) {
    extern __shared__ __attribute__((aligned(16))) unsigned char lds[];
    cg::grid_group grid = cg::this_grid();
    LAS unsigned char* L = (LAS unsigned char*)lds;
    const int G = gridDim.x, bx = blockIdx.x;
    const int vcu = (G % 8 == 0) ? (bx % 8) * (G / 8) + bx / 8 : bx;
    const int NGW = G * 8;
#define IDS() int tid = threadIdx.x; asm volatile("" : "+v"(tid)); const int lane = tid & 63, wave = __builtin_amdgcn_readfirstlane(tid >> 6), gw = vcu * 8 + wave; (void)lane; (void)gw
    Ptrs P;
    P.x = args.in[0]; P.mixg = args.in[1]; P.w_in = args.in[2]; P.b_f = args.in[3]; P.lng = args.in[4]; P.lnb = args.in[5]; P.w_s = args.in[6]; P.b_s = args.in[7];
    P.outg = args.in[8]; P.w_out = args.in[9]; P.ffng = args.in[10]; P.w_gu = args.in[11]; P.w_d = args.in[12]; P.fing = args.in[13]; P.out = args.out; P.ws = args.ws;
    unsigned char* ws = args.ws;
    unsigned* ctl = (unsigned*)(ws + WS_CTL);
    float* wf = (float*)(ws + WS_WF);
    bf16r* WinT = (bf16r*)(ws + WS_WIN); bf16r* WoutT = (bf16r*)(ws + WS_WOUT); bf16r* WguT = (bf16r*)(ws + WS_WGU); bf16r* WdT = (bf16r*)(ws + WS_WD);
    bf16r* XB = (bf16r*)(ws + WS_XB); float* RSTD = (float*)(ws + WS_RSTD); float* LOGF = (float*)(ws + WS_LOGF); float* C2A = (float*)(ws + WS_C2);
    bf16r* QKVZ = (bf16r*)(ws + WS_QKVZ); bf16r* OB = (bf16r*)(ws + WS_O); bf16r* MG = (bf16r*)(ws + WS_MG); bf16r* HB = (bf16r*)(ws + WS_H); bf16r* OP1 = (bf16r*)(ws + WS_OP); float* MLB = (float*)(ws + WS_ML);
    constexpr size_t QS = (size_t)S_ * 512;
    const int lo = args.ph_lo, hi = args.ph_hi;
    { LAS unsigned* misc = (LAS unsigned*)(L + 147456 - 8); if (threadIdx.x < 2) misc[threadIdx.x] = 0u; __syncthreads(); }
    XcdBarrier xbar = xcd_barrier_post(ctl + CW_BAR, (volatile LAS unsigned*)(L + 147456 - 8));
    int ph = 0;
#define RUN() (ph >= lo && ph < hi)
#ifdef PROBE_SYNC
#define SEAM() do { ++ph; if (ph > lo && ph < hi) { if (ph == 1) { grid.sync(); grid.sync(); } else { xcd_barrier(xbar); xcd_barrier(xbar); } } } while (0)
#else
#define SEAM() do { ++ph; if (ph > lo && ph < hi) { if (ph == 1) grid.sync(); else xcd_barrier(xbar); } } while (0)
#endif
#ifdef PROBE_SMALL
#define REPS 2
#else
#define REPS 1
#endif
#ifdef PROBE_ATTN
#define REPA 2
#else
#define REPA 1
#endif

#ifndef NO_P0
    if (RUN()) { IDS(); for (int rp = 0; rp < REPS; ++rp) phase_prep(P, L, gw, NGW, wave, lane); }
#endif
    SEAM();
#ifndef NO_P0
    if (RUN()) { IDS(); for (int rp = 0; rp < REPS; ++rp) phase_rowstats<0>(P.x, XB, RSTD, wf, P.b_f, LOGF, nullptr, nullptr, gw, NGW, lane); }
#endif
    SEAM();
    for (int l = 0; l < NL; ++l) {
#ifndef NO_INPROJ
        if (RUN()) {
            if (bx >= G - NHD) { IDS(); for (int rp = 0; rp < REPS; ++rp) cumsum_head(LOGF, C2A, bx - (G - NHD), L, tid); }
            pg8::Gemm g{XB, WinT + (size_t)l * NIN * DMOD, S_, NIN, DMOD}; pg8::StaticOrder So; So.init(S_, NIN, G, bx);
            pg8::EpiInProj E{QKVZ, QS, RSTD, ctl + CW_KMAX + l * 16};
            pg8::gemm_phase<pg8::EpiInProj, pg8::StaticOrder, true, true>(L, g, So, E);
        }
#endif
        SEAM();
#ifndef NO_ATTN
        if (RUN()) {
            IDS(); LAS unsigned* bc = (LAS unsigned*)(L + 147456 - 64);
            for (int rp = 0; rp < REPA; ++rp)
            for (int qi = 0; qi < NHD; ++qi) { const int h = (bx + qi) & 7;
                const float kn = sqrtf((__uint_as_float(ctl[CW_KMAX + l * 16 + 2 * h]) + __uint_as_float(ctl[CW_KMAX + l * 16 + 2 * h + 1])) * 1.02f);
                for (;;) {
                    if (tid == 0) bc[0] = atomicAdd(ctl + ((rp * NL + l) * NHD + h) * 64, 1u);
                    __syncthreads(); const unsigned u = bc[0]; __syncthreads();
                    if (u >= 160u) break;
                    int qb, jc;
                    if (u < 64u) { qb = 63 - (int)(u >> 2); jc = (int)(u & 3u); } else if (u < 112u) { const int v = (int)u - 64; qb = 47 - v / 3; jc = v % 3; }
                    else if (u < 144u) { const int v = (int)u - 112; qb = 31 - (v >> 1); jc = v & 1; } else { qb = 15 - ((int)u - 144); jc = 0; }
                    attn_body::fox_unit2<8>(h, qb, jc, kn, (const attn_body::bf16*)QKVZ, (const attn_body::bf16*)(QKVZ + QS), (const attn_body::bf16*)(QKVZ + 2 * QS),
                                            (attn_body::bf16*)(jc == 0 ? OB : OP1 + (size_t)(jc - 1) * QS), MLB + (size_t)jc * S_ * 16, C2A + (size_t)h * S_, (char*)lds, (float*)(lds + 147456 - 48));
                } }
        }
#endif
        SEAM();
#ifndef NO_MERGE
        if (RUN()) {
            IDS(); for (int rp = 0; rp < REPS; ++rp) for (int it = vcu; it < 2 * (S_ / 128); it += G) {
                if (it < S_ / 128) sgu_item(it, QKVZ + 3 * QS, QKVZ + 4 * QS, MG, P.lng + l * 512, P.lnb + l * 512, P.w_s + (size_t)l * 8 * 128 * 128, P.b_s + l * 8 * 128, L, wave, lane);
                else combine_item(it - S_ / 128, OB, OP1, MLB, MG, wave, lane); }
        }
#endif
        SEAM();
#ifndef NO_OUTPROJ
        if (RUN()) {
            pg8::Gemm g{MG, WoutT + (size_t)l * DMOD * DMOD, S_, DMOD, DMOD}; pg8::StaticOrder So; So.init(S_, DMOD, G, bx);
            pg8::EpiResid E{l == 0 ? P.x : P.out, P.out};
            pg8::gemm_phase<pg8::EpiResid, pg8::StaticOrder, true, true>(L, g, So, E);
        }
#endif
        SEAM();
#ifndef NO_RS1
        if (RUN()) { IDS(); for (int rp = 0; rp < REPS; ++rp) phase_rowstats<1>(P.out, XB, RSTD, nullptr, nullptr, nullptr, nullptr, nullptr, gw, NGW, lane); }
#endif
        SEAM();
#ifndef NO_GU
        if (RUN()) {
            pg8::Gemm g{XB, WguT + (size_t)l * NGU * DMOD, S_, NGU, DMOD}; pg8::StaticOrder So; So.init(S_, NGU, G, bx);
            pg8::EpiSwiGLU E{HB, RSTD};
            pg8::gemm_phase<pg8::EpiSwiGLU, pg8::StaticOrder, true, true>(L, g, So, E);
        }
#endif
        SEAM();
#ifndef NO_DOWN
        if (RUN()) {
            pg8::Gemm g{HB, WdT + (size_t)l * DMOD * DFF, S_, DMOD, DFF}; pg8::StaticOrder So; So.init(S_, DMOD, G, bx);
            pg8::EpiResid E{P.out, P.out};
            pg8::gemm_phase<pg8::EpiResid, pg8::StaticOrder, true, true>(L, g, So, E);
        }
#endif
        SEAM();
#ifndef NO_RSN
        if (RUN()) { IDS();
            if (l + 1 < NL) for (int rp = 0; rp < REPS; ++rp) phase_rowstats<0>(P.out, XB, RSTD, wf + (size_t)(l + 1) * 8 * DMOD, P.b_f + (l + 1) * 8, LOGF, nullptr, nullptr, gw, NGW, lane);
            else phase_rowstats<2>(P.out, nullptr, nullptr, nullptr, nullptr, nullptr, P.fing, P.out, gw, NGW, lane);
        }
#endif
        SEAM();
    }
#undef RUN
#undef SEAM
}

extern "C" void kernel_launch(void* const* d_in, const int* in_sizes, int n_in, void* d_out, int out_size, void* d_ws, size_t ws_size, hipStream_t stream) {
    static int grid = 0;
    if (grid == 0) {
        if (n_in != 14 || out_size != S_ * DMOD || ws_size < WS_END) { fprintf(stderr, "kernel_launch: unexpected shapes (n_in %d out %d ws %zu)\n", n_in, out_size, ws_size); grid = -1; return; }
        int dev = 0, cus = 0, per_cu = 0;
        hipGetDevice(&dev); hipDeviceGetAttribute(&cus, hipDeviceAttributeMultiprocessorCount, dev);
        if (hipFuncSetAttribute((const void*)fox_fwd, hipFuncAttributeMaxDynamicSharedMemorySize, LDS_BYTES) != hipSuccess) { fprintf(stderr, "kernel_launch: hipFuncSetAttribute failed\n"); grid = -1; return; }
        if (hipOccupancyMaxActiveBlocksPerMultiprocessor(&per_cu, (const void*)fox_fwd, 512, LDS_BYTES) != hipSuccess || per_cu < 1) { fprintf(stderr, "kernel_launch: occupancy query says %d\n", per_cu); per_cu = 1; }
        (void)hipGetLastError();
        grid = cus * per_cu;
        fprintf(stderr, "kernel_launch: grid %d (cus %d x %d)\n", grid, cus, per_cu);
    }
    if (grid < 0) return;
    hipMemsetAsync((char*)d_ws + WS_CTL, 0, CTL_BYTES, stream);
    Args a{};
    for (int i = 0; i < 14; ++i) a.in[i] = (const float*)d_in[i];
    a.out = (float*)d_out; a.ws = (unsigned char*)d_ws;
#if MK_MULTI
    for (int p = 0; p < NPHASE; ++p) { a.ph_lo = p; a.ph_hi = p + 1; hipLaunchKernelGGL(fox_fwd, dim3(grid), dim3(512), LDS_BYTES, stream, a); }
#else
    a.ph_lo = 0; a.ph_hi = NPHASE;
    void* kargs[] = {&a};
    hipError_t e = hipLaunchCooperativeKernel((const void*)fox_fwd, dim3(grid), dim3(512), kargs, LDS_BYTES, stream);
    if (e != hipSuccess) fprintf(stderr, "kernel_launch: cooperative launch failed: %s (grid %d)\n", hipGetErrorString(e), grid);
#endif
}
```

```cpp
#define MK_MULTI 0
#include <hip/hip_runtime.h>
#include <hip/hip_cooperative_groups.h>
#include <cstdio>
#include <cstdint>
namespace pg8 {
#define PG8_LAS __attribute__((address_space(3)))
typedef unsigned short bf16_t;
typedef short bf16x8 __attribute__((ext_vector_type(8)));
typedef float f32x4 __attribute__((ext_vector_type(4)));
typedef unsigned u32x4 __attribute__((ext_vector_type(4)));
constexpr int BM = 256, BK = 64, HALF = 128, HTB = HALF * BK * 2  , STAGE_BYTES = 8 * HTB, NXCD = 8, WGM = 8;

__host__ __device__ __forceinline__ int lds_byte(int r, int c) { const int st = (r >> 4) * 2 + (c >> 5), rr = r & 15, cc = c & 31, ob = rr * 64 + cc * 2; return st * 1024 + (ob ^ (((ob >> 9) & 1) << 5)); }
__host__ __device__ __forceinline__ void stage_rc(int b, int& R, int& C) { const int st = b / 1024, sb = b % 1024, swz = sb ^ (((sb >> 9) & 1) << 5); R = (st >> 1) * 16 + swz / 64; C = (st & 1) * 32 + (swz % 64) / 2; }
__host__ __device__ __forceinline__ int perm32(int rho) { const int n = rho >> 4, i = rho & 15; return 8 * (i >> 2) + 4 * n + (i & 3); }

struct Unit { int pm, pn; };
struct Gemm { const bf16_t* A; const bf16_t* Bt; int M, N, K; };

struct StaticOrder {
    int nM, nN, nwg, G, c;
    __host__ __device__ void init(int M, int N, int G_, int c_) { nM = M / BM; nN = N / BM; nwg = nM * nN; G = G_; c = c_; }
    __host__ __device__ bool next(int i, Unit& u) const {
        const long L = (long)i * G + c; if (L >= nwg) return false;
        int wgid = (int)L; { const int q = nwg / NXCD, r = nwg % NXCD, xcd = wgid % NXCD, off = wgid / NXCD; wgid = (xcd < r ? xcd * (q + 1) : r * (q + 1) + (xcd - r) * q) + off; }
        const int nig = WGM * nN, gid = wgid / nig, fm = gid * WGM, gsz = (nM - fm) < WGM ? (nM - fm) : WGM;
        u.pm = fm + ((wgid % nig) % gsz); u.pn = (wgid % nig) / gsz; return true;
    }
    __device__ __forceinline__ void a_ready(const Unit&) const {}
    __device__ __forceinline__ void done(const Unit&) const {}
};

__device__ __forceinline__ unsigned cvt_pk_bf16(float lo, float hi) { unsigned r; asm volatile("v_cvt_pk_bf16_f32 %0, %1, %2" : "=v"(r) : "v"(lo), "v"(hi)); return r; }
typedef float f32x2 __attribute__((ext_vector_type(2)));
__device__ __forceinline__ f32x2 gelu_pk(f32x2 v) {
    const f32x2 av = __builtin_elementwise_abs(v), d = av * 0.2316418882f + 1.0f;
    f32x2 t; t.x = __builtin_amdgcn_rcpf(d.x); t.y = __builtin_amdgcn_rcpf(d.y);
    f32x2 q = t * 0.5307027145f + (-0.7265760135f); q = q * t + 0.7107068705f; q = q * t + (-0.142248368f); q = q * t + 0.127414796f; q = q * t;
    const f32x2 s = (v * v) * (-0.72134752044f);
    f32x2 e; e.x = __builtin_amdgcn_exp2f(s.x); e.y = __builtin_amdgcn_exp2f(s.y);
    const f32x2 m = v * (q * e), r = v - m;
    f32x2 o; o.x = v.x < 0.f ? m.x : r.x; o.y = v.y < 0.f ? m.y : r.y; return o;
}
constexpr float C2Q = 0.125f * 1.4426950408889634f;
constexpr float RSS_INV = 1.0f / (1024.0f * 16777216.0f);
struct EpiInProj {
    static constexpr bool PERM = true, AFTER_DRAIN = false;
    bf16_t* O; size_t split_stride; const unsigned long long* rss; unsigned* kmax; const float* bfv; float* logf;
    __device__ __forceinline__ void operator()(const f32x4 (&acc)[2][2][4][2], const Unit& u, int wr, int wc, int fr, int fq) const {
        if (u.pn == 10) {
            if (wc == 0 && fq == 0) {
#pragma unroll
                for (int ai = 0; ai < 2; ++ai)
#pragma unroll
                    for (int m = 0; m < 4; ++m) { const int row = u.pm * BM + wr * 64 + fr + ai * HALF + m * 16; const float rs = __builtin_amdgcn_rsqf((float)rss[row] * RSS_INV + 1e-6f);
#pragma unroll
                        for (int n = 0; n < 2; ++n)
#pragma unroll
                            for (int e = 0; e < 4; ++e) { const float z = (acc[ai][0][m][n][e] + acc[ai][1][m][n][e]) * rs + bfv[4 * n + e];
                                logf[(size_t)(4 * n + e) * 16384 + row] = fminf(z, 0.f) - 0.6931471805599453f * __builtin_amdgcn_logf(1.0f + __builtin_amdgcn_exp2f(-1.4426950408889634f * fabsf(z))); } } }
            return; }
        const int t = u.pn >> 1; float kmx[2] = {0.f, 0.f}; bf16_t* base = O + (size_t)t * split_stride;
        const int row0 = u.pm * BM + wr * 64 + fr, col0 = (u.pn & 1) * 256 + wc * 32 + 8 * fq;
        const float s0 = (t == 0) ? C2Q : 1.0f;
#pragma unroll
        for (int ai = 0; ai < 2; ++ai)
#pragma unroll
            for (int m = 0; m < 4; ++m) { const int row = row0 + ai * HALF + m * 16; const float rs = __builtin_amdgcn_rsqf((float)rss[row] * RSS_INV + 1e-6f) * s0; bf16_t* rowp = base + (size_t)row * 512 + col0;
#pragma unroll
                for (int bj = 0; bj < 2; ++bj) { f32x4 v0 = acc[ai][bj][m][0] * rs, v1 = acc[ai][bj][m][1] * rs;
                    if (t == 1) { const f32x4 q0 = v0 * v0, q1 = v1 * v1; float sq = ((q0[0] + q0[1]) + (q0[2] + q0[3])) + ((q1[0] + q1[1]) + (q1[2] + q1[3])); sq += __shfl_xor(sq, 16); sq += __shfl_xor(sq, 32); kmx[bj] = fmaxf(kmx[bj], sq); }
                    if (t >= 3) { f32x2 a = gelu_pk((f32x2){v0[0], v0[1]}), b = gelu_pk((f32x2){v0[2], v0[3]}), c = gelu_pk((f32x2){v1[0], v1[1]}), d = gelu_pk((f32x2){v1[2], v1[3]});
                        v0 = (f32x4){a.x, a.y, b.x, b.y}; v1 = (f32x4){c.x, c.y, d.x, d.y}; }
                    u32x4 w; w.x = cvt_pk_bf16(v0[0], v0[1]); w.y = cvt_pk_bf16(v0[2], v0[3]); w.z = cvt_pk_bf16(v1[0], v1[1]); w.w = cvt_pk_bf16(v1[2], v1[3]);
                    *(u32x4*)(rowp + bj * HALF) = w; } }
        if (t == 1) {
#pragma unroll
            for (int bj = 0; bj < 2; ++bj) { float v = kmx[bj]; v = fmaxf(v, __shfl_xor(v, 1)); v = fmaxf(v, __shfl_xor(v, 2)); v = fmaxf(v, __shfl_xor(v, 4)); v = fmaxf(v, __shfl_xor(v, 8));
                if (fr == 0 && fq == 0) atomicMax(kmax + ((u.pn & 1) * 4 + bj * 2 + (wc >> 1)) * 2 + (wc & 1), __float_as_uint(v)); } }
    }
};
struct EpiResid {
    static constexpr bool PERM = false, AFTER_DRAIN = false;
    const float* base; float* out; bf16_t* xb; unsigned long long* rss;
    __device__ __forceinline__ void operator()(const f32x4 (&acc)[2][2][4][2], const Unit& u, int wr, int wc, int fr, int fq) const {
        typedef unsigned u32x2v __attribute__((ext_vector_type(2)));
        const int col0 = u.pn * BM + wc * 32 + 4 * fq;
#pragma unroll
        for (int ai = 0; ai < 2; ++ai)
#pragma unroll
            for (int m = 0; m < 4; ++m) { const int row = u.pm * BM + ai * HALF + wr * 64 + m * 16 + fr; const size_t off = (size_t)row * 1024 + col0; float sq = 0.f;
#pragma unroll
                for (int bj = 0; bj < 2; ++bj)
#pragma unroll
                    for (int n = 0; n < 2; ++n) { const f32x4 b = *(const f32x4*)(base + off + bj * HALF + n * 16); const f32x4 o = b + acc[ai][bj][m][n]; *(f32x4*)(out + off + bj * HALF + n * 16) = o;
                        u32x2v w; w.x = cvt_pk_bf16(o[0], o[1]); w.y = cvt_pk_bf16(o[2], o[3]); *(u32x2v*)(xb + off + bj * HALF + n * 16) = w;
                        sq += (o[0] * o[0] + o[1] * o[1]) + (o[2] * o[2] + o[3] * o[3]); }
                sq += __shfl_xor(sq, 16); sq += __shfl_xor(sq, 32);
                if (fq == 0) { const unsigned long long qv = (unsigned long long)__float2ull_rn(sq * 16777216.0f);
#ifdef PROBE_ATOM
                    atomicAdd(rss + row, qv >> 1); atomicAdd(rss + row, qv - (qv >> 1));
#else
                    atomicAdd(rss + row, qv);
#endif
                } }
    }
};
struct EpiSwiGLU {
    static constexpr bool PERM = true, AFTER_DRAIN = false;
    bf16_t* H; const unsigned long long* rss;
    __device__ __forceinline__ void operator()(const f32x4 (&acc)[2][2][4][2], const Unit& u, int wr, int wc, int fr, int fq) const {
        const int row0 = u.pm * BM + wr * 64 + fr, col0 = u.pn * 128 + wc * 32 + 8 * fq;
#pragma unroll
        for (int ai = 0; ai < 2; ++ai)
#pragma unroll
            for (int m = 0; m < 4; ++m) { const int row = row0 + ai * HALF + m * 16; const float rs = __builtin_amdgcn_rsqf((float)rss[row] * RSS_INV + 1e-6f);
                float hv[8];
#pragma unroll
                for (int n = 0; n < 2; ++n)
#pragma unroll
                    for (int e = 0; e < 4; ++e) { const float g = acc[ai][0][m][n][e] * rs, up = acc[ai][1][m][n][e] * rs;
                        const float sg = __builtin_amdgcn_rcpf(1.0f + __builtin_amdgcn_exp2f(-1.4426950408889634f * g)); hv[n * 4 + e] = g * sg * up; }
                u32x4 w; w.x = cvt_pk_bf16(hv[0], hv[1]); w.y = cvt_pk_bf16(hv[2], hv[3]); w.z = cvt_pk_bf16(hv[4], hv[5]); w.w = cvt_pk_bf16(hv[6], hv[7]);
                *(u32x4*)(H + (size_t)row * 2816 + col0) = w; }
    }
};
template <class Epi, class Sched, bool ALIGN_EPI = false, bool SP2 = false>
__device__ __forceinline__ void gemm_phase(PG8_LAS unsigned char* lds, const Gemm g, const Sched& S, const Epi& E) {
    int tid = threadIdx.x; asm volatile("" : "+v"(tid));
    const int wid = __builtin_amdgcn_readfirstlane(tid >> 6), lane = tid & 63, wr = wid >> 2, wc = wid & 3, fr = lane & 15, fq = lane >> 4;
    const int K = g.K, nt = K / BK;
    unsigned voffA[2], voffB[2];
#pragma unroll
    for (int i = 0; i < 2; ++i) { int R, C; stage_rc(tid * 16 + i * 8192, R, C); const int Rb = Epi::PERM ? ((R & ~31) + perm32(R & 31)) : R;
        voffA[i] = (unsigned)(R * K + C) * 2u; voffB[i] = (unsigned)(Rb * K + C) * 2u; }
    const size_t kstep = (size_t)(BK * 2);
    const size_t hstep = (size_t)HALF * K * 2;
    const size_t tstep = 2 * hstep;
    const unsigned ldsw = (unsigned)wid * 1024u;
    const int aoff = lds_byte(wr * 64 + fr, fq * 8), boff = lds_byte(wc * 32 + fr, fq * 8);
#define PG8_SA(b, h) (((b) * 2 + (h)) * HTB)
#define PG8_SB(b, h) ((4 + (b) * 2 + (h)) * HTB)
#define PG8_STAGE(bufoff, gbase, voff) do { _Pragma("unroll") for (int _i = 0; _i < 2; ++_i) \
        __builtin_amdgcn_global_load_lds((const unsigned*)((const char*)(gbase) + (voff)[_i]), (PG8_LAS unsigned*)(lds + (bufoff) + ldsw + _i * 8192), 16, 0, 0); } while (0)
#define PG8_LDA(dst, b, h) do { _Pragma("unroll") for (int m = 0; m < 4; ++m) _Pragma("unroll") for (int k = 0; k < 2; ++k) dst[m][k] = *(const PG8_LAS bf16x8*)(lds + PG8_SA(b, h) + aoff + m * 2048 + k * 1024); } while (0)
#define PG8_LDB(dst, b, h) do { _Pragma("unroll") for (int n = 0; n < 2; ++n) _Pragma("unroll") for (int k = 0; k < 2; ++k) dst[n][k] = *(const PG8_LAS bf16x8*)(lds + PG8_SB(b, h) + boff + n * 2048 + k * 1024); } while (0)
#define PG8_MMA(ai, bj, At, Bt) do { __builtin_amdgcn_s_setprio(1); _Pragma("unroll") for (int m = 0; m < 4; ++m) _Pragma("unroll") for (int n = 0; n < 2; ++n) _Pragma("unroll") for (int k = 0; k < 2; ++k) \
        acc[ai][bj][m][n] = __builtin_amdgcn_mfma_f32_16x16x32_bf16(Bt[n][k], At[m][k], acc[ai][bj][m][n], 0, 0, 0); __builtin_amdgcn_s_setprio(0); } while (0)
#define PG8_WAIT_V(n) asm volatile("s_waitcnt vmcnt(" #n ")" ::: "memory")
#define PG8_WAIT_L(n) asm volatile("s_waitcnt lgkmcnt(" #n ")" ::: "memory")
#define PG8_BAR __builtin_amdgcn_s_barrier()
#define PG8_SCHED __builtin_amdgcn_sched_barrier(0)
    Unit cur, nxt; int ui = 0;
    if (!S.next(0, cur)) return;
    f32x4 acc[2][2][4][2];
#pragma unroll
    for (int a = 0; a < 2; ++a)
#pragma unroll
        for (int b = 0; b < 2; ++b)
#pragma unroll
            for (int m = 0; m < 4; ++m)
#pragma unroll
                for (int n = 0; n < 2; ++n) acc[a][b][m][n] = (f32x4){0.f, 0.f, 0.f, 0.f};
    bf16x8 At[4][2], B0[2][2], B1[2][2];
    const char* cA = (const char*)g.A + (size_t)cur.pm * tstep; const char* cB = (const char*)g.Bt + (size_t)cur.pn * tstep;
    S.a_ready(cur);
    if constexpr (SP2) {
        PG8_STAGE(PG8_SB(0, 0), cB, voffB); PG8_STAGE(PG8_SB(0, 1), cB + hstep, voffB); PG8_STAGE(PG8_SA(0, 0), cA, voffA); PG8_STAGE(PG8_SA(0, 1), cA + hstep, voffA);
        if (wr == 1) PG8_BAR;
        PG8_WAIT_V(2); PG8_BAR;
        PG8_STAGE(PG8_SB(1, 0), cB + kstep, voffB); PG8_STAGE(PG8_SA(1, 0), cA + kstep, voffA); PG8_STAGE(PG8_SB(1, 1), cB + hstep + kstep, voffB);
        PG8_WAIT_V(6); PG8_BAR;
    } else {
        PG8_STAGE(PG8_SB(0, 0), cB, voffB); PG8_STAGE(PG8_SA(0, 0), cA, voffA); PG8_STAGE(PG8_SB(0, 1), cB + hstep, voffB); PG8_STAGE(PG8_SA(0, 1), cA + hstep, voffA);
        if (wr == 1) PG8_BAR;
        PG8_WAIT_V(4); PG8_BAR;
        PG8_STAGE(PG8_SB(1, 0), cB + kstep, voffB); PG8_STAGE(PG8_SA(1, 0), cA + kstep, voffA); PG8_STAGE(PG8_SB(1, 1), cB + hstep + kstep, voffB);
        PG8_WAIT_V(6); PG8_BAR;
    }
    for (;;) {
        const bool has_next = S.next(ui + 1, nxt);
        const char* nA = has_next ? (const char*)g.A + (size_t)nxt.pm * tstep : cA; const char* nB = has_next ? (const char*)g.Bt + (size_t)nxt.pn * tstep : cB;
        for (int t = 0; t < nt; t += 2) {
            const bool last = (t == nt - 2);
            const char* a1 = cA + (size_t)(t + 1) * kstep;
            const char* a2 = last ? nA : cA + (size_t)(t + 2) * kstep; const char* b2 = last ? nB : cB + (size_t)(t + 2) * kstep;
            const char* a3 = a2 + kstep; const char* b3 = b2 + kstep;
            if (last && has_next) S.a_ready(nxt);
            if constexpr (SP2) {
            PG8_LDB(B0, 0, 0); PG8_LDB(B1, 0, 1); PG8_SCHED; PG8_LDA(At, 0, 0); PG8_STAGE(PG8_SA(1, 1), a1 + hstep, voffA);
            PG8_WAIT_V(8); PG8_WAIT_L(0); PG8_BAR; PG8_MMA(0, 0, At, B0); PG8_MMA(0, 1, At, B1); PG8_BAR; PG8_SCHED;
            PG8_LDA(At, 0, 1); PG8_STAGE(PG8_SB(0, 0), b2, voffB); PG8_STAGE(PG8_SB(0, 1), b2 + hstep, voffB); PG8_STAGE(PG8_SA(0, 0), a2, voffA);
            PG8_WAIT_V(8); PG8_WAIT_L(0); PG8_BAR; PG8_MMA(1, 0, At, B0); PG8_MMA(1, 1, At, B1); PG8_BAR; PG8_SCHED;
            PG8_LDB(B0, 1, 0); PG8_LDB(B1, 1, 1); PG8_SCHED; PG8_LDA(At, 1, 0); PG8_STAGE(PG8_SA(0, 1), a2 + hstep, voffA);
            PG8_WAIT_V(8); PG8_WAIT_L(0); PG8_BAR; PG8_MMA(0, 0, At, B0); PG8_MMA(0, 1, At, B1); PG8_BAR; PG8_SCHED;
            PG8_LDA(At, 1, 1); PG8_STAGE(PG8_SB(1, 0), b3, voffB); PG8_STAGE(PG8_SB(1, 1), b3 + hstep, voffB); PG8_STAGE(PG8_SA(1, 0), a3, voffA);
            PG8_WAIT_V(8); PG8_WAIT_L(0); PG8_BAR; PG8_MMA(1, 0, At, B0); PG8_MMA(1, 1, At, B1); PG8_BAR; PG8_SCHED;
            } else {
            PG8_LDB(B0, 0, 0); PG8_SCHED; PG8_LDA(At, 0, 0); PG8_STAGE(PG8_SA(1, 1), a1 + hstep, voffA);
            PG8_WAIT_L(8); PG8_BAR; PG8_WAIT_L(0); PG8_MMA(0, 0, At, B0); PG8_BAR; PG8_SCHED;
            PG8_LDB(B1, 0, 1); PG8_STAGE(PG8_SB(0, 0), b2, voffB);
            PG8_BAR; PG8_WAIT_L(0); PG8_MMA(0, 1, At, B1); PG8_BAR;
            PG8_LDA(At, 0, 1); PG8_STAGE(PG8_SA(0, 0), a2, voffA);
            PG8_BAR; PG8_WAIT_L(0); PG8_MMA(1, 0, At, B0); PG8_BAR; PG8_SCHED;
            PG8_STAGE(PG8_SB(0, 1), b2 + hstep, voffB);
            PG8_WAIT_V(6); PG8_BAR; PG8_MMA(1, 1, At, B1); PG8_BAR;
            PG8_LDB(B0, 1, 0); PG8_SCHED; PG8_LDA(At, 1, 0); PG8_STAGE(PG8_SA(0, 1), a2 + hstep, voffA);
            PG8_WAIT_L(8); PG8_BAR; PG8_WAIT_L(0); PG8_MMA(0, 0, At, B0); PG8_BAR; PG8_SCHED;
            PG8_LDB(B1, 1, 1); PG8_STAGE(PG8_SB(1, 0), b3, voffB);
            PG8_BAR; PG8_WAIT_L(0); PG8_MMA(0, 1, At, B1); PG8_BAR;
            PG8_LDA(At, 1, 1); PG8_STAGE(PG8_SA(1, 0), a3, voffA);
            PG8_BAR; PG8_WAIT_L(0); PG8_MMA(1, 0, At, B0); PG8_BAR; PG8_SCHED;
            PG8_STAGE(PG8_SB(1, 1), b3 + hstep, voffB);
            PG8_WAIT_V(6); PG8_BAR; PG8_MMA(1, 1, At, B1); PG8_BAR;
            }
        }
        if constexpr (ALIGN_EPI) { if (wr == 0) PG8_BAR; }
        if constexpr (!Epi::AFTER_DRAIN) { E(acc, cur, wr, wc, fr, fq); S.done(cur); }
        if (!has_next) break;
#pragma unroll
        for (int a = 0; a < 2; ++a)
#pragma unroll
            for (int b = 0; b < 2; ++b)
#pragma unroll
                for (int m = 0; m < 4; ++m)
#pragma unroll
                    for (int n = 0; n < 2; ++n) acc[a][b][m][n] = (f32x4){0.f, 0.f, 0.f, 0.f};
        cur = nxt; cA = nA; cB = nB; ++ui;
        if constexpr (ALIGN_EPI) { if (wr == 1) PG8_BAR; }
    }
    PG8_WAIT_V(0);
    if constexpr (!ALIGN_EPI) { if (wr == 0) PG8_BAR; }
    PG8_BAR;
    if constexpr (Epi::AFTER_DRAIN) { E.fused(acc, cur, wr, wc, fr, fq, lds, wid, lane); S.done(cur); }
#undef PG8_SA
#undef PG8_SB
#undef PG8_STAGE
#undef PG8_LDA
#undef PG8_LDB
#undef PG8_MMA
#undef PG8_WAIT_V
#undef PG8_WAIT_L
#undef PG8_BAR
#undef PG8_SCHED
}
}
#include <hip/hip_bf16.h>
#include <cmath>
namespace attn_body {
using bf16=__hip_bfloat16;
using bf16x8=__attribute__((ext_vector_type(8)))short;
using s16x4=__attribute__((ext_vector_type(4)))short;
using f32x16=__attribute__((ext_vector_type(16)))float;
using u32x4=__attribute__((ext_vector_type(4)))unsigned;
constexpr int BATCH=1,NHEAD=8,SEQ=16384,D=64,DM=NHEAD*D;
constexpr int NW=8,QBLK=32,QB=QBLK*NW,KVBLK=64,NQB=SEQ/QB;
constexpr int ATTN_PITCH=DM, ATTN_UNIT_ROWS=QB;
__device__ __forceinline__ int crow(int r,int hi){return (r&3)+8*(r>>2)+4*hi;}
#define SBAR() __builtin_amdgcn_sched_barrier(0)
__device__ __forceinline__ void cmask(f32x16&p0,f32x16&p1,int jb,int qrel,int hi){
  const float NEG=-INFINITY; int kb=64*jb+4*hi;
  #pragma unroll
  for(int r=0;r<16;++r){int kv=kb+(r&3)+8*(r>>2); if(kv>qrel)p0[r]=NEG; if(kv+32>qrel)p1[r]=NEG;}
}

constexpr int NSLOT=3, SLOTB=8192;
constexpr int LDS_K=0, LDS_V=NSLOT*SLOTB, LDS_WS=2*NSLOT*SLOTB, LDS_OST=LDS_WS+NW*64*4, LDS_BYTES=LDS_OST+NW*4096;
constexpr float C2=0.125f*1.4426950408889634f;
__device__ __forceinline__ void glds16(const void*gsrc,unsigned lds_dst){unsigned keep;
  asm volatile("s_mov_b32 %0, m0\n\ts_mov_b32 m0, %2\n\ts_nop 0\n\tglobal_load_lds_dwordx4 %1, off\n\ts_mov_b32 m0, %0":"=&s"(keep):"v"(gsrc),"s"(lds_dst):"memory");}
__device__ __forceinline__ float max3f(float a,float b,float c){float r;asm("v_max3_f32 %0, %1, %2, %3":"=v"(r):"v"(a),"v"(b),"v"(c));return r;}
__device__ __forceinline__ float max2f(float a,float b){float r;asm("v_max_f32_e32 %0, %1, %2":"=v"(r):"v"(a),"v"(b));return r;}
__device__ __forceinline__ float fadd_s(float a,float b){float r;asm("v_add_f32_e32 %0, %1, %2":"=v"(r):"v"(a),"v"(b));return r;}
__device__ __forceinline__ float fsub_s(float a,float b){float r;asm("v_sub_f32_e32 %0, %1, %2":"=v"(r):"v"(a),"v"(b));return r;}
typedef float f32x2_t __attribute__((ext_vector_type(2))); typedef __bf16 bf16x2_t __attribute__((ext_vector_type(2)));
__device__ __forceinline__ unsigned cvtpk_s(float lo,float hi){f32x2_t v={lo,hi};bf16x2_t b=__builtin_convertvector(v,bf16x2_t);return __builtin_bit_cast(unsigned,b);}
#define WAIT_BAR(N) asm volatile("s_waitcnt vmcnt(" #N ") lgkmcnt(0)\n\ts_barrier":::"memory")

__device__ __forceinline__ void qkt(f32x16&p0,f32x16&p1,const char*Kslot,const bf16x8*qr,const f32x16&negm,int r32,int hi){
  const char*kb=Kslot+hi*1024+r32*16;
  #pragma unroll
  for(int d0=0;d0<4;++d0){
    const bf16x8 b0=*reinterpret_cast<const bf16x8*>(kb+d0*2048);
    const bf16x8 b1=*reinterpret_cast<const bf16x8*>(kb+d0*2048+512);
    if(d0==0){p0=__builtin_amdgcn_mfma_f32_32x32x16_bf16(b0,qr[0],negm,0,0,0);p1=__builtin_amdgcn_mfma_f32_32x32x16_bf16(b1,qr[0],negm,0,0,0);}
    else{p0=__builtin_amdgcn_mfma_f32_32x32x16_bf16(b0,qr[d0],p0,0,0,0);p1=__builtin_amdgcn_mfma_f32_32x32x16_bf16(b1,qr[d0],p1,0,0,0);}}
}
typedef __attribute__((address_space(3))) const char* lds_cptr;
typedef short v4i16_t __attribute__((ext_vector_type(4)));
__device__ __forceinline__ void kload8(bf16x8*kf,lds_cptr kp){
  kf[0]=*(const __attribute__((address_space(3))) bf16x8*)(kp);      kf[1]=*(const __attribute__((address_space(3))) bf16x8*)(kp+512);
  kf[2]=*(const __attribute__((address_space(3))) bf16x8*)(kp+2048); kf[3]=*(const __attribute__((address_space(3))) bf16x8*)(kp+2560);
  kf[4]=*(const __attribute__((address_space(3))) bf16x8*)(kp+4096); kf[5]=*(const __attribute__((address_space(3))) bf16x8*)(kp+4608);
  kf[6]=*(const __attribute__((address_space(3))) bf16x8*)(kp+6144); kf[7]=*(const __attribute__((address_space(3))) bf16x8*)(kp+6656);
}
__device__ __forceinline__ void kload2(bf16x8*kf,lds_cptr kp,int j){ kf[2*j]=*(const __attribute__((address_space(3))) bf16x8*)(kp+j*2048); kf[2*j+1]=*(const __attribute__((address_space(3))) bf16x8*)(kp+j*2048+512); }
__device__ __forceinline__ s16x4 vtr(lds_cptr p){ return __builtin_bit_cast(s16x4,__builtin_amdgcn_ds_read_tr16_b64_v4i16((__attribute__((address_space(3))) v4i16_t*)p)); }
__device__ __forceinline__ float rowmax(const f32x16&p0,const f32x16&p1){
  float a=max3f(p0[0],p0[1],p1[0]),b=max3f(p0[2],p0[3],p1[1]);a=max3f(a,p1[2],p1[3]);
  #pragma unroll
  for(int r=4;r<16;r+=4){a=max3f(a,p0[r],p0[r+1]);b=max3f(b,p0[r+2],p0[r+3]);a=max3f(a,p1[r],p1[r+1]);b=max3f(b,p1[r+2],p1[r+3]);}
  const float m=max2f(a,b);
  auto rr=__builtin_amdgcn_permlane32_swap(__float_as_uint(m),__float_as_uint(m),false,false);
  return max2f(__uint_as_float(rr[0]),__uint_as_float(rr[1]));
}
__device__ __forceinline__ void pv(f32x16*o,int vb,bf16x8 pa0,bf16x8 pa1,bf16x8 pa2,bf16x8 pa3){
  #pragma unroll
  for(int d0=0;d0<2;++d0){s16x4 lo[4],hi[4];
    #pragma unroll
    for(int ks=0;ks<4;++ks){
      asm volatile("ds_read_b64_tr_b16 %0,%1 offset:%c2":"=&v"(lo[ks]):"v"(vb),"i"(d0*4096+ks*1024):"memory");
      asm volatile("ds_read_b64_tr_b16 %0,%1 offset:%c2":"=&v"(hi[ks]):"v"(vb),"i"(d0*4096+ks*1024+512):"memory");}
    asm volatile("s_waitcnt lgkmcnt(0)":::"memory");SBAR();
    #define PK(k) (bf16x8){lo[k][0],lo[k][1],lo[k][2],lo[k][3],hi[k][0],hi[k][1],hi[k][2],hi[k][3]}
    o[d0]=__builtin_amdgcn_mfma_f32_32x32x16_bf16(pa0,PK(0),o[d0],0,0,0);
    o[d0]=__builtin_amdgcn_mfma_f32_32x32x16_bf16(pa1,PK(1),o[d0],0,0,0);
    o[d0]=__builtin_amdgcn_mfma_f32_32x32x16_bf16(pa2,PK(2),o[d0],0,0,0);
    o[d0]=__builtin_amdgcn_mfma_f32_32x32x16_bf16(pa3,PK(3),o[d0],0,0,0);
    #undef PK
  }
}
typedef float f32x4_t __attribute__((ext_vector_type(4)));

#ifndef ATTN_STORE16
#define ATTN_STORE16(p,v) (*(u32x4*)(p)=(v))
#endif
constexpr int FCH=64;
constexpr int F2_CK=LDS_BYTES, FOX2_LDS_BYTES=F2_CK+FCH*64*4;
template<int THRL> __device__ __forceinline__ void fox_unit2(int h,int qb,int jc,float kn,const bf16*Q,const bf16*__restrict__ K,const bf16*__restrict__ V,bf16*O,float*ML,const float*__restrict__ c2h,char*shm,float*qmx){
  int tid=threadIdx.x; asm volatile("":"+v"(tid)); const int lane=tid&63,r32=lane&31,hi=lane>>5; const int wid=__builtin_amdgcn_readfirstlane(tid>>6);
  const long rowbase=0; const int q0=qb*QB;
  const bf16*Qw=Q+(rowbase+q0+wid*QBLK)*DM+h*D;
  const bf16*Kh=K+rowbase*DM+h*D,*Vh=V+rowbase*DM+h*D;
  const unsigned lds0=(unsigned)(uintptr_t)shm;
  float*wsf=(float*)(shm+LDS_WS)+wid*64;
  float*ckl=(float*)(shm+F2_CK);
  const int NTg=(q0+QB)/KVBLK;
  bf16x8 qr[4];
  #pragma unroll
  for(int d0=0;d0<4;++d0)qr[d0]=*reinterpret_cast<const bf16x8*>(&Qw[(long)r32*DM+d0*16+hi*8]);
  int ts;
  { float qs=0.f;
    #pragma unroll
    for(int d0=0;d0<4;++d0)
      #pragma unroll
      for(int e=0;e<8;++e){ const float v=__builtin_bit_cast(float,(unsigned)(unsigned short)qr[d0][e]<<16); qs+=v*v; }
    { auto rr=__builtin_amdgcn_permlane32_swap(__float_as_uint(qs),__float_as_uint(qs),false,false); qs=__uint_as_float(rr[0])+__uint_as_float(rr[1]); }
    #pragma unroll
    for(int o_=1;o_<32;o_<<=1) qs=__builtin_fmaxf(qs,__shfl_xor(qs,o_));
    if(lane==0)qmx[wid]=qs;
    __syncthreads();
    float q2=qmx[0];
    #pragma unroll
    for(int w_=1;w_<8;++w_)q2=__builtin_fmaxf(q2,qmx[w_]);
    const float lim=c2h[q0]+152.0f+2.0f*sqrtf(q2)*kn;
    ts=__syncthreads_count((tid<NTg-4)&&(c2h[64*tid+63]>lim)); ts&=~3; }
  const int t1=NTg-FCH*jc; int t0=t1-FCH; t0=t0<0?0:t0; t0=t0<ts?ts:t0;
  if(t0>=t1){ if(hi==0){ float*mlp=ML+((long)(q0+wid*QBLK+r32)*NHEAD+h)*2; mlp[0]=-1.0e30f; mlp[1]=0.f; } return; }
  const int NT=t1-t0;
  const int NTm=(jc==0)?NT:(1<<20);
  { const float cref=c2h[q0]; const int nck=NT*64;
    for(int i=tid*4;i<nck;i+=2048){ f32x4_t v=*(const f32x4_t*)(c2h+t0*64+i); v=v-cref; *(f32x4_t*)(ckl+i)=v; } }
  asm volatile("s_waitcnt vmcnt(0)":::"memory");
  const bf16*ksrc=Kh+(long)(t0*KVBLK+lane)*DM+wid*8;
  const bf16*vsrc=Vh+(long)(t0*KVBLK+16*(wid&3)+(lane>>2))*DM+(wid>>2)*32+(lane&3)*8;
  const unsigned kdst=lds0+LDS_K+wid*1024, vdst=lds0+LDS_V+wid*1024;
  #define DMA_K(t,slot) glds16(ksrc+(long)(t)*KVBLK*DM,(unsigned)__builtin_amdgcn_readfirstlane(kdst+(slot)))
  #define DMA_V(t,slot) glds16(vsrc+(long)(t)*KVBLK*DM,(unsigned)__builtin_amdgcn_readfirstlane(vdst+(slot)))
  const int vb0=(int)(lds0+LDS_V)+((lane>>4)&1)*32+(lane&3)*8+(4*hi+((lane&15)>>2))*64;
  const char*Kbase=shm+LDS_K; bf16x8 kf[8];
  const lds_cptr shm3=(lds_cptr)shm; const lds_cptr kp0=shm3+LDS_K+hi*1024+r32*16; const lds_cptr vp0=shm3+LDS_V+((lane>>4)&1)*32+(lane&3)*8+(4*hi+((lane&15)>>2))*64;
  DMA_K(0,0);DMA_V(0,0);DMA_K(1,SLOTB);
  float mhat=0.f,l_reg=0.f;f32x16 o[2];o[0]=f32x16{};o[1]=f32x16{};f32x16 negm=f32x16{};asm volatile("":"+v"(negm));
  const int qrel=wid*QBLK+r32;
  #define CMASK(P0,P1,t) do{int jb_=(t)-(NTm-4); if(jb_>=0)cmask(P0,P1,jb_,qrel,hi);}while(0)
  #define BIAS(P0,P1,t) do{ const float*cb_=ckl+(t)*64+4*hi; _Pragma("unroll") for(int g_=0;g_<4;++g_){ const f32x4_t a_=*(const f32x4_t*)(cb_+8*g_), b_=*(const f32x4_t*)(cb_+32+8*g_); _Pragma("unroll") for(int e_=0;e_<4;++e_){P0[4*g_+e_]-=a_[e_];P1[4*g_+e_]-=b_[e_];} SBAR(); } }while(0)
  bool resc=false;
  #define START(P0,P1) do{ const float rm=rowmax(P0,P1); resc=false; \
    { const float dl=rm; mhat=fadd_s(mhat,dl); \
      _Pragma("unroll") for(int r=0;r<16;++r){P0[r]=fsub_s(P0[r],dl);P1[r]=fsub_s(P1[r],dl);} \
      _Pragma("unroll") for(int r=0;r<16;++r)negm[r]=-mhat; asm volatile("":"+v"(negm)); } \
    _Pragma("unroll") for(int r=0;r<16;++r)P0[r]=__builtin_amdgcn_exp2f(P0[r]); }while(0)
  #define RESC() do{ if(resc){ asm volatile("s_waitcnt lgkmcnt(0)":::"memory"); \
      _Pragma("unroll") for(int d_=0;d_<2;++d_) _Pragma("unroll") for(int r=0;r<16;++r)o[d_][r]*=wsf[crow(r,hi)]; } }while(0)
  f32x16 pA0,pA1,pB0,pB1;
  int sl_prev=0,sl_cur=0,sl_next=SLOTB;
  #define ROT() do{sl_prev=sl_cur;sl_cur=sl_next;sl_next=(sl_next==(NSLOT-1)*SLOTB)?0:sl_next+SLOTB;}while(0)
  DMA_K(2,2*SLOTB);
  WAIT_BAR(3);
  qkt(pA0,pA1,Kbase,qr,negm,r32,hi);asm volatile("s_nop 15\n\ts_nop 7":"+v"(pA0),"+v"(pA1));BIAS(pA0,pA1,0);CMASK(pA0,pA1,0);
  START(pA0,pA1);
  _Pragma("unroll") for(int r=0;r<16;++r)pA1[r]=__builtin_amdgcn_exp2f(pA1[r]);
  WAIT_BAR(0);
  DMA_K(3,0);DMA_V(1,SLOTB);
  ROT();
  kload8(kf,kp0+sl_cur);
  WAIT_BAR(2);
  s16x4 vlo[8],vhi[8]; u32x4 pw0,pw1,pw2,pw3;
  #define PKW(P,B) cvtpk_s(P[B],P[B+1])
  #define PAF(k) __builtin_bit_cast(bf16x8,pw##k)
  #define VFR(i) (bf16x8){vlo[i][0],vlo[i][1],vlo[i][2],vlo[i][3],vhi[i][0],vhi[i][1],vhi[i][2],vhi[i][3]}
  #define PIN(x) asm volatile("":"+v"(x))
  #define MX3(a,b,c) __builtin_fmaxf(__builtin_fmaxf((a),(b)),(c))
  #define GAPA(MF,A0,A1,A2,A3,W0,W1,PW) do{ MF; sacc+=A0; sacc+=A1; sacc+=A2; sacc+=A3; PIN(sacc); W0; W1; PIN(PW); SBAR(); }while(0)
  #define EX(v) __builtin_amdgcn_exp2f(v)
  #define GAPB(MF,X,B) do{ MF; X[B]=EX(X[B]); X[B+1]=EX(X[B+1]); X[B+2]=EX(X[B+2]); X[B+3]=EX(X[B+3]); PIN(X); SBAR(); }while(0)
  #define VRD(i) do{ vlo[i]=vtr(vp_+(((i)>>2)*4096+((i)&3)*1024)); vhi[i]=vtr(vp_+(((i)>>2)*4096+((i)&3)*1024+512)); }while(0)
  #define KRD(G,j) do{ if(G){ kload2(kf,kp0+sl_next,j); SBAR(); } }while(0)
  #define STEP(C0,C1,P0,P1,t,GK,GV,GL) do{ SBAR(); \
    const lds_cptr vp_=vp0+sl_prev; \
    VRD(0); SBAR(); float sacc=(P0[0]+P0[1]); \
    GAPA(C0=__builtin_amdgcn_mfma_f32_32x32x16_bf16(kf[0],qr[0],negm,0,0,0), P0[2],P0[3],P0[4],P0[5],     pw0[0]=PKW(P0,0), pw0[1]=PKW(P0,2), pw0); \
    VRD(4); SBAR(); GAPA(C1=__builtin_amdgcn_mfma_f32_32x32x16_bf16(kf[1],qr[0],negm,0,0,0), P0[6],P0[7],P0[8],P0[9],     pw0[2]=PKW(P0,4), pw0[3]=PKW(P0,6), pw0); \
    VRD(1); SBAR(); GAPA(C0=__builtin_amdgcn_mfma_f32_32x32x16_bf16(kf[2],qr[1],C0,0,0,0),   P0[10],P0[11],P0[12],P0[13], pw1[0]=PKW(P0,8), pw1[1]=PKW(P0,10), pw1); \
    VRD(5); SBAR(); GAPA(C1=__builtin_amdgcn_mfma_f32_32x32x16_bf16(kf[3],qr[1],C1,0,0,0),   P0[14],P0[15],P1[0],P1[1],   pw1[2]=PKW(P0,12),pw1[3]=PKW(P0,14), pw1); \
    VRD(2); SBAR(); GAPA(C0=__builtin_amdgcn_mfma_f32_32x32x16_bf16(kf[4],qr[2],C0,0,0,0),   P1[2],P1[3],P1[4],P1[5],     pw2[0]=PKW(P1,0), pw2[1]=PKW(P1,2), pw2); \
    VRD(6); SBAR(); GAPA(C1=__builtin_amdgcn_mfma_f32_32x32x16_bf16(kf[5],qr[2],C1,0,0,0),   P1[6],P1[7],P1[8],P1[9],     pw2[2]=PKW(P1,4), pw2[3]=PKW(P1,6), pw2); \
    VRD(3); SBAR(); GAPA(C0=__builtin_amdgcn_mfma_f32_32x32x16_bf16(kf[6],qr[3],C0,0,0,0),   P1[10],P1[11],P1[12],P1[13], pw3[0]=PKW(P1,8), pw3[1]=PKW(P1,10), pw3); \
    VRD(7); SBAR(); GAPA(C1=__builtin_amdgcn_mfma_f32_32x32x16_bf16(kf[7],qr[3],C1,0,0,0),   P1[14],P1[15],0.f,0.f,       pw3[2]=PKW(P1,12),pw3[3]=PKW(P1,14), pw3); \
    l_reg+=sacc; \
    if(GK){DMA_K((t)+3,sl_cur);} if(GV){DMA_V((t)+1,sl_next);} \
    BIAS(C0,C1,t); CMASK(C0,C1,t); \
    { float a=MX3(C0[0],C0[1],C1[0]),b=MX3(C0[2],C0[3],C1[1]); a=MX3(a,C1[2],C1[3]); \
      _Pragma("unroll") for(int r=4;r<16;r+=4){a=MX3(a,C0[r],C0[r+1]);b=MX3(b,C0[r+2],C0[r+3]);a=MX3(a,C1[r],C1[r+1]);b=MX3(b,C1[r+2],C1[r+3]);} \
      float rm=__builtin_fmaxf(a,b); { auto rr=__builtin_amdgcn_permlane32_swap(__float_as_uint(rm),__float_as_uint(rm),false,false); rm=__builtin_fmaxf(__uint_as_float(rr[0]),__uint_as_float(rr[1])); } \
      resc=false; \
      if(__builtin_expect(__any(rm>(float)THRL),0)){ const float dl=__builtin_fmaxf(rm,0.f); mhat+=dl; \
        _Pragma("unroll") for(int r=0;r<16;++r){C0[r]-=dl;C1[r]-=dl;} \
        _Pragma("unroll") for(int r=0;r<16;++r)negm[r]=-mhat; asm volatile("":"+v"(negm)); \
        const float f=__builtin_amdgcn_exp2f(-dl); l_reg*=f; if(hi==0)wsf[r32]=f; resc=true; } } \
    SBAR(); \
    GAPB(o[0]=__builtin_amdgcn_mfma_f32_32x32x16_bf16(PAF(0),VFR(0),o[0],0,0,0), C0,0); \
    GAPB(o[1]=__builtin_amdgcn_mfma_f32_32x32x16_bf16(PAF(0),VFR(4),o[1],0,0,0), C0,4); \
    KRD(GL,0); GAPB(o[0]=__builtin_amdgcn_mfma_f32_32x32x16_bf16(PAF(1),VFR(1),o[0],0,0,0), C0,8); \
    KRD(GL,1); GAPB(o[1]=__builtin_amdgcn_mfma_f32_32x32x16_bf16(PAF(1),VFR(5),o[1],0,0,0), C0,12); \
    KRD(GL,2); GAPB(o[0]=__builtin_amdgcn_mfma_f32_32x32x16_bf16(PAF(2),VFR(2),o[0],0,0,0), C1,0); \
    KRD(GL,3); GAPB(o[1]=__builtin_amdgcn_mfma_f32_32x32x16_bf16(PAF(2),VFR(6),o[1],0,0,0), C1,4); \
    GAPB(o[0]=__builtin_amdgcn_mfma_f32_32x32x16_bf16(PAF(3),VFR(3),o[0],0,0,0), C1,8); \
    GAPB(o[1]=__builtin_amdgcn_mfma_f32_32x32x16_bf16(PAF(3),VFR(7),o[1],0,0,0), C1,12); \
    }while(0)
  int t=1;
  #undef CMASK
  #define CMASK(P0,P1,t) do{}while(0)
  for(;t+5<NT;t+=2){
    STEP(pB0,pB1,pA0,pA1,t,true,true,true);     WAIT_BAR(2); RESC(); ROT();
    STEP(pA0,pA1,pB0,pB1,t+1,true,true,true);   WAIT_BAR(2); RESC(); ROT();
  }
  #undef CMASK
  #define CMASK(P0,P1,t) do{int jb_=(t)-(NTm-4); if(jb_>=0)cmask(P0,P1,jb_,qrel,hi);}while(0)
  #define ENDW(tt) do{ if((tt)+3<NT){WAIT_BAR(2);} else if((tt)+2<NT){WAIT_BAR(1);} else {WAIT_BAR(0);} }while(0)
  for(;t+1<NT;t+=2){
    STEP(pB0,pB1,pA0,pA1,t,(t+3<NT),(t+1<NT),(t+1<NT));       ENDW(t);   RESC(); ROT();
    STEP(pA0,pA1,pB0,pB1,t+1,(t+4<NT),(t+2<NT),(t+2<NT));     ENDW(t+1); RESC(); ROT();
  }
  STEP(pB0,pB1,pA0,pA1,NT-1,false,false,false); RESC();
  { float sacc=pB0[0]+pB0[1]; _Pragma("unroll") for(int r=2;r<16;++r)sacc+=pB0[r]; _Pragma("unroll") for(int r=0;r<16;++r)sacc+=pB1[r]; l_reg+=sacc;
    pw0=(u32x4){PKW(pB0,0),PKW(pB0,2),PKW(pB0,4),PKW(pB0,6)};pw1=(u32x4){PKW(pB0,8),PKW(pB0,10),PKW(pB0,12),PKW(pB0,14)};pw2=(u32x4){PKW(pB1,0),PKW(pB1,2),PKW(pB1,4),PKW(pB1,6)};pw3=(u32x4){PKW(pB1,8),PKW(pB1,10),PKW(pB1,12),PKW(pB1,14)};
    SBAR(); pv(o,vb0+sl_cur,PAF(0),PAF(1),PAF(2),PAF(3)); }
  #undef PKW
  #undef PAF
  #undef VFR
  #undef PIN
  #undef MX3
  #undef GAPA
  #undef GAPB
  #undef EX
  #undef VRD
  #undef KRD
  #undef STEP
  #undef ENDW
  {auto rr=__builtin_amdgcn_permlane32_swap(__float_as_uint(l_reg),__float_as_uint(l_reg),false,false);l_reg=__uint_as_float(rr[0])+__uint_as_float(rr[1]);}
  if(hi==0){ wsf[32+r32]=l_reg; float*mlp=ML+((long)(q0+wid*QBLK+r32)*NHEAD+h)*2; mlp[0]=mhat; mlp[1]=l_reg; } asm volatile("s_waitcnt lgkmcnt(0)":::"memory");
  float rli[16];
  #pragma unroll
  for(int r=0;r<16;++r)rli[r]=__builtin_amdgcn_rcpf(wsf[32+crow(r,hi)]);
  bf16*Ow=O+(rowbase+q0+wid*QBLK)*DM+h*D;
  { bf16*stg=(bf16*)(shm+LDS_OST)+wid*2048;
    #pragma unroll
    for(int r=0;r<16;++r){const int orow=crow(r,hi);
      #pragma unroll
      for(int d0=0;d0<2;++d0)stg[orow*64+d0*32+r32]=__float2bfloat16(o[d0][r]*rli[r]);}
    asm volatile("s_waitcnt lgkmcnt(0)":::"memory");
    #pragma unroll
    for(int i=0;i<4;++i){const int row=i*8+(lane>>3),ch=lane&7; const u32x4 v=*(const u32x4*)(stg+row*64+ch*8); ATTN_STORE16(Ow+(long)row*DM+ch*8,v);} }
  asm volatile("s_waitcnt lgkmcnt(0)\n\ts_barrier":::"memory");
  #undef DMA_K
  #undef DMA_V
  #undef CMASK
  #undef BIAS
  #undef START
  #undef RESC
  #undef ROT
}

#undef SBAR
#undef WAIT_BAR
}
namespace cg = cooperative_groups;
constexpr int S_ = 16384, DMOD = 1024, NL = 4, DIN = 2568, NIN = 2816, DFF = 2816, NGU = 5632, NHD = 8;
constexpr float EPSN = 1e-6f;
constexpr size_t MiB = 1u << 20;
constexpr size_t WS_CTL = 0, CTL_BYTES = 65536;
constexpr size_t WS_WIN = 2 * MiB;
constexpr size_t WS_WOUT = 24 * MiB;
constexpr size_t WS_WGU = 32 * MiB;
constexpr size_t WS_WD = 76 * MiB;
constexpr size_t WS_XB = 98 * MiB;
constexpr size_t WS_RSSM = 130 * MiB;
constexpr size_t WS_RSSF = 130 * MiB + 128 * 1024;
constexpr size_t WS_LOGF = 130 * MiB + 256 * 1024;
constexpr size_t WS_C2 = 131 * MiB;
constexpr size_t WS_QKVZ = 132 * MiB;
constexpr size_t WS_O = 212 * MiB;
constexpr size_t WS_MG = 228 * MiB;
constexpr size_t WS_H = 132 * MiB;
constexpr size_t WS_OP = 260 * MiB;
constexpr size_t WS_ML = 308 * MiB;
constexpr size_t WS_END = 312 * MiB;
static_assert(WS_H + (size_t)S_ * DFF * 2 <= WS_MG, "h overlay");
constexpr int LDS_BYTES = 147456;
constexpr int CW_KMAX = 8192, CW_BAR = 9216, CW_SGUQ = 13312;
constexpr int NPHASE = 3 + 7 * NL;

#define LAS __attribute__((address_space(3)))
typedef unsigned short bf16r;
typedef unsigned v4u __attribute__((ext_vector_type(4)));
typedef float f32x4 __attribute__((ext_vector_type(4)));
typedef float f32x16 __attribute__((ext_vector_type(16)));
typedef short bf16x8 __attribute__((ext_vector_type(8)));
#define LDS_WAIT() asm volatile("s_waitcnt lgkmcnt(0)" ::: "memory")
__device__ __forceinline__ unsigned f2bf(float f) { unsigned u = __builtin_bit_cast(unsigned, f); return (u + 0x7fffu + ((u >> 16) & 1u)) >> 16; }
__device__ __forceinline__ unsigned pk2(float lo, float hi) { return f2bf(lo) | (f2bf(hi) << 16); }
__device__ __forceinline__ float bflo(unsigned w) { return __builtin_bit_cast(float, w << 16); }
__device__ __forceinline__ float bfhi(unsigned w) { return __builtin_bit_cast(float, w & 0xffff0000u); }
__device__ __forceinline__ float bf1(bf16r w) { return __builtin_bit_cast(float, (unsigned)w << 16); }
#define DPPF(v, ctrl) __builtin_bit_cast(float, __builtin_amdgcn_update_dpp(0, __builtin_bit_cast(int, (v)), (ctrl), 0xf, 0xf, true))
__device__ __forceinline__ float wave_sum(float v) {
    v += DPPF(v, 0xB1); v += DPPF(v, 0x4E); v += DPPF(v, 0x141); v += DPPF(v, 0x140);
    const int iv = __builtin_bit_cast(int, v);
    const float s0 = __builtin_bit_cast(float, __builtin_amdgcn_readlane(iv, 0)), s1 = __builtin_bit_cast(float, __builtin_amdgcn_readlane(iv, 16)),
                s2 = __builtin_bit_cast(float, __builtin_amdgcn_readlane(iv, 32)), s3 = __builtin_bit_cast(float, __builtin_amdgcn_readlane(iv, 48));
    return (s0 + s1) + (s2 + s3);
}
constexpr int PREP_P = 132;
__device__ __forceinline__ void prep_item(const float* W, int ldw, int srccol, const float* gs, bf16r* WT, int K, int dstrow, int k0, LAS float* scr, int lane) {
#pragma unroll 8
    for (int i = 0; i < 16; ++i) { const int kk = 2 * i + (lane >> 5); f32x4 w = *(const f32x4*)(W + (size_t)(k0 + kk) * ldw + srccol + 4 * (lane & 31)); if (gs) w = w * gs[k0 + kk];
        *(LAS f32x4*)(scr + kk * PREP_P + 4 * (lane & 31)) = w; }
    LDS_WAIT(); asm volatile("" ::: "memory");
    const int c = lane & 3;
#pragma unroll
    for (int j = 0; j < 8; ++j) { const int n = (lane >> 2) + 16 * j; const LAS float* s = scr + (8 * c) * PREP_P + n;
        v4u o; o.x = pk2(s[0 * PREP_P], s[1 * PREP_P]); o.y = pk2(s[2 * PREP_P], s[3 * PREP_P]); o.z = pk2(s[4 * PREP_P], s[5 * PREP_P]); o.w = pk2(s[6 * PREP_P], s[7 * PREP_P]);
        *(v4u*)(WT + (size_t)(dstrow + n) * K + k0 + 8 * c) = o; }
    LDS_WAIT(); asm volatile("" ::: "memory");
}
template <int OFF> __device__ __forceinline__ unsigned long long ldk() {
    unsigned long long v; auto ka = __builtin_amdgcn_kernarg_segment_ptr();
    asm volatile("s_load_dwordx2 %0, %1, %2\n\ts_waitcnt lgkmcnt(0)" : "=s"(v) : "s"(ka), "i"(OFF) : "memory");
    return v;
}
struct Ptrs {
    const float *x, *mixg, *w_in, *b_f, *lng, *lnb, *w_s, *b_s, *outg, *w_out, *ffng, *w_gu, *w_d, *fing;
    float* out; unsigned char* ws;
};
__device__ __forceinline__ void phase_prep(const Ptrs& P, LAS unsigned char* lds, int l0, int l1, int gw, int NGW, int wave, int lane) {
    LAS float* scr = (LAS float*)(lds + wave * (32 * PREP_P * 4));
    bf16r* WinT = (bf16r*)(P.ws + WS_WIN); bf16r* WoutT = (bf16r*)(P.ws + WS_WOUT); bf16r* WguT = (bf16r*)(P.ws + WS_WGU); bf16r* WdT = (bf16r*)(P.ws + WS_WD);
    constexpr int I_IN = 32 * 20, I_OUT = 32 * 8, I_GU = 32 * 44, I_D = 88 * 8, I_L = I_IN + I_OUT + I_GU + I_D;
    for (int it = l0 * I_L + gw; it < l1 * I_L; it += NGW) {
        const int l = it / I_L; int r = it % I_L;
        if (r < I_IN) { const int kb = r / 20, nb = r % 20, n0 = 128 * nb, src = n0 < 1536 ? n0 : n0 + 8;
            prep_item(P.w_in + (size_t)l * DMOD * DIN, DIN, src, P.mixg + l * DMOD, WinT + (size_t)l * NIN * DMOD, DMOD, n0, 32 * kb, scr, lane); continue; }
        r -= I_IN;
        if (r < I_OUT) { const int kb = r / 8, nb = r % 8;
            prep_item(P.w_out + (size_t)l * DMOD * DMOD, DMOD, 128 * nb, P.outg + l * DMOD, WoutT + (size_t)l * DMOD * DMOD, DMOD, 128 * nb, 32 * kb, scr, lane); continue; }
        r -= I_OUT;
        if (r < I_GU) { const int kb = r / 44, nb = r % 44, n0 = 128 * nb, pn = n0 >> 8, src = (n0 & 255) == 0 ? 128 * pn : DFF + 128 * pn;
            prep_item(P.w_gu + (size_t)l * DMOD * NGU, NGU, src, P.ffng + l * DMOD, WguT + (size_t)l * NGU * DMOD, DMOD, n0, 32 * kb, scr, lane); continue; }
        r -= I_GU;
        { const int kb = r / 8, nb = r % 8;
            prep_item(P.w_d + (size_t)l * DFF * DMOD, DMOD, 128 * nb, nullptr, WdT + (size_t)l * DMOD * DFF, DFF, 128 * nb, 32 * kb, scr, lane); }
    }
    for (int idx = l0 * 262144 + gw * 64 + lane; idx < l1 * 262144; idx += NGW * 64) { const int l = idx >> 18, rr = (idx >> 10) & 255, k = idx & 1023; unsigned v = 0u;
        if ((rr & 127) < 8) { const float w = P.w_in[((size_t)l * DMOD + k) * DIN + 1536 + (rr & 7)] * P.mixg[l * DMOD + k]; const unsigned hb = f2bf(w);
            v = rr < 128 ? hb : f2bf(w - __builtin_bit_cast(float, hb << 16)); }
        WinT[((size_t)l * NIN + 2560 + rr) * DMOD + k] = (bf16r)v; }
}
template <int MODE>
__device__ __forceinline__ void phase_rowstats(const float* xin, bf16r* xb, unsigned long long* rss_out, const float* gfin, float* outp, int gw, int NGW, int lane) {
#pragma unroll 2
    for (int m = gw; m < S_; m += NGW) {
        const f32x4* xr = (const f32x4*)(xin + (size_t)m * DMOD) + lane;
        f32x4 v[4]; float s = 0.f;
#pragma unroll
        for (int j = 0; j < 4; ++j) { v[j] = xr[64 * j]; s += (v[j].x * v[j].x + v[j].y * v[j].y) + (v[j].z * v[j].z + v[j].w * v[j].w); }
        const float tot = wave_sum(s);
        if (MODE == 2) {
            const float rs = 1.0f / sqrtf(tot * (1.0f / DMOD) + EPSN);
            f32x4* orow = (f32x4*)(outp + (size_t)m * DMOD) + lane; const f32x4* gr = (const f32x4*)gfin + lane;
#pragma unroll
            for (int j = 0; j < 4; ++j) orow[64 * j] = v[j] * rs * gr[64 * j];
        } else {
            unsigned long long* o8 = (unsigned long long*)(xb + (size_t)m * DMOD) + lane;
#pragma unroll
            for (int j = 0; j < 4; ++j) o8[64 * j] = (unsigned long long)pk2(v[j].x, v[j].y) | ((unsigned long long)pk2(v[j].z, v[j].w) << 32);
            if (lane == 0) rss_out[m] = (unsigned long long)__float2ull_rn(tot * 16777216.0f);
        }
    }
}
__device__ __forceinline__ void cumsum_head(const float* logf, float* c2, int h, LAS unsigned char* lds, int tid) {
    LAS double* scr = (LAS double*)lds;
    const f32x4* src = (const f32x4*)(logf + (size_t)h * S_ + tid * 32);
    f32x4 v[8]; double sum = 0.0;
#pragma unroll
    for (int e = 0; e < 8; ++e) { v[e] = src[e]; sum += ((double)v[e].x + (double)v[e].y) + ((double)v[e].z + (double)v[e].w); }
    scr[tid] = sum; __syncthreads();
    double pre = 0.0; for (int i = 0; i < tid; ++i) pre += scr[i];
    f32x4* dst = (f32x4*)(c2 + (size_t)h * S_ + tid * 32);
#pragma unroll
    for (int e = 0; e < 8; ++e) { f32x4 o; pre += (double)v[e].x; o.x = (float)(pre * 1.4426950408889634); pre += (double)v[e].y; o.y = (float)(pre * 1.4426950408889634);
        pre += (double)v[e].z; o.z = (float)(pre * 1.4426950408889634); pre += (double)v[e].w; o.w = (float)(pre * 1.4426950408889634); dst[e] = o; }
    __syncthreads();
}
__device__ __forceinline__ void sgu_item(int c, const bf16r* ZU, const bf16r* ZV, bf16r* MG, const float* lng, const float* lnb, const float* wsl, const float* bsl,
                                         LAS unsigned char* lds, int wid, int lane) {
    LAS float* bsb = (LAS float*)lds;
    LAS bf16r* zt = (LAS bf16r*)(lds + 4096);
    const int r32 = lane & 31, hi = lane >> 5, g = wid, tid = wid * 64 + lane;
    bsb[tid] = bsl[tid]; bsb[tid + 512] = bsl[tid + 512];
    float gl[8], bl[8];
    { const f32x4 g0 = *(const f32x4*)(lng + 8 * lane), g1 = *(const f32x4*)(lng + 8 * lane + 4), b0 = *(const f32x4*)(lnb + 8 * lane), b1 = *(const f32x4*)(lnb + 8 * lane + 4);
      gl[0] = g0.x; gl[1] = g0.y; gl[2] = g0.z; gl[3] = g0.w; gl[4] = g1.x; gl[5] = g1.y; gl[6] = g1.z; gl[7] = g1.w;
      bl[0] = b0.x; bl[1] = b0.y; bl[2] = b0.z; bl[3] = b0.w; bl[4] = b1.x; bl[5] = b1.y; bl[6] = b1.z; bl[7] = b1.w; }
#pragma unroll 2
    for (int rr = 0; rr < 16; ++rr) { const int i = 16 * wid + rr; const size_t row = (size_t)c * 128 + i;
        const v4u zr = *(const v4u*)(ZV + row * 512 + 8 * lane);
        float z[8] = {bflo(zr.x), bfhi(zr.x), bflo(zr.y), bfhi(zr.y), bflo(zr.z), bfhi(zr.z), bflo(zr.w), bfhi(zr.w)};
        float s = 0.f;
#pragma unroll
        for (int e = 0; e < 8; ++e) s += z[e];
        const float mean = wave_sum(s) * (1.0f / 512.0f); float q = 0.f;
#pragma unroll
        for (int e = 0; e < 8; ++e) { z[e] -= mean; q += z[e] * z[e]; }
        const float rstd = 1.0f / sqrtf(wave_sum(q) * (1.0f / 512.0f) + EPSN);
#pragma unroll
        for (int e = 0; e < 8; ++e) z[e] = z[e] * rstd * gl[e] + bl[e];
        v4u zw; zw.x = pk2(z[0], z[1]); zw.y = pk2(z[2], z[3]); zw.z = pk2(z[4], z[5]); zw.w = pk2(z[6], z[7]);
        *(LAS v4u*)(zt + i * 512 + 8 * lane) = zw;
    }
    LDS_WAIT(); __syncthreads();
#pragma unroll 1
    for (int ni = 0; ni < 2; ++ni) {
        const int d = 64 * g + 32 * ni + r32;
        bf16x8 bfr[8];
#pragma unroll
        for (int ks = 0; ks < 8; ++ks) { const LAS bf16r* zp = zt + (16 * ks + 8 * hi) * 512 + d;
            v4u w; w.x = (unsigned)zp[0] | ((unsigned)zp[512] << 16); w.y = (unsigned)zp[1024] | ((unsigned)zp[1536] << 16); w.z = (unsigned)zp[2048] | ((unsigned)zp[2560] << 16); w.w = (unsigned)zp[3072] | ((unsigned)zp[3584] << 16);
            bfr[ks] = __builtin_bit_cast(bf16x8, w); }
        LDS_WAIT(); asm volatile("" ::: "memory");
        f32x16 acc[4];
#pragma unroll
        for (int mi = 0; mi < 4; ++mi) { acc[mi] = f32x16{};
#pragma unroll
            for (int ks = 0; ks < 8; ++ks) { if (mi < 2 && ks >= 4) continue;
                const float* wp = wsl + ((size_t)g * 128 + 32 * mi + r32) * 128 + 16 * ks + 8 * hi; const f32x4 a0 = *(const f32x4*)wp, a1 = *(const f32x4*)(wp + 4);
                v4u w; w.x = pk2(a0.x, a0.y); w.y = pk2(a0.z, a0.w); w.z = pk2(a1.x, a1.y); w.w = pk2(a1.z, a1.w);
                acc[mi] = __builtin_amdgcn_mfma_f32_32x32x16_bf16(__builtin_bit_cast(bf16x8, w), bfr[ks], acc[mi], 0, 0, 0); }
            asm volatile("" ::: "memory"); }
#pragma unroll
        for (int mi = 0; mi < 4; ++mi)
#pragma unroll
            for (int r = 0; r < 16; ++r) { const int i = 32 * mi + (r & 3) + 8 * (r >> 2) + 4 * hi;
                zt[i * 512 + d] = (bf16r)f2bf(acc[mi][r] + bsb[g * 128 + i]); }
        LDS_WAIT(); asm volatile("" ::: "memory");
    }
    __syncthreads();
#pragma unroll 4
    for (int rr = 0; rr < 16; ++rr) { const int i = 16 * wid + rr; const size_t row = (size_t)c * 128 + i;
        const v4u tr = *(const LAS v4u*)(zt + i * 512 + 8 * lane);
        const v4u ur = *(const v4u*)(ZU + row * 512 + 8 * lane);
        float a[8] = {bflo(tr.x) * bflo(ur.x), bfhi(tr.x) * bfhi(ur.x), bflo(tr.y) * bflo(ur.y), bfhi(tr.y) * bfhi(ur.y), bflo(tr.z) * bflo(ur.z), bfhi(tr.z) * bfhi(ur.z), bflo(tr.w) * bflo(ur.w), bfhi(tr.w) * bfhi(ur.w)};
        float ss = 0.f;
#pragma unroll
        for (int e = 0; e < 8; ++e) ss += a[e] * a[e];
        const float ra = 1.0f / sqrtf(wave_sum(ss) * (1.0f / 512.0f) + EPSN);
        v4u w; w.x = pk2(a[0] * ra, a[1] * ra); w.y = pk2(a[2] * ra, a[3] * ra); w.z = pk2(a[4] * ra, a[5] * ra); w.w = pk2(a[6] * ra, a[7] * ra);
        *(v4u*)(MG + row * 1024 + 512 + 8 * lane) = w;
    }
    LDS_WAIT(); __syncthreads();
}
__device__ __forceinline__ void combine_item(int c, const bf16r* O, const bf16r* OP1, const float* ML, bf16r* MG, int wid, int lane) {
#pragma unroll 4
    for (int rr = 0; rr < 8; ++rr) { const size_t row = (size_t)c * 64 + 8 * wid + rr;
        float a[8];
        { const int nch = ((int)(row >> 12)) + 1, hh = lane >> 3; float Mj[4], lj[4]; v4u oj[4];
#pragma unroll
          for (int j = 0; j < 4; ++j) { if (j < nch) { const float* mlp = ML + (size_t)j * S_ * 16 + (row * 8 + hh) * 2; Mj[j] = mlp[0]; lj[j] = mlp[1];
                  oj[j] = *(const v4u*)((j == 0 ? O : OP1 + (size_t)(j - 1) * S_ * 512) + row * 512 + 8 * lane); } else { Mj[j] = -1.0e30f; lj[j] = 0.f; oj[j] = (v4u){0u, 0u, 0u, 0u}; } }
          const float Mmax = fmaxf(fmaxf(Mj[0], Mj[1]), fmaxf(Mj[2], Mj[3])); float wsum = 0.f;
#pragma unroll
          for (int e = 0; e < 8; ++e) a[e] = 0.f;
#pragma unroll
          for (int j = 0; j < 4; ++j) { const float w = lj[j] > 0.f ? lj[j] * __builtin_amdgcn_exp2f(Mj[j] - Mmax) : 0.f; wsum += w;
              if (w > 0.f) { a[0] += w * bflo(oj[j].x); a[1] += w * bfhi(oj[j].x); a[2] += w * bflo(oj[j].y); a[3] += w * bfhi(oj[j].y); a[4] += w * bflo(oj[j].z); a[5] += w * bfhi(oj[j].z); a[6] += w * bflo(oj[j].w); a[7] += w * bfhi(oj[j].w); } }
          const float iw = 1.0f / wsum;
#pragma unroll
          for (int e = 0; e < 8; ++e) a[e] *= iw; }
        float ss = 0.f;
#pragma unroll
        for (int e = 0; e < 8; ++e) ss += a[e] * a[e];
        const float ra = 1.0f / sqrtf(wave_sum(ss) * (1.0f / 512.0f) + EPSN);
        v4u w; w.x = pk2(a[0] * ra, a[1] * ra); w.y = pk2(a[2] * ra, a[3] * ra); w.z = pk2(a[4] * ra, a[5] * ra); w.w = pk2(a[6] * ra, a[7] * ra);
        *(v4u*)(MG + row * 1024 + 8 * lane) = w;
    }
}
#define XB_TMO      128
#define XB_XCNT(j)  (256  + 64 * (j))
#define XB_XSUB(j)  (1280 + 64 * (j))
#define XB_XGEN(j)  (2304 + 64 * (j))
#define XB_TOP      3328
#define XB_TOPGEN   3392
#define XCD_BAR_WORDS 3456
#define XB_SPIN_CAP (1u << 18)

__device__ __forceinline__ unsigned xb_ld(unsigned* p)              { return __hip_atomic_load(p, __ATOMIC_RELAXED, __HIP_MEMORY_SCOPE_AGENT); }
__device__ __forceinline__ unsigned xb_add(unsigned* p, unsigned v) { return __hip_atomic_fetch_add(p, v, __ATOMIC_RELAXED, __HIP_MEMORY_SCOPE_AGENT); }
__device__ __forceinline__ unsigned xb_xcc_id() { return (unsigned)__builtin_amdgcn_s_getreg((3 << 11) | 20) & 0xFu; }
#define XB_SPIN(cond, bar) do { unsigned _sp = 0; while (cond) { __builtin_amdgcn_s_sleep(1); \
    if ((++_sp & 255u) == 0u) { if (xb_ld(&(bar)[XB_TMO])) break; if (_sp > XB_SPIN_CAP) { atomicAdd(&(bar)[XB_TMO], 1u); break; } } } } while (0)

struct XcdBarrier {
    unsigned* bar; unsigned x;
    volatile LAS unsigned* st;
};

__device__ __forceinline__ XcdBarrier xcd_barrier_post(unsigned* bar, volatile LAS unsigned* st) {
    XcdBarrier b; b.bar = bar; b.x = xb_xcc_id(); b.st = st;
    if (threadIdx.x == 0) (void)xb_add(&bar[XB_XCNT(b.x)], 1u);
    return b;
}
__device__ __forceinline__ void xcd_barrier_complete(unsigned* bar, unsigned x, unsigned& nloc, unsigned& nx) {
    const unsigned G = gridDim.x * gridDim.y * gridDim.z;
    unsigned sum, cnt, mine, sp = 0u;
    for (;;) {
        sum = 0u; cnt = 0u; mine = 0u;
#pragma unroll
        for (unsigned j = 0; j < 16; ++j) { const unsigned c = xb_ld(&bar[XB_XCNT(j)]); sum += c; cnt += (c > 0u) ? 1u : 0u; mine = (j == x) ? c : mine; }
        if (sum == G) break;
        __builtin_amdgcn_s_sleep(1);
        if ((++sp & 255u) == 0u) { if (xb_ld(&bar[XB_TMO])) break; if (sp > XB_SPIN_CAP) { atomicAdd(&bar[XB_TMO], 1u); break; } }
    }
    nloc = mine > 0u ? mine : 1u; nx = cnt > 0u ? cnt : 1u;
}

__device__ __forceinline__ void xcd_barrier(const XcdBarrier& b) {
    asm volatile("s_waitcnt vmcnt(0)" ::: "memory");
    __syncthreads();
    if (threadIdx.x == 0) {
        unsigned* bar = b.bar;
        __builtin_amdgcn_s_waitcnt(0);
        unsigned nloc = b.st[0], nx = b.st[1];
        if (nloc == 0u) { xcd_barrier_complete(bar, b.x, nloc, nx); b.st[0] = nloc; b.st[1] = nx; }
        const unsigned old = xb_add(&bar[XB_XSUB(b.x)], 1u);
        const unsigned gen = old / nloc;
        if (old + 1u == (gen + 1u) * nloc) {
            __builtin_amdgcn_fence(__ATOMIC_RELEASE, "agent");
            asm volatile("s_waitcnt vmcnt(0)" ::: "memory");
            const unsigned og = xb_add(&bar[XB_TOP], 1u);
            const unsigned tg = og / nx;
            if (og + 1u == (tg + 1u) * nx) xb_add(&bar[XB_TOPGEN], 1u);
            else XB_SPIN(xb_ld(&bar[XB_TOPGEN]) == tg, bar);
            __builtin_amdgcn_fence(__ATOMIC_ACQUIRE, "agent");
            xb_add(&bar[XB_XGEN(b.x)], 1u);
            asm volatile("s_waitcnt vmcnt(0)" ::: "memory");
        } else {
            XB_SPIN(xb_ld(&bar[XB_XGEN(b.x)]) == gen, bar);
            __builtin_amdgcn_fence(__ATOMIC_ACQUIRE, "agent");
            asm volatile("s_waitcnt vmcnt(0)" ::: "memory");
        }
    }
    __syncthreads();
}
#ifndef MK_MULTI
#define MK_MULTI 0
#endif
struct Args { const float* in[14]; float* out; unsigned char* ws; int ph_lo, ph_hi; };
__global__ void __launch_bounds__(512, 2) fox_fwd(Args args) {
    extern __shared__ __attribute__((aligned(16))) unsigned char lds[];
    cg::grid_group grid = cg::this_grid();
    LAS unsigned char* L = (LAS unsigned char*)lds;
    const int G = gridDim.x, bx = blockIdx.x;
    const int vcu = (G % 8 == 0) ? (bx % 8) * (G / 8) + bx / 8 : bx;
    const int NGW = G * 8;
#define IDS() int tid = threadIdx.x; asm volatile("" : "+v"(tid)); const int lane = tid & 63, wave = __builtin_amdgcn_readfirstlane(tid >> 6), gw = vcu * 8 + wave; (void)lane; (void)gw
#define KIN(k) ((const float*)ldk<8 * (k)>())
#define WSB() ((unsigned char*)ldk<120>())
#define P_OUT ((float*)ldk<112>())
#define ctl ((unsigned*)(WSB() + WS_CTL))
#define WinT ((bf16r*)(WSB() + WS_WIN))
#define WoutT ((bf16r*)(WSB() + WS_WOUT))
#define WguT ((bf16r*)(WSB() + WS_WGU))
#define WdT ((bf16r*)(WSB() + WS_WD))
#define XB ((bf16r*)(WSB() + WS_XB))
#define RSSM ((unsigned long long*)(WSB() + WS_RSSM))
#define RSSF ((unsigned long long*)(WSB() + WS_RSSF))
#define LOGF ((float*)(WSB() + WS_LOGF))
#define C2A ((float*)(WSB() + WS_C2))
#define QKVZ ((bf16r*)(WSB() + WS_QKVZ))
#define OB ((bf16r*)(WSB() + WS_O))
#define MG ((bf16r*)(WSB() + WS_MG))
#define HB ((bf16r*)(WSB() + WS_H))
#define OP1 ((bf16r*)(WSB() + WS_OP))
#define MLB ((float*)(WSB() + WS_ML))
#define MKP() Ptrs P; P.x = KIN(0); P.mixg = KIN(1); P.w_in = KIN(2); P.b_f = KIN(3); P.lng = KIN(4); P.lnb = KIN(5); P.w_s = KIN(6); P.b_s = KIN(7); \
    P.outg = KIN(8); P.w_out = KIN(9); P.ffng = KIN(10); P.w_gu = KIN(11); P.w_d = KIN(12); P.fing = KIN(13); P.out = P_OUT; P.ws = WSB()
    constexpr size_t QS = (size_t)S_ * 512;
    const int lo = args.ph_lo, hi = args.ph_hi;
    { LAS unsigned* misc = (LAS unsigned*)(L + 147456 - 8); if (threadIdx.x < 2) misc[threadIdx.x] = 0u; __syncthreads(); }
    XcdBarrier xbar = xcd_barrier_post((unsigned*)(WSB() + WS_CTL) + CW_BAR, (volatile LAS unsigned*)(L + 147456 - 8));
    int ph = 0;
#define RUN() (ph >= lo && ph < hi)
#ifdef PROBE_SYNC
#define SEAM() do { ++ph; if (ph > lo && ph < hi) { if (ph == 1) { grid.sync(); grid.sync(); } else { xcd_barrier(xbar); xcd_barrier(xbar); } } } while (0)
#else
#define SEAM() do { ++ph; if (ph > lo && ph < hi) { if (ph == 1) grid.sync(); else xcd_barrier(xbar); } } while (0)
#endif
#ifdef PROBE_SMALL
#define REPS 2
#else
#define REPS 1
#endif
#ifdef PROBE_ATTN
#define REPA 2
#else
#define REPA 1
#endif

#ifndef NO_P0
    if (RUN()) { IDS(); MKP(); for (int rp = 0; rp < REPS; ++rp) phase_prep(P, L, 0, 1, gw, NGW, wave, lane); }
#endif
    SEAM();
#ifndef NO_P0
    if (RUN()) { IDS(); for (int rp = 0; rp < REPS; ++rp) phase_rowstats<1>(KIN(0), XB, RSSM, nullptr, nullptr, gw, NGW, lane); }
#endif
    SEAM();
    for (int l = 0; l < NL; ++l) {
#ifndef NO_INPROJ
        if (RUN()) {
            { IDS(); unsigned long long* rz = RSSF; if (bx < 256 && tid < 64) { unsigned zlo = 0u; asm volatile("" : "+v"(zlo)); rz[bx * 64 + tid] = (unsigned long long)zlo; }     }
            pg8::Gemm g{XB, WinT + (size_t)l * NIN * DMOD, S_, NIN, DMOD}; pg8::StaticOrder So; So.init(S_, NIN, G, bx);
            pg8::EpiInProj E{QKVZ, QS, RSSM, ctl + CW_KMAX + l * 16, KIN(3) + l * 8, LOGF};
            pg8::gemm_phase<pg8::EpiInProj, pg8::StaticOrder, true, true>(L, g, So, E);
        }
#endif
        SEAM();
#ifndef NO_MERGE
        if (RUN()) {
            IDS();
            if (bx >= G - NHD) { for (int rp = 0; rp < REPS; ++rp) cumsum_head(LOGF, C2A, bx - (G - NHD), L, tid); }
        }
#endif
        SEAM();
#ifndef NO_ATTN
        if (RUN()) {
            IDS(); LAS unsigned* bc = (LAS unsigned*)(L + 147456 - 64);
            unsigned* const ctlp = ctl; unsigned char* const wsp = WSB();
            for (int rp = 0; rp < REPS; ++rp)
            for (;;) {
                if (tid == 0) bc[0] = atomicAdd(ctlp + CW_SGUQ + (rp * NL + l) * 64, 1u);
                __syncthreads(); const unsigned u = bc[0]; __syncthreads();
                if (u >= (unsigned)(S_ / 128)) break;
                bf16r* const qkvz = (bf16r*)(wsp + WS_QKVZ);
                sgu_item((int)u, qkvz + 3 * QS, qkvz + 4 * QS, (bf16r*)(wsp + WS_MG), KIN(4) + l * 512, KIN(5) + l * 512, KIN(6) + (size_t)l * 8 * 128 * 128, KIN(7) + l * 8 * 128, L, wave, lane);
            }
            for (int rp = 0; rp < REPA; ++rp)
            for (int qi = 0; qi < NHD; ++qi) { const int h = (bx + qi) & 7;
                const float kn = sqrtf((__uint_as_float(ctlp[CW_KMAX + l * 16 + 2 * h]) + __uint_as_float(ctlp[CW_KMAX + l * 16 + 2 * h + 1])) * 1.02f);
                for (;;) {
                    if (tid == 0) bc[0] = atomicAdd(ctlp + ((rp * NL + l) * NHD + h) * 64, 1u);
                    __syncthreads(); const unsigned u = bc[0]; __syncthreads();
                    if (u >= 160u) break;
                    int qb, jc;
                    if (u < 64u) { qb = 63 - (int)(u >> 2); jc = (int)(u & 3u); } else if (u < 112u) { const int v = (int)u - 64; qb = 47 - v / 3; jc = v % 3; }
                    else if (u < 144u) { const int v = (int)u - 112; qb = 31 - (v >> 1); jc = v & 1; } else { qb = 15 - ((int)u - 144); jc = 0; }
                    bf16r* const qkvz = (bf16r*)(wsp + WS_QKVZ);
                    attn_body::fox_unit2<8>(h, qb, jc, kn, (const attn_body::bf16*)qkvz, (const attn_body::bf16*)(qkvz + QS), (const attn_body::bf16*)(qkvz + 2 * QS),
                                            (attn_body::bf16*)(jc == 0 ? (bf16r*)(wsp + WS_O) : (bf16r*)(wsp + WS_OP) + (size_t)(jc - 1) * QS), (float*)(wsp + WS_ML) + (size_t)jc * S_ * 16, (float*)(wsp + WS_C2) + (size_t)h * S_, (char*)lds, (float*)(lds + 147456 - 48));
                } }
        }
#endif
        SEAM();
#ifndef NO_MERGE
        if (RUN()) { IDS(); for (int rp = 0; rp < REPS; ++rp) for (int it = vcu; it < S_ / 64; it += G) combine_item(it, OB, OP1, MLB, MG, wave, lane); }
#endif
        SEAM();
#ifndef NO_OUTPROJ
        if (RUN()) {
            { IDS(); unsigned long long* rz = RSSM; if (bx < 256 && tid < 64) { unsigned zlo = 0u; asm volatile("" : "+v"(zlo)); rz[bx * 64 + tid] = (unsigned long long)zlo; }     }
            pg8::Gemm g{MG, WoutT + (size_t)l * DMOD * DMOD, S_, DMOD, DMOD}; pg8::StaticOrder So; So.init(S_, DMOD, G, bx);
            float* const po = P_OUT; pg8::EpiResid E{l == 0 ? KIN(0) : (const float*)po, po, XB, RSSF};
            pg8::gemm_phase<pg8::EpiResid, pg8::StaticOrder, true, true>(L, g, So, E);
        }
#endif
        SEAM();
#ifndef NO_GU
        if (RUN()) {
            pg8::Gemm g{XB, WguT + (size_t)l * NGU * DMOD, S_, NGU, DMOD}; pg8::StaticOrder So; So.init(S_, NGU, G, bx);
            pg8::EpiSwiGLU E{HB, RSSF};
            pg8::gemm_phase<pg8::EpiSwiGLU, pg8::StaticOrder, true, true>(L, g, So, E);
            if (l + 1 < NL) { IDS(); MKP(); if (G == 256) { if (bx >= 128) phase_prep(P, L, l + 1, l + 2, (bx - 128) * 8 + wave, 1024, wave, lane); } else phase_prep(P, L, l + 1, l + 2, gw, NGW, wave, lane); }
        }
#endif
        SEAM();
#ifndef NO_DOWN
        if (RUN()) {
            pg8::Gemm g{HB, WdT + (size_t)l * DMOD * DFF, S_, DMOD, DFF}; pg8::StaticOrder So; So.init(S_, DMOD, G, bx);
            float* const po = P_OUT; pg8::EpiResid E{po, po, XB, RSSM};
            pg8::gemm_phase<pg8::EpiResid, pg8::StaticOrder, true, true>(L, g, So, E);
        }
#endif
        SEAM();
    }
#ifndef NO_RSN
    if (RUN()) { IDS(); float* const po = P_OUT; phase_rowstats<2>(po, nullptr, nullptr, KIN(13), po, gw, NGW, lane); }
#endif
    SEAM();
#undef RUN
#undef SEAM
}

extern "C" void kernel_launch(void* const* d_in, const int* in_sizes, int n_in, void* d_out, int out_size, void* d_ws, size_t ws_size, hipStream_t stream) {
    static int grid = 0;
    if (grid == 0) {
        if (n_in != 14 || out_size != S_ * DMOD || ws_size < WS_END) { fprintf(stderr, "kernel_launch: unexpected shapes (n_in %d out %d ws %zu)\n", n_in, out_size, ws_size); grid = -1; return; }
        int dev = 0, cus = 0, per_cu = 0;
        hipGetDevice(&dev); hipDeviceGetAttribute(&cus, hipDeviceAttributeMultiprocessorCount, dev);
        if (hipFuncSetAttribute((const void*)fox_fwd, hipFuncAttributeMaxDynamicSharedMemorySize, LDS_BYTES) != hipSuccess) { fprintf(stderr, "kernel_launch: hipFuncSetAttribute failed\n"); grid = -1; return; }
        if (hipOccupancyMaxActiveBlocksPerMultiprocessor(&per_cu, (const void*)fox_fwd, 512, LDS_BYTES) != hipSuccess || per_cu < 1) { fprintf(stderr, "kernel_launch: occupancy query says %d\n", per_cu); per_cu = 1; }
        (void)hipGetLastError();
        grid = cus * per_cu;
        if (grid < 256) { fprintf(stderr, "kernel_launch: this kernel needs a resident grid of at least 256 workgroups, got %d\n", grid); grid = -1; return; }
        fprintf(stderr, "kernel_launch: grid %d (cus %d x %d)\n", grid, cus, per_cu);
    }
    if (grid < 0) return;
    hipMemsetAsync((char*)d_ws + WS_CTL, 0, CTL_BYTES, stream);
    Args a{};
    for (int i = 0; i < 14; ++i) a.in[i] = (const float*)d_in[i];
    a.out = (float*)d_out; a.ws = (unsigned char*)d_ws;
#if MK_MULTI
    for (int p = 0; p < NPHASE; ++p) { a.ph_lo = p; a.ph_hi = p + 1; hipLaunchKernelGGL(fox_fwd, dim3(grid), dim3(512), LDS_BYTES, stream, a); }
#else
    a.ph_lo = 0; a.ph_hi = NPHASE;
    void* kargs[] = {&a};
    hipError_t e = hipLaunchCooperativeKernel((const void*)fox_fwd, dim3(grid), dim3(512), kargs, LDS_BYTES, stream);
    if (e != hipSuccess) fprintf(stderr, "kernel_launch: cooperative launch failed: %s (grid %d)\n", hipGetErrorString(e), grid);
#endif
}
```

```cpp
#define MK_MULTI 0
#include <hip/hip_runtime.h>
#include <hip/hip_cooperative_groups.h>
#include <cstdio>
#include <cstdint>
namespace pg8 {
#define PG8_LAS __attribute__((address_space(3)))
typedef unsigned short bf16_t;
typedef short bf16x8 __attribute__((ext_vector_type(8)));
typedef float f32x4 __attribute__((ext_vector_type(4)));
typedef unsigned u32x4 __attribute__((ext_vector_type(4)));
constexpr int BM = 256, BK = 64, HALF = 128, HTB = HALF * BK * 2  , STAGE_BYTES = 8 * HTB, NXCD = 8, WGM = 8;

__host__ __device__ __forceinline__ int lds_byte(int r, int c) { const int st = (r >> 4) * 2 + (c >> 5), rr = r & 15, cc = c & 31, ob = rr * 64 + cc * 2; return st * 1024 + (ob ^ (((ob >> 9) & 1) << 5)); }
__host__ __device__ __forceinline__ void stage_rc(int b, int& R, int& C) { const int st = b / 1024, sb = b % 1024, swz = sb ^ (((sb >> 9) & 1) << 5); R = (st >> 1) * 16 + swz / 64; C = (st & 1) * 32 + (swz % 64) / 2; }
__host__ __device__ __forceinline__ int perm32(int rho) { const int n = rho >> 4, i = rho & 15; return 8 * (i >> 2) + 4 * n + (i & 3); }

struct Unit { int pm, pn; };
struct Gemm { const bf16_t* A; const bf16_t* Bt; int M, N, K; };

struct StaticOrder {
    int nM, nN, nwg, G, c, rot;
    __host__ __device__ void init(int M, int N, int G_, int c_) { nM = M / BM; nN = N / BM; nwg = nM * nN; G = G_; c = c_; rot = 0; }
    __host__ __device__ __forceinline__ bool next(int i, Unit& u) const {
        const long L = (long)i * G + c; if (L >= nwg) return false;
        int wgid = (int)L; { const int q = nwg / NXCD, r = nwg % NXCD, xcd = wgid % NXCD, off = wgid / NXCD; wgid = (xcd < r ? xcd * (q + 1) : r * (q + 1) + (xcd - r) * q) + off; }
        const int nig = WGM * nN, gid = wgid / nig, fm = gid * WGM, gsz = (nM - fm) < WGM ? (nM - fm) : WGM;
        u.pm = fm + ((wgid % nig) % gsz); u.pn = (wgid % nig) / gsz + rot; if (u.pn >= nN) u.pn -= nN; return true;
    }
    __device__ __forceinline__ void a_ready(const Unit&) const {}
    __device__ __forceinline__ void done(const Unit&) const {}
};

__device__ __forceinline__ unsigned cvt_pk_bf16(float lo, float hi) { unsigned r; asm volatile("v_cvt_pk_bf16_f32 %0, %1, %2" : "=v"(r) : "v"(lo), "v"(hi)); return r; }
typedef float f32x2 __attribute__((ext_vector_type(2)));
__device__ __forceinline__ f32x2 gelu_pk(f32x2 v) {
    const f32x2 av = __builtin_elementwise_abs(v), d = av * 0.2316418882f + 1.0f;
    f32x2 t; t.x = __builtin_amdgcn_rcpf(d.x); t.y = __builtin_amdgcn_rcpf(d.y);
    f32x2 q = t * 0.5307027145f + (-0.7265760135f); q = q * t + 0.7107068705f; q = q * t + (-0.142248368f); q = q * t + 0.127414796f; q = q * t;
    const f32x2 s = (v * v) * (-0.72134752044f);
    f32x2 e; e.x = __builtin_amdgcn_exp2f(s.x); e.y = __builtin_amdgcn_exp2f(s.y);
    const f32x2 m = v * (q * e), r = v - m;
    f32x2 o; o.x = v.x < 0.f ? m.x : r.x; o.y = v.y < 0.f ? m.y : r.y; return o;
}
constexpr float C2Q = 0.125f * 1.4426950408889634f;
constexpr float RSS_INV = 1.0f / (1024.0f * 16777216.0f);
struct EpiInProj {
    static constexpr bool PERM = true, AFTER_DRAIN = false;
    bf16_t* O; size_t split_stride; const unsigned long long* rss; unsigned* kmax; const float* bfv; float* logf; unsigned* fcnt;
    __device__ __forceinline__ void operator()(const f32x4 (&acc)[2][2][4][2], const Unit& u, int wr, int wc, int fr, int fq) const {
        if (u.pn == 10) {
            if (wc == 0 && fq == 0) {
#pragma unroll
                for (int ai = 0; ai < 2; ++ai)
#pragma unroll
                    for (int m = 0; m < 4; ++m) { const int row = u.pm * BM + wr * 64 + fr + ai * HALF + m * 16; const float rs = __builtin_amdgcn_rsqf((float)rss[row] * RSS_INV + 1e-6f);
#pragma unroll
                        for (int n = 0; n < 2; ++n)
#pragma unroll
                            for (int e = 0; e < 4; ++e) { const float z = (acc[ai][0][m][n][e] + acc[ai][1][m][n][e]) * rs + bfv[4 * n + e];
                                const float lf = fminf(z, 0.f) - 0.6931471805599453f * __builtin_amdgcn_logf(1.0f + __builtin_amdgcn_exp2f(-1.4426950408889634f * fabsf(z)));
                                __hip_atomic_store((unsigned*)(logf + (size_t)(4 * n + e) * 16384 + row), __float_as_uint(lf), __ATOMIC_RELAXED, __HIP_MEMORY_SCOPE_AGENT); } } }
            asm volatile("s_waitcnt vmcnt(0)" ::: "memory"); __builtin_amdgcn_s_barrier();
            if (wr == 0 && wc == 0 && fr == 0 && fq == 0) __hip_atomic_fetch_add(fcnt, 1u, __ATOMIC_RELAXED, __HIP_MEMORY_SCOPE_AGENT);
            return; }
        const int t = u.pn >> 1; float kmx[2] = {0.f, 0.f}; bf16_t* base = O + (size_t)t * split_stride;
        const int row0 = u.pm * BM + wr * 64 + fr, col0 = (u.pn & 1) * 256 + wc * 32 + 8 * fq;
        const float s0 = (t == 0) ? C2Q : 1.0f;
#pragma unroll
        for (int ai = 0; ai < 2; ++ai)
#pragma unroll
            for (int m = 0; m < 4; ++m) { const int row = row0 + ai * HALF + m * 16; const float rs = __builtin_amdgcn_rsqf((float)rss[row] * RSS_INV + 1e-6f) * s0; bf16_t* rowp = base + (size_t)row * 512 + col0;
#pragma unroll
                for (int bj = 0; bj < 2; ++bj) { f32x4 v0 = acc[ai][bj][m][0] * rs, v1 = acc[ai][bj][m][1] * rs;
                    if (t == 1) { const f32x4 q0 = v0 * v0, q1 = v1 * v1; float sq = ((q0[0] + q0[1]) + (q0[2] + q0[3])) + ((q1[0] + q1[1]) + (q1[2] + q1[3])); sq += __shfl_xor(sq, 16); sq += __shfl_xor(sq, 32); kmx[bj] = fmaxf(kmx[bj], sq); }
                    if (t >= 3) { f32x2 a = gelu_pk((f32x2){v0[0], v0[1]}), b = gelu_pk((f32x2){v0[2], v0[3]}), c = gelu_pk((f32x2){v1[0], v1[1]}), d = gelu_pk((f32x2){v1[2], v1[3]});
                        v0 = (f32x4){a.x, a.y, b.x, b.y}; v1 = (f32x4){c.x, c.y, d.x, d.y}; }
                    u32x4 w; w.x = cvt_pk_bf16(v0[0], v0[1]); w.y = cvt_pk_bf16(v0[2], v0[3]); w.z = cvt_pk_bf16(v1[0], v1[1]); w.w = cvt_pk_bf16(v1[2], v1[3]);
                    *(u32x4*)(rowp + bj * HALF) = w; } }
        if (t == 1) {
#pragma unroll
            for (int bj = 0; bj < 2; ++bj) { float v = kmx[bj]; v = fmaxf(v, __shfl_xor(v, 1)); v = fmaxf(v, __shfl_xor(v, 2)); v = fmaxf(v, __shfl_xor(v, 4)); v = fmaxf(v, __shfl_xor(v, 8));
                if (fr == 0 && fq == 0) atomicMax(kmax + ((u.pn & 1) * 4 + bj * 2 + (wc >> 1)) * 2 + (wc & 1), __float_as_uint(v)); } }
    }
};
struct EpiResid {
    static constexpr bool PERM = false, AFTER_DRAIN = false;
    bf16_t* xb; unsigned long long* rss;
    __device__ __forceinline__ void operator()(const f32x4 (&acc)[2][2][4][2], const Unit& u, int wr, int wc, int fr, int fq) const {
        typedef unsigned u32x2v __attribute__((ext_vector_type(2)));
        const int col0 = u.pn * BM + wc * 32 + 4 * fq;
#pragma unroll
        for (int ai = 0; ai < 2; ++ai)
#pragma unroll
            for (int m = 0; m < 4; ++m) { const int row = u.pm * BM + ai * HALF + wr * 64 + m * 16 + fr; const size_t off = (size_t)row * 1024 + col0; float sq = 0.f;
#pragma unroll
                for (int bj = 0; bj < 2; ++bj)
#pragma unroll
                    for (int n = 0; n < 2; ++n) { const u32x2v bw = *(const u32x2v*)(xb + off + bj * HALF + n * 16);
                        const f32x4 b = (f32x4){__builtin_bit_cast(float, bw.x << 16), __builtin_bit_cast(float, bw.x & 0xffff0000u), __builtin_bit_cast(float, bw.y << 16), __builtin_bit_cast(float, bw.y & 0xffff0000u)};
                        const f32x4 o = b + acc[ai][bj][m][n];
                        u32x2v w; w.x = cvt_pk_bf16(o[0], o[1]); w.y = cvt_pk_bf16(o[2], o[3]); *(u32x2v*)(xb + off + bj * HALF + n * 16) = w;
                        sq += (o[0] * o[0] + o[1] * o[1]) + (o[2] * o[2] + o[3] * o[3]); }
                sq += __shfl_xor(sq, 16); sq += __shfl_xor(sq, 32);
                if (fq == 0) atomicAdd(rss + row, (unsigned long long)__float2ull_rn(sq * 16777216.0f)); }
    }
};
struct EpiSwiGLU {
    static constexpr bool PERM = true, AFTER_DRAIN = false;
    bf16_t* H; const unsigned long long* rss;
    __device__ __forceinline__ void operator()(const f32x4 (&acc)[2][2][4][2], const Unit& u, int wr, int wc, int fr, int fq) const {
        const int row0 = u.pm * BM + wr * 64 + fr, col0 = u.pn * 128 + wc * 32 + 8 * fq;
#pragma unroll
        for (int ai = 0; ai < 2; ++ai)
#pragma unroll
            for (int m = 0; m < 4; ++m) { const int row = row0 + ai * HALF + m * 16; const float rs = __builtin_amdgcn_rsqf((float)rss[row] * RSS_INV + 1e-6f);
                float hv[8];
#pragma unroll
                for (int n = 0; n < 2; ++n)
#pragma unroll
                    for (int e = 0; e < 4; ++e) { const float g = acc[ai][0][m][n][e] * rs, up = acc[ai][1][m][n][e] * rs;
                        const float sg = __builtin_amdgcn_rcpf(1.0f + __builtin_amdgcn_exp2f(-1.4426950408889634f * g)); hv[n * 4 + e] = g * sg * up; }
                u32x4 w; w.x = cvt_pk_bf16(hv[0], hv[1]); w.y = cvt_pk_bf16(hv[2], hv[3]); w.z = cvt_pk_bf16(hv[4], hv[5]); w.w = cvt_pk_bf16(hv[6], hv[7]);
                *(u32x4*)(H + (size_t)row * 2816 + col0) = w; }
    }
};
template <class Epi, class Sched, bool ALIGN_EPI = false, bool SP2 = false>
__device__ __forceinline__ void gemm_phase(PG8_LAS unsigned char* lds, const Gemm g, const Sched& S, const Epi& E) {
    int tid = threadIdx.x; asm volatile("" : "+v"(tid));
    const int wid = __builtin_amdgcn_readfirstlane(tid >> 6), lane = tid & 63, wr = wid >> 2, wc = wid & 3, fr = lane & 15, fq = lane >> 4;
    const int K = g.K, nt = K / BK;
    unsigned voffA[2], voffB[2];
#pragma unroll
    for (int i = 0; i < 2; ++i) { int R, C; stage_rc(tid * 16 + i * 8192, R, C); const int Rb = Epi::PERM ? ((R & ~31) + perm32(R & 31)) : R;
        voffA[i] = (unsigned)(R * K + C) * 2u; voffB[i] = (unsigned)(Rb * K + C) * 2u; }
    const size_t kstep = (size_t)(BK * 2);
    const size_t hstep = (size_t)HALF * K * 2;
    const size_t tstep = 2 * hstep;
    const unsigned ldsw = (unsigned)wid * 1024u;
    const int aoff = lds_byte(wr * 64 + fr, fq * 8), boff = lds_byte(wc * 32 + fr, fq * 8);
#define PG8_SA(b, h) (((b) * 2 + (h)) * HTB)
#define PG8_SB(b, h) ((4 + (b) * 2 + (h)) * HTB)
#define PG8_STAGE(bufoff, gbase, voff) do { _Pragma("unroll") for (int _i = 0; _i < 2; ++_i) \
        __builtin_amdgcn_global_load_lds((const unsigned*)((const char*)(gbase) + (voff)[_i]), (PG8_LAS unsigned*)(lds + (bufoff) + ldsw + _i * 8192), 16, 0, 0); } while (0)
#define PG8_LDA(dst, b, h) do { _Pragma("unroll") for (int m = 0; m < 4; ++m) _Pragma("unroll") for (int k = 0; k < 2; ++k) dst[m][k] = *(const PG8_LAS bf16x8*)(lds + PG8_SA(b, h) + aoff + m * 2048 + k * 1024); } while (0)
#define PG8_LDB(dst, b, h) do { _Pragma("unroll") for (int n = 0; n < 2; ++n) _Pragma("unroll") for (int k = 0; k < 2; ++k) dst[n][k] = *(const PG8_LAS bf16x8*)(lds + PG8_SB(b, h) + boff + n * 2048 + k * 1024); } while (0)
#define PG8_MMA(ai, bj, At, Bt) do { __builtin_amdgcn_s_setprio(1); _Pragma("unroll") for (int m = 0; m < 4; ++m) _Pragma("unroll") for (int n = 0; n < 2; ++n) _Pragma("unroll") for (int k = 0; k < 2; ++k) \
        acc[ai][bj][m][n] = __builtin_amdgcn_mfma_f32_16x16x32_bf16(Bt[n][k], At[m][k], acc[ai][bj][m][n], 0, 0, 0); __builtin_amdgcn_s_setprio(0); } while (0)
#define PG8_WAIT_V(n) asm volatile("s_waitcnt vmcnt(" #n ")" ::: "memory")
#define PG8_WAIT_L(n) asm volatile("s_waitcnt lgkmcnt(" #n ")" ::: "memory")
#define PG8_BAR __builtin_amdgcn_s_barrier()
#define PG8_SCHED __builtin_amdgcn_sched_barrier(0)
    Unit cur, nxt; int ui = 0;
    if (!S.next(0, cur)) return;
    f32x4 acc[2][2][4][2];
#pragma unroll
    for (int a = 0; a < 2; ++a)
#pragma unroll
        for (int b = 0; b < 2; ++b)
#pragma unroll
            for (int m = 0; m < 4; ++m)
#pragma unroll
                for (int n = 0; n < 2; ++n) acc[a][b][m][n] = (f32x4){0.f, 0.f, 0.f, 0.f};
    bf16x8 At[4][2], B0[2][2], B1[2][2];
    const char* cA = (const char*)g.A + (size_t)cur.pm * tstep; const char* cB = (const char*)g.Bt + (size_t)cur.pn * tstep;
    S.a_ready(cur);
    if constexpr (SP2) {
        PG8_STAGE(PG8_SB(0, 0), cB, voffB); PG8_STAGE(PG8_SB(0, 1), cB + hstep, voffB); PG8_STAGE(PG8_SA(0, 0), cA, voffA); PG8_STAGE(PG8_SA(0, 1), cA + hstep, voffA);
        if (wr == 1) PG8_BAR;
        PG8_WAIT_V(2); PG8_BAR;
        PG8_STAGE(PG8_SB(1, 0), cB + kstep, voffB); PG8_STAGE(PG8_SA(1, 0), cA + kstep, voffA); PG8_STAGE(PG8_SB(1, 1), cB + hstep + kstep, voffB);
        PG8_WAIT_V(6); PG8_BAR;
    } else {
        PG8_STAGE(PG8_SB(0, 0), cB, voffB); PG8_STAGE(PG8_SA(0, 0), cA, voffA); PG8_STAGE(PG8_SB(0, 1), cB + hstep, voffB); PG8_STAGE(PG8_SA(0, 1), cA + hstep, voffA);
        if (wr == 1) PG8_BAR;
        PG8_WAIT_V(4); PG8_BAR;
        PG8_STAGE(PG8_SB(1, 0), cB + kstep, voffB); PG8_STAGE(PG8_SA(1, 0), cA + kstep, voffA); PG8_STAGE(PG8_SB(1, 1), cB + hstep + kstep, voffB);
        PG8_WAIT_V(6); PG8_BAR;
    }
    for (;;) {
        const bool has_next = S.next(ui + 1, nxt);
        const char* nA = has_next ? (const char*)g.A + (size_t)nxt.pm * tstep : cA; const char* nB = has_next ? (const char*)g.Bt + (size_t)nxt.pn * tstep : cB;
        for (int t = 0; t < nt; t += 2) {
            const bool last = (t == nt - 2);
            const char* a1 = cA + (size_t)(t + 1) * kstep;
            const char* a2 = last ? nA : cA + (size_t)(t + 2) * kstep; const char* b2 = last ? nB : cB + (size_t)(t + 2) * kstep;
            const char* a3 = a2 + kstep; const char* b3 = b2 + kstep;
            if (last && has_next) S.a_ready(nxt);
            if constexpr (SP2) {
            PG8_LDB(B0, 0, 0); PG8_LDB(B1, 0, 1); PG8_SCHED; PG8_LDA(At, 0, 0); PG8_STAGE(PG8_SA(1, 1), a1 + hstep, voffA);
            PG8_WAIT_V(8); PG8_WAIT_L(0); PG8_BAR; PG8_MMA(0, 0, At, B0); PG8_MMA(0, 1, At, B1); PG8_BAR; PG8_SCHED;
            PG8_LDA(At, 0, 1); PG8_STAGE(PG8_SB(0, 0), b2, voffB); PG8_STAGE(PG8_SB(0, 1), b2 + hstep, voffB); PG8_STAGE(PG8_SA(0, 0), a2, voffA);
            PG8_WAIT_V(8); PG8_WAIT_L(0); PG8_BAR; PG8_MMA(1, 0, At, B0); PG8_MMA(1, 1, At, B1); PG8_BAR; PG8_SCHED;
            PG8_LDB(B0, 1, 0); PG8_LDB(B1, 1, 1); PG8_SCHED; PG8_LDA(At, 1, 0); PG8_STAGE(PG8_SA(0, 1), a2 + hstep, voffA);
            PG8_WAIT_V(8); PG8_WAIT_L(0); PG8_BAR; PG8_MMA(0, 0, At, B0); PG8_MMA(0, 1, At, B1); PG8_BAR; PG8_SCHED;
            PG8_LDA(At, 1, 1); PG8_STAGE(PG8_SB(1, 0), b3, voffB); PG8_STAGE(PG8_SB(1, 1), b3 + hstep, voffB); PG8_STAGE(PG8_SA(1, 0), a3, voffA);
            PG8_WAIT_V(8); PG8_WAIT_L(0); PG8_BAR; PG8_MMA(1, 0, At, B0); PG8_MMA(1, 1, At, B1); PG8_BAR; PG8_SCHED;
            } else {
            PG8_LDB(B0, 0, 0); PG8_SCHED; PG8_LDA(At, 0, 0); PG8_STAGE(PG8_SA(1, 1), a1 + hstep, voffA);
            PG8_WAIT_L(8); PG8_BAR; PG8_WAIT_L(0); PG8_MMA(0, 0, At, B0); PG8_BAR; PG8_SCHED;
            PG8_LDB(B1, 0, 1); PG8_STAGE(PG8_SB(0, 0), b2, voffB);
            PG8_BAR; PG8_WAIT_L(0); PG8_MMA(0, 1, At, B1); PG8_BAR;
            PG8_LDA(At, 0, 1); PG8_STAGE(PG8_SA(0, 0), a2, voffA);
            PG8_BAR; PG8_WAIT_L(0); PG8_MMA(1, 0, At, B0); PG8_BAR; PG8_SCHED;
            PG8_STAGE(PG8_SB(0, 1), b2 + hstep, voffB);
            PG8_WAIT_V(6); PG8_BAR; PG8_MMA(1, 1, At, B1); PG8_BAR;
            PG8_LDB(B0, 1, 0); PG8_SCHED; PG8_LDA(At, 1, 0); PG8_STAGE(PG8_SA(0, 1), a2 + hstep, voffA);
            PG8_WAIT_L(8); PG8_BAR; PG8_WAIT_L(0); PG8_MMA(0, 0, At, B0); PG8_BAR; PG8_SCHED;
            PG8_LDB(B1, 1, 1); PG8_STAGE(PG8_SB(1, 0), b3, voffB);
            PG8_BAR; PG8_WAIT_L(0); PG8_MMA(0, 1, At, B1); PG8_BAR;
            PG8_LDA(At, 1, 1); PG8_STAGE(PG8_SA(1, 0), a3, voffA);
            PG8_BAR; PG8_WAIT_L(0); PG8_MMA(1, 0, At, B0); PG8_BAR; PG8_SCHED;
            PG8_STAGE(PG8_SB(1, 1), b3 + hstep, voffB);
            PG8_WAIT_V(6); PG8_BAR; PG8_MMA(1, 1, At, B1); PG8_BAR;
            }
        }
        if constexpr (ALIGN_EPI) { if (wr == 0) PG8_BAR; }
        if constexpr (!Epi::AFTER_DRAIN) { E(acc, cur, wr, wc, fr, fq); S.done(cur); }
        if (!has_next) break;
#pragma unroll
        for (int a = 0; a < 2; ++a)
#pragma unroll
            for (int b = 0; b < 2; ++b)
#pragma unroll
                for (int m = 0; m < 4; ++m)
#pragma unroll
                    for (int n = 0; n < 2; ++n) acc[a][b][m][n] = (f32x4){0.f, 0.f, 0.f, 0.f};
        cur = nxt; cA = nA; cB = nB; ++ui;
        if constexpr (ALIGN_EPI) { if (wr == 1) PG8_BAR; }
    }
    PG8_WAIT_V(0);
    if constexpr (!ALIGN_EPI) { if (wr == 0) PG8_BAR; }
    PG8_BAR;
    if constexpr (Epi::AFTER_DRAIN) { E.fused(acc, cur, wr, wc, fr, fq, lds, wid, lane); S.done(cur); }
#undef PG8_SA
#undef PG8_SB
#undef PG8_STAGE
#undef PG8_LDA
#undef PG8_LDB
#undef PG8_MMA
#undef PG8_WAIT_V
#undef PG8_WAIT_L
#undef PG8_BAR
#undef PG8_SCHED
}
}
#include <hip/hip_bf16.h>
#include <cmath>
namespace attn_body {
using bf16=__hip_bfloat16;
using bf16x8=__attribute__((ext_vector_type(8)))short;
using s16x4=__attribute__((ext_vector_type(4)))short;
using f32x16=__attribute__((ext_vector_type(16)))float;
using u32x4=__attribute__((ext_vector_type(4)))unsigned;
constexpr int BATCH=1,NHEAD=8,SEQ=16384,D=64,DM=NHEAD*D;
constexpr int NW=8,QBLK=32,QB=QBLK*NW,KVBLK=64,NQB=SEQ/QB;
constexpr int ATTN_PITCH=DM, ATTN_UNIT_ROWS=QB;
__device__ __forceinline__ int crow(int r,int hi){return (r&3)+8*(r>>2)+4*hi;}
#define SBAR() __builtin_amdgcn_sched_barrier(0)
__device__ __forceinline__ void cmask(f32x16&p0,f32x16&p1,int jb,int qrel,int hi){
  const float NEG=-INFINITY; int kb=64*jb+4*hi;
  #pragma unroll
  for(int r=0;r<16;++r){int kv=kb+(r&3)+8*(r>>2); if(kv>qrel)p0[r]=NEG; if(kv+32>qrel)p1[r]=NEG;}
}

constexpr int NSLOT=3, SLOTB=8192;
constexpr int LDS_K=0, LDS_V=NSLOT*SLOTB, LDS_WS=2*NSLOT*SLOTB, LDS_OST=LDS_WS+NW*64*4, LDS_BYTES=LDS_OST+NW*4096;
constexpr float C2=0.125f*1.4426950408889634f;
__device__ __forceinline__ void glds16(const void*gsrc,unsigned lds_dst){unsigned keep;
  asm volatile("s_mov_b32 %0, m0\n\ts_mov_b32 m0, %2\n\ts_nop 0\n\tglobal_load_lds_dwordx4 %1, off\n\ts_mov_b32 m0, %0":"=&s"(keep):"v"(gsrc),"s"(lds_dst):"memory");}
__device__ __forceinline__ float max3f(float a,float b,float c){float r;asm("v_max3_f32 %0, %1, %2, %3":"=v"(r):"v"(a),"v"(b),"v"(c));return r;}
__device__ __forceinline__ float max2f(float a,float b){float r;asm("v_max_f32_e32 %0, %1, %2":"=v"(r):"v"(a),"v"(b));return r;}
__device__ __forceinline__ float fadd_s(float a,float b){float r;asm("v_add_f32_e32 %0, %1, %2":"=v"(r):"v"(a),"v"(b));return r;}
__device__ __forceinline__ float fsub_s(float a,float b){float r;asm("v_sub_f32_e32 %0, %1, %2":"=v"(r):"v"(a),"v"(b));return r;}
typedef float f32x2_t __attribute__((ext_vector_type(2))); typedef __bf16 bf16x2_t __attribute__((ext_vector_type(2)));
__device__ __forceinline__ unsigned cvtpk_s(float lo,float hi){f32x2_t v={lo,hi};bf16x2_t b=__builtin_convertvector(v,bf16x2_t);return __builtin_bit_cast(unsigned,b);}
#define WAIT_BAR(N) asm volatile("s_waitcnt vmcnt(" #N ") lgkmcnt(0)\n\ts_barrier":::"memory")

__device__ __forceinline__ void qkt(f32x16&p0,f32x16&p1,const char*Kslot,const bf16x8*qr,const f32x16&negm,int r32,int hi){
  const char*kb=Kslot+hi*1024+r32*16;
  #pragma unroll
  for(int d0=0;d0<4;++d0){
    const bf16x8 b0=*reinterpret_cast<const bf16x8*>(kb+d0*2048);
    const bf16x8 b1=*reinterpret_cast<const bf16x8*>(kb+d0*2048+512);
    if(d0==0){p0=__builtin_amdgcn_mfma_f32_32x32x16_bf16(b0,qr[0],negm,0,0,0);p1=__builtin_amdgcn_mfma_f32_32x32x16_bf16(b1,qr[0],negm,0,0,0);}
    else{p0=__builtin_amdgcn_mfma_f32_32x32x16_bf16(b0,qr[d0],p0,0,0,0);p1=__builtin_amdgcn_mfma_f32_32x32x16_bf16(b1,qr[d0],p1,0,0,0);}}
}
typedef __attribute__((address_space(3))) const char* lds_cptr;
typedef short v4i16_t __attribute__((ext_vector_type(4)));
__device__ __forceinline__ void kload8(bf16x8*kf,lds_cptr kp){
  kf[0]=*(const __attribute__((address_space(3))) bf16x8*)(kp);      kf[1]=*(const __attribute__((address_space(3))) bf16x8*)(kp+512);
  kf[2]=*(const __attribute__((address_space(3))) bf16x8*)(kp+2048); kf[3]=*(const __attribute__((address_space(3))) bf16x8*)(kp+2560);
  kf[4]=*(const __attribute__((address_space(3))) bf16x8*)(kp+4096); kf[5]=*(const __attribute__((address_space(3))) bf16x8*)(kp+4608);
  kf[6]=*(const __attribute__((address_space(3))) bf16x8*)(kp+6144); kf[7]=*(const __attribute__((address_space(3))) bf16x8*)(kp+6656);
}
__device__ __forceinline__ void kload2(bf16x8*kf,lds_cptr kp,int j){ kf[2*j]=*(const __attribute__((address_space(3))) bf16x8*)(kp+j*2048); kf[2*j+1]=*(const __attribute__((address_space(3))) bf16x8*)(kp+j*2048+512); }
__device__ __forceinline__ s16x4 vtr(lds_cptr p){ return __builtin_bit_cast(s16x4,__builtin_amdgcn_ds_read_tr16_b64_v4i16((__attribute__((address_space(3))) v4i16_t*)p)); }
__device__ __forceinline__ float rowmax(const f32x16&p0,const f32x16&p1){
  float a=max3f(p0[0],p0[1],p1[0]),b=max3f(p0[2],p0[3],p1[1]);a=max3f(a,p1[2],p1[3]);
  #pragma unroll
  for(int r=4;r<16;r+=4){a=max3f(a,p0[r],p0[r+1]);b=max3f(b,p0[r+2],p0[r+3]);a=max3f(a,p1[r],p1[r+1]);b=max3f(b,p1[r+2],p1[r+3]);}
  const float m=max2f(a,b);
  auto rr=__builtin_amdgcn_permlane32_swap(__float_as_uint(m),__float_as_uint(m),false,false);
  return max2f(__uint_as_float(rr[0]),__uint_as_float(rr[1]));
}
__device__ __forceinline__ void pv(f32x16*o,int vb,bf16x8 pa0,bf16x8 pa1,bf16x8 pa2,bf16x8 pa3){
  #pragma unroll
  for(int d0=0;d0<2;++d0){s16x4 lo[4],hi[4];
    #pragma unroll
    for(int ks=0;ks<4;++ks){
      asm volatile("ds_read_b64_tr_b16 %0,%1 offset:%c2":"=&v"(lo[ks]):"v"(vb),"i"(d0*4096+ks*1024):"memory");
      asm volatile("ds_read_b64_tr_b16 %0,%1 offset:%c2":"=&v"(hi[ks]):"v"(vb),"i"(d0*4096+ks*1024+512):"memory");}
    asm volatile("s_waitcnt lgkmcnt(0)":::"memory");SBAR();
    #define PK(k) (bf16x8){lo[k][0],lo[k][1],lo[k][2],lo[k][3],hi[k][0],hi[k][1],hi[k][2],hi[k][3]}
    o[d0]=__builtin_amdgcn_mfma_f32_32x32x16_bf16(pa0,PK(0),o[d0],0,0,0);
    o[d0]=__builtin_amdgcn_mfma_f32_32x32x16_bf16(pa1,PK(1),o[d0],0,0,0);
    o[d0]=__builtin_amdgcn_mfma_f32_32x32x16_bf16(pa2,PK(2),o[d0],0,0,0);
    o[d0]=__builtin_amdgcn_mfma_f32_32x32x16_bf16(pa3,PK(3),o[d0],0,0,0);
    #undef PK
  }
}
typedef float f32x4_t __attribute__((ext_vector_type(4)));

#ifndef ATTN_STORE16
#define ATTN_STORE16(p,v) (*(u32x4*)(p)=(v))
#endif
constexpr int FCH=64;
constexpr int F2_CK=LDS_BYTES, FOX2_LDS_BYTES=F2_CK+FCH*64*4;
template<int THRL> __device__ __forceinline__ void fox_unit2(int h,int qb,int jc,float kn,const bf16*Q,const bf16*__restrict__ K,const bf16*__restrict__ V,bf16*O,float*ML,const float*__restrict__ c2h,char*shm,float*qmx){
  int tid=threadIdx.x; asm volatile("":"+v"(tid)); const int lane=tid&63,r32=lane&31,hi=lane>>5; const int wid=__builtin_amdgcn_readfirstlane(tid>>6);
  const long rowbase=0; const int q0=qb*QB;
  const bf16*Qw=Q+(rowbase+q0+wid*QBLK)*DM+h*D;
  const bf16*Kh=K+rowbase*DM+h*D,*Vh=V+rowbase*DM+h*D;
  const unsigned lds0=(unsigned)(uintptr_t)shm;
  float*wsf=(float*)(shm+LDS_WS)+wid*64;
  float*ckl=(float*)(shm+F2_CK);
  const int NTg=(q0+QB)/KVBLK;
  bf16x8 qr[4];
  #pragma unroll
  for(int d0=0;d0<4;++d0)qr[d0]=*reinterpret_cast<const bf16x8*>(&Qw[(long)r32*DM+d0*16+hi*8]);
  bf16x8 kd[4];
  { const bf16*Kd=K+(long)(q0+wid*QBLK+r32)*DM+h*D;
    #pragma unroll
    for(int d0=0;d0<4;++d0)kd[d0]=*reinterpret_cast<const bf16x8*>(&Kd[d0*16+hi*8]); }
  int ts;
  const float cq0_=c2h[q0], cte_=(tid<NTg-4)?c2h[64*tid+63]:0.f;
  { float qs=0.f,dg=0.f;
    #pragma unroll
    for(int d0=0;d0<4;++d0)
      #pragma unroll
      for(int e=0;e<8;++e){ const float v=__builtin_bit_cast(float,(unsigned)(unsigned short)qr[d0][e]<<16); qs+=v*v; dg+=v*__builtin_bit_cast(float,(unsigned)(unsigned short)kd[d0][e]<<16); }
    { auto rr=__builtin_amdgcn_permlane32_swap(__float_as_uint(qs),__float_as_uint(qs),false,false); qs=__uint_as_float(rr[0])+__uint_as_float(rr[1]); }
    { auto rr=__builtin_amdgcn_permlane32_swap(__float_as_uint(dg),__float_as_uint(dg),false,false); dg=__uint_as_float(rr[0])+__uint_as_float(rr[1]); }
    #pragma unroll
    for(int o_=1;o_<32;o_<<=1){ qs=__builtin_fmaxf(qs,__shfl_xor(qs,o_)); dg=__builtin_fminf(dg,__shfl_xor(dg,o_)); }
    if(lane==0){qmx[wid]=qs;qmx[wid-20]=dg;}
    __syncthreads();
    float q2=qmx[0];
    #pragma unroll
    for(int w_=1;w_<8;++w_)q2=__builtin_fmaxf(q2,qmx[w_]);
    float dmin=qmx[-20];
    #pragma unroll
    for(int w_=1;w_<8;++w_)dmin=__builtin_fminf(dmin,qmx[w_-20]);
    const float lim=cq0_+152.05f+sqrtf(q2)*kn-dmin;
    ts=__syncthreads_count((tid<NTg-4)&&(cte_>lim)); ts&=~3; }
  const int t1=NTg-FCH*jc; int t0=t1-FCH; t0=t0<0?0:t0; t0=t0<ts?ts:t0;
  if(t0>=t1){ if(hi==0){ float*mlp=ML+((long)(q0+wid*QBLK+r32)*NHEAD+h)*2; mlp[0]=-1.0e30f; mlp[1]=0.f; } return; }
  const int NT=t1-t0;
  const int NTm=(jc==0)?NT:(1<<20);
  const bf16*ksrc=Kh+(long)(t0*KVBLK+lane)*DM+wid*8;
  const bf16*vsrc=Vh+(long)(t0*KVBLK+16*(wid&3)+(lane>>2))*DM+(wid>>2)*32+(lane&3)*8;
  const unsigned kdst=lds0+LDS_K+wid*1024, vdst=lds0+LDS_V+wid*1024;
  #define DMA_K(t,slot) glds16(ksrc+(long)(t)*KVBLK*DM,(unsigned)__builtin_amdgcn_readfirstlane(kdst+(slot)))
  #define DMA_V(t,slot) glds16(vsrc+(long)(t)*KVBLK*DM,(unsigned)__builtin_amdgcn_readfirstlane(vdst+(slot)))
  const int vb0=(int)(lds0+LDS_V)+((lane>>4)&1)*32+(lane&3)*8+(4*hi+((lane&15)>>2))*64;
  const char*Kbase=shm+LDS_K; bf16x8 kf[8];
  const lds_cptr shm3=(lds_cptr)shm; const lds_cptr kp0=shm3+LDS_K+hi*1024+r32*16; const lds_cptr vp0=shm3+LDS_V+((lane>>4)&1)*32+(lane&3)*8+(4*hi+((lane&15)>>2))*64;
  DMA_K(0,0);DMA_V(0,0);DMA_K(1,SLOTB);
  { const float cref=cq0_; const int nck=NT*64;
    for(int i=tid*4;i<nck;i+=2048){ f32x4_t v=*(const f32x4_t*)(c2h+t0*64+i); v=v-cref; *(f32x4_t*)(ckl+i)=v; } }
  float mhat=0.f,l_reg=0.f;f32x16 o[2];o[0]=f32x16{};o[1]=f32x16{};const f32x16 zc16=f32x16{};
  const int qrel=wid*QBLK+r32;
  #define CMASK(P0,P1,t) do{int jb_=(t)-(NTm-4); if(jb_>=0)cmask(P0,P1,jb_,qrel,hi);}while(0)
  #define BIAS(P0,P1,t) do{ const float*cb_=ckl+(t)*64+4*hi; _Pragma("unroll") for(int g_=0;g_<4;++g_){ const f32x4_t a_=*(const f32x4_t*)(cb_+8*g_), b_=*(const f32x4_t*)(cb_+32+8*g_); _Pragma("unroll") for(int e_=0;e_<4;++e_){P0[4*g_+e_]-=a_[e_];P1[4*g_+e_]-=b_[e_];} SBAR(); } }while(0)
  bool resc=false;
  #define START(P0,P1) do{ const float rm=rowmax(P0,P1); resc=false; \
    { const float dl=rm; mhat=fadd_s(mhat,dl); \
      _Pragma("unroll") for(int r=0;r<16;++r){P0[r]=fsub_s(P0[r],dl);P1[r]=fsub_s(P1[r],dl);} \
      } \
    _Pragma("unroll") for(int r=0;r<16;++r)P0[r]=__builtin_amdgcn_exp2f(P0[r]); }while(0)
  #define RESC() do{ if(resc){ asm volatile("s_waitcnt lgkmcnt(0)":::"memory"); \
      _Pragma("unroll") for(int d_=0;d_<2;++d_) _Pragma("unroll") for(int r=0;r<16;++r)o[d_][r]*=wsf[crow(r,hi)]; } }while(0)
  f32x16 pA0,pA1,pB0,pB1;
  int sl_prev=0,sl_cur=0,sl_next=SLOTB;
  #define ROT() do{sl_prev=sl_cur;sl_cur=sl_next;sl_next=(sl_next==(NSLOT-1)*SLOTB)?0:sl_next+SLOTB;}while(0)
  DMA_K(2,2*SLOTB);
  WAIT_BAR(3);
  qkt(pA0,pA1,Kbase,qr,zc16,r32,hi);asm volatile("s_nop 15\n\ts_nop 7":"+v"(pA0),"+v"(pA1));BIAS(pA0,pA1,0);CMASK(pA0,pA1,0);
  START(pA0,pA1);
  _Pragma("unroll") for(int r=0;r<16;++r)pA1[r]=__builtin_amdgcn_exp2f(pA1[r]);
  #define PFG(X0,X1,tn,k) do{ const f32x4_t a_=*(const f32x4_t*)(ckl+(tn)*64+4*hi+(((k)<4)?8*(k):32+8*((k)-4))); const float nm_=-mhat; \
      if((k)<4){ X0[4*(k)]=nm_-a_[0]; X0[4*(k)+1]=nm_-a_[1]; X0[4*(k)+2]=nm_-a_[2]; X0[4*(k)+3]=nm_-a_[3]; } \
      else { X1[4*((k)-4)]=nm_-a_[0]; X1[4*((k)-4)+1]=nm_-a_[1]; X1[4*((k)-4)+2]=nm_-a_[2]; X1[4*((k)-4)+3]=nm_-a_[3]; } }while(0)
  { PFG(pB0,pB1,1,0);PFG(pB0,pB1,1,1);PFG(pB0,pB1,1,2);PFG(pB0,pB1,1,3);PFG(pB0,pB1,1,4);PFG(pB0,pB1,1,5);PFG(pB0,pB1,1,6);PFG(pB0,pB1,1,7); }
  WAIT_BAR(0);
  DMA_K(3,0);DMA_V(1,SLOTB);
  ROT();
  kload8(kf,kp0+sl_cur);
  WAIT_BAR(2);
  s16x4 vlo[8],vhi[8]; u32x4 pw0,pw1,pw2,pw3;
  #define PKW(P,B) cvtpk_s(P[B],P[B+1])
  #define PAF(k) __builtin_bit_cast(bf16x8,pw##k)
  #define VFR(i) (bf16x8){vlo[i][0],vlo[i][1],vlo[i][2],vlo[i][3],vhi[i][0],vhi[i][1],vhi[i][2],vhi[i][3]}
  #define PIN(x) asm volatile("":"+v"(x))
  #define MX3(a,b,c) __builtin_fmaxf(__builtin_fmaxf((a),(b)),(c))
  #define GAPA(MF,A0,A1,A2,A3,W0,W1,PW) do{ MF; sacc+=A0; sacc+=A1; sacc+=A2; sacc+=A3; PIN(sacc); W0; W1; PIN(PW); SBAR(); }while(0)
  #define EX(v) __builtin_amdgcn_exp2f(v)
  #define GAPB(MF,X,B,PF) do{ MF; PF; X[B]=EX(X[B]); X[B+1]=EX(X[B+1]); X[B+2]=EX(X[B+2]); X[B+3]=EX(X[B+3]); PIN(X); SBAR(); }while(0)
  #define PFN(G,X0,X1,tt,k) do{ if(G){ PFG(X0,X1,(tt)+1,k); } }while(0)
  #define VRD(i) do{ vlo[i]=vtr(vp_+(((i)>>2)*4096+((i)&3)*1024)); vhi[i]=vtr(vp_+(((i)>>2)*4096+((i)&3)*1024+512)); }while(0)
  #define KRD(G,j) do{ if(G){ kload2(kf,kp0+sl_next,j); SBAR(); } }while(0)
  #define STEP(C0,C1,P0,P1,t,GK,GV,GL) do{ SBAR(); \
    const lds_cptr vp_=vp0+sl_prev; \
    VRD(0); SBAR(); float sacc=(P0[0]+P0[1]); \
    GAPA(C0=__builtin_amdgcn_mfma_f32_32x32x16_bf16(kf[0],qr[0],C0,0,0,0), P0[2],P0[3],P0[4],P0[5],     pw0[0]=PKW(P0,0), pw0[1]=PKW(P0,2), pw0); \
    VRD(4); SBAR(); GAPA(C1=__builtin_amdgcn_mfma_f32_32x32x16_bf16(kf[1],qr[0],C1,0,0,0), P0[6],P0[7],P0[8],P0[9],     pw0[2]=PKW(P0,4), pw0[3]=PKW(P0,6), pw0); \
    VRD(1); SBAR(); GAPA(C0=__builtin_amdgcn_mfma_f32_32x32x16_bf16(kf[2],qr[1],C0,0,0,0),   P0[10],P0[11],P0[12],P0[13], pw1[0]=PKW(P0,8), pw1[1]=PKW(P0,10), pw1); \
    VRD(5); SBAR(); GAPA(C1=__builtin_amdgcn_mfma_f32_32x32x16_bf16(kf[3],qr[1],C1,0,0,0),   P0[14],P0[15],P1[0],P1[1],   pw1[2]=PKW(P0,12),pw1[3]=PKW(P0,14), pw1); \
    VRD(2); SBAR(); GAPA(C0=__builtin_amdgcn_mfma_f32_32x32x16_bf16(kf[4],qr[2],C0,0,0,0),   P1[2],P1[3],P1[4],P1[5],     pw2[0]=PKW(P1,0), pw2[1]=PKW(P1,2), pw2); \
    VRD(6); SBAR(); GAPA(C1=__builtin_amdgcn_mfma_f32_32x32x16_bf16(kf[5],qr[2],C1,0,0,0),   P1[6],P1[7],P1[8],P1[9],     pw2[2]=PKW(P1,4), pw2[3]=PKW(P1,6), pw2); \
    VRD(3); SBAR(); GAPA(C0=__builtin_amdgcn_mfma_f32_32x32x16_bf16(kf[6],qr[3],C0,0,0,0),   P1[10],P1[11],P1[12],P1[13], pw3[0]=PKW(P1,8), pw3[1]=PKW(P1,10), pw3); \
    VRD(7); SBAR(); GAPA(C1=__builtin_amdgcn_mfma_f32_32x32x16_bf16(kf[7],qr[3],C1,0,0,0),   P1[14],P1[15],0.f,0.f,       pw3[2]=PKW(P1,12),pw3[3]=PKW(P1,14), pw3); \
    l_reg+=sacc; \
    if(GK){DMA_K((t)+3,sl_cur);} if(GV){DMA_V((t)+1,sl_next);} \
    CMASK(C0,C1,t); \
    { float a=MX3(C0[0],C0[1],C1[0]),b=MX3(C0[2],C0[3],C1[1]); a=MX3(a,C1[2],C1[3]); \
      _Pragma("unroll") for(int r=4;r<16;r+=4){a=MX3(a,C0[r],C0[r+1]);b=MX3(b,C0[r+2],C0[r+3]);a=MX3(a,C1[r],C1[r+1]);b=MX3(b,C1[r+2],C1[r+3]);} \
      float rm=__builtin_fmaxf(a,b); { auto rr=__builtin_amdgcn_permlane32_swap(__float_as_uint(rm),__float_as_uint(rm),false,false); rm=__builtin_fmaxf(__uint_as_float(rr[0]),__uint_as_float(rr[1])); } \
      resc=false; \
      if(__builtin_expect(__any(rm>(float)THRL),0)){ const float dl=__builtin_fmaxf(rm,0.f); mhat+=dl; \
        _Pragma("unroll") for(int r=0;r<16;++r){C0[r]-=dl;C1[r]-=dl;} \
        const float f=__builtin_amdgcn_exp2f(-dl); l_reg*=f; if(hi==0)wsf[r32]=f; resc=true; } } \
    SBAR(); \
    GAPB(o[0]=__builtin_amdgcn_mfma_f32_32x32x16_bf16(PAF(0),VFR(0),o[0],0,0,0), C0,0, PFN(GL,P0,P1,t,0)); \
    GAPB(o[1]=__builtin_amdgcn_mfma_f32_32x32x16_bf16(PAF(0),VFR(4),o[1],0,0,0), C0,4, PFN(GL,P0,P1,t,1)); \
    KRD(GL,0); GAPB(o[0]=__builtin_amdgcn_mfma_f32_32x32x16_bf16(PAF(1),VFR(1),o[0],0,0,0), C0,8, PFN(GL,P0,P1,t,2)); \
    KRD(GL,1); GAPB(o[1]=__builtin_amdgcn_mfma_f32_32x32x16_bf16(PAF(1),VFR(5),o[1],0,0,0), C0,12, PFN(GL,P0,P1,t,3)); \
    KRD(GL,2); GAPB(o[0]=__builtin_amdgcn_mfma_f32_32x32x16_bf16(PAF(2),VFR(2),o[0],0,0,0), C1,0, PFN(GL,P0,P1,t,4)); \
    KRD(GL,3); GAPB(o[1]=__builtin_amdgcn_mfma_f32_32x32x16_bf16(PAF(2),VFR(6),o[1],0,0,0), C1,4, PFN(GL,P0,P1,t,5)); \
    GAPB(o[0]=__builtin_amdgcn_mfma_f32_32x32x16_bf16(PAF(3),VFR(3),o[0],0,0,0), C1,8, PFN(GL,P0,P1,t,6)); \
    GAPB(o[1]=__builtin_amdgcn_mfma_f32_32x32x16_bf16(PAF(3),VFR(7),o[1],0,0,0), C1,12, PFN(GL,P0,P1,t,7)); \
    }while(0)
  int t=1;
  #undef CMASK
  #define CMASK(P0,P1,t) do{}while(0)
  for(;t+5<NT;t+=2){
    STEP(pB0,pB1,pA0,pA1,t,true,true,true);     WAIT_BAR(2); RESC(); ROT();
    STEP(pA0,pA1,pB0,pB1,t+1,true,true,true);   WAIT_BAR(2); RESC(); ROT();
  }
  #undef CMASK
  #define CMASK(P0,P1,t) do{int jb_=(t)-(NTm-4); if(jb_>=0)cmask(P0,P1,jb_,qrel,hi);}while(0)
  #define ENDW(tt) do{ if((tt)+3<NT){WAIT_BAR(2);} else if((tt)+2<NT){WAIT_BAR(1);} else {WAIT_BAR(0);} }while(0)
  for(;t+1<NT;t+=2){
    STEP(pB0,pB1,pA0,pA1,t,(t+3<NT),(t+1<NT),(t+1<NT));       ENDW(t);   RESC(); ROT();
    STEP(pA0,pA1,pB0,pB1,t+1,(t+4<NT),(t+2<NT),(t+2<NT));     ENDW(t+1); RESC(); ROT();
  }
  STEP(pB0,pB1,pA0,pA1,NT-1,false,false,false); RESC();
  { float sacc=pB0[0]+pB0[1]; _Pragma("unroll") for(int r=2;r<16;++r)sacc+=pB0[r]; _Pragma("unroll") for(int r=0;r<16;++r)sacc+=pB1[r]; l_reg+=sacc;
    pw0=(u32x4){PKW(pB0,0),PKW(pB0,2),PKW(pB0,4),PKW(pB0,6)};pw1=(u32x4){PKW(pB0,8),PKW(pB0,10),PKW(pB0,12),PKW(pB0,14)};pw2=(u32x4){PKW(pB1,0),PKW(pB1,2),PKW(pB1,4),PKW(pB1,6)};pw3=(u32x4){PKW(pB1,8),PKW(pB1,10),PKW(pB1,12),PKW(pB1,14)};
    SBAR(); pv(o,vb0+sl_cur,PAF(0),PAF(1),PAF(2),PAF(3)); }
  #undef PKW
  #undef PAF
  #undef VFR
  #undef PIN
  #undef MX3
  #undef GAPA
  #undef GAPB
  #undef PFN
  #undef PFG
  #undef EX
  #undef VRD
  #undef KRD
  #undef STEP
  #undef ENDW
  {auto rr=__builtin_amdgcn_permlane32_swap(__float_as_uint(l_reg),__float_as_uint(l_reg),false,false);l_reg=__uint_as_float(rr[0])+__uint_as_float(rr[1]);}
  if(hi==0){ wsf[32+r32]=l_reg; float*mlp=ML+((long)(q0+wid*QBLK+r32)*NHEAD+h)*2; mlp[0]=mhat; mlp[1]=l_reg; } asm volatile("s_waitcnt lgkmcnt(0)":::"memory");
  float rli[16];
  #pragma unroll
  for(int r=0;r<16;++r)rli[r]=__builtin_amdgcn_rcpf(wsf[32+crow(r,hi)]);
  bf16*Ow=O+(rowbase+q0+wid*QBLK)*DM+h*D;
  { bf16*stg=(bf16*)(shm+LDS_OST)+wid*2048;
    #pragma unroll
    for(int r=0;r<16;++r){const int orow=crow(r,hi);
      #pragma unroll
      for(int d0=0;d0<2;++d0)stg[orow*64+d0*32+r32]=__float2bfloat16(o[d0][r]*rli[r]);}
    asm volatile("s_waitcnt lgkmcnt(0)":::"memory");
    #pragma unroll
    for(int i=0;i<4;++i){const int row=i*8+(lane>>3),ch=lane&7; const u32x4 v=*(const u32x4*)(stg+row*64+ch*8); ATTN_STORE16(Ow+(long)row*DM+ch*8,v);} }
  asm volatile("s_waitcnt lgkmcnt(0)\n\ts_barrier":::"memory");
  #undef DMA_K
  #undef DMA_V
  #undef CMASK
  #undef BIAS
  #undef START
  #undef RESC
  #undef ROT
}

#undef SBAR
#undef WAIT_BAR
}
namespace cg = cooperative_groups;
constexpr int S_ = 16384, DMOD = 1024, NL = 4, DIN = 2568, NIN = 2816, DFF = 2816, NGU = 5632, NHD = 8;
constexpr float EPSN = 1e-6f;
constexpr size_t MiB = 1u << 20;
constexpr size_t WS_CTL = 0, CTL_BYTES = 65536;
constexpr size_t WS_WIN = 2 * MiB;
constexpr size_t WS_WOUT = 24 * MiB;
constexpr size_t WS_WGU = 32 * MiB;
constexpr size_t WS_WD = 76 * MiB;
constexpr size_t WS_XB = 98 * MiB;
constexpr size_t WS_RSSM = 130 * MiB;
constexpr size_t WS_RSSF = 130 * MiB + 128 * 1024;
constexpr size_t WS_LOGF = 130 * MiB + 256 * 1024;
constexpr size_t WS_C2 = 131 * MiB;
constexpr size_t WS_QKVZ = 132 * MiB;
constexpr size_t WS_O = 212 * MiB;
constexpr size_t WS_MG = 228 * MiB;
constexpr size_t WS_H = 132 * MiB;
constexpr size_t WS_OP = 260 * MiB;
constexpr size_t WS_ML = 308 * MiB;
constexpr size_t WS_END = 312 * MiB;
static_assert(WS_H + (size_t)S_ * DFF * 2 <= WS_MG, "h overlay");
constexpr int LDS_BYTES = 147456;
constexpr int CW_KMAX = 8192, CW_BAR = 9216, CW_SGUQ = 13312, CW_TS = 14336, CW_FCNT = 14400;
constexpr int NPHASE = 2 + 6 * NL;

#define LAS __attribute__((address_space(3)))
typedef unsigned short bf16r;
typedef unsigned v4u __attribute__((ext_vector_type(4)));
typedef float f32x4 __attribute__((ext_vector_type(4)));
typedef float f32x16 __attribute__((ext_vector_type(16)));
typedef short bf16x8 __attribute__((ext_vector_type(8)));
#define LDS_WAIT() asm volatile("s_waitcnt lgkmcnt(0)" ::: "memory")
__device__ __forceinline__ unsigned f2bf(float f) { unsigned u = __builtin_bit_cast(unsigned, f); return (u + 0x7fffu + ((u >> 16) & 1u)) >> 16; }
__device__ __forceinline__ unsigned pk2(float lo, float hi) { return f2bf(lo) | (f2bf(hi) << 16); }
__device__ __forceinline__ float bflo(unsigned w) { return __builtin_bit_cast(float, w << 16); }
__device__ __forceinline__ float bfhi(unsigned w) { return __builtin_bit_cast(float, w & 0xffff0000u); }
__device__ __forceinline__ float bf1(bf16r w) { return __builtin_bit_cast(float, (unsigned)w << 16); }
#define DPPF(v, ctrl) __builtin_bit_cast(float, __builtin_amdgcn_update_dpp(0, __builtin_bit_cast(int, (v)), (ctrl), 0xf, 0xf, true))
__device__ __forceinline__ float row16_sum(float v) {
    v += DPPF(v, 0xB1); v += DPPF(v, 0x4E); v += DPPF(v, 0x141); v += DPPF(v, 0x140); return v;
}
__device__ __forceinline__ float wave_sum(float v) {
    v += DPPF(v, 0xB1); v += DPPF(v, 0x4E); v += DPPF(v, 0x141); v += DPPF(v, 0x140);
    const int iv = __builtin_bit_cast(int, v);
    const float s0 = __builtin_bit_cast(float, __builtin_amdgcn_readlane(iv, 0)), s1 = __builtin_bit_cast(float, __builtin_amdgcn_readlane(iv, 16)),
                s2 = __builtin_bit_cast(float, __builtin_amdgcn_readlane(iv, 32)), s3 = __builtin_bit_cast(float, __builtin_amdgcn_readlane(iv, 48));
    return (s0 + s1) + (s2 + s3);
}
constexpr int PREP_P = 132;
__device__ __forceinline__ void prep_item(const float* W, int ldw, int srccol, const float* gs, bf16r* WT, int K, int dstrow, int k0, LAS float* scr, int lane) {
#pragma unroll 8
    for (int i = 0; i < 16; ++i) { const int kk = 2 * i + (lane >> 5); f32x4 w = *(const f32x4*)(W + (size_t)(k0 + kk) * ldw + srccol + 4 * (lane & 31)); if (gs) w = w * gs[k0 + kk];
        *(LAS f32x4*)(scr + kk * PREP_P + 4 * (lane & 31)) = w; }
    LDS_WAIT(); asm volatile("" ::: "memory");
    const int c = lane & 3;
#pragma unroll
    for (int j = 0; j < 8; ++j) { const int n = (lane >> 2) + 16 * j; const LAS float* s = scr + (8 * c) * PREP_P + n;
        v4u o; o.x = pk2(s[0 * PREP_P], s[1 * PREP_P]); o.y = pk2(s[2 * PREP_P], s[3 * PREP_P]); o.z = pk2(s[4 * PREP_P], s[5 * PREP_P]); o.w = pk2(s[6 * PREP_P], s[7 * PREP_P]);
        *(v4u*)(WT + (size_t)(dstrow + n) * K + k0 + 8 * c) = o; }
    LDS_WAIT(); asm volatile("" ::: "memory");
}
template <int OFF> __device__ __forceinline__ unsigned long long ldk() {
    unsigned long long v; auto ka = __builtin_amdgcn_kernarg_segment_ptr();
    asm volatile("s_load_dwordx2 %0, %1, %2\n\ts_waitcnt lgkmcnt(0)" : "=s"(v) : "s"(ka), "i"(OFF) : "memory");
    return v;
}
struct Ptrs {
    const float *x, *mixg, *w_in, *b_f, *lng, *lnb, *w_s, *b_s, *outg, *w_out, *ffng, *w_gu, *w_d, *fing;
    float* out; unsigned char* ws;
};
__device__ __forceinline__ void phase_prep(const Ptrs& P, LAS unsigned char* lds, int l0, int l1, int gw, int NGW, int wave, int lane) {
    LAS float* scr = (LAS float*)(lds + wave * (32 * PREP_P * 4));
    bf16r* WinT = (bf16r*)(P.ws + WS_WIN); bf16r* WoutT = (bf16r*)(P.ws + WS_WOUT); bf16r* WguT = (bf16r*)(P.ws + WS_WGU); bf16r* WdT = (bf16r*)(P.ws + WS_WD);
    constexpr int I_IN = 32 * 20, I_OUT = 32 * 8, I_GU = 32 * 44, I_D = 88 * 8, I_L = I_IN + I_OUT + I_GU + I_D;
    for (int it = l0 * I_L + gw; it < l1 * I_L; it += NGW) {
        const int l = it / I_L; int r = it % I_L;
        if (r < I_IN) { const int kb = r / 20, nb = r % 20, n0 = 128 * nb, src = n0 < 1536 ? n0 : n0 + 8;
            prep_item(P.w_in + (size_t)l * DMOD * DIN, DIN, src, P.mixg + l * DMOD, WinT + (size_t)l * NIN * DMOD, DMOD, n0, 32 * kb, scr, lane); continue; }
        r -= I_IN;
        if (r < I_OUT) { const int kb = r / 8, nb = r % 8;
            prep_item(P.w_out + (size_t)l * DMOD * DMOD, DMOD, 128 * nb, P.outg + l * DMOD, WoutT + (size_t)l * DMOD * DMOD, DMOD, 128 * nb, 32 * kb, scr, lane); continue; }
        r -= I_OUT;
        if (r < I_GU) { const int kb = r / 44, nb = r % 44, n0 = 128 * nb, pn = n0 >> 8, src = (n0 & 255) == 0 ? 128 * pn : DFF + 128 * pn;
            prep_item(P.w_gu + (size_t)l * DMOD * NGU, NGU, src, P.ffng + l * DMOD, WguT + (size_t)l * NGU * DMOD, DMOD, n0, 32 * kb, scr, lane); continue; }
        r -= I_GU;
        { const int kb = r / 8, nb = r % 8;
            prep_item(P.w_d + (size_t)l * DFF * DMOD, DMOD, 128 * nb, nullptr, WdT + (size_t)l * DMOD * DFF, DFF, 128 * nb, 32 * kb, scr, lane); }
    }
    for (int idx = l0 * 262144 + gw * 64 + lane; idx < l1 * 262144; idx += NGW * 64) { const int l = idx >> 18, rr = (idx >> 10) & 255, k = idx & 1023; unsigned v = 0u;
        if ((rr & 127) < 8) { const float w = P.w_in[((size_t)l * DMOD + k) * DIN + 1536 + (rr & 7)] * P.mixg[l * DMOD + k]; const unsigned hb = f2bf(w);
            v = rr < 128 ? hb : f2bf(w - __builtin_bit_cast(float, hb << 16)); }
        WinT[((size_t)l * NIN + 2560 + rr) * DMOD + k] = (bf16r)v; }
}
template <int MODE>
__device__ __forceinline__ void phase_rowstats(const float* xin, bf16r* xb, unsigned long long* rss_out, const float* gfin, float* outp, int gw, int NGW, int lane, float tdelta = 0.f) {
#pragma unroll 2
    for (int m = gw; m < S_; m += NGW) {
        const f32x4* xr = (const f32x4*)(xin + (size_t)m * DMOD) + lane;
        f32x4 v[4]; float s = 0.f;
#pragma unroll
        for (int j = 0; j < 4; ++j) { v[j] = xr[64 * j]; s += (v[j].x * v[j].x + v[j].y * v[j].y) + (v[j].z * v[j].z + v[j].w * v[j].w); }
        const float tot = wave_sum(s);
        if (MODE == 2) {
            const float rs = 1.0f / sqrtf(tot * (1.0f / DMOD) + EPSN);
            f32x4* orow = (f32x4*)(outp + (size_t)m * DMOD) + lane; const f32x4* gr = (const f32x4*)gfin + lane;
#pragma unroll
            for (int j = 0; j < 4; ++j) orow[64 * j] = v[j] * rs * gr[64 * j] + (m < 1024 ? tdelta : 0.f);
        } else {
            unsigned long long* o8 = (unsigned long long*)(xb + (size_t)m * DMOD) + lane;
#pragma unroll
            for (int j = 0; j < 4; ++j) o8[64 * j] = (unsigned long long)pk2(v[j].x, v[j].y) | ((unsigned long long)pk2(v[j].z, v[j].w) << 32);
            if (lane == 0) rss_out[m] = (unsigned long long)__float2ull_rn(tot * 16777216.0f);
        }
    }
}
__device__ __forceinline__ void final_norm(const bf16r* xb, const unsigned long long* rss, const float* g, float* outp, int gw, int NGW, int lane) {
#pragma unroll 2
    for (int m = gw; m < S_; m += NGW) {
        const v4u a = *(const v4u*)(xb + (size_t)m * DMOD + 8 * lane), b = *(const v4u*)(xb + (size_t)m * DMOD + 512 + 8 * lane);
        const float rs = 1.0f / sqrtf((float)rss[m] * (1.0f / (1024.0f * 16777216.0f)) + EPSN);
        const f32x4* gr = (const f32x4*)g; f32x4* orow = (f32x4*)(outp + (size_t)m * DMOD);
        const f32x4 g0 = gr[2 * lane], g1 = gr[2 * lane + 1], g2 = gr[128 + 2 * lane], g3 = gr[128 + 2 * lane + 1];
        orow[2 * lane] = (f32x4){bflo(a.x), bfhi(a.x), bflo(a.y), bfhi(a.y)} * rs * g0; orow[2 * lane + 1] = (f32x4){bflo(a.z), bfhi(a.z), bflo(a.w), bfhi(a.w)} * rs * g1;
        orow[128 + 2 * lane] = (f32x4){bflo(b.x), bfhi(b.x), bflo(b.y), bfhi(b.y)} * rs * g2; orow[128 + 2 * lane + 1] = (f32x4){bflo(b.z), bfhi(b.z), bflo(b.w), bfhi(b.w)} * rs * g3;
    }
}
__device__ __forceinline__ void cumsum_head(const float* logf, float* c2, int h, LAS unsigned char* lds, int tid) {
    LAS double* scr = (LAS double*)lds;
    const f32x4* src = (const f32x4*)(logf + (size_t)h * S_ + tid * 32);
    f32x4 v[8]; double sum = 0.0;
#pragma unroll
    for (int e = 0; e < 8; ++e) { v[e] = src[e]; sum += ((double)v[e].x + (double)v[e].y) + ((double)v[e].z + (double)v[e].w); }
    scr[tid] = sum; __syncthreads();
    double pre = 0.0; for (int i = 0; i < tid; ++i) pre += scr[i];
    f32x4* dst = (f32x4*)(c2 + (size_t)h * S_ + tid * 32);
#pragma unroll
    for (int e = 0; e < 8; ++e) { f32x4 o; pre += (double)v[e].x; o.x = (float)(pre * 1.4426950408889634); pre += (double)v[e].y; o.y = (float)(pre * 1.4426950408889634);
        pre += (double)v[e].z; o.z = (float)(pre * 1.4426950408889634); pre += (double)v[e].w; o.w = (float)(pre * 1.4426950408889634); dst[e] = o; }
    __syncthreads();
}
__device__ __forceinline__ void sgu_item(int c, const bf16r* ZU, const bf16r* ZV, bf16r* MG, const float* lng, const float* lnb, const float* wsl, const float* bsl,
                                         LAS unsigned char* lds, int wid, int lane) {
    LAS float* bsb = (LAS float*)lds;
    LAS bf16r* zt = (LAS bf16r*)(lds + 4096);
    const int r32 = lane & 31, hi = lane >> 5, g = wid, tid = wid * 64 + lane;
    bsb[tid] = bsl[tid]; bsb[tid + 512] = bsl[tid + 512];
    const int rs4 = lane >> 4, l16 = lane & 15;
#pragma unroll 2
    for (int it = 0; it < 4; ++it) { const int i = 16 * wid + 4 * it + rs4; const size_t row = (size_t)c * 128 + i;
        v4u zr[4];
#pragma unroll
        for (int j = 0; j < 4; ++j) zr[j] = *(const v4u*)(ZV + row * 512 + 128 * j + 8 * l16);
        float z[32]; float s = 0.f;
#pragma unroll
        for (int j = 0; j < 4; ++j) { z[8 * j] = bflo(zr[j].x); z[8 * j + 1] = bfhi(zr[j].x); z[8 * j + 2] = bflo(zr[j].y); z[8 * j + 3] = bfhi(zr[j].y); z[8 * j + 4] = bflo(zr[j].z); z[8 * j + 5] = bfhi(zr[j].z); z[8 * j + 6] = bflo(zr[j].w); z[8 * j + 7] = bfhi(zr[j].w); }
#pragma unroll
        for (int e = 0; e < 32; ++e) s += z[e];
        const float mean = row16_sum(s) * (1.0f / 512.0f); float q = 0.f;
#pragma unroll
        for (int e = 0; e < 32; ++e) { z[e] -= mean; q += z[e] * z[e]; }
        const float rstd = 1.0f / sqrtf(row16_sum(q) * (1.0f / 512.0f) + EPSN);
#pragma unroll
        for (int j = 0; j < 4; ++j) { const f32x4 g0 = *(const f32x4*)(lng + 128 * j + 8 * l16), g1 = *(const f32x4*)(lng + 128 * j + 8 * l16 + 4), b0 = *(const f32x4*)(lnb + 128 * j + 8 * l16), b1 = *(const f32x4*)(lnb + 128 * j + 8 * l16 + 4);
            v4u zw; zw.x = pk2(z[8 * j] * rstd * g0.x + b0.x, z[8 * j + 1] * rstd * g0.y + b0.y); zw.y = pk2(z[8 * j + 2] * rstd * g0.z + b0.z, z[8 * j + 3] * rstd * g0.w + b0.w);
            zw.z = pk2(z[8 * j + 4] * rstd * g1.x + b1.x, z[8 * j + 5] * rstd * g1.y + b1.y); zw.w = pk2(z[8 * j + 6] * rstd * g1.z + b1.z, z[8 * j + 7] * rstd * g1.w + b1.w);
            *(LAS v4u*)(zt + i * 512 + 128 * j + 8 * l16) = zw; }
    }
    LDS_WAIT(); __syncthreads();
#pragma unroll 1
    for (int ni = 0; ni < 2; ++ni) {
        const int d = 64 * g + 32 * ni + r32;
        bf16x8 bfr[8];
#pragma unroll
        for (int ks = 0; ks < 8; ++ks) { const LAS bf16r* zp = zt + (16 * ks + 8 * hi) * 512 + d;
            v4u w; w.x = (unsigned)zp[0] | ((unsigned)zp[512] << 16); w.y = (unsigned)zp[1024] | ((unsigned)zp[1536] << 16); w.z = (unsigned)zp[2048] | ((unsigned)zp[2560] << 16); w.w = (unsigned)zp[3072] | ((unsigned)zp[3584] << 16);
            bfr[ks] = __builtin_bit_cast(bf16x8, w); }
        LDS_WAIT(); asm volatile("" ::: "memory");
        f32x16 acc[4];
#pragma unroll
        for (int mi = 0; mi < 4; ++mi) { acc[mi] = f32x16{};
#pragma unroll
            for (int ks = 0; ks < 8; ++ks) { if (mi < 2 && ks >= 4) continue;
                const float* wp = wsl + ((size_t)g * 128 + 32 * mi + r32) * 128 + 16 * ks + 8 * hi; const f32x4 a0 = *(const f32x4*)wp, a1 = *(const f32x4*)(wp + 4);
                v4u w; w.x = pk2(a0.x, a0.y); w.y = pk2(a0.z, a0.w); w.z = pk2(a1.x, a1.y); w.w = pk2(a1.z, a1.w);
                acc[mi] = __builtin_amdgcn_mfma_f32_32x32x16_bf16(__builtin_bit_cast(bf16x8, w), bfr[ks], acc[mi], 0, 0, 0); }
            asm volatile("" ::: "memory"); }
#pragma unroll
        for (int mi = 0; mi < 4; ++mi)
#pragma unroll
            for (int r = 0; r < 16; ++r) { const int i = 32 * mi + (r & 3) + 8 * (r >> 2) + 4 * hi;
                zt[i * 512 + d] = (bf16r)f2bf(acc[mi][r] + bsb[g * 128 + i]); }
        LDS_WAIT(); asm volatile("" ::: "memory");
    }
    __syncthreads();
#pragma unroll 2
    for (int it = 0; it < 4; ++it) { const int i = 16 * wid + 4 * it + rs4; const size_t row = (size_t)c * 128 + i;
        float a[32]; float ss = 0.f;
#pragma unroll
        for (int j = 0; j < 4; ++j) { const v4u tr = *(const LAS v4u*)(zt + i * 512 + 128 * j + 8 * l16); const v4u ur = *(const v4u*)(ZU + row * 512 + 128 * j + 8 * l16);
            a[8 * j] = bflo(tr.x) * bflo(ur.x); a[8 * j + 1] = bfhi(tr.x) * bfhi(ur.x); a[8 * j + 2] = bflo(tr.y) * bflo(ur.y); a[8 * j + 3] = bfhi(tr.y) * bfhi(ur.y);
            a[8 * j + 4] = bflo(tr.z) * bflo(ur.z); a[8 * j + 5] = bfhi(tr.z) * bfhi(ur.z); a[8 * j + 6] = bflo(tr.w) * bflo(ur.w); a[8 * j + 7] = bfhi(tr.w) * bfhi(ur.w); }
#pragma unroll
        for (int e = 0; e < 32; ++e) ss += a[e] * a[e];
        const float ra = 1.0f / sqrtf(row16_sum(ss) * (1.0f / 512.0f) + EPSN);
#pragma unroll
        for (int j = 0; j < 4; ++j) { v4u w; w.x = pk2(a[8 * j] * ra, a[8 * j + 1] * ra); w.y = pk2(a[8 * j + 2] * ra, a[8 * j + 3] * ra); w.z = pk2(a[8 * j + 4] * ra, a[8 * j + 5] * ra); w.w = pk2(a[8 * j + 6] * ra, a[8 * j + 7] * ra);
            *(v4u*)(MG + row * 1024 + 512 + 128 * j + 8 * l16) = w; }
    }
    LDS_WAIT(); __syncthreads();
}
__device__ __forceinline__ void combine_item(int c, const bf16r* O, const bf16r* OP1, const float* ML, bf16r* MG, int wid, int lane) {
#pragma unroll
    for (int rr = 0; rr < 8; ++rr) { const size_t row = (size_t)c * 64 + 8 * wid + rr;
        float a[8];
        { const int nch = ((int)(row >> 12)) + 1, hh = lane >> 3; float Mj[4], lj[4]; v4u oj[4];
#pragma unroll
          for (int j = 0; j < 4; ++j) { if (j < nch) { const float* mlp = ML + (size_t)j * S_ * 16 + (row * 8 + hh) * 2; Mj[j] = mlp[0]; lj[j] = mlp[1];
                  oj[j] = (j == 0 || lj[j] > 0.f) ? *(const v4u*)((j == 0 ? O : OP1 + (size_t)(j - 1) * S_ * 512) + row * 512 + 8 * lane) : (v4u){0u, 0u, 0u, 0u}; } else { Mj[j] = -1.0e30f; lj[j] = 0.f; oj[j] = (v4u){0u, 0u, 0u, 0u}; } }
          const float Mmax = fmaxf(fmaxf(Mj[0], Mj[1]), fmaxf(Mj[2], Mj[3])); float wsum = 0.f;
#pragma unroll
          for (int e = 0; e < 8; ++e) a[e] = 0.f;
#pragma unroll
          for (int j = 0; j < 4; ++j) { const float w = lj[j] > 0.f ? lj[j] * __builtin_amdgcn_exp2f(Mj[j] - Mmax) : 0.f; wsum += w;
              if (w > 0.f) { a[0] += w * bflo(oj[j].x); a[1] += w * bfhi(oj[j].x); a[2] += w * bflo(oj[j].y); a[3] += w * bfhi(oj[j].y); a[4] += w * bflo(oj[j].z); a[5] += w * bfhi(oj[j].z); a[6] += w * bflo(oj[j].w); a[7] += w * bfhi(oj[j].w); } }
          const float iw = 1.0f / wsum;
#pragma unroll
          for (int e = 0; e < 8; ++e) a[e] *= iw; }
        float ss = 0.f;
#pragma unroll
        for (int e = 0; e < 8; ++e) ss += a[e] * a[e];
        const float ra = 1.0f / sqrtf(wave_sum(ss) * (1.0f / 512.0f) + EPSN);
        v4u w; w.x = pk2(a[0] * ra, a[1] * ra); w.y = pk2(a[2] * ra, a[3] * ra); w.z = pk2(a[4] * ra, a[5] * ra); w.w = pk2(a[6] * ra, a[7] * ra);
        *(v4u*)(MG + row * 1024 + 8 * lane) = w;
    }
}
#define XB_TMO      128
#define XB_XCNT(j)  (256  + 64 * (j))
#define XB_XSUB(j)  (1280 + 64 * (j))
#define XB_XGEN(j)  (2304 + 64 * (j))
#define XB_TOP      3328
#define XB_TOPGEN   3392
#define XCD_BAR_WORDS 3456
#define XB_SPIN_CAP (1u << 18)

__device__ __forceinline__ unsigned xb_ld(unsigned* p)              { return __hip_atomic_load(p, __ATOMIC_RELAXED, __HIP_MEMORY_SCOPE_AGENT); }
__device__ __forceinline__ unsigned xb_add(unsigned* p, unsigned v) { return __hip_atomic_fetch_add(p, v, __ATOMIC_RELAXED, __HIP_MEMORY_SCOPE_AGENT); }
__device__ __forceinline__ unsigned xb_xcc_id() { return (unsigned)__builtin_amdgcn_s_getreg((3 << 11) | 20) & 0xFu; }
#define XB_SPIN(cond, bar) do { unsigned _sp = 0; while (cond) { __builtin_amdgcn_s_sleep(1); \
    if ((++_sp & 255u) == 0u) { if (xb_ld(&(bar)[XB_TMO])) break; if (_sp > XB_SPIN_CAP) { atomicAdd(&(bar)[XB_TMO], 1u); break; } } } } while (0)

struct XcdBarrier {
    unsigned* bar; unsigned x;
    volatile LAS unsigned* st;
};

__device__ __forceinline__ XcdBarrier xcd_barrier_post(unsigned* bar, volatile LAS unsigned* st) {
    XcdBarrier b; b.bar = bar; b.x = xb_xcc_id(); b.st = st;
    if (threadIdx.x == 0) (void)xb_add(&bar[XB_XCNT(b.x)], 1u);
    return b;
}
__device__ __forceinline__ void xcd_barrier_complete(unsigned* bar, unsigned x, unsigned& nloc, unsigned& nx) {
    const unsigned G = gridDim.x * gridDim.y * gridDim.z;
    unsigned sum, cnt, mine, sp = 0u;
    for (;;) {
        sum = 0u; cnt = 0u; mine = 0u;
#pragma unroll
        for (unsigned j = 0; j < 16; ++j) { const unsigned c = xb_ld(&bar[XB_XCNT(j)]); sum += c; cnt += (c > 0u) ? 1u : 0u; mine = (j == x) ? c : mine; }
        if (sum == G) break;
        __builtin_amdgcn_s_sleep(1);
        if ((++sp & 255u) == 0u) { if (xb_ld(&bar[XB_TMO])) break; if (sp > XB_SPIN_CAP) { atomicAdd(&bar[XB_TMO], 1u); break; } }
    }
    nloc = mine > 0u ? mine : 1u; nx = cnt > 0u ? cnt : 1u;
}

__device__ __forceinline__ void xcd_barrier(const XcdBarrier& b) {
    asm volatile("s_waitcnt vmcnt(0)" ::: "memory");
    __syncthreads();
    if (threadIdx.x == 0) {
        unsigned* bar = b.bar;
        __builtin_amdgcn_s_waitcnt(0);
        unsigned nloc = b.st[0], nx = b.st[1];
        if (nloc == 0u) { xcd_barrier_complete(bar, b.x, nloc, nx); b.st[0] = nloc; b.st[1] = nx; }
        const unsigned old = xb_add(&bar[XB_XSUB(b.x)], 1u);
        const unsigned gen = old / nloc;
        if (old + 1u == (gen + 1u) * nloc) {
            __builtin_amdgcn_fence(__ATOMIC_RELEASE, "agent");
            asm volatile("s_waitcnt vmcnt(0)" ::: "memory");
            const unsigned og = xb_add(&bar[XB_TOP], 1u);
            const unsigned tg = og / nx;
            if (og + 1u == (tg + 1u) * nx) xb_add(&bar[XB_TOPGEN], 1u);
            else XB_SPIN(xb_ld(&bar[XB_TOPGEN]) == tg, bar);
            __builtin_amdgcn_fence(__ATOMIC_ACQUIRE, "agent");
            xb_add(&bar[XB_XGEN(b.x)], 1u);
            asm volatile("s_waitcnt vmcnt(0)" ::: "memory");
        } else {
            XB_SPIN(xb_ld(&bar[XB_XGEN(b.x)]) == gen, bar);
            __builtin_amdgcn_fence(__ATOMIC_ACQUIRE, "agent");
            asm volatile("s_waitcnt vmcnt(0)" ::: "memory");
        }
    }
    __syncthreads();
}
#ifndef MK_MULTI
#define MK_MULTI 0
#endif
struct Args { const float* in[14]; float* out; unsigned char* ws; int ph_lo, ph_hi; };
__global__ void __launch_bounds__(512, 2) fox_fwd(Args args) {
    extern __shared__ __attribute__((aligned(16))) unsigned char lds[];
    cg::grid_group grid = cg::this_grid();
    LAS unsigned char* L = (LAS unsigned char*)lds;
    const int G = gridDim.x, bx = blockIdx.x;
    const int vcu = (G % 8 == 0) ? (bx % 8) * (G / 8) + bx / 8 : bx;
    const int NGW = G * 8;
#define IDS() int tid = threadIdx.x; asm volatile("" : "+v"(tid)); const int lane = tid & 63, wave = __builtin_amdgcn_readfirstlane(tid >> 6), gw = vcu * 8 + wave; (void)lane; (void)gw
#define KIN(k) ((const float*)(const __attribute__((address_space(1))) float*)ldk<8 * (k)>())
#define WSB() ((unsigned char*)(__attribute__((address_space(1))) unsigned char*)ldk<120>())
#define P_OUT ((float*)(__attribute__((address_space(1))) float*)ldk<112>())
#define ctl ((unsigned*)(WSB() + WS_CTL))
#define WinT ((bf16r*)(WSB() + WS_WIN))
#define WoutT ((bf16r*)(WSB() + WS_WOUT))
#define WguT ((bf16r*)(WSB() + WS_WGU))
#define WdT ((bf16r*)(WSB() + WS_WD))
#define XB ((bf16r*)(WSB() + WS_XB))
#define RSSM ((unsigned long long*)(WSB() + WS_RSSM))
#define RSSF ((unsigned long long*)(WSB() + WS_RSSF))
#define LOGF ((float*)(WSB() + WS_LOGF))
#define C2A ((float*)(WSB() + WS_C2))
#define QKVZ ((bf16r*)(WSB() + WS_QKVZ))
#define OB ((bf16r*)(WSB() + WS_O))
#define MG ((bf16r*)(WSB() + WS_MG))
#define HB ((bf16r*)(WSB() + WS_H))
#define OP1 ((bf16r*)(WSB() + WS_OP))
#define MLB ((float*)(WSB() + WS_ML))
#define MKP() Ptrs P; P.x = KIN(0); P.mixg = KIN(1); P.w_in = KIN(2); P.b_f = KIN(3); P.lng = KIN(4); P.lnb = KIN(5); P.w_s = KIN(6); P.b_s = KIN(7); \
    P.outg = KIN(8); P.w_out = KIN(9); P.ffng = KIN(10); P.w_gu = KIN(11); P.w_d = KIN(12); P.fing = KIN(13); P.out = P_OUT; P.ws = WSB()
    constexpr size_t QS = (size_t)S_ * 512;
    const int lo = args.ph_lo, hi = args.ph_hi;
    { LAS unsigned* misc = (LAS unsigned*)(L + 147456 - 8); if (threadIdx.x < 2) misc[threadIdx.x] = 0u; __syncthreads(); }
    XcdBarrier xbar = xcd_barrier_post((unsigned*)(WSB() + WS_CTL) + CW_BAR, (volatile LAS unsigned*)(L + 147456 - 8));
    int ph = 0;
#ifdef PROBE_T
    unsigned long long tacc_ = 0ull, tst_ = 0ull;
#define TCLS() ((ph == 0) ? 0 : (ph <= 7 * NL ? ((ph - 1) % 7) + 1 : 8))
#define TBEG() do { if (TCLS() == PROBE_T) tst_ = __builtin_amdgcn_s_memrealtime(); } while (0)
#define TEND() do { if (TCLS() == PROBE_T) tacc_ += __builtin_amdgcn_s_memrealtime() - tst_; } while (0)
#else
#define TBEG() do {} while (0)
#define TEND() do {} while (0)
#endif
#define RUN() (ph >= lo && ph < hi)
#ifdef PROBE_SYNC
#define SEAM() do { ++ph; if (ph > lo && ph < hi) { if (ph == 1) { grid.sync(); grid.sync(); } else { xcd_barrier(xbar); xcd_barrier(xbar); } } } while (0)
#else
#define SEAM() do { ++ph; if (ph > lo && ph < hi) { if (lo < 0) grid.sync(); xcd_barrier(xbar); } --ph; TEND(); ++ph; TBEG(); } while (0)
#endif
#ifdef PROBE_SMALL
#define REPS 2
#else
#define REPS 1
#endif
#ifndef FH_TABLE
#define FH_TABLE 0x76545677u
#endif
#ifndef SGU_AT
#define SGU_AT 1
#endif
#ifdef PROBE_GEMM
#define REPG 2
#else
#define REPG 1
#endif
#ifdef PROBE_ATTN
#define REPA 2
#else
#define REPA 1
#endif

#ifndef NO_P0
    if (RUN()) { IDS(); MKP(); for (int rp = 0; rp < REPS; ++rp) { phase_prep(P, L, 0, 1, gw, NGW, wave, lane); phase_rowstats<1>(P.x, (bf16r*)(P.ws + WS_XB), (unsigned long long*)(P.ws + WS_RSSM), nullptr, nullptr, gw, NGW, lane); } }
#endif
    SEAM();
    for (int l = 0; l < NL; ++l) {
#ifndef NO_INPROJ
        if (RUN()) {
            { IDS(); unsigned long long* rz = RSSF; if (bx < 256 && tid < 64) { unsigned zlo = 0u; asm volatile("" : "+v"(zlo)); rz[bx * 64 + tid] = (unsigned long long)zlo; }     }
            pg8::Gemm g{XB, WinT + (size_t)l * NIN * DMOD, S_, NIN, DMOD}; pg8::StaticOrder So; So.init(S_, NIN, G, bx); So.rot = NIN / 256 - 1;
            pg8::EpiInProj E{QKVZ, QS, RSSM, ctl + CW_KMAX + l * 16, KIN(3) + l * 8, LOGF, ctl + CW_FCNT + l * 64};
            for (int rg = 0; rg < REPG; ++rg) pg8::gemm_phase<pg8::EpiInProj, pg8::StaticOrder, true, true>(L, g, So, E);
            if (bx >= G - NHD) {
                IDS(); unsigned* const fc = ctl + CW_FCNT + l * 64;
                if (tid == 0) { unsigned sp = 0; while (__hip_atomic_load(fc, __ATOMIC_RELAXED, __HIP_MEMORY_SCOPE_AGENT) < 64u * REPG) { __builtin_amdgcn_s_sleep(8); if (++sp > (1u << 20)) break; }
                    __builtin_amdgcn_fence(__ATOMIC_ACQUIRE, "agent"); }
                __syncthreads();
                cumsum_head(LOGF, C2A, bx - (G - NHD), L, tid);
            }
        }
#endif
        SEAM();
#ifndef NO_ATTN
        if (RUN()) {
            IDS(); LAS unsigned* bc = (LAS unsigned*)(L + 147456 - 64);
            unsigned* const ctlp = ctl; unsigned char* const wsp = WSB();
            const int fh = (int)((FH_TABLE >> (4 * (bx & 7))) & 7u);
            for (int rp = 0; rp < REPA; ++rp)
            for (int qi = 0; qi <= NHD; ++qi) { const int h = (qi == 0) ? fh : (NHD - qi); if (qi > 0 && h == fh) continue;
                if (qi == SGU_AT && rp == 0) {
            for (;;) {
                if (tid == 0) bc[0] = atomicAdd(ctlp + CW_SGUQ + (l) * 64, 1u);
                __syncthreads(); const unsigned u = bc[0]; __syncthreads();
                if (u >= (unsigned)(S_ / 128)) break;
                bf16r* const qkvz = (bf16r*)(wsp + WS_QKVZ);
                sgu_item((int)u, qkvz + 3 * QS, qkvz + 4 * QS, (bf16r*)(wsp + WS_MG), KIN(4) + l * 512, KIN(5) + l * 512, KIN(6) + (size_t)l * 8 * 128 * 128, KIN(7) + l * 8 * 128, L, wave, lane);
            }
                }
                const float kn = sqrtf((__uint_as_float(ctlp[CW_KMAX + l * 16 + 2 * h]) + __uint_as_float(ctlp[CW_KMAX + l * 16 + 2 * h + 1])) * 1.02f);
                for (;;) {
                    if (tid == 0) bc[0] = atomicAdd(ctlp + ((rp * NL + l) * NHD + h) * 64, 1u);
                    __syncthreads(); const unsigned u = bc[0]; __syncthreads();
                    if (u >= 160u) break;
                    int qb, jc;
                    if (u < 64u) { qb = 63 - (int)(u >> 2); jc = (int)(u & 3u); } else if (u < 112u) { const int v = (int)u - 64; qb = 47 - v / 3; jc = v % 3; }
                    else if (u < 144u) { const int v = (int)u - 112; qb = 31 - (v >> 1); jc = v & 1; } else { qb = 15 - ((int)u - 144); jc = 0; }
                    bf16r* const qkvz = (bf16r*)(wsp + WS_QKVZ);
                    attn_body::fox_unit2<8>(h, qb, jc, kn, (const attn_body::bf16*)qkvz, (const attn_body::bf16*)(qkvz + QS), (const attn_body::bf16*)(qkvz + 2 * QS),
                                            (attn_body::bf16*)(jc == 0 ? (bf16r*)(wsp + WS_O) : (bf16r*)(wsp + WS_OP) + (size_t)(jc - 1) * QS), (float*)(wsp + WS_ML) + (size_t)jc * S_ * 16, (float*)(wsp + WS_C2) + (size_t)h * S_, (char*)lds, (float*)(lds + 147456 - 48));
                } }
        }
#endif
        SEAM();
#ifndef NO_MERGE
        if (RUN()) { IDS(); for (int rp = 0; rp < REPS; ++rp) for (int it = vcu; it < S_ / 64; it += G) combine_item(it, OB, OP1, MLB, MG, wave, lane); }
#endif
        SEAM();
#ifndef NO_OUTPROJ
        if (RUN()) {
            { IDS(); unsigned long long* rz = RSSM; if (bx < 256 && tid < 64) { unsigned zlo = 0u; asm volatile("" : "+v"(zlo)); rz[bx * 64 + tid] = (unsigned long long)zlo; }     }
            pg8::Gemm g{MG, WoutT + (size_t)l * DMOD * DMOD, S_, DMOD, DMOD}; pg8::StaticOrder So; So.init(S_, DMOD, G, bx);
            pg8::EpiResid E{XB, RSSF};
            pg8::gemm_phase<pg8::EpiResid, pg8::StaticOrder, true, true>(L, g, So, E);
        }
#endif
        SEAM();
#ifndef NO_GU
        if (RUN()) {
            pg8::Gemm g{XB, WguT + (size_t)l * NGU * DMOD, S_, NGU, DMOD}; pg8::StaticOrder So; So.init(S_, NGU, G, bx);
            pg8::EpiSwiGLU E{HB, RSSF};
            for (int rg = 0; rg < REPG; ++rg) pg8::gemm_phase<pg8::EpiSwiGLU, pg8::StaticOrder, true, true>(L, g, So, E);
            if (l + 1 < NL) { IDS(); MKP(); if (G == 256) { if (bx >= 128) phase_prep(P, L, l + 1, l + 2, (bx - 128) * 8 + wave, 1024, wave, lane); } else phase_prep(P, L, l + 1, l + 2, gw, NGW, wave, lane); }
        }
#endif
        SEAM();
#ifndef NO_DOWN
        if (RUN()) {
            pg8::Gemm g{HB, WdT + (size_t)l * DMOD * DFF, S_, DMOD, DFF}; pg8::StaticOrder So; So.init(S_, DMOD, G, bx);
            pg8::EpiResid E{XB, RSSM};
            pg8::gemm_phase<pg8::EpiResid, pg8::StaticOrder, true, true>(L, g, So, E);
        }
#endif
        SEAM();
    }
#ifndef NO_RSN
#ifdef PROBE_T
    { if (blockIdx.x == 0 && threadIdx.x == 0) { ((unsigned*)(WSB() + WS_CTL))[CW_TS] = (unsigned)tacc_; __threadfence(); } xcd_barrier(xbar); }
    const float tdelta = (PROBE_T == 99) ? 0.1f : (float)__hip_atomic_load((unsigned*)(WSB() + WS_CTL) + CW_TS, __ATOMIC_RELAXED, __HIP_MEMORY_SCOPE_AGENT) * 2.0e-7f;
#else
    const float tdelta = 0.f;
#endif
    if (RUN()) { IDS(); final_norm(XB, RSSM, KIN(13), P_OUT, gw, NGW, lane); }
#endif
    SEAM();
#undef RUN
#undef SEAM
}

extern "C" void kernel_launch(void* const* d_in, const int* in_sizes, int n_in, void* d_out, int out_size, void* d_ws, size_t ws_size, hipStream_t stream) {
    static int grid = 0;
    if (grid == 0) {
        if (n_in != 14 || out_size != S_ * DMOD || ws_size < WS_END) { fprintf(stderr, "kernel_launch: unexpected shapes (n_in %d out %d ws %zu)\n", n_in, out_size, ws_size); grid = -1; return; }
        int dev = 0, cus = 0, per_cu = 0;
        hipGetDevice(&dev); hipDeviceGetAttribute(&cus, hipDeviceAttributeMultiprocessorCount, dev);
        if (hipFuncSetAttribute((const void*)fox_fwd, hipFuncAttributeMaxDynamicSharedMemorySize, LDS_BYTES) != hipSuccess) { fprintf(stderr, "kernel_launch: hipFuncSetAttribute failed\n"); grid = -1; return; }
        if (hipOccupancyMaxActiveBlocksPerMultiprocessor(&per_cu, (const void*)fox_fwd, 512, LDS_BYTES) != hipSuccess || per_cu < 1) { fprintf(stderr, "kernel_launch: occupancy query says %d\n", per_cu); per_cu = 1; }
        (void)hipGetLastError();
        grid = cus * per_cu;
        if (grid < 256) { fprintf(stderr, "kernel_launch: this kernel needs a resident grid of at least 256 workgroups, got %d\n", grid); grid = -1; return; }
        fprintf(stderr, "kernel_launch: grid %d (cus %d x %d)\n", grid, cus, per_cu);
    }
    if (grid < 0) return;
    hipMemsetAsync((char*)d_ws + WS_CTL, 0, CTL_BYTES, stream);
    Args a{};
    for (int i = 0; i < 14; ++i) a.in[i] = (const float*)d_in[i];
    a.out = (float*)d_out; a.ws = (unsigned char*)d_ws;
#if MK_MULTI
    for (int p = 0; p < NPHASE; ++p) { a.ph_lo = p; a.ph_hi = p + 1; hipLaunchKernelGGL(fox_fwd, dim3(grid), dim3(512), LDS_BYTES, stream, a); }
#else
    a.ph_lo = 0; a.ph_hi = NPHASE;
    void* kargs[] = {&a};
    hipError_t e = hipLaunchCooperativeKernel((const void*)fox_fwd, dim3(grid), dim3(512), kargs, LDS_BYTES, stream);
    if (e != hipSuccess) fprintf(stderr, "kernel_launch: cooperative launch failed: %s (grid %d)\n", hipGetErrorString(e), grid);
#endif
}
```

```cpp
#define MK_MULTI 0
#include <hip/hip_runtime.h>
#include <hip/hip_cooperative_groups.h>
#include <cstdio>
#include <cstdint>
namespace pg8 {
#define PG8_LAS __attribute__((address_space(3)))
typedef unsigned short bf16_t;
typedef short bf16x8 __attribute__((ext_vector_type(8)));
typedef float f32x4 __attribute__((ext_vector_type(4)));
typedef unsigned u32x4 __attribute__((ext_vector_type(4)));
constexpr int BM = 256, BK = 64, HALF = 128, HTB = HALF * BK * 2  , STAGE_BYTES = 8 * HTB, NXCD = 8, WGM = 8;

__host__ __device__ __forceinline__ int lds_byte(int r, int c) { const int st = (r >> 4) * 2 + (c >> 5), rr = r & 15, cc = c & 31, ob = rr * 64 + cc * 2; return st * 1024 + (ob ^ (((ob >> 9) & 1) << 5)); }
__host__ __device__ __forceinline__ void stage_rc(int b, int& R, int& C) { const int st = b / 1024, sb = b % 1024, swz = sb ^ (((sb >> 9) & 1) << 5); R = (st >> 1) * 16 + swz / 64; C = (st & 1) * 32 + (swz % 64) / 2; }
__host__ __device__ __forceinline__ int perm32(int rho) { const int n = rho >> 4, i = rho & 15; return 8 * (i >> 2) + 4 * n + (i & 3); }

struct Unit { int pm, pn; };
struct Gemm { const bf16_t* A; const bf16_t* Bt; int M, N, K; };

struct StaticOrder {
    int nM, nN, nwg, G, c, rot;
    __host__ __device__ void init(int M, int N, int G_, int c_) { nM = M / BM; nN = N / BM; nwg = nM * nN; G = G_; c = c_; rot = 0; }
    __host__ __device__ __forceinline__ bool next(int i, Unit& u) const {
        const long L = (long)i * G + c; if (L >= nwg) return false;
        int wgid = (int)L; { const int q = nwg / NXCD, r = nwg % NXCD, xcd = wgid % NXCD, off = wgid / NXCD; wgid = (xcd < r ? xcd * (q + 1) : r * (q + 1) + (xcd - r) * q) + off; }
        const int nig = WGM * nN, gid = wgid / nig, fm = gid * WGM, gsz = (nM - fm) < WGM ? (nM - fm) : WGM;
        u.pm = fm + ((wgid % nig) % gsz); u.pn = (wgid % nig) / gsz + rot; if (u.pn >= nN) u.pn -= nN; return true;
    }
    __device__ __forceinline__ void a_ready(const Unit&) const {}
    __device__ __forceinline__ void done(const Unit&) const {}
};

__device__ __forceinline__ unsigned cvt_pk_bf16(float lo, float hi) { unsigned r; asm volatile("v_cvt_pk_bf16_f32 %0, %1, %2" : "=v"(r) : "v"(lo), "v"(hi)); return r; }
typedef float f32x2 __attribute__((ext_vector_type(2)));
__device__ __forceinline__ f32x2 gelu_pk(f32x2 v) {
    const f32x2 av = __builtin_elementwise_abs(v), d = av * 0.2316418882f + 1.0f;
    f32x2 t; t.x = __builtin_amdgcn_rcpf(d.x); t.y = __builtin_amdgcn_rcpf(d.y);
    f32x2 q = t * 0.5307027145f + (-0.7265760135f); q = q * t + 0.7107068705f; q = q * t + (-0.142248368f); q = q * t + 0.127414796f; q = q * t;
    const f32x2 s = (v * v) * (-0.72134752044f);
    f32x2 e; e.x = __builtin_amdgcn_exp2f(s.x); e.y = __builtin_amdgcn_exp2f(s.y);
    const f32x2 m = v * (q * e), r = v - m;
    f32x2 o; o.x = v.x < 0.f ? m.x : r.x; o.y = v.y < 0.f ? m.y : r.y; return o;
}
constexpr float C2Q = 0.125f * 1.4426950408889634f;
constexpr float RSS_INV = 1.0f / (1024.0f * 16777216.0f);
struct EpiInProj {
    static constexpr bool PERM = true, AFTER_DRAIN = false;
    bf16_t* O; size_t split_stride; const unsigned long long* rss; unsigned* kmax; const float* bfv; float* logf; unsigned* fcnt;
    __device__ __forceinline__ void operator()(const f32x4 (&acc)[2][2][4][2], const Unit& u, int wr, int wc, int fr, int fq) const {
        if (u.pn == 10) {
            if (wc == 0 && fq == 0) {
#pragma unroll
                for (int ai = 0; ai < 2; ++ai)
#pragma unroll
                    for (int m = 0; m < 4; ++m) { const int row = u.pm * BM + wr * 64 + fr + ai * HALF + m * 16; const float rs = __builtin_amdgcn_rsqf((float)rss[row] * RSS_INV + 1e-6f);
#pragma unroll
                        for (int n = 0; n < 2; ++n)
#pragma unroll
                            for (int e = 0; e < 4; ++e) { const float z = (acc[ai][0][m][n][e] + acc[ai][1][m][n][e]) * rs + bfv[4 * n + e];
                                const float lf = fminf(z, 0.f) - 0.6931471805599453f * __builtin_amdgcn_logf(1.0f + __builtin_amdgcn_exp2f(-1.4426950408889634f * fabsf(z)));
                                __hip_atomic_store((unsigned*)(logf + (size_t)(4 * n + e) * 16384 + row), __float_as_uint(lf), __ATOMIC_RELAXED, __HIP_MEMORY_SCOPE_AGENT); } } }
            asm volatile("s_waitcnt vmcnt(0)" ::: "memory"); __builtin_amdgcn_s_barrier();
            if (wr == 0 && wc == 0 && fr == 0 && fq == 0) __hip_atomic_fetch_add(fcnt, 1u, __ATOMIC_RELAXED, __HIP_MEMORY_SCOPE_AGENT);
            return; }
        const int t = u.pn >> 1; float kmx[2] = {0.f, 0.f}; bf16_t* base = O + (size_t)t * split_stride;
        const int row0 = u.pm * BM + wr * 64 + fr, col0 = (u.pn & 1) * 256 + wc * 32 + 8 * fq;
        const float s0 = (t == 0) ? C2Q : 1.0f;
#pragma unroll
        for (int ai = 0; ai < 2; ++ai)
#pragma unroll
            for (int m = 0; m < 4; ++m) { const int row = row0 + ai * HALF + m * 16; const float rs = __builtin_amdgcn_rsqf((float)rss[row] * RSS_INV + 1e-6f) * s0; bf16_t* rowp = base + (size_t)row * 512 + col0;
#pragma unroll
                for (int bj = 0; bj < 2; ++bj) { f32x4 v0 = acc[ai][bj][m][0] * rs, v1 = acc[ai][bj][m][1] * rs;
                    if (t == 1) { const f32x4 q0 = v0 * v0, q1 = v1 * v1; float sq = ((q0[0] + q0[1]) + (q0[2] + q0[3])) + ((q1[0] + q1[1]) + (q1[2] + q1[3])); sq += __shfl_xor(sq, 16); sq += __shfl_xor(sq, 32); kmx[bj] = fmaxf(kmx[bj], sq); }
                    if (t >= 3) { f32x2 a = gelu_pk((f32x2){v0[0], v0[1]}), b = gelu_pk((f32x2){v0[2], v0[3]}), c = gelu_pk((f32x2){v1[0], v1[1]}), d = gelu_pk((f32x2){v1[2], v1[3]});
                        v0 = (f32x4){a.x, a.y, b.x, b.y}; v1 = (f32x4){c.x, c.y, d.x, d.y}; }
                    u32x4 w; w.x = cvt_pk_bf16(v0[0], v0[1]); w.y = cvt_pk_bf16(v0[2], v0[3]); w.z = cvt_pk_bf16(v1[0], v1[1]); w.w = cvt_pk_bf16(v1[2], v1[3]);
                    *(u32x4*)(rowp + bj * HALF) = w; } }
        if (t == 1) {
#pragma unroll
            for (int bj = 0; bj < 2; ++bj) { float v = kmx[bj]; v = fmaxf(v, __shfl_xor(v, 1)); v = fmaxf(v, __shfl_xor(v, 2)); v = fmaxf(v, __shfl_xor(v, 4)); v = fmaxf(v, __shfl_xor(v, 8));
                if (fr == 0 && fq == 0) atomicMax(kmax + ((u.pn & 1) * 4 + bj * 2 + (wc >> 1)) * 2 + (wc & 1), __float_as_uint(v)); } }
    }
};
struct EpiResid {
    static constexpr bool PERM = false, AFTER_DRAIN = false;
    bf16_t* xb; unsigned long long* rss;
    __device__ __forceinline__ void operator()(const f32x4 (&acc)[2][2][4][2], const Unit& u, int wr, int wc, int fr, int fq) const {
        typedef unsigned u32x2v __attribute__((ext_vector_type(2)));
        const int col0 = u.pn * BM + wc * 32 + 4 * fq;
#pragma unroll
        for (int ai = 0; ai < 2; ++ai)
#pragma unroll
            for (int m = 0; m < 4; ++m) { const int row = u.pm * BM + ai * HALF + wr * 64 + m * 16 + fr; const size_t off = (size_t)row * 1024 + col0; float sq = 0.f;
#pragma unroll
                for (int bj = 0; bj < 2; ++bj)
#pragma unroll
                    for (int n = 0; n < 2; ++n) { const u32x2v bw = *(const u32x2v*)(xb + off + bj * HALF + n * 16);
                        const f32x4 b = (f32x4){__builtin_bit_cast(float, bw.x << 16), __builtin_bit_cast(float, bw.x & 0xffff0000u), __builtin_bit_cast(float, bw.y << 16), __builtin_bit_cast(float, bw.y & 0xffff0000u)};
                        const f32x4 o = b + acc[ai][bj][m][n];
                        u32x2v w; w.x = cvt_pk_bf16(o[0], o[1]); w.y = cvt_pk_bf16(o[2], o[3]); *(u32x2v*)(xb + off + bj * HALF + n * 16) = w;
                        sq += (o[0] * o[0] + o[1] * o[1]) + (o[2] * o[2] + o[3] * o[3]); }
                sq += __shfl_xor(sq, 16); sq += __shfl_xor(sq, 32);
                if (fq == 0) atomicAdd(rss + row, (unsigned long long)__float2ull_rn(sq * 16777216.0f)); }
    }
};
struct EpiSwiGLU {
    static constexpr bool PERM = true, AFTER_DRAIN = false;
    bf16_t* H; const unsigned long long* rss;
    __device__ __forceinline__ void operator()(const f32x4 (&acc)[2][2][4][2], const Unit& u, int wr, int wc, int fr, int fq) const {
        const int row0 = u.pm * BM + wr * 64 + fr, col0 = u.pn * 128 + wc * 32 + 8 * fq;
#pragma unroll
        for (int ai = 0; ai < 2; ++ai)
#pragma unroll
            for (int m = 0; m < 4; ++m) { const int row = row0 + ai * HALF + m * 16; const float rs = __builtin_amdgcn_rsqf((float)rss[row] * RSS_INV + 1e-6f);
                float hv[8];
#pragma unroll
                for (int n = 0; n < 2; ++n)
#pragma unroll
                    for (int e = 0; e < 4; ++e) { const float g = acc[ai][0][m][n][e] * rs, up = acc[ai][1][m][n][e] * rs;
                        const float sg = __builtin_amdgcn_rcpf(1.0f + __builtin_amdgcn_exp2f(-1.4426950408889634f * g)); hv[n * 4 + e] = g * sg * up; }
                u32x4 w; w.x = cvt_pk_bf16(hv[0], hv[1]); w.y = cvt_pk_bf16(hv[2], hv[3]); w.z = cvt_pk_bf16(hv[4], hv[5]); w.w = cvt_pk_bf16(hv[6], hv[7]);
                *(u32x4*)(H + (size_t)row * 2816 + col0) = w; }
    }
};
template <class Epi, class Sched, bool ALIGN_EPI = false, bool SP2 = false>
__device__ __forceinline__ void gemm_phase(PG8_LAS unsigned char* lds, const Gemm g, const Sched& S, const Epi& E) {
    int tid = threadIdx.x; asm volatile("" : "+v"(tid));
    const int wid = __builtin_amdgcn_readfirstlane(tid >> 6), lane = tid & 63, wr = wid >> 2, wc = wid & 3, fr = lane & 15, fq = lane >> 4;
    const int K = g.K, nt = K / BK;
    unsigned voffA[2], voffB[2];
#pragma unroll
    for (int i = 0; i < 2; ++i) { int R, C; stage_rc(tid * 16 + i * 8192, R, C); const int Rb = Epi::PERM ? ((R & ~31) + perm32(R & 31)) : R;
        voffA[i] = (unsigned)(R * K + C) * 2u; voffB[i] = (unsigned)(Rb * K + C) * 2u; }
    const size_t kstep = (size_t)(BK * 2);
    const size_t hstep = (size_t)HALF * K * 2;
    const size_t tstep = 2 * hstep;
    const unsigned ldsw = (unsigned)wid * 1024u;
    const int aoff = lds_byte(wr * 64 + fr, fq * 8), boff = lds_byte(wc * 32 + fr, fq * 8);
#define PG8_SA(b, h) (((b) * 2 + (h)) * HTB)
#define PG8_SB(b, h) ((4 + (b) * 2 + (h)) * HTB)
#define PG8_STAGE(bufoff, gbase, voff) do { _Pragma("unroll") for (int _i = 0; _i < 2; ++_i) \
        __builtin_amdgcn_global_load_lds((const unsigned*)((const char*)(gbase) + (voff)[_i]), (PG8_LAS unsigned*)(lds + (bufoff) + ldsw + _i * 8192), 16, 0, 0); } while (0)
#define PG8_LDA(dst, b, h) do { _Pragma("unroll") for (int m = 0; m < 4; ++m) _Pragma("unroll") for (int k = 0; k < 2; ++k) dst[m][k] = *(const PG8_LAS bf16x8*)(lds + PG8_SA(b, h) + aoff + m * 2048 + k * 1024); } while (0)
#define PG8_LDB(dst, b, h) do { _Pragma("unroll") for (int n = 0; n < 2; ++n) _Pragma("unroll") for (int k = 0; k < 2; ++k) dst[n][k] = *(const PG8_LAS bf16x8*)(lds + PG8_SB(b, h) + boff + n * 2048 + k * 1024); } while (0)
#define PG8_MMA(ai, bj, At, Bt) do { __builtin_amdgcn_s_setprio(1); _Pragma("unroll") for (int m = 0; m < 4; ++m) _Pragma("unroll") for (int n = 0; n < 2; ++n) _Pragma("unroll") for (int k = 0; k < 2; ++k) \
        acc[ai][bj][m][n] = __builtin_amdgcn_mfma_f32_16x16x32_bf16(Bt[n][k], At[m][k], acc[ai][bj][m][n], 0, 0, 0); __builtin_amdgcn_s_setprio(0); } while (0)
#define PG8_WAIT_V(n) asm volatile("s_waitcnt vmcnt(" #n ")" ::: "memory")
#define PG8_WAIT_L(n) asm volatile("s_waitcnt lgkmcnt(" #n ")" ::: "memory")
#define PG8_BAR __builtin_amdgcn_s_barrier()
#define PG8_SCHED __builtin_amdgcn_sched_barrier(0)
    Unit cur, nxt; int ui = 0;
    if (!S.next(0, cur)) return;
    f32x4 acc[2][2][4][2];
#pragma unroll
    for (int a = 0; a < 2; ++a)
#pragma unroll
        for (int b = 0; b < 2; ++b)
#pragma unroll
            for (int m = 0; m < 4; ++m)
#pragma unroll
                for (int n = 0; n < 2; ++n) acc[a][b][m][n] = (f32x4){0.f, 0.f, 0.f, 0.f};
    bf16x8 At[4][2], B0[2][2], B1[2][2];
    const char* cA = (const char*)g.A + (size_t)cur.pm * tstep; const char* cB = (const char*)g.Bt + (size_t)cur.pn * tstep;
    S.a_ready(cur);
    if constexpr (SP2) {
        PG8_STAGE(PG8_SB(0, 0), cB, voffB); PG8_STAGE(PG8_SB(0, 1), cB + hstep, voffB); PG8_STAGE(PG8_SA(0, 0), cA, voffA); PG8_STAGE(PG8_SA(0, 1), cA + hstep, voffA);
        if (wr == 1) PG8_BAR;
        PG8_WAIT_V(2); PG8_BAR;
        PG8_STAGE(PG8_SB(1, 0), cB + kstep, voffB); PG8_STAGE(PG8_SA(1, 0), cA + kstep, voffA); PG8_STAGE(PG8_SB(1, 1), cB + hstep + kstep, voffB);
        PG8_WAIT_V(6); PG8_BAR;
    } else {
        PG8_STAGE(PG8_SB(0, 0), cB, voffB); PG8_STAGE(PG8_SA(0, 0), cA, voffA); PG8_STAGE(PG8_SB(0, 1), cB + hstep, voffB); PG8_STAGE(PG8_SA(0, 1), cA + hstep, voffA);
        if (wr == 1) PG8_BAR;
        PG8_WAIT_V(4); PG8_BAR;
        PG8_STAGE(PG8_SB(1, 0), cB + kstep, voffB); PG8_STAGE(PG8_SA(1, 0), cA + kstep, voffA); PG8_STAGE(PG8_SB(1, 1), cB + hstep + kstep, voffB);
        PG8_WAIT_V(6); PG8_BAR;
    }
    for (;;) {
        const bool has_next = S.next(ui + 1, nxt);
        const char* nA = has_next ? (const char*)g.A + (size_t)nxt.pm * tstep : cA; const char* nB = has_next ? (const char*)g.Bt + (size_t)nxt.pn * tstep : cB;
        for (int t = 0; t < nt; t += 2) {
            const bool last = (t == nt - 2);
            const char* a1 = cA + (size_t)(t + 1) * kstep;
            const char* a2 = last ? nA : cA + (size_t)(t + 2) * kstep; const char* b2 = last ? nB : cB + (size_t)(t + 2) * kstep;
            const char* a3 = a2 + kstep; const char* b3 = b2 + kstep;
            if (last && has_next) S.a_ready(nxt);
            if constexpr (SP2) {
            PG8_LDB(B0, 0, 0); PG8_LDB(B1, 0, 1); PG8_SCHED; PG8_LDA(At, 0, 0); PG8_STAGE(PG8_SA(1, 1), a1 + hstep, voffA);
            PG8_WAIT_V(8); PG8_WAIT_L(0); PG8_BAR; PG8_MMA(0, 0, At, B0); PG8_MMA(0, 1, At, B1); PG8_BAR; PG8_SCHED;
            PG8_LDA(At, 0, 1); PG8_STAGE(PG8_SB(0, 0), b2, voffB); PG8_STAGE(PG8_SB(0, 1), b2 + hstep, voffB); PG8_STAGE(PG8_SA(0, 0), a2, voffA);
            PG8_WAIT_V(8); PG8_WAIT_L(0); PG8_BAR; PG8_MMA(1, 0, At, B0); PG8_MMA(1, 1, At, B1); PG8_BAR; PG8_SCHED;
            PG8_LDB(B0, 1, 0); PG8_LDB(B1, 1, 1); PG8_SCHED; PG8_LDA(At, 1, 0); PG8_STAGE(PG8_SA(0, 1), a2 + hstep, voffA);
            PG8_WAIT_V(8); PG8_WAIT_L(0); PG8_BAR; PG8_MMA(0, 0, At, B0); PG8_MMA(0, 1, At, B1); PG8_BAR; PG8_SCHED;
            PG8_LDA(At, 1, 1); PG8_STAGE(PG8_SB(1, 0), b3, voffB); PG8_STAGE(PG8_SB(1, 1), b3 + hstep, voffB); PG8_STAGE(PG8_SA(1, 0), a3, voffA);
            PG8_WAIT_V(8); PG8_WAIT_L(0); PG8_BAR; PG8_MMA(1, 0, At, B0); PG8_MMA(1, 1, At, B1); PG8_BAR; PG8_SCHED;
            } else {
            PG8_LDB(B0, 0, 0); PG8_SCHED; PG8_LDA(At, 0, 0); PG8_STAGE(PG8_SA(1, 1), a1 + hstep, voffA);
            PG8_WAIT_L(8); PG8_BAR; PG8_WAIT_L(0); PG8_MMA(0, 0, At, B0); PG8_BAR; PG8_SCHED;
            PG8_LDB(B1, 0, 1); PG8_STAGE(PG8_SB(0, 0), b2, voffB);
            PG8_BAR; PG8_WAIT_L(0); PG8_MMA(0, 1, At, B1); PG8_BAR;
            PG8_LDA(At, 0, 1); PG8_STAGE(PG8_SA(0, 0), a2, voffA);
            PG8_BAR; PG8_WAIT_L(0); PG8_MMA(1, 0, At, B0); PG8_BAR; PG8_SCHED;
            PG8_STAGE(PG8_SB(0, 1), b2 + hstep, voffB);
            PG8_WAIT_V(6); PG8_BAR; PG8_MMA(1, 1, At, B1); PG8_BAR;
            PG8_LDB(B0, 1, 0); PG8_SCHED; PG8_LDA(At, 1, 0); PG8_STAGE(PG8_SA(0, 1), a2 + hstep, voffA);
            PG8_WAIT_L(8); PG8_BAR; PG8_WAIT_L(0); PG8_MMA(0, 0, At, B0); PG8_BAR; PG8_SCHED;
            PG8_LDB(B1, 1, 1); PG8_STAGE(PG8_SB(1, 0), b3, voffB);
            PG8_BAR; PG8_WAIT_L(0); PG8_MMA(0, 1, At, B1); PG8_BAR;
            PG8_LDA(At, 1, 1); PG8_STAGE(PG8_SA(1, 0), a3, voffA);
            PG8_BAR; PG8_WAIT_L(0); PG8_MMA(1, 0, At, B0); PG8_BAR; PG8_SCHED;
            PG8_STAGE(PG8_SB(1, 1), b3 + hstep, voffB);
            PG8_WAIT_V(6); PG8_BAR; PG8_MMA(1, 1, At, B1); PG8_BAR;
            }
        }
        if constexpr (ALIGN_EPI) { if (wr == 0) PG8_BAR; }
        if constexpr (!Epi::AFTER_DRAIN) { E(acc, cur, wr, wc, fr, fq); S.done(cur); }
        if (!has_next) break;
#pragma unroll
        for (int a = 0; a < 2; ++a)
#pragma unroll
            for (int b = 0; b < 2; ++b)
#pragma unroll
                for (int m = 0; m < 4; ++m)
#pragma unroll
                    for (int n = 0; n < 2; ++n) acc[a][b][m][n] = (f32x4){0.f, 0.f, 0.f, 0.f};
        cur = nxt; cA = nA; cB = nB; ++ui;
        if constexpr (ALIGN_EPI) { if (wr == 1) PG8_BAR; }
    }
    PG8_WAIT_V(0);
    if constexpr (!ALIGN_EPI) { if (wr == 0) PG8_BAR; }
    PG8_BAR;
    if constexpr (Epi::AFTER_DRAIN) { E.fused(acc, cur, wr, wc, fr, fq, lds, wid, lane); S.done(cur); }
#undef PG8_SA
#undef PG8_SB
#undef PG8_STAGE
#undef PG8_LDA
#undef PG8_LDB
#undef PG8_MMA
#undef PG8_WAIT_V
#undef PG8_WAIT_L
#undef PG8_BAR
#undef PG8_SCHED
}
}
#include <hip/hip_bf16.h>
#include <cmath>
namespace attn_body {
using bf16=__hip_bfloat16;
using bf16x8=__attribute__((ext_vector_type(8)))short;
using s16x4=__attribute__((ext_vector_type(4)))short;
using f32x16=__attribute__((ext_vector_type(16)))float;
using u32x4=__attribute__((ext_vector_type(4)))unsigned;
constexpr int BATCH=1,NHEAD=8,SEQ=16384,D=64,DM=NHEAD*D;
constexpr int NW=8,QBLK=32,QB=QBLK*NW,KVBLK=64,NQB=SEQ/QB;
constexpr int ATTN_PITCH=DM, ATTN_UNIT_ROWS=QB;
__device__ __forceinline__ int crow(int r,int hi){return (r&3)+8*(r>>2)+4*hi;}
#define SBAR() __builtin_amdgcn_sched_barrier(0)
__device__ __forceinline__ void cmask(f32x16&p0,f32x16&p1,int jb,int qrel,int hi){
  const float NEG=-INFINITY; int kb=64*jb+4*hi;
  #pragma unroll
  for(int r=0;r<16;++r){int kv=kb+(r&3)+8*(r>>2); if(kv>qrel)p0[r]=NEG; if(kv+32>qrel)p1[r]=NEG;}
}

constexpr int NSLOT=3, SLOTB=8192;
constexpr int LDS_K=0, LDS_V=NSLOT*SLOTB, LDS_WS=2*NSLOT*SLOTB, LDS_OST=LDS_WS+NW*64*4, LDS_BYTES=LDS_OST+NW*4096;
constexpr float C2=0.125f*1.4426950408889634f;
__device__ __forceinline__ void glds16(const void*gsrc,unsigned lds_dst){unsigned keep;
  asm volatile("s_mov_b32 %0, m0\n\ts_mov_b32 m0, %2\n\ts_nop 0\n\tglobal_load_lds_dwordx4 %1, off\n\ts_mov_b32 m0, %0":"=&s"(keep):"v"(gsrc),"s"(lds_dst):"memory");}
__device__ __forceinline__ float max3f(float a,float b,float c){float r;asm("v_max3_f32 %0, %1, %2, %3":"=v"(r):"v"(a),"v"(b),"v"(c));return r;}
__device__ __forceinline__ float max2f(float a,float b){float r;asm("v_max_f32_e32 %0, %1, %2":"=v"(r):"v"(a),"v"(b));return r;}
__device__ __forceinline__ float fadd_s(float a,float b){float r;asm("v_add_f32_e32 %0, %1, %2":"=v"(r):"v"(a),"v"(b));return r;}
__device__ __forceinline__ float fsub_s(float a,float b){float r;asm("v_sub_f32_e32 %0, %1, %2":"=v"(r):"v"(a),"v"(b));return r;}
typedef float f32x2_t __attribute__((ext_vector_type(2))); typedef __bf16 bf16x2_t __attribute__((ext_vector_type(2)));
__device__ __forceinline__ unsigned cvtpk_s(float lo,float hi){f32x2_t v={lo,hi};bf16x2_t b=__builtin_convertvector(v,bf16x2_t);return __builtin_bit_cast(unsigned,b);}
#define WAIT_BAR(N) asm volatile("s_waitcnt vmcnt(" #N ") lgkmcnt(0)\n\ts_barrier":::"memory")

__device__ __forceinline__ void qkt(f32x16&p0,f32x16&p1,const char*Kslot,const bf16x8*qr,const f32x16&negm,int r32,int hi){
  const char*kb=Kslot+hi*1024+r32*16;
  #pragma unroll
  for(int d0=0;d0<4;++d0){
    const bf16x8 b0=*reinterpret_cast<const bf16x8*>(kb+d0*2048);
    const bf16x8 b1=*reinterpret_cast<const bf16x8*>(kb+d0*2048+512);
    if(d0==0){p0=__builtin_amdgcn_mfma_f32_32x32x16_bf16(b0,qr[0],negm,0,0,0);p1=__builtin_amdgcn_mfma_f32_32x32x16_bf16(b1,qr[0],negm,0,0,0);}
    else{p0=__builtin_amdgcn_mfma_f32_32x32x16_bf16(b0,qr[d0],p0,0,0,0);p1=__builtin_amdgcn_mfma_f32_32x32x16_bf16(b1,qr[d0],p1,0,0,0);}}
}
typedef __attribute__((address_space(3))) const char* lds_cptr;
typedef short v4i16_t __attribute__((ext_vector_type(4)));
__device__ __forceinline__ void kload8(bf16x8*kf,lds_cptr kp){
  kf[0]=*(const __attribute__((address_space(3))) bf16x8*)(kp);      kf[1]=*(const __attribute__((address_space(3))) bf16x8*)(kp+512);
  kf[2]=*(const __attribute__((address_space(3))) bf16x8*)(kp+2048); kf[3]=*(const __attribute__((address_space(3))) bf16x8*)(kp+2560);
  kf[4]=*(const __attribute__((address_space(3))) bf16x8*)(kp+4096); kf[5]=*(const __attribute__((address_space(3))) bf16x8*)(kp+4608);
  kf[6]=*(const __attribute__((address_space(3))) bf16x8*)(kp+6144); kf[7]=*(const __attribute__((address_space(3))) bf16x8*)(kp+6656);
}
__device__ __forceinline__ void kload2(bf16x8*kf,lds_cptr kp,int j){ kf[2*j]=*(const __attribute__((address_space(3))) bf16x8*)(kp+j*2048); kf[2*j+1]=*(const __attribute__((address_space(3))) bf16x8*)(kp+j*2048+512); }
__device__ __forceinline__ s16x4 vtr(lds_cptr p){ return __builtin_bit_cast(s16x4,__builtin_amdgcn_ds_read_tr16_b64_v4i16((__attribute__((address_space(3))) v4i16_t*)p)); }
__device__ __forceinline__ float rowmax(const f32x16&p0,const f32x16&p1){
  float a=max3f(p0[0],p0[1],p1[0]),b=max3f(p0[2],p0[3],p1[1]);a=max3f(a,p1[2],p1[3]);
  #pragma unroll
  for(int r=4;r<16;r+=4){a=max3f(a,p0[r],p0[r+1]);b=max3f(b,p0[r+2],p0[r+3]);a=max3f(a,p1[r],p1[r+1]);b=max3f(b,p1[r+2],p1[r+3]);}
  const float m=max2f(a,b);
  auto rr=__builtin_amdgcn_permlane32_swap(__float_as_uint(m),__float_as_uint(m),false,false);
  return max2f(__uint_as_float(rr[0]),__uint_as_float(rr[1]));
}
__device__ __forceinline__ void pv(f32x16*o,int vb,bf16x8 pa0,bf16x8 pa1,bf16x8 pa2,bf16x8 pa3){
  #pragma unroll
  for(int d0=0;d0<2;++d0){s16x4 lo[4],hi[4];
    #pragma unroll
    for(int ks=0;ks<4;++ks){
      asm volatile("ds_read_b64_tr_b16 %0,%1 offset:%c2":"=&v"(lo[ks]):"v"(vb),"i"(d0*4096+ks*1024):"memory");
      asm volatile("ds_read_b64_tr_b16 %0,%1 offset:%c2":"=&v"(hi[ks]):"v"(vb),"i"(d0*4096+ks*1024+512):"memory");}
    asm volatile("s_waitcnt lgkmcnt(0)":::"memory");SBAR();
    #define PK(k) (bf16x8){lo[k][0],lo[k][1],lo[k][2],lo[k][3],hi[k][0],hi[k][1],hi[k][2],hi[k][3]}
    o[d0]=__builtin_amdgcn_mfma_f32_32x32x16_bf16(pa0,PK(0),o[d0],0,0,0);
    o[d0]=__builtin_amdgcn_mfma_f32_32x32x16_bf16(pa1,PK(1),o[d0],0,0,0);
    o[d0]=__builtin_amdgcn_mfma_f32_32x32x16_bf16(pa2,PK(2),o[d0],0,0,0);
    o[d0]=__builtin_amdgcn_mfma_f32_32x32x16_bf16(pa3,PK(3),o[d0],0,0,0);
    #undef PK
  }
}
typedef float f32x4_t __attribute__((ext_vector_type(4)));

#ifndef ATTN_STORE16
#define ATTN_STORE16(p,v) (*(u32x4*)(p)=(v))
#endif
constexpr int FCH=64;
constexpr int F2_CK=LDS_BYTES, FOX2_LDS_BYTES=F2_CK+FCH*64*4;
template<int THRL> __device__ __forceinline__ void fox_unit2(int h,int qb,int jc,float kn,const bf16*Q,const bf16*__restrict__ K,const bf16*__restrict__ V,bf16*O,float*ML,const float*__restrict__ c2h,char*shm,float*qmx){
  int tid=threadIdx.x; asm volatile("":"+v"(tid)); const int lane=tid&63,r32=lane&31,hi=lane>>5; const int wid=__builtin_amdgcn_readfirstlane(tid>>6);
  const long rowbase=0; const int q0=qb*QB;
  const bf16*Qw=Q+(rowbase+q0+wid*QBLK)*DM+h*D;
  const bf16*Kh=K+rowbase*DM+h*D,*Vh=V+rowbase*DM+h*D;
  const unsigned lds0=(unsigned)(uintptr_t)shm;
  float*wsf=(float*)(shm+LDS_WS)+wid*64;
  float*ckl=(float*)(shm+F2_CK);
  const int NTg=(q0+QB)/KVBLK;
  bf16x8 qr[4];
  #pragma unroll
  for(int d0=0;d0<4;++d0)qr[d0]=*reinterpret_cast<const bf16x8*>(&Qw[(long)r32*DM+d0*16+hi*8]);
  bf16x8 kd[4];
  { const bf16*Kd=K+(long)(q0+wid*QBLK+r32)*DM+h*D;
    #pragma unroll
    for(int d0=0;d0<4;++d0)kd[d0]=*reinterpret_cast<const bf16x8*>(&Kd[d0*16+hi*8]); }
  int ts;
  const float cq0_=c2h[q0], cte_=(tid<NTg-4)?c2h[64*tid+63]:0.f;
  { float qs=0.f,dg=0.f;
    #pragma unroll
    for(int d0=0;d0<4;++d0)
      #pragma unroll
      for(int e=0;e<8;++e){ const float v=__builtin_bit_cast(float,(unsigned)(unsigned short)qr[d0][e]<<16); qs+=v*v; dg+=v*__builtin_bit_cast(float,(unsigned)(unsigned short)kd[d0][e]<<16); }
    { auto rr=__builtin_amdgcn_permlane32_swap(__float_as_uint(qs),__float_as_uint(qs),false,false); qs=__uint_as_float(rr[0])+__uint_as_float(rr[1]); }
    { auto rr=__builtin_amdgcn_permlane32_swap(__float_as_uint(dg),__float_as_uint(dg),false,false); dg=__uint_as_float(rr[0])+__uint_as_float(rr[1]); }
    #pragma unroll
    for(int o_=1;o_<32;o_<<=1){ qs=__builtin_fmaxf(qs,__shfl_xor(qs,o_)); dg=__builtin_fminf(dg,__shfl_xor(dg,o_)); }
    if(lane==0){qmx[wid]=qs;qmx[wid-20]=dg;}
    __syncthreads();
    float q2=qmx[0];
    #pragma unroll
    for(int w_=1;w_<8;++w_)q2=__builtin_fmaxf(q2,qmx[w_]);
    float dmin=qmx[-20];
    #pragma unroll
    for(int w_=1;w_<8;++w_)dmin=__builtin_fminf(dmin,qmx[w_-20]);
    const float lim=cq0_+152.05f+sqrtf(q2)*kn-dmin;
    ts=__syncthreads_count((tid<NTg-4)&&(cte_>lim)); ts&=~3; }
  const int t1=NTg-FCH*jc; int t0=t1-FCH; t0=t0<0?0:t0; t0=t0<ts?ts:t0;
  if(t0>=t1){ if(hi==0){ float*mlp=ML+((long)(q0+wid*QBLK+r32)*NHEAD+h)*2; mlp[0]=-1.0e30f; mlp[1]=0.f; } return; }
  const int NT=t1-t0;
  const int NTm=(jc==0)?NT:(1<<20);
  const bf16*ksrc=Kh+(long)(t0*KVBLK+lane)*DM+wid*8;
  const bf16*vsrc=Vh+(long)(t0*KVBLK+16*(wid&3)+(lane>>2))*DM+(wid>>2)*32+(lane&3)*8;
  const unsigned kdst=lds0+LDS_K+wid*1024, vdst=lds0+LDS_V+wid*1024;
  #define DMA_K(t,slot) glds16(ksrc+(long)(t)*KVBLK*DM,(unsigned)__builtin_amdgcn_readfirstlane(kdst+(slot)))
  #define DMA_V(t,slot) glds16(vsrc+(long)(t)*KVBLK*DM,(unsigned)__builtin_amdgcn_readfirstlane(vdst+(slot)))
  const int vb0=(int)(lds0+LDS_V)+((lane>>4)&1)*32+(lane&3)*8+(4*hi+((lane&15)>>2))*64;
  const char*Kbase=shm+LDS_K; bf16x8 kf[8];
  const lds_cptr shm3=(lds_cptr)shm; const lds_cptr kp0=shm3+LDS_K+hi*1024+r32*16; const lds_cptr vp0=shm3+LDS_V+((lane>>4)&1)*32+(lane&3)*8+(4*hi+((lane&15)>>2))*64;
  DMA_K(0,0);DMA_V(0,0);DMA_K(1,SLOTB);
  { const float cref=cq0_; const int nck=NT*64;
    for(int i=tid*4;i<nck;i+=2048){ f32x4_t v=*(const f32x4_t*)(c2h+t0*64+i); v=v-cref; *(f32x4_t*)(ckl+i)=v; } }
  float mhat=0.f,l_reg=0.f;f32x16 o[2];o[0]=f32x16{};o[1]=f32x16{};const f32x16 zc16=f32x16{};
  const int qrel=wid*QBLK+r32;
  #define CMASK(P0,P1,t) do{int jb_=(t)-(NTm-4); if(jb_>=0)cmask(P0,P1,jb_,qrel,hi);}while(0)
  #define BIAS(P0,P1,t) do{ const float*cb_=ckl+(t)*64+4*hi; _Pragma("unroll") for(int g_=0;g_<4;++g_){ const f32x4_t a_=*(const f32x4_t*)(cb_+8*g_), b_=*(const f32x4_t*)(cb_+32+8*g_); _Pragma("unroll") for(int e_=0;e_<4;++e_){P0[4*g_+e_]-=a_[e_];P1[4*g_+e_]-=b_[e_];} SBAR(); } }while(0)
  bool resc=false;
  #define START(P0,P1) do{ const float rm=rowmax(P0,P1); resc=false; \
    { const float dl=rm; mhat=fadd_s(mhat,dl); \
      _Pragma("unroll") for(int r=0;r<16;++r){P0[r]=fsub_s(P0[r],dl);P1[r]=fsub_s(P1[r],dl);} \
      } \
    _Pragma("unroll") for(int r=0;r<16;++r)P0[r]=__builtin_amdgcn_exp2f(P0[r]); }while(0)
  #define RESC() do{ if(resc){ asm volatile("s_waitcnt lgkmcnt(0)":::"memory"); \
      _Pragma("unroll") for(int d_=0;d_<2;++d_) _Pragma("unroll") for(int r=0;r<16;++r)o[d_][r]*=wsf[crow(r,hi)]; } }while(0)
  f32x16 pA0,pA1,pB0,pB1;
  int sl_prev=0,sl_cur=0,sl_next=SLOTB;
  #define ROT() do{sl_prev=sl_cur;sl_cur=sl_next;sl_next=(sl_next==(NSLOT-1)*SLOTB)?0:sl_next+SLOTB;}while(0)
  DMA_K(2,2*SLOTB);
  WAIT_BAR(3);
  qkt(pA0,pA1,Kbase,qr,zc16,r32,hi);asm volatile("s_nop 15\n\ts_nop 7":"+v"(pA0),"+v"(pA1));BIAS(pA0,pA1,0);CMASK(pA0,pA1,0);
  START(pA0,pA1);
  _Pragma("unroll") for(int r=0;r<16;++r)pA1[r]=__builtin_amdgcn_exp2f(pA1[r]);
  #define PFG(X0,X1,tn,k) do{ const f32x4_t a_=*(const f32x4_t*)(ckl+(tn)*64+4*hi+(((k)<4)?8*(k):32+8*((k)-4))); const float nm_=-mhat; \
      if((k)<4){ X0[4*(k)]=nm_-a_[0]; X0[4*(k)+1]=nm_-a_[1]; X0[4*(k)+2]=nm_-a_[2]; X0[4*(k)+3]=nm_-a_[3]; } \
      else { X1[4*((k)-4)]=nm_-a_[0]; X1[4*((k)-4)+1]=nm_-a_[1]; X1[4*((k)-4)+2]=nm_-a_[2]; X1[4*((k)-4)+3]=nm_-a_[3]; } }while(0)
  { PFG(pB0,pB1,1,0);PFG(pB0,pB1,1,1);PFG(pB0,pB1,1,2);PFG(pB0,pB1,1,3);PFG(pB0,pB1,1,4);PFG(pB0,pB1,1,5);PFG(pB0,pB1,1,6);PFG(pB0,pB1,1,7); }
  WAIT_BAR(0);
  DMA_K(3,0);DMA_V(1,SLOTB);
  ROT();
  kload8(kf,kp0+sl_cur);
  WAIT_BAR(2);
  s16x4 vlo[8],vhi[8]; u32x4 pw0,pw1,pw2,pw3;
  #define PKW(P,B) cvtpk_s(P[B],P[B+1])
  #define PAF(k) __builtin_bit_cast(bf16x8,pw##k)
  #define VFR(i) (bf16x8){vlo[i][0],vlo[i][1],vlo[i][2],vlo[i][3],vhi[i][0],vhi[i][1],vhi[i][2],vhi[i][3]}
  #define PIN(x) asm volatile("":"+v"(x))
  #define MX3(a,b,c) __builtin_fmaxf(__builtin_fmaxf((a),(b)),(c))
  #define GAPA(MF,A0,A1,A2,A3,W0,W1,PW) do{ MF; sacc+=A0; sacc+=A1; sacc+=A2; sacc+=A3; PIN(sacc); W0; W1; PIN(PW); SBAR(); }while(0)
  #define EX(v) __builtin_amdgcn_exp2f(v)
  #define GAPB(MF,X,B,PF) do{ MF; PF; X[B]=EX(X[B]); X[B+1]=EX(X[B+1]); X[B+2]=EX(X[B+2]); X[B+3]=EX(X[B+3]); PIN(X); SBAR(); }while(0)
  #define PFN(G,X0,X1,tt,k) do{ if(G){ PFG(X0,X1,(tt)+1,k); } }while(0)
  #define VRD(i) do{ vlo[i]=vtr(vp_+(((i)>>2)*4096+((i)&3)*1024)); vhi[i]=vtr(vp_+(((i)>>2)*4096+((i)&3)*1024+512)); }while(0)
  #define KRD(G,j) do{ if(G){ kload2(kf,kp0+sl_next,j); SBAR(); } }while(0)
  #define STEP(C0,C1,P0,P1,t,GK,GV,GL) do{ SBAR(); \
    const lds_cptr vp_=vp0+sl_prev; \
    VRD(0); SBAR(); float sacc=(P0[0]+P0[1]); \
    GAPA(C0=__builtin_amdgcn_mfma_f32_32x32x16_bf16(kf[0],qr[0],C0,0,0,0), P0[2],P0[3],P0[4],P0[5],     pw0[0]=PKW(P0,0), pw0[1]=PKW(P0,2), pw0); \
    VRD(4); SBAR(); GAPA(C1=__builtin_amdgcn_mfma_f32_32x32x16_bf16(kf[1],qr[0],C1,0,0,0), P0[6],P0[7],P0[8],P0[9],     pw0[2]=PKW(P0,4), pw0[3]=PKW(P0,6), pw0); \
    VRD(1); SBAR(); GAPA(C0=__builtin_amdgcn_mfma_f32_32x32x16_bf16(kf[2],qr[1],C0,0,0,0),   P0[10],P0[11],P0[12],P0[13], pw1[0]=PKW(P0,8), pw1[1]=PKW(P0,10), pw1); \
    VRD(5); SBAR(); GAPA(C1=__builtin_amdgcn_mfma_f32_32x32x16_bf16(kf[3],qr[1],C1,0,0,0),   P0[14],P0[15],P1[0],P1[1],   pw1[2]=PKW(P0,12),pw1[3]=PKW(P0,14), pw1); \
    VRD(2); SBAR(); GAPA(C0=__builtin_amdgcn_mfma_f32_32x32x16_bf16(kf[4],qr[2],C0,0,0,0),   P1[2],P1[3],P1[4],P1[5],     pw2[0]=PKW(P1,0), pw2[1]=PKW(P1,2), pw2); \
    VRD(6); SBAR(); GAPA(C1=__builtin_amdgcn_mfma_f32_32x32x16_bf16(kf[5],qr[2],C1,0,0,0),   P1[6],P1[7],P1[8],P1[9],     pw2[2]=PKW(P1,4), pw2[3]=PKW(P1,6), pw2); \
    VRD(3); SBAR(); GAPA(C0=__builtin_amdgcn_mfma_f32_32x32x16_bf16(kf[6],qr[3],C0,0,0,0),   P1[10],P1[11],P1[12],P1[13], pw3[0]=PKW(P1,8), pw3[1]=PKW(P1,10), pw3); \
    VRD(7); SBAR(); GAPA(C1=__builtin_amdgcn_mfma_f32_32x32x16_bf16(kf[7],qr[3],C1,0,0,0),   P1[14],P1[15],0.f,0.f,       pw3[2]=PKW(P1,12),pw3[3]=PKW(P1,14), pw3); \
    l_reg+=sacc; \
    if(GK){DMA_K((t)+3,sl_cur);} if(GV){DMA_V((t)+1,sl_next);} \
    CMASK(C0,C1,t); \
    { float a=MX3(C0[0],C0[1],C1[0]),b=MX3(C0[2],C0[3],C1[1]); a=MX3(a,C1[2],C1[3]); \
      _Pragma("unroll") for(int r=4;r<16;r+=4){a=MX3(a,C0[r],C0[r+1]);b=MX3(b,C0[r+2],C0[r+3]);a=MX3(a,C1[r],C1[r+1]);b=MX3(b,C1[r+2],C1[r+3]);} \
      float rm=__builtin_fmaxf(a,b); { auto rr=__builtin_amdgcn_permlane32_swap(__float_as_uint(rm),__float_as_uint(rm),false,false); rm=__builtin_fmaxf(__uint_as_float(rr[0]),__uint_as_float(rr[1])); } \
      resc=false; \
      if(__builtin_expect(__any(rm>(float)THRL),0)){ const float dl=__builtin_fmaxf(rm,0.f); mhat+=dl; \
        _Pragma("unroll") for(int r=0;r<16;++r){C0[r]-=dl;C1[r]-=dl;} \
        const float f=__builtin_amdgcn_exp2f(-dl); l_reg*=f; if(hi==0)wsf[r32]=f; resc=true; } } \
    SBAR(); \
    GAPB(o[0]=__builtin_amdgcn_mfma_f32_32x32x16_bf16(PAF(0),VFR(0),o[0],0,0,0), C0,0, PFN(GL,P0,P1,t,0)); \
    GAPB(o[1]=__builtin_amdgcn_mfma_f32_32x32x16_bf16(PAF(0),VFR(4),o[1],0,0,0), C0,4, PFN(GL,P0,P1,t,1)); \
    KRD(GL,0); GAPB(o[0]=__builtin_amdgcn_mfma_f32_32x32x16_bf16(PAF(1),VFR(1),o[0],0,0,0), C0,8, PFN(GL,P0,P1,t,2)); \
    KRD(GL,1); GAPB(o[1]=__builtin_amdgcn_mfma_f32_32x32x16_bf16(PAF(1),VFR(5),o[1],0,0,0), C0,12, PFN(GL,P0,P1,t,3)); \
    KRD(GL,2); GAPB(o[0]=__builtin_amdgcn_mfma_f32_32x32x16_bf16(PAF(2),VFR(2),o[0],0,0,0), C1,0, PFN(GL,P0,P1,t,4)); \
    KRD(GL,3); GAPB(o[1]=__builtin_amdgcn_mfma_f32_32x32x16_bf16(PAF(2),VFR(6),o[1],0,0,0), C1,4, PFN(GL,P0,P1,t,5)); \
    GAPB(o[0]=__builtin_amdgcn_mfma_f32_32x32x16_bf16(PAF(3),VFR(3),o[0],0,0,0), C1,8, PFN(GL,P0,P1,t,6)); \
    GAPB(o[1]=__builtin_amdgcn_mfma_f32_32x32x16_bf16(PAF(3),VFR(7),o[1],0,0,0), C1,12, PFN(GL,P0,P1,t,7)); \
    }while(0)
  int t=1;
  #undef CMASK
  #define CMASK(P0,P1,t) do{}while(0)
  for(;t+5<NT;t+=2){
    STEP(pB0,pB1,pA0,pA1,t,true,true,true);     WAIT_BAR(2); RESC(); ROT();
    STEP(pA0,pA1,pB0,pB1,t+1,true,true,true);   WAIT_BAR(2); RESC(); ROT();
  }
  #undef CMASK
  #define CMASK(P0,P1,t) do{int jb_=(t)-(NTm-4); if(jb_>=0)cmask(P0,P1,jb_,qrel,hi);}while(0)
  #define ENDW(tt) do{ if((tt)+3<NT){WAIT_BAR(2);} else if((tt)+2<NT){WAIT_BAR(1);} else {WAIT_BAR(0);} }while(0)
  for(;t+1<NT;t+=2){
    STEP(pB0,pB1,pA0,pA1,t,(t+3<NT),(t+1<NT),(t+1<NT));       ENDW(t);   RESC(); ROT();
    STEP(pA0,pA1,pB0,pB1,t+1,(t+4<NT),(t+2<NT),(t+2<NT));     ENDW(t+1); RESC(); ROT();
  }
  STEP(pB0,pB1,pA0,pA1,NT-1,false,false,false); RESC();
  { float sacc=pB0[0]+pB0[1]; _Pragma("unroll") for(int r=2;r<16;++r)sacc+=pB0[r]; _Pragma("unroll") for(int r=0;r<16;++r)sacc+=pB1[r]; l_reg+=sacc;
    pw0=(u32x4){PKW(pB0,0),PKW(pB0,2),PKW(pB0,4),PKW(pB0,6)};pw1=(u32x4){PKW(pB0,8),PKW(pB0,10),PKW(pB0,12),PKW(pB0,14)};pw2=(u32x4){PKW(pB1,0),PKW(pB1,2),PKW(pB1,4),PKW(pB1,6)};pw3=(u32x4){PKW(pB1,8),PKW(pB1,10),PKW(pB1,12),PKW(pB1,14)};
    SBAR(); pv(o,vb0+sl_cur,PAF(0),PAF(1),PAF(2),PAF(3)); }
  #undef PKW
  #undef PAF
  #undef VFR
  #undef PIN
  #undef MX3
  #undef GAPA
  #undef GAPB
  #undef PFN
  #undef PFG
  #undef EX
  #undef VRD
  #undef KRD
  #undef STEP
  #undef ENDW
  {auto rr=__builtin_amdgcn_permlane32_swap(__float_as_uint(l_reg),__float_as_uint(l_reg),false,false);l_reg=__uint_as_float(rr[0])+__uint_as_float(rr[1]);}
  if(hi==0){ wsf[32+r32]=l_reg; float*mlp=ML+((long)(q0+wid*QBLK+r32)*NHEAD+h)*2; mlp[0]=mhat; mlp[1]=l_reg; } asm volatile("s_waitcnt lgkmcnt(0)":::"memory");
  float rli[16];
  #pragma unroll
  for(int r=0;r<16;++r)rli[r]=__builtin_amdgcn_rcpf(wsf[32+crow(r,hi)]);
  bf16*Ow=O+(rowbase+q0+wid*QBLK)*DM+h*D;
  { bf16*stg=(bf16*)(shm+LDS_OST)+wid*2048;
    #pragma unroll
    for(int r=0;r<16;++r){const int orow=crow(r,hi);
      #pragma unroll
      for(int d0=0;d0<2;++d0)stg[orow*64+d0*32+r32]=__float2bfloat16(o[d0][r]*rli[r]);}
    asm volatile("s_waitcnt lgkmcnt(0)":::"memory");
    #pragma unroll
    for(int i=0;i<4;++i){const int row=i*8+(lane>>3),ch=lane&7; const u32x4 v=*(const u32x4*)(stg+row*64+ch*8); ATTN_STORE16(Ow+(long)row*DM+ch*8,v);} }
  asm volatile("s_waitcnt lgkmcnt(0)\n\ts_barrier":::"memory");
  #undef DMA_K
  #undef DMA_V
  #undef CMASK
  #undef BIAS
  #undef START
  #undef RESC
  #undef ROT
}

#undef SBAR
#undef WAIT_BAR
}
namespace cg = cooperative_groups;
constexpr int S_ = 16384, DMOD = 1024, NL = 4, DIN = 2568, NIN = 2816, DFF = 2816, NGU = 5632, NHD = 8;
constexpr float EPSN = 1e-6f;
constexpr size_t MiB = 1u << 20;
constexpr size_t WS_CTL = 0, CTL_BYTES = 65536;
constexpr size_t WS_WIN = 2 * MiB;
constexpr size_t WS_WOUT = 24 * MiB;
constexpr size_t WS_WGU = 32 * MiB;
constexpr size_t WS_WD = 76 * MiB;
constexpr size_t WS_XB = 98 * MiB;
constexpr size_t WS_RSSM = 130 * MiB;
constexpr size_t WS_RSSF = 130 * MiB + 128 * 1024;
constexpr size_t WS_LOGF = 130 * MiB + 256 * 1024;
constexpr size_t WS_C2 = 131 * MiB;
constexpr size_t WS_QKVZ = 132 * MiB;
constexpr size_t WS_O = 212 * MiB;
constexpr size_t WS_MG = 228 * MiB;
constexpr size_t WS_H = 132 * MiB;
constexpr size_t WS_OP = 260 * MiB;
constexpr size_t WS_ML = 308 * MiB;
constexpr size_t WS_END = 312 * MiB;
static_assert(WS_H + (size_t)S_ * DFF * 2 <= WS_MG, "h overlay");
constexpr int LDS_BYTES = 147456;
constexpr int CW_KMAX = 8192, CW_BAR = 9216, CW_SGUQ = 13312, CW_TS = 14336, CW_FCNT = 14400;
constexpr int NPHASE = 2 + 6 * NL;

#define LAS __attribute__((address_space(3)))
typedef unsigned short bf16r;
typedef unsigned v4u __attribute__((ext_vector_type(4)));
typedef float f32x4 __attribute__((ext_vector_type(4)));
typedef float f32x16 __attribute__((ext_vector_type(16)));
typedef short bf16x8 __attribute__((ext_vector_type(8)));
#define LDS_WAIT() asm volatile("s_waitcnt lgkmcnt(0)" ::: "memory")
__device__ __forceinline__ unsigned f2bf(float f) { unsigned u = __builtin_bit_cast(unsigned, f); return (u + 0x7fffu + ((u >> 16) & 1u)) >> 16; }
__device__ __forceinline__ unsigned pk2(float lo, float hi) { return f2bf(lo) | (f2bf(hi) << 16); }
__device__ __forceinline__ float bflo(unsigned w) { return __builtin_bit_cast(float, w << 16); }
__device__ __forceinline__ float bfhi(unsigned w) { return __builtin_bit_cast(float, w & 0xffff0000u); }
__device__ __forceinline__ float bf1(bf16r w) { return __builtin_bit_cast(float, (unsigned)w << 16); }
#define DPPF(v, ctrl) __builtin_bit_cast(float, __builtin_amdgcn_update_dpp(0, __builtin_bit_cast(int, (v)), (ctrl), 0xf, 0xf, true))
__device__ __forceinline__ float row16_sum(float v) {
    v += DPPF(v, 0xB1); v += DPPF(v, 0x4E); v += DPPF(v, 0x141); v += DPPF(v, 0x140); return v;
}
__device__ __forceinline__ float wave_sum(float v) {
    v += DPPF(v, 0xB1); v += DPPF(v, 0x4E); v += DPPF(v, 0x141); v += DPPF(v, 0x140);
    const int iv = __builtin_bit_cast(int, v);
    const float s0 = __builtin_bit_cast(float, __builtin_amdgcn_readlane(iv, 0)), s1 = __builtin_bit_cast(float, __builtin_amdgcn_readlane(iv, 16)),
                s2 = __builtin_bit_cast(float, __builtin_amdgcn_readlane(iv, 32)), s3 = __builtin_bit_cast(float, __builtin_amdgcn_readlane(iv, 48));
    return (s0 + s1) + (s2 + s3);
}
constexpr int PREP_P = 132;
__device__ __forceinline__ void prep_item(const float* W, int ldw, int srccol, const float* gs, bf16r* WT, int K, int dstrow, int k0, LAS float* scr, int lane) {
#pragma unroll 8
    for (int i = 0; i < 16; ++i) { const int kk = 2 * i + (lane >> 5); f32x4 w = *(const f32x4*)(W + (size_t)(k0 + kk) * ldw + srccol + 4 * (lane & 31)); if (gs) w = w * gs[k0 + kk];
        *(LAS f32x4*)(scr + kk * PREP_P + 4 * (lane & 31)) = w; }
    LDS_WAIT(); asm volatile("" ::: "memory");
    const int c = lane & 3;
#pragma unroll
    for (int j = 0; j < 8; ++j) { const int n = (lane >> 2) + 16 * j; const LAS float* s = scr + (8 * c) * PREP_P + n;
        v4u o; o.x = pk2(s[0 * PREP_P], s[1 * PREP_P]); o.y = pk2(s[2 * PREP_P], s[3 * PREP_P]); o.z = pk2(s[4 * PREP_P], s[5 * PREP_P]); o.w = pk2(s[6 * PREP_P], s[7 * PREP_P]);
        *(v4u*)(WT + (size_t)(dstrow + n) * K + k0 + 8 * c) = o; }
    LDS_WAIT(); asm volatile("" ::: "memory");
}
template <int OFF> __device__ __forceinline__ unsigned long long ldk() {
    unsigned long long v; auto ka = __builtin_amdgcn_kernarg_segment_ptr();
    asm volatile("s_load_dwordx2 %0, %1, %2\n\ts_waitcnt lgkmcnt(0)" : "=s"(v) : "s"(ka), "i"(OFF) : "memory");
    return v;
}
struct Ptrs {
    const float *x, *mixg, *w_in, *b_f, *lng, *lnb, *w_s, *b_s, *outg, *w_out, *ffng, *w_gu, *w_d, *fing;
    float* out; unsigned char* ws;
};
__device__ __forceinline__ void phase_prep(const Ptrs& P, LAS unsigned char* lds, int l0, int l1, int gw, int NGW, int wave, int lane) {
    LAS float* scr = (LAS float*)(lds + wave * (32 * PREP_P * 4));
    bf16r* WinT = (bf16r*)(P.ws + WS_WIN); bf16r* WoutT = (bf16r*)(P.ws + WS_WOUT); bf16r* WguT = (bf16r*)(P.ws + WS_WGU); bf16r* WdT = (bf16r*)(P.ws + WS_WD);
    constexpr int I_IN = 32 * 20, I_OUT = 32 * 8, I_GU = 32 * 44, I_D = 88 * 8, I_L = I_IN + I_OUT + I_GU + I_D;
    for (int it = l0 * I_L + gw; it < l1 * I_L; it += NGW) {
        const int l = it / I_L; int r = it % I_L;
        if (r < I_IN) { const int kb = r / 20, nb = r % 20, n0 = 128 * nb, src = n0 < 1536 ? n0 : n0 + 8;
            prep_item(P.w_in + (size_t)l * DMOD * DIN, DIN, src, P.mixg + l * DMOD, WinT + (size_t)l * NIN * DMOD, DMOD, n0, 32 * kb, scr, lane); continue; }
        r -= I_IN;
        if (r < I_OUT) { const int kb = r / 8, nb = r % 8;
            prep_item(P.w_out + (size_t)l * DMOD * DMOD, DMOD, 128 * nb, P.outg + l * DMOD, WoutT + (size_t)l * DMOD * DMOD, DMOD, 128 * nb, 32 * kb, scr, lane); continue; }
        r -= I_OUT;
        if (r < I_GU) { const int kb = r / 44, nb = r % 44, n0 = 128 * nb, pn = n0 >> 8, src = (n0 & 255) == 0 ? 128 * pn : DFF + 128 * pn;
            prep_item(P.w_gu + (size_t)l * DMOD * NGU, NGU, src, P.ffng + l * DMOD, WguT + (size_t)l * NGU * DMOD, DMOD, n0, 32 * kb, scr, lane); continue; }
        r -= I_GU;
        { const int kb = r / 8, nb = r % 8;
            prep_item(P.w_d + (size_t)l * DFF * DMOD, DMOD, 128 * nb, nullptr, WdT + (size_t)l * DMOD * DFF, DFF, 128 * nb, 32 * kb, scr, lane); }
    }
    for (int idx = l0 * 262144 + gw * 64 + lane; idx < l1 * 262144; idx += NGW * 64) { const int l = idx >> 18, rr = (idx >> 10) & 255, k = idx & 1023; unsigned v = 0u;
        if ((rr & 127) < 8) { const float w = P.w_in[((size_t)l * DMOD + k) * DIN + 1536 + (rr & 7)] * P.mixg[l * DMOD + k]; const unsigned hb = f2bf(w);
            v = rr < 128 ? hb : f2bf(w - __builtin_bit_cast(float, hb << 16)); }
        WinT[((size_t)l * NIN + 2560 + rr) * DMOD + k] = (bf16r)v; }
}
template <int MODE>
__device__ __forceinline__ void phase_rowstats(const float* xin, bf16r* xb, unsigned long long* rss_out, const float* gfin, float* outp, int gw, int NGW, int lane, float tdelta = 0.f) {
#pragma unroll 2
    for (int m = gw; m < S_; m += NGW) {
        const f32x4* xr = (const f32x4*)(xin + (size_t)m * DMOD) + lane;
        f32x4 v[4]; float s = 0.f;
#pragma unroll
        for (int j = 0; j < 4; ++j) { v[j] = xr[64 * j]; s += (v[j].x * v[j].x + v[j].y * v[j].y) + (v[j].z * v[j].z + v[j].w * v[j].w); }
        const float tot = wave_sum(s);
        if (MODE == 2) {
            const float rs = 1.0f / sqrtf(tot * (1.0f / DMOD) + EPSN);
            f32x4* orow = (f32x4*)(outp + (size_t)m * DMOD) + lane; const f32x4* gr = (const f32x4*)gfin + lane;
#pragma unroll
            for (int j = 0; j < 4; ++j) orow[64 * j] = v[j] * rs * gr[64 * j] + (m < 1024 ? tdelta : 0.f);
        } else {
            unsigned long long* o8 = (unsigned long long*)(xb + (size_t)m * DMOD) + lane;
#pragma unroll
            for (int j = 0; j < 4; ++j) o8[64 * j] = (unsigned long long)pk2(v[j].x, v[j].y) | ((unsigned long long)pk2(v[j].z, v[j].w) << 32);
            if (lane == 0) rss_out[m] = (unsigned long long)__float2ull_rn(tot * 16777216.0f);
        }
    }
}
__device__ __forceinline__ void final_norm(const bf16r* xb, const unsigned long long* rss, const float* g, float* outp, int gw, int NGW, int lane) {
#pragma unroll 2
    for (int m = gw; m < S_; m += NGW) {
        const v4u a = *(const v4u*)(xb + (size_t)m * DMOD + 8 * lane), b = *(const v4u*)(xb + (size_t)m * DMOD + 512 + 8 * lane);
        const float rs = 1.0f / sqrtf((float)rss[m] * (1.0f / (1024.0f * 16777216.0f)) + EPSN);
        const f32x4* gr = (const f32x4*)g; f32x4* orow = (f32x4*)(outp + (size_t)m * DMOD);
        const f32x4 g0 = gr[2 * lane], g1 = gr[2 * lane + 1], g2 = gr[128 + 2 * lane], g3 = gr[128 + 2 * lane + 1];
        orow[2 * lane] = (f32x4){bflo(a.x), bfhi(a.x), bflo(a.y), bfhi(a.y)} * rs * g0; orow[2 * lane + 1] = (f32x4){bflo(a.z), bfhi(a.z), bflo(a.w), bfhi(a.w)} * rs * g1;
        orow[128 + 2 * lane] = (f32x4){bflo(b.x), bfhi(b.x), bflo(b.y), bfhi(b.y)} * rs * g2; orow[128 + 2 * lane + 1] = (f32x4){bflo(b.z), bfhi(b.z), bflo(b.w), bfhi(b.w)} * rs * g3;
    }
}
__device__ __forceinline__ void cumsum_head(const float* logf, float* c2, int h, LAS unsigned char* lds, int tid) {
    LAS double* scr = (LAS double*)lds;
    const f32x4* src = (const f32x4*)(logf + (size_t)h * S_ + tid * 32);
    f32x4 v[8]; double sum = 0.0;
#pragma unroll
    for (int e = 0; e < 8; ++e) { v[e] = src[e]; sum += ((double)v[e].x + (double)v[e].y) + ((double)v[e].z + (double)v[e].w); }
    scr[tid] = sum; __syncthreads();
    double pre = 0.0; for (int i = 0; i < tid; ++i) pre += scr[i];
    f32x4* dst = (f32x4*)(c2 + (size_t)h * S_ + tid * 32);
#pragma unroll
    for (int e = 0; e < 8; ++e) { f32x4 o; pre += (double)v[e].x; o.x = (float)(pre * 1.4426950408889634); pre += (double)v[e].y; o.y = (float)(pre * 1.4426950408889634);
        pre += (double)v[e].z; o.z = (float)(pre * 1.4426950408889634); pre += (double)v[e].w; o.w = (float)(pre * 1.4426950408889634); dst[e] = o; }
    __syncthreads();
}
__device__ __forceinline__ void sgu_item(int c, const bf16r* ZU, const bf16r* ZV, bf16r* MG, const float* lng, const float* lnb, const float* wsl, const float* bsl,
                                         LAS unsigned char* lds, int wid, int lane) {
    LAS float* bsb = (LAS float*)lds;
    LAS bf16r* zt = (LAS bf16r*)(lds + 4096);
    const int r32 = lane & 31, hi = lane >> 5, g = wid, tid = wid * 64 + lane;
    bsb[tid] = bsl[tid]; bsb[tid + 512] = bsl[tid + 512];
    const int rs4 = lane >> 4, l16 = lane & 15;
#pragma unroll 2
    for (int it = 0; it < 4; ++it) { const int i = 16 * wid + 4 * it + rs4; const size_t row = (size_t)c * 128 + i;
        v4u zr[4];
#pragma unroll
        for (int j = 0; j < 4; ++j) zr[j] = *(const v4u*)(ZV + row * 512 + 128 * j + 8 * l16);
        float z[32]; float s = 0.f;
#pragma unroll
        for (int j = 0; j < 4; ++j) { z[8 * j] = bflo(zr[j].x); z[8 * j + 1] = bfhi(zr[j].x); z[8 * j + 2] = bflo(zr[j].y); z[8 * j + 3] = bfhi(zr[j].y); z[8 * j + 4] = bflo(zr[j].z); z[8 * j + 5] = bfhi(zr[j].z); z[8 * j + 6] = bflo(zr[j].w); z[8 * j + 7] = bfhi(zr[j].w); }
#pragma unroll
        for (int e = 0; e < 32; ++e) s += z[e];
        const float mean = row16_sum(s) * (1.0f / 512.0f); float q = 0.f;
#pragma unroll
        for (int e = 0; e < 32; ++e) { z[e] -= mean; q += z[e] * z[e]; }
        const float rstd = 1.0f / sqrtf(row16_sum(q) * (1.0f / 512.0f) + EPSN);
#pragma unroll
        for (int j = 0; j < 4; ++j) { const f32x4 g0 = *(const f32x4*)(lng + 128 * j + 8 * l16), g1 = *(const f32x4*)(lng + 128 * j + 8 * l16 + 4), b0 = *(const f32x4*)(lnb + 128 * j + 8 * l16), b1 = *(const f32x4*)(lnb + 128 * j + 8 * l16 + 4);
            v4u zw; zw.x = pk2(z[8 * j] * rstd * g0.x + b0.x, z[8 * j + 1] * rstd * g0.y + b0.y); zw.y = pk2(z[8 * j + 2] * rstd * g0.z + b0.z, z[8 * j + 3] * rstd * g0.w + b0.w);
            zw.z = pk2(z[8 * j + 4] * rstd * g1.x + b1.x, z[8 * j + 5] * rstd * g1.y + b1.y); zw.w = pk2(z[8 * j + 6] * rstd * g1.z + b1.z, z[8 * j + 7] * rstd * g1.w + b1.w);
            *(LAS v4u*)(zt + i * 512 + 128 * j + 8 * l16) = zw; }
    }
    LDS_WAIT(); __syncthreads();
#pragma unroll 1
    for (int ni = 0; ni < 2; ++ni) {
        const int d = 64 * g + 32 * ni + r32;
        bf16x8 bfr[8];
#pragma unroll
        for (int ks = 0; ks < 8; ++ks) { const LAS bf16r* zp = zt + (16 * ks + 8 * hi) * 512 + d;
            v4u w; w.x = (unsigned)zp[0] | ((unsigned)zp[512] << 16); w.y = (unsigned)zp[1024] | ((unsigned)zp[1536] << 16); w.z = (unsigned)zp[2048] | ((unsigned)zp[2560] << 16); w.w = (unsigned)zp[3072] | ((unsigned)zp[3584] << 16);
            bfr[ks] = __builtin_bit_cast(bf16x8, w); }
        LDS_WAIT(); asm volatile("" ::: "memory");
        f32x16 acc[4];
#pragma unroll
        for (int mi = 0; mi < 4; ++mi) { acc[mi] = f32x16{};
#pragma unroll
            for (int ks = 0; ks < 8; ++ks) { if (mi < 2 && ks >= 4) continue;
                const float* wp = wsl + ((size_t)g * 128 + 32 * mi + r32) * 128 + 16 * ks + 8 * hi; const f32x4 a0 = *(const f32x4*)wp, a1 = *(const f32x4*)(wp + 4);
                v4u w; w.x = pk2(a0.x, a0.y); w.y = pk2(a0.z, a0.w); w.z = pk2(a1.x, a1.y); w.w = pk2(a1.z, a1.w);
                acc[mi] = __builtin_amdgcn_mfma_f32_32x32x16_bf16(__builtin_bit_cast(bf16x8, w), bfr[ks], acc[mi], 0, 0, 0); }
            asm volatile("" ::: "memory"); }
#pragma unroll
        for (int mi = 0; mi < 4; ++mi)
#pragma unroll
            for (int r = 0; r < 16; ++r) { const int i = 32 * mi + (r & 3) + 8 * (r >> 2) + 4 * hi;
                zt[i * 512 + d] = (bf16r)f2bf(acc[mi][r] + bsb[g * 128 + i]); }
        LDS_WAIT(); asm volatile("" ::: "memory");
    }
    __syncthreads();
#pragma unroll 2
    for (int it = 0; it < 4; ++it) { const int i = 16 * wid + 4 * it + rs4; const size_t row = (size_t)c * 128 + i;
        float a[32]; float ss = 0.f;
#pragma unroll
        for (int j = 0; j < 4; ++j) { const v4u tr = *(const LAS v4u*)(zt + i * 512 + 128 * j + 8 * l16); const v4u ur = *(const v4u*)(ZU + row * 512 + 128 * j + 8 * l16);
            a[8 * j] = bflo(tr.x) * bflo(ur.x); a[8 * j + 1] = bfhi(tr.x) * bfhi(ur.x); a[8 * j + 2] = bflo(tr.y) * bflo(ur.y); a[8 * j + 3] = bfhi(tr.y) * bfhi(ur.y);
            a[8 * j + 4] = bflo(tr.z) * bflo(ur.z); a[8 * j + 5] = bfhi(tr.z) * bfhi(ur.z); a[8 * j + 6] = bflo(tr.w) * bflo(ur.w); a[8 * j + 7] = bfhi(tr.w) * bfhi(ur.w); }
#pragma unroll
        for (int e = 0; e < 32; ++e) ss += a[e] * a[e];
        const float ra = 1.0f / sqrtf(row16_sum(ss) * (1.0f / 512.0f) + EPSN);
#pragma unroll
        for (int j = 0; j < 4; ++j) { v4u w; w.x = pk2(a[8 * j] * ra, a[8 * j + 1] * ra); w.y = pk2(a[8 * j + 2] * ra, a[8 * j + 3] * ra); w.z = pk2(a[8 * j + 4] * ra, a[8 * j + 5] * ra); w.w = pk2(a[8 * j + 6] * ra, a[8 * j + 7] * ra);
            *(v4u*)(MG + row * 1024 + 512 + 128 * j + 8 * l16) = w; }
    }
    LDS_WAIT(); __syncthreads();
}
__device__ __forceinline__ void combine_item(int c, const bf16r* O, const bf16r* OP1, const float* ML, bf16r* MG, int wid, int lane) {
    const int rs4 = lane >> 4, l16 = lane & 15;
#pragma unroll
    for (int it = 0; it < 2; ++it) { const size_t row = (size_t)c * 64 + 8 * wid + 4 * it + rs4; const int nch = ((int)(row >> 12)) + 1;
        float a[32]; float ss = 0.f;
#pragma unroll
        for (int j = 0; j < 4; ++j) { const int hh = 2 * j + (l16 >> 3); float Mj[4], lj[4]; v4u oj[4];
#pragma unroll
            for (int q = 0; q < 4; ++q) { if (q < nch) { const float* mlp = ML + (size_t)q * S_ * 16 + (row * 8 + hh) * 2; Mj[q] = mlp[0]; lj[q] = mlp[1];
                    oj[q] = (q == 0 || lj[q] > 0.f) ? *(const v4u*)((q == 0 ? O : OP1 + (size_t)(q - 1) * S_ * 512) + row * 512 + 128 * j + 8 * l16) : (v4u){0u, 0u, 0u, 0u}; } else { Mj[q] = -1.0e30f; lj[q] = 0.f; oj[q] = (v4u){0u, 0u, 0u, 0u}; } }
            const float Mmax = fmaxf(fmaxf(Mj[0], Mj[1]), fmaxf(Mj[2], Mj[3])); float wsum = 0.f; float t[8] = {0.f, 0.f, 0.f, 0.f, 0.f, 0.f, 0.f, 0.f};
#pragma unroll
            for (int q = 0; q < 4; ++q) { const float w = lj[q] > 0.f ? lj[q] * __builtin_amdgcn_exp2f(Mj[q] - Mmax) : 0.f; wsum += w;
                if (w > 0.f) { t[0] += w * bflo(oj[q].x); t[1] += w * bfhi(oj[q].x); t[2] += w * bflo(oj[q].y); t[3] += w * bfhi(oj[q].y); t[4] += w * bflo(oj[q].z); t[5] += w * bfhi(oj[q].z); t[6] += w * bflo(oj[q].w); t[7] += w * bfhi(oj[q].w); } }
            const float iw = 1.0f / wsum;
#pragma unroll
            for (int e = 0; e < 8; ++e) { a[8 * j + e] = t[e] * iw; ss += a[8 * j + e] * a[8 * j + e]; } }
        const float ra = 1.0f / sqrtf(row16_sum(ss) * (1.0f / 512.0f) + EPSN);
#pragma unroll
        for (int j = 0; j < 4; ++j) { v4u w; w.x = pk2(a[8 * j] * ra, a[8 * j + 1] * ra); w.y = pk2(a[8 * j + 2] * ra, a[8 * j + 3] * ra); w.z = pk2(a[8 * j + 4] * ra, a[8 * j + 5] * ra); w.w = pk2(a[8 * j + 6] * ra, a[8 * j + 7] * ra);
            *(v4u*)(MG + row * 1024 + 128 * j + 8 * l16) = w; }
    }
}
#define XB_TMO      128
#define XB_XCNT(j)  (256  + 64 * (j))
#define XB_XSUB(j)  (1280 + 64 * (j))
#define XB_XGEN(j)  (2304 + 64 * (j))
#define XB_TOP      3328
#define XB_TOPGEN   3392
#define XCD_BAR_WORDS 3456
#define XB_SPIN_CAP (1u << 18)

__device__ __forceinline__ unsigned xb_ld(unsigned* p)              { return __hip_atomic_load(p, __ATOMIC_RELAXED, __HIP_MEMORY_SCOPE_AGENT); }
__device__ __forceinline__ unsigned xb_add(unsigned* p, unsigned v) { return __hip_atomic_fetch_add(p, v, __ATOMIC_RELAXED, __HIP_MEMORY_SCOPE_AGENT); }
__device__ __forceinline__ unsigned xb_xcc_id() { return (unsigned)__builtin_amdgcn_s_getreg((3 << 11) | 20) & 0xFu; }
#define XB_SPIN(cond, bar) do { unsigned _sp = 0; while (cond) { __builtin_amdgcn_s_sleep(1); \
    if ((++_sp & 255u) == 0u) { if (xb_ld(&(bar)[XB_TMO])) break; if (_sp > XB_SPIN_CAP) { atomicAdd(&(bar)[XB_TMO], 1u); break; } } } } while (0)

struct XcdBarrier {
    unsigned* bar; unsigned x;
    volatile LAS unsigned* st;
};

__device__ __forceinline__ XcdBarrier xcd_barrier_post(unsigned* bar, volatile LAS unsigned* st) {
    XcdBarrier b; b.bar = bar; b.x = xb_xcc_id(); b.st = st;
    if (threadIdx.x == 0) (void)xb_add(&bar[XB_XCNT(b.x)], 1u);
    return b;
}
__device__ __forceinline__ void xcd_barrier_complete(unsigned* bar, unsigned x, unsigned& nloc, unsigned& nx) {
    const unsigned G = gridDim.x * gridDim.y * gridDim.z;
    unsigned sum, cnt, mine, sp = 0u;
    for (;;) {
        sum = 0u; cnt = 0u; mine = 0u;
#pragma unroll
        for (unsigned j = 0; j < 16; ++j) { const unsigned c = xb_ld(&bar[XB_XCNT(j)]); sum += c; cnt += (c > 0u) ? 1u : 0u; mine = (j == x) ? c : mine; }
        if (sum == G) break;
        __builtin_amdgcn_s_sleep(1);
        if ((++sp & 255u) == 0u) { if (xb_ld(&bar[XB_TMO])) break; if (sp > XB_SPIN_CAP) { atomicAdd(&bar[XB_TMO], 1u); break; } }
    }
    nloc = mine > 0u ? mine : 1u; nx = cnt > 0u ? cnt : 1u;
}

__device__ __forceinline__ void xcd_barrier(const XcdBarrier& b) {
    asm volatile("s_waitcnt vmcnt(0)" ::: "memory");
    __syncthreads();
    if (threadIdx.x == 0) {
        unsigned* bar = b.bar;
        __builtin_amdgcn_s_waitcnt(0);
        unsigned nloc = b.st[0], nx = b.st[1];
        if (nloc == 0u) { xcd_barrier_complete(bar, b.x, nloc, nx); b.st[0] = nloc; b.st[1] = nx; }
        const unsigned old = xb_add(&bar[XB_XSUB(b.x)], 1u);
        const unsigned gen = old / nloc;
        if (old + 1u == (gen + 1u) * nloc) {
            __builtin_amdgcn_fence(__ATOMIC_RELEASE, "agent");
            asm volatile("s_waitcnt vmcnt(0)" ::: "memory");
            const unsigned og = xb_add(&bar[XB_TOP], 1u);
            const unsigned tg = og / nx;
            if (og + 1u == (tg + 1u) * nx) xb_add(&bar[XB_TOPGEN], 1u);
            else XB_SPIN(xb_ld(&bar[XB_TOPGEN]) == tg, bar);
            __builtin_amdgcn_fence(__ATOMIC_ACQUIRE, "agent");
            xb_add(&bar[XB_XGEN(b.x)], 1u);
            asm volatile("s_waitcnt vmcnt(0)" ::: "memory");
        } else {
            XB_SPIN(xb_ld(&bar[XB_XGEN(b.x)]) == gen, bar);
            __builtin_amdgcn_fence(__ATOMIC_ACQUIRE, "agent");
            asm volatile("s_waitcnt vmcnt(0)" ::: "memory");
        }
    }
    __syncthreads();
}
#ifndef MK_MULTI
#define MK_MULTI 0
#endif
struct Args { const float* in[14]; float* out; unsigned char* ws; int ph_lo, ph_hi; };
__global__ void __launch_bounds__(512, 2) fox_fwd(Args args) {
    extern __shared__ __attribute__((aligned(16))) unsigned char lds[];
    cg::grid_group grid = cg::this_grid();
    LAS unsigned char* L = (LAS unsigned char*)lds;
    const int G = gridDim.x, bx = blockIdx.x;
    const int vcu = (G % 8 == 0) ? (bx % 8) * (G / 8) + bx / 8 : bx;
    const int NGW = G * 8;
#define IDS() int tid = threadIdx.x; asm volatile("" : "+v"(tid)); const int lane = tid & 63, wave = __builtin_amdgcn_readfirstlane(tid >> 6), gw = vcu * 8 + wave; (void)lane; (void)gw
#define KIN(k) ((const float*)(const __attribute__((address_space(1))) float*)ldk<8 * (k)>())
#define WSB() ((unsigned char*)(__attribute__((address_space(1))) unsigned char*)ldk<120>())
#define P_OUT ((float*)(__attribute__((address_space(1))) float*)ldk<112>())
#define ctl ((unsigned*)(WSB() + WS_CTL))
#define WinT ((bf16r*)(WSB() + WS_WIN))
#define WoutT ((bf16r*)(WSB() + WS_WOUT))
#define WguT ((bf16r*)(WSB() + WS_WGU))
#define WdT ((bf16r*)(WSB() + WS_WD))
#define XB ((bf16r*)(WSB() + WS_XB))
#define RSSM ((unsigned long long*)(WSB() + WS_RSSM))
#define RSSF ((unsigned long long*)(WSB() + WS_RSSF))
#define LOGF ((float*)(WSB() + WS_LOGF))
#define C2A ((float*)(WSB() + WS_C2))
#define QKVZ ((bf16r*)(WSB() + WS_QKVZ))
#define OB ((bf16r*)(WSB() + WS_O))
#define MG ((bf16r*)(WSB() + WS_MG))
#define HB ((bf16r*)(WSB() + WS_H))
#define OP1 ((bf16r*)(WSB() + WS_OP))
#define MLB ((float*)(WSB() + WS_ML))
#define MKP() Ptrs P; P.x = KIN(0); P.mixg = KIN(1); P.w_in = KIN(2); P.b_f = KIN(3); P.lng = KIN(4); P.lnb = KIN(5); P.w_s = KIN(6); P.b_s = KIN(7); \
    P.outg = KIN(8); P.w_out = KIN(9); P.ffng = KIN(10); P.w_gu = KIN(11); P.w_d = KIN(12); P.fing = KIN(13); P.out = P_OUT; P.ws = WSB()
    constexpr size_t QS = (size_t)S_ * 512;
    const int lo = args.ph_lo, hi = args.ph_hi;
    { LAS unsigned* misc = (LAS unsigned*)(L + 147456 - 8); if (threadIdx.x < 2) misc[threadIdx.x] = 0u; __syncthreads(); }
    XcdBarrier xbar = xcd_barrier_post((unsigned*)(WSB() + WS_CTL) + CW_BAR, (volatile LAS unsigned*)(L + 147456 - 8));
    int ph = 0;
#ifdef PROBE_T
    unsigned long long tacc_ = 0ull, tst_ = 0ull;
#define TCLS() ((ph == 0) ? 0 : (ph <= 7 * NL ? ((ph - 1) % 7) + 1 : 8))
#define TBEG() do { if (TCLS() == PROBE_T) tst_ = __builtin_amdgcn_s_memrealtime(); } while (0)
#define TEND() do { if (TCLS() == PROBE_T) tacc_ += __builtin_amdgcn_s_memrealtime() - tst_; } while (0)
#else
#define TBEG() do {} while (0)
#define TEND() do {} while (0)
#endif
#define RUN() (ph >= lo && ph < hi)
#ifdef PROBE_SYNC
#define SEAM() do { ++ph; if (ph > lo && ph < hi) { if (ph == 1) { grid.sync(); grid.sync(); } else { xcd_barrier(xbar); xcd_barrier(xbar); } } } while (0)
#else
#define SEAM() do { ++ph; if (ph > lo && ph < hi) { if (lo < 0) grid.sync(); xcd_barrier(xbar); } --ph; TEND(); ++ph; TBEG(); } while (0)
#endif
#ifdef PROBE_SMALL
#define REPS 2
#else
#define REPS 1
#endif
#ifndef FH_TABLE
#define FH_TABLE 0x76545677u
#endif
#ifndef SGU_AT
#define SGU_AT 1
#endif
#ifdef PROBE_GEMM
#define REPG 2
#else
#define REPG 1
#endif
#ifdef PROBE_ATTN
#define REPA 2
#else
#define REPA 1
#endif

#ifndef NO_P0
    if (RUN()) { IDS(); MKP(); for (int rp = 0; rp < REPS; ++rp) { phase_prep(P, L, 0, 1, gw, NGW, wave, lane); phase_rowstats<1>(P.x, (bf16r*)(P.ws + WS_XB), (unsigned long long*)(P.ws + WS_RSSM), nullptr, nullptr, gw, NGW, lane); } }
#endif
    SEAM();
    for (int l = 0; l < NL; ++l) {
#ifndef NO_INPROJ
        if (RUN()) {
            { IDS(); unsigned long long* rz = RSSF; if (bx < 256 && tid < 64) { unsigned zlo = 0u; asm volatile("" : "+v"(zlo)); rz[bx * 64 + tid] = (unsigned long long)zlo; }     }
            pg8::Gemm g{XB, WinT + (size_t)l * NIN * DMOD, S_, NIN, DMOD}; pg8::StaticOrder So; So.init(S_, NIN, G, bx); So.rot = NIN / 256 - 1;
            pg8::EpiInProj E{QKVZ, QS, RSSM, ctl + CW_KMAX + l * 16, KIN(3) + l * 8, LOGF, ctl + CW_FCNT + l * 64};
            for (int rg = 0; rg < REPG; ++rg) pg8::gemm_phase<pg8::EpiInProj, pg8::StaticOrder, true, true>(L, g, So, E);
            if (bx >= G - NHD) {
                IDS(); unsigned* const fc = ctl + CW_FCNT + l * 64;
                if (tid == 0) { unsigned sp = 0; while (__hip_atomic_load(fc, __ATOMIC_RELAXED, __HIP_MEMORY_SCOPE_AGENT) < 64u * REPG) { __builtin_amdgcn_s_sleep(8); if (++sp > (1u << 20)) break; }
                    __builtin_amdgcn_fence(__ATOMIC_ACQUIRE, "agent"); }
                __syncthreads();
                cumsum_head(LOGF, C2A, bx - (G - NHD), L, tid);
            }
        }
#endif
        SEAM();
#ifndef NO_ATTN
        if (RUN()) {
            IDS(); LAS unsigned* bc = (LAS unsigned*)(L + 147456 - 64);
            unsigned* const ctlp = ctl; unsigned char* const wsp = WSB();
            const int fh = (int)((FH_TABLE >> (4 * (bx & 7))) & 7u);
            for (int rp = 0; rp < REPA; ++rp)
            for (int qi = 0; qi <= NHD; ++qi) { const int h = (qi == 0) ? fh : (NHD - qi); if (qi > 0 && h == fh) continue;
                if (qi == SGU_AT && rp == 0) {
            for (;;) {
                if (tid == 0) bc[0] = atomicAdd(ctlp + CW_SGUQ + (l) * 64, 1u);
                __syncthreads(); const unsigned u = bc[0]; __syncthreads();
                if (u >= (unsigned)(S_ / 128)) break;
                bf16r* const qkvz = (bf16r*)(wsp + WS_QKVZ);
                sgu_item((int)u, qkvz + 3 * QS, qkvz + 4 * QS, (bf16r*)(wsp + WS_MG), KIN(4) + l * 512, KIN(5) + l * 512, KIN(6) + (size_t)l * 8 * 128 * 128, KIN(7) + l * 8 * 128, L, wave, lane);
            }
                }
                const float kn = sqrtf((__uint_as_float(ctlp[CW_KMAX + l * 16 + 2 * h]) + __uint_as_float(ctlp[CW_KMAX + l * 16 + 2 * h + 1])) * 1.02f);
                for (;;) {
                    if (tid == 0) bc[0] = atomicAdd(ctlp + ((rp * NL + l) * NHD + h) * 64, 1u);
                    __syncthreads(); const unsigned u = bc[0]; __syncthreads();
                    if (u >= 160u) break;
                    int qb, jc;
                    if (u < 64u) { qb = 63 - (int)(u >> 2); jc = (int)(u & 3u); } else if (u < 112u) { const int v = (int)u - 64; qb = 47 - v / 3; jc = v % 3; }
                    else if (u < 144u) { const int v = (int)u - 112; qb = 31 - (v >> 1); jc = v & 1; } else { qb = 15 - ((int)u - 144); jc = 0; }
                    bf16r* const qkvz = (bf16r*)(wsp + WS_QKVZ);
                    attn_body::fox_unit2<8>(h, qb, jc, kn, (const attn_body::bf16*)qkvz, (const attn_body::bf16*)(qkvz + QS), (const attn_body::bf16*)(qkvz + 2 * QS),
                                            (attn_body::bf16*)(jc == 0 ? (bf16r*)(wsp + WS_O) : (bf16r*)(wsp + WS_OP) + (size_t)(jc - 1) * QS), (float*)(wsp + WS_ML) + (size_t)jc * S_ * 16, (float*)(wsp + WS_C2) + (size_t)h * S_, (char*)lds, (float*)(lds + 147456 - 48));
                } }
        }
#endif
        SEAM();
#ifndef NO_MERGE
        if (RUN()) { IDS(); for (int rp = 0; rp < REPS; ++rp) for (int it = vcu; it < S_ / 64; it += G) combine_item(it, OB, OP1, MLB, MG, wave, lane); }
#endif
        SEAM();
#ifndef NO_OUTPROJ
        if (RUN()) {
            { IDS(); unsigned long long* rz = RSSM; if (bx < 256 && tid < 64) { unsigned zlo = 0u; asm volatile("" : "+v"(zlo)); rz[bx * 64 + tid] = (unsigned long long)zlo; }     }
            pg8::Gemm g{MG, WoutT + (size_t)l * DMOD * DMOD, S_, DMOD, DMOD}; pg8::StaticOrder So; So.init(S_, DMOD, G, bx);
            pg8::EpiResid E{XB, RSSF};
            pg8::gemm_phase<pg8::EpiResid, pg8::StaticOrder, true, true>(L, g, So, E);
        }
#endif
        SEAM();
#ifndef NO_GU
        if (RUN()) {
            pg8::Gemm g{XB, WguT + (size_t)l * NGU * DMOD, S_, NGU, DMOD}; pg8::StaticOrder So; So.init(S_, NGU, G, bx);
            pg8::EpiSwiGLU E{HB, RSSF};
            for (int rg = 0; rg < REPG; ++rg) pg8::gemm_phase<pg8::EpiSwiGLU, pg8::StaticOrder, true, true>(L, g, So, E);
            if (l + 1 < NL) { IDS(); MKP(); if (G == 256) { if (bx >= 128) phase_prep(P, L, l + 1, l + 2, (bx - 128) * 8 + wave, 1024, wave, lane); } else phase_prep(P, L, l + 1, l + 2, gw, NGW, wave, lane); }
        }
#endif
        SEAM();
#ifndef NO_DOWN
        if (RUN()) {
            pg8::Gemm g{HB, WdT + (size_t)l * DMOD * DFF, S_, DMOD, DFF}; pg8::StaticOrder So; So.init(S_, DMOD, G, bx);
            pg8::EpiResid E{XB, RSSM};
            pg8::gemm_phase<pg8::EpiResid, pg8::StaticOrder, true, true>(L, g, So, E);
        }
#endif
        SEAM();
    }
#ifndef NO_RSN
#ifdef PROBE_T
    { if (blockIdx.x == 0 && threadIdx.x == 0) { ((unsigned*)(WSB() + WS_CTL))[CW_TS] = (unsigned)tacc_; __threadfence(); } xcd_barrier(xbar); }
    const float tdelta = (PROBE_T == 99) ? 0.1f : (float)__hip_atomic_load((unsigned*)(WSB() + WS_CTL) + CW_TS, __ATOMIC_RELAXED, __HIP_MEMORY_SCOPE_AGENT) * 2.0e-7f;
#else
    const float tdelta = 0.f;
#endif
    if (RUN()) { IDS(); final_norm(XB, RSSM, KIN(13), P_OUT, gw, NGW, lane); }
#endif
    SEAM();
#undef RUN
#undef SEAM
}

extern "C" void kernel_launch(void* const* d_in, const int* in_sizes, int n_in, void* d_out, int out_size, void* d_ws, size_t ws_size, hipStream_t stream) {
    static int grid = 0;
    if (grid == 0) {
        if (n_in != 14 || out_size != S_ * DMOD || ws_size < WS_END) { fprintf(stderr, "kernel_launch: unexpected shapes (n_in %d out %d ws %zu)\n", n_in, out_size, ws_size); grid = -1; return; }
        int dev = 0, cus = 0, per_cu = 0;
        hipGetDevice(&dev); hipDeviceGetAttribute(&cus, hipDeviceAttributeMultiprocessorCount, dev);
        if (hipFuncSetAttribute((const void*)fox_fwd, hipFuncAttributeMaxDynamicSharedMemorySize, LDS_BYTES) != hipSuccess) { fprintf(stderr, "kernel_launch: hipFuncSetAttribute failed\n"); grid = -1; return; }
        if (hipOccupancyMaxActiveBlocksPerMultiprocessor(&per_cu, (const void*)fox_fwd, 512, LDS_BYTES) != hipSuccess || per_cu < 1) { fprintf(stderr, "kernel_launch: occupancy query says %d\n", per_cu); per_cu = 1; }
        (void)hipGetLastError();
        grid = cus * per_cu;
        if (grid < 256) { fprintf(stderr, "kernel_launch: this kernel needs a resident grid of at least 256 workgroups, got %d\n", grid); grid = -1; return; }
        fprintf(stderr, "kernel_launch: grid %d (cus %d x %d)\n", grid, cus, per_cu);
    }
    if (grid < 0) return;
    hipMemsetAsync((char*)d_ws + WS_CTL, 0, CTL_BYTES, stream);
    Args a{};
    for (int i = 0; i < 14; ++i) a.in[i] = (const float*)d_in[i];
    a.out = (float*)d_out; a.ws = (unsigned char*)d_ws;
#if MK_MULTI
    for (int p = 0; p < NPHASE; ++p) { a.ph_lo = p; a.ph_hi = p + 1; hipLaunchKernelGGL(fox_fwd, dim3(grid), dim3(512), LDS_BYTES, stream, a); }
#else
    a.ph_lo = 0; a.ph_hi = NPHASE;
    void* kargs[] = {&a};
    hipError_t e = hipLaunchCooperativeKernel((const void*)fox_fwd, dim3(grid), dim3(512), kargs, LDS_BYTES, stream);
    if (e != hipSuccess) fprintf(stderr, "kernel_launch: cooperative launch failed: %s (grid %d)\n", hipGetErrorString(e), grid);
#endif
}
```

```cpp
#define MK_MULTI 0
#include <hip/hip_runtime.h>
#include <hip/hip_cooperative_groups.h>
#include <cstdio>
#include <cstdint>
namespace pg8 {
#define PG8_LAS __attribute__((address_space(3)))
typedef unsigned short bf16_t;
typedef short bf16x8 __attribute__((ext_vector_type(8)));
typedef float f32x4 __attribute__((ext_vector_type(4)));
typedef unsigned u32x4 __attribute__((ext_vector_type(4)));
constexpr int BM = 256, BK = 64, HALF = 128, HTB = HALF * BK * 2  , STAGE_BYTES = 8 * HTB, NXCD = 8, WGM = 8;

__host__ __device__ __forceinline__ int lds_byte(int r, int c) { const int st = (r >> 4) * 2 + (c >> 5), rr = r & 15, cc = c & 31, ob = rr * 64 + cc * 2; return st * 1024 + (ob ^ (((ob >> 9) & 1) << 5)); }
__host__ __device__ __forceinline__ void stage_rc(int b, int& R, int& C) { const int st = b / 1024, sb = b % 1024, swz = sb ^ (((sb >> 9) & 1) << 5); R = (st >> 1) * 16 + swz / 64; C = (st & 1) * 32 + (swz % 64) / 2; }
__host__ __device__ __forceinline__ int perm32(int rho) { const int n = rho >> 4, i = rho & 15; return 8 * (i >> 2) + 4 * n + (i & 3); }

struct Unit { int pm, pn; };
struct Gemm { const bf16_t* A; const bf16_t* Bt; int M, N, K; };

struct StaticOrder {
    int nM, nN, nwg, G, c, rot;
    __host__ __device__ void init(int M, int N, int G_, int c_) { nM = M / BM; nN = N / BM; nwg = nM * nN; G = G_; c = c_; rot = 0; }
    __host__ __device__ __forceinline__ bool next(int i, Unit& u) const {
        const long L = (long)i * G + c; if (L >= nwg) return false;
        int wgid = (int)L; { const int q = nwg / NXCD, r = nwg % NXCD, xcd = wgid % NXCD, off = wgid / NXCD; wgid = (xcd < r ? xcd * (q + 1) : r * (q + 1) + (xcd - r) * q) + off; }
        const int nig = WGM * nN, gid = wgid / nig, fm = gid * WGM, gsz = (nM - fm) < WGM ? (nM - fm) : WGM;
        u.pm = fm + ((wgid % nig) % gsz); u.pn = (wgid % nig) / gsz + rot; if (u.pn >= nN) u.pn -= nN; return true;
    }
    __device__ __forceinline__ void a_ready(const Unit&) const {}
    __device__ __forceinline__ void done(const Unit&) const {}
};

__device__ __forceinline__ unsigned cvt_pk_bf16(float lo, float hi) { unsigned r; asm volatile("v_cvt_pk_bf16_f32 %0, %1, %2" : "=v"(r) : "v"(lo), "v"(hi)); return r; }
typedef float f32x2 __attribute__((ext_vector_type(2)));
__device__ __forceinline__ f32x2 gelu_pk(f32x2 v) {
    const f32x2 av = __builtin_elementwise_abs(v), d = av * 0.2316418882f + 1.0f;
    f32x2 t; t.x = __builtin_amdgcn_rcpf(d.x); t.y = __builtin_amdgcn_rcpf(d.y);
    f32x2 q = t * 0.5307027145f + (-0.7265760135f); q = q * t + 0.7107068705f; q = q * t + (-0.142248368f); q = q * t + 0.127414796f; q = q * t;
    const f32x2 s = (v * v) * (-0.72134752044f);
    f32x2 e; e.x = __builtin_amdgcn_exp2f(s.x); e.y = __builtin_amdgcn_exp2f(s.y);
    const f32x2 m = v * (q * e), r = v - m;
    f32x2 o; o.x = v.x < 0.f ? m.x : r.x; o.y = v.y < 0.f ? m.y : r.y; return o;
}
constexpr float C2Q = 0.125f * 1.4426950408889634f;
constexpr float RSS_INV = 1.0f / (1024.0f * 16777216.0f);
struct EpiInProj {
    static constexpr bool PERM = true, AFTER_DRAIN = false;
    bf16_t* O; size_t split_stride; const unsigned long long* rss; unsigned* kmax; const float* bfv; float* logf; unsigned* fcnt;
    __device__ __forceinline__ void operator()(const f32x4 (&acc)[2][2][4][2], const Unit& u, int wr, int wc, int fr, int fq) const {
        if (u.pn == 10) {
            if (wc == 0 && fq == 0) {
#pragma unroll
                for (int ai = 0; ai < 2; ++ai)
#pragma unroll
                    for (int m = 0; m < 4; ++m) { const int row = u.pm * BM + wr * 64 + fr + ai * HALF + m * 16; const float rs = __builtin_amdgcn_rsqf((float)rss[row] * RSS_INV + 1e-6f);
#pragma unroll
                        for (int n = 0; n < 2; ++n)
#pragma unroll
                            for (int e = 0; e < 4; ++e) { const float z = (acc[ai][0][m][n][e] + acc[ai][1][m][n][e]) * rs + bfv[4 * n + e];
                                const float lf = fminf(z, 0.f) - 0.6931471805599453f * __builtin_amdgcn_logf(1.0f + __builtin_amdgcn_exp2f(-1.4426950408889634f * fabsf(z)));
                                __hip_atomic_store((unsigned*)(logf + (size_t)(4 * n + e) * 16384 + row), __float_as_uint(lf), __ATOMIC_RELAXED, __HIP_MEMORY_SCOPE_AGENT); } } }
            asm volatile("s_waitcnt vmcnt(0)" ::: "memory"); __builtin_amdgcn_s_barrier();
            if (wr == 0 && wc == 0 && fr == 0 && fq == 0) __hip_atomic_fetch_add(fcnt, 1u, __ATOMIC_RELAXED, __HIP_MEMORY_SCOPE_AGENT);
            return; }
        const int t = u.pn >> 1; float kmx[2] = {0.f, 0.f}; bf16_t* base = O + (size_t)t * split_stride;
        const int row0 = u.pm * BM + wr * 64 + fr, col0 = (u.pn & 1) * 256 + wc * 32 + 8 * fq;
        const float s0 = (t == 0) ? C2Q : 1.0f;
#pragma unroll
        for (int ai = 0; ai < 2; ++ai)
#pragma unroll
            for (int m = 0; m < 4; ++m) { const int row = row0 + ai * HALF + m * 16; const float rs = __builtin_amdgcn_rsqf((float)rss[row] * RSS_INV + 1e-6f) * s0; bf16_t* rowp = base + (size_t)row * 512 + col0;
#pragma unroll
                for (int bj = 0; bj < 2; ++bj) { f32x4 v0 = acc[ai][bj][m][0] * rs, v1 = acc[ai][bj][m][1] * rs;
                    if (t == 1) { const f32x4 q0 = v0 * v0, q1 = v1 * v1; float sq = ((q0[0] + q0[1]) + (q0[2] + q0[3])) + ((q1[0] + q1[1]) + (q1[2] + q1[3])); sq += __shfl_xor(sq, 16); sq += __shfl_xor(sq, 32); kmx[bj] = fmaxf(kmx[bj], sq); }
                    if (t >= 3) { f32x2 a = gelu_pk((f32x2){v0[0], v0[1]}), b = gelu_pk((f32x2){v0[2], v0[3]}), c = gelu_pk((f32x2){v1[0], v1[1]}), d = gelu_pk((f32x2){v1[2], v1[3]});
                        v0 = (f32x4){a.x, a.y, b.x, b.y}; v1 = (f32x4){c.x, c.y, d.x, d.y}; }
                    u32x4 w; w.x = cvt_pk_bf16(v0[0], v0[1]); w.y = cvt_pk_bf16(v0[2], v0[3]); w.z = cvt_pk_bf16(v1[0], v1[1]); w.w = cvt_pk_bf16(v1[2], v1[3]);
                    *(u32x4*)(rowp + bj * HALF) = w; } }
        if (t == 1) {
#pragma unroll
            for (int bj = 0; bj < 2; ++bj) { float v = kmx[bj]; v = fmaxf(v, __shfl_xor(v, 1)); v = fmaxf(v, __shfl_xor(v, 2)); v = fmaxf(v, __shfl_xor(v, 4)); v = fmaxf(v, __shfl_xor(v, 8));
                if (fr == 0 && fq == 0) atomicMax(kmax + ((u.pn & 1) * 4 + bj * 2 + (wc >> 1)) * 2 + (wc & 1), __float_as_uint(v)); } }
    }
};
struct EpiResid {
    static constexpr bool PERM = true, AFTER_DRAIN = false;
    bf16_t* xb; unsigned long long* rss;
    __device__ __forceinline__ void operator()(const f32x4 (&acc)[2][2][4][2], const Unit& u, int wr, int wc, int fr, int fq) const {
        const int col0 = u.pn * BM + wc * 32 + 8 * fq;
#pragma unroll
        for (int ai = 0; ai < 2; ++ai)
#pragma unroll
            for (int m = 0; m < 4; ++m) { const int row = u.pm * BM + ai * HALF + wr * 64 + m * 16 + fr; const size_t off = (size_t)row * 1024 + col0; float sq = 0.f;
#pragma unroll
                for (int bj = 0; bj < 2; ++bj) { const u32x4 bw = *(const u32x4*)(xb + off + bj * HALF);
                    const f32x4 b0 = (f32x4){__builtin_bit_cast(float, bw.x << 16), __builtin_bit_cast(float, bw.x & 0xffff0000u), __builtin_bit_cast(float, bw.y << 16), __builtin_bit_cast(float, bw.y & 0xffff0000u)};
                    const f32x4 b1 = (f32x4){__builtin_bit_cast(float, bw.z << 16), __builtin_bit_cast(float, bw.z & 0xffff0000u), __builtin_bit_cast(float, bw.w << 16), __builtin_bit_cast(float, bw.w & 0xffff0000u)};
                    const f32x4 o0 = b0 + acc[ai][bj][m][0], o1 = b1 + acc[ai][bj][m][1];
                    u32x4 w; w.x = cvt_pk_bf16(o0[0], o0[1]); w.y = cvt_pk_bf16(o0[2], o0[3]); w.z = cvt_pk_bf16(o1[0], o1[1]); w.w = cvt_pk_bf16(o1[2], o1[3]);
                    *(u32x4*)(xb + off + bj * HALF) = w;
                    sq += ((o0[0] * o0[0] + o0[1] * o0[1]) + (o0[2] * o0[2] + o0[3] * o0[3])) + ((o1[0] * o1[0] + o1[1] * o1[1]) + (o1[2] * o1[2] + o1[3] * o1[3])); }
                sq += __shfl_xor(sq, 16); sq += __shfl_xor(sq, 32);
                if (fq == 0) atomicAdd(rss + row, (unsigned long long)__float2ull_rn(sq * 16777216.0f)); }
    }
};
struct EpiSwiGLU {
    static constexpr bool PERM = true, AFTER_DRAIN = false;
    bf16_t* H; const unsigned long long* rss;
    __device__ __forceinline__ void operator()(const f32x4 (&acc)[2][2][4][2], const Unit& u, int wr, int wc, int fr, int fq) const {
        const int row0 = u.pm * BM + wr * 64 + fr, col0 = u.pn * 128 + wc * 32 + 8 * fq;
#pragma unroll
        for (int ai = 0; ai < 2; ++ai)
#pragma unroll
            for (int m = 0; m < 4; ++m) { const int row = row0 + ai * HALF + m * 16; const float rs = __builtin_amdgcn_rsqf((float)rss[row] * RSS_INV + 1e-6f);
                float hv[8];
#pragma unroll
                for (int n = 0; n < 2; ++n)
#pragma unroll
                    for (int e = 0; e < 4; ++e) { const float g = acc[ai][0][m][n][e] * rs, up = acc[ai][1][m][n][e] * rs;
                        const float sg = __builtin_amdgcn_rcpf(1.0f + __builtin_amdgcn_exp2f(-1.4426950408889634f * g)); hv[n * 4 + e] = g * sg * up; }
                u32x4 w; w.x = cvt_pk_bf16(hv[0], hv[1]); w.y = cvt_pk_bf16(hv[2], hv[3]); w.z = cvt_pk_bf16(hv[4], hv[5]); w.w = cvt_pk_bf16(hv[6], hv[7]);
                *(u32x4*)(H + (size_t)row * 2816 + col0) = w; }
    }
};
template <class Epi, class Sched, bool ALIGN_EPI = false, bool SP2 = false>
__device__ __forceinline__ void gemm_phase(PG8_LAS unsigned char* lds, const Gemm g, const Sched& S, const Epi& E) {
    int tid = threadIdx.x; asm volatile("" : "+v"(tid));
    const int wid = __builtin_amdgcn_readfirstlane(tid >> 6), lane = tid & 63, wr = wid >> 2, wc = wid & 3, fr = lane & 15, fq = lane >> 4;
    const int K = g.K, nt = K / BK;
    unsigned voffA[2], voffB[2];
#pragma unroll
    for (int i = 0; i < 2; ++i) { int R, C; stage_rc(tid * 16 + i * 8192, R, C); const int Rb = Epi::PERM ? ((R & ~31) + perm32(R & 31)) : R;
        voffA[i] = (unsigned)(R * K + C) * 2u; voffB[i] = (unsigned)(Rb * K + C) * 2u; }
    const size_t kstep = (size_t)(BK * 2);
    const size_t hstep = (size_t)HALF * K * 2;
    const size_t tstep = 2 * hstep;
    const unsigned ldsw = (unsigned)wid * 1024u;
    const int aoff = lds_byte(wr * 64 + fr, fq * 8), boff = lds_byte(wc * 32 + fr, fq * 8);
#define PG8_SA(b, h) (((b) * 2 + (h)) * HTB)
#define PG8_SB(b, h) ((4 + (b) * 2 + (h)) * HTB)
#define PG8_STAGE(bufoff, gbase, voff) do { _Pragma("unroll") for (int _i = 0; _i < 2; ++_i) \
        __builtin_amdgcn_global_load_lds((const unsigned*)((const char*)(gbase) + (voff)[_i]), (PG8_LAS unsigned*)(lds + (bufoff) + ldsw + _i * 8192), 16, 0, 0); } while (0)
#define PG8_LDA(dst, b, h) do { _Pragma("unroll") for (int m = 0; m < 4; ++m) _Pragma("unroll") for (int k = 0; k < 2; ++k) dst[m][k] = *(const PG8_LAS bf16x8*)(lds + PG8_SA(b, h) + aoff + m * 2048 + k * 1024); } while (0)
#define PG8_LDB(dst, b, h) do { _Pragma("unroll") for (int n = 0; n < 2; ++n) _Pragma("unroll") for (int k = 0; k < 2; ++k) dst[n][k] = *(const PG8_LAS bf16x8*)(lds + PG8_SB(b, h) + boff + n * 2048 + k * 1024); } while (0)
#define PG8_MMA(ai, bj, At, Bt) do { __builtin_amdgcn_s_setprio(1); _Pragma("unroll") for (int m = 0; m < 4; ++m) _Pragma("unroll") for (int n = 0; n < 2; ++n) _Pragma("unroll") for (int k = 0; k < 2; ++k) \
        acc[ai][bj][m][n] = __builtin_amdgcn_mfma_f32_16x16x32_bf16(Bt[n][k], At[m][k], acc[ai][bj][m][n], 0, 0, 0); __builtin_amdgcn_s_setprio(0); } while (0)
#define PG8_WAIT_V(n) asm volatile("s_waitcnt vmcnt(" #n ")" ::: "memory")
#define PG8_WAIT_L(n) asm volatile("s_waitcnt lgkmcnt(" #n ")" ::: "memory")
#define PG8_BAR __builtin_amdgcn_s_barrier()
#define PG8_SCHED __builtin_amdgcn_sched_barrier(0)
    Unit cur, nxt; int ui = 0;
    if (!S.next(0, cur)) return;
    f32x4 acc[2][2][4][2];
#pragma unroll
    for (int a = 0; a < 2; ++a)
#pragma unroll
        for (int b = 0; b < 2; ++b)
#pragma unroll
            for (int m = 0; m < 4; ++m)
#pragma unroll
                for (int n = 0; n < 2; ++n) acc[a][b][m][n] = (f32x4){0.f, 0.f, 0.f, 0.f};
    bf16x8 At[4][2], B0[2][2], B1[2][2];
    const char* cA = (const char*)g.A + (size_t)cur.pm * tstep; const char* cB = (const char*)g.Bt + (size_t)cur.pn * tstep;
    S.a_ready(cur);
    if constexpr (SP2) {
        PG8_STAGE(PG8_SB(0, 0), cB, voffB); PG8_STAGE(PG8_SB(0, 1), cB + hstep, voffB); PG8_STAGE(PG8_SA(0, 0), cA, voffA); PG8_STAGE(PG8_SA(0, 1), cA + hstep, voffA);
        if (wr == 1) PG8_BAR;
        PG8_WAIT_V(2); PG8_BAR;
        PG8_STAGE(PG8_SB(1, 0), cB + kstep, voffB); PG8_STAGE(PG8_SA(1, 0), cA + kstep, voffA); PG8_STAGE(PG8_SB(1, 1), cB + hstep + kstep, voffB);
        PG8_WAIT_V(6); PG8_BAR;
    } else {
        PG8_STAGE(PG8_SB(0, 0), cB, voffB); PG8_STAGE(PG8_SA(0, 0), cA, voffA); PG8_STAGE(PG8_SB(0, 1), cB + hstep, voffB); PG8_STAGE(PG8_SA(0, 1), cA + hstep, voffA);
        if (wr == 1) PG8_BAR;
        PG8_WAIT_V(4); PG8_BAR;
        PG8_STAGE(PG8_SB(1, 0), cB + kstep, voffB); PG8_STAGE(PG8_SA(1, 0), cA + kstep, voffA); PG8_STAGE(PG8_SB(1, 1), cB + hstep + kstep, voffB);
        PG8_WAIT_V(6); PG8_BAR;
    }
    for (;;) {
        const bool has_next = S.next(ui + 1, nxt);
        const char* nA = has_next ? (const char*)g.A + (size_t)nxt.pm * tstep : cA; const char* nB = has_next ? (const char*)g.Bt + (size_t)nxt.pn * tstep : cB;
        for (int t = 0; t < nt; t += 2) {
            const bool last = (t == nt - 2);
            const char* a1 = cA + (size_t)(t + 1) * kstep;
            const char* a2 = last ? nA : cA + (size_t)(t + 2) * kstep; const char* b2 = last ? nB : cB + (size_t)(t + 2) * kstep;
            const char* a3 = a2 + kstep; const char* b3 = b2 + kstep;
            if (last && has_next) S.a_ready(nxt);
            if constexpr (SP2) {
            PG8_LDB(B0, 0, 0); PG8_LDB(B1, 0, 1); PG8_SCHED; PG8_LDA(At, 0, 0); PG8_STAGE(PG8_SA(1, 1), a1 + hstep, voffA);
            PG8_WAIT_V(8); PG8_WAIT_L(0); PG8_BAR; PG8_MMA(0, 0, At, B0); PG8_MMA(0, 1, At, B1); PG8_BAR; PG8_SCHED;
            PG8_LDA(At, 0, 1); PG8_STAGE(PG8_SB(0, 0), b2, voffB); PG8_STAGE(PG8_SB(0, 1), b2 + hstep, voffB); PG8_STAGE(PG8_SA(0, 0), a2, voffA);
            PG8_WAIT_V(8); PG8_WAIT_L(0); PG8_BAR; PG8_MMA(1, 0, At, B0); PG8_MMA(1, 1, At, B1); PG8_BAR; PG8_SCHED;
            PG8_LDB(B0, 1, 0); PG8_LDB(B1, 1, 1); PG8_SCHED; PG8_LDA(At, 1, 0); PG8_STAGE(PG8_SA(0, 1), a2 + hstep, voffA);
            PG8_WAIT_V(8); PG8_WAIT_L(0); PG8_BAR; PG8_MMA(0, 0, At, B0); PG8_MMA(0, 1, At, B1); PG8_BAR; PG8_SCHED;
            PG8_LDA(At, 1, 1); PG8_STAGE(PG8_SB(1, 0), b3, voffB); PG8_STAGE(PG8_SB(1, 1), b3 + hstep, voffB); PG8_STAGE(PG8_SA(1, 0), a3, voffA);
            PG8_WAIT_V(8); PG8_WAIT_L(0); PG8_BAR; PG8_MMA(1, 0, At, B0); PG8_MMA(1, 1, At, B1); PG8_BAR; PG8_SCHED;
            } else {
            PG8_LDB(B0, 0, 0); PG8_SCHED; PG8_LDA(At, 0, 0); PG8_STAGE(PG8_SA(1, 1), a1 + hstep, voffA);
            PG8_WAIT_L(8); PG8_BAR; PG8_WAIT_L(0); PG8_MMA(0, 0, At, B0); PG8_BAR; PG8_SCHED;
            PG8_LDB(B1, 0, 1); PG8_STAGE(PG8_SB(0, 0), b2, voffB);
            PG8_BAR; PG8_WAIT_L(0); PG8_MMA(0, 1, At, B1); PG8_BAR;
            PG8_LDA(At, 0, 1); PG8_STAGE(PG8_SA(0, 0), a2, voffA);
            PG8_BAR; PG8_WAIT_L(0); PG8_MMA(1, 0, At, B0); PG8_BAR; PG8_SCHED;
            PG8_STAGE(PG8_SB(0, 1), b2 + hstep, voffB);
            PG8_WAIT_V(6); PG8_BAR; PG8_MMA(1, 1, At, B1); PG8_BAR;
            PG8_LDB(B0, 1, 0); PG8_SCHED; PG8_LDA(At, 1, 0); PG8_STAGE(PG8_SA(0, 1), a2 + hstep, voffA);
            PG8_WAIT_L(8); PG8_BAR; PG8_WAIT_L(0); PG8_MMA(0, 0, At, B0); PG8_BAR; PG8_SCHED;
            PG8_LDB(B1, 1, 1); PG8_STAGE(PG8_SB(1, 0), b3, voffB);
            PG8_BAR; PG8_WAIT_L(0); PG8_MMA(0, 1, At, B1); PG8_BAR;
            PG8_LDA(At, 1, 1); PG8_STAGE(PG8_SA(1, 0), a3, voffA);
            PG8_BAR; PG8_WAIT_L(0); PG8_MMA(1, 0, At, B0); PG8_BAR; PG8_SCHED;
            PG8_STAGE(PG8_SB(1, 1), b3 + hstep, voffB);
            PG8_WAIT_V(6); PG8_BAR; PG8_MMA(1, 1, At, B1); PG8_BAR;
            }
        }
        if constexpr (ALIGN_EPI) { if (wr == 0) PG8_BAR; }
        if constexpr (!Epi::AFTER_DRAIN) { E(acc, cur, wr, wc, fr, fq); S.done(cur); }
        if (!has_next) break;
#pragma unroll
        for (int a = 0; a < 2; ++a)
#pragma unroll
            for (int b = 0; b < 2; ++b)
#pragma unroll
                for (int m = 0; m < 4; ++m)
#pragma unroll
                    for (int n = 0; n < 2; ++n) acc[a][b][m][n] = (f32x4){0.f, 0.f, 0.f, 0.f};
        cur = nxt; cA = nA; cB = nB; ++ui;
        if constexpr (ALIGN_EPI) { if (wr == 1) PG8_BAR; }
    }
    PG8_WAIT_V(0);
    if constexpr (!ALIGN_EPI) { if (wr == 0) PG8_BAR; }
    PG8_BAR;
    if constexpr (Epi::AFTER_DRAIN) { E.fused(acc, cur, wr, wc, fr, fq, lds, wid, lane); S.done(cur); }
#undef PG8_SA
#undef PG8_SB
#undef PG8_STAGE
#undef PG8_LDA
#undef PG8_LDB
#undef PG8_MMA
#undef PG8_WAIT_V
#undef PG8_WAIT_L
#undef PG8_BAR
#undef PG8_SCHED
}
}
#include <hip/hip_bf16.h>
#include <cmath>
namespace attn_body {
using bf16=__hip_bfloat16;
using bf16x8=__attribute__((ext_vector_type(8)))short;
using s16x4=__attribute__((ext_vector_type(4)))short;
using f32x16=__attribute__((ext_vector_type(16)))float;
using u32x4=__attribute__((ext_vector_type(4)))unsigned;
constexpr int BATCH=1,NHEAD=8,SEQ=16384,D=64,DM=NHEAD*D;
constexpr int NW=8,QBLK=32,QB=QBLK*NW,KVBLK=64,NQB=SEQ/QB;
constexpr int ATTN_PITCH=DM, ATTN_UNIT_ROWS=QB;
__device__ __forceinline__ int crow(int r,int hi){return (r&3)+8*(r>>2)+4*hi;}
#define SBAR() __builtin_amdgcn_sched_barrier(0)
__device__ __forceinline__ void cmask(f32x16&p0,f32x16&p1,int jb,int qrel,int hi){
  const float NEG=-INFINITY; int kb=64*jb+4*hi;
  #pragma unroll
  for(int r=0;r<16;++r){int kv=kb+(r&3)+8*(r>>2); if(kv>qrel)p0[r]=NEG; if(kv+32>qrel)p1[r]=NEG;}
}

constexpr int NSLOT=3, SLOTB=8192;
constexpr int LDS_K=0, LDS_V=NSLOT*SLOTB, LDS_WS=2*NSLOT*SLOTB, LDS_OST=LDS_WS+NW*64*4, LDS_BYTES=LDS_OST+NW*4096;
constexpr float C2=0.125f*1.4426950408889634f;
__device__ __forceinline__ void glds16(const void*gsrc,unsigned lds_dst){unsigned keep;
  asm volatile("s_mov_b32 %0, m0\n\ts_mov_b32 m0, %2\n\ts_nop 0\n\tglobal_load_lds_dwordx4 %1, off\n\ts_mov_b32 m0, %0":"=&s"(keep):"v"(gsrc),"s"(lds_dst):"memory");}
__device__ __forceinline__ float max3f(float a,float b,float c){float r;asm("v_max3_f32 %0, %1, %2, %3":"=v"(r):"v"(a),"v"(b),"v"(c));return r;}
__device__ __forceinline__ float max2f(float a,float b){float r;asm("v_max_f32_e32 %0, %1, %2":"=v"(r):"v"(a),"v"(b));return r;}
__device__ __forceinline__ float fadd_s(float a,float b){float r;asm("v_add_f32_e32 %0, %1, %2":"=v"(r):"v"(a),"v"(b));return r;}
__device__ __forceinline__ float fsub_s(float a,float b){float r;asm("v_sub_f32_e32 %0, %1, %2":"=v"(r):"v"(a),"v"(b));return r;}
typedef float f32x2_t __attribute__((ext_vector_type(2))); typedef __bf16 bf16x2_t __attribute__((ext_vector_type(2)));
__device__ __forceinline__ unsigned cvtpk_s(float lo,float hi){f32x2_t v={lo,hi};bf16x2_t b=__builtin_convertvector(v,bf16x2_t);return __builtin_bit_cast(unsigned,b);}
#define WAIT_BAR(N) asm volatile("s_waitcnt vmcnt(" #N ") lgkmcnt(0)\n\ts_barrier":::"memory")

__device__ __forceinline__ void qkt(f32x16&p0,f32x16&p1,const char*Kslot,const bf16x8*qr,const f32x16&negm,int r32,int hi){
  const char*kb=Kslot+hi*1024+r32*16;
  #pragma unroll
  for(int d0=0;d0<4;++d0){
    const bf16x8 b0=*reinterpret_cast<const bf16x8*>(kb+d0*2048);
    const bf16x8 b1=*reinterpret_cast<const bf16x8*>(kb+d0*2048+512);
    if(d0==0){p0=__builtin_amdgcn_mfma_f32_32x32x16_bf16(b0,qr[0],negm,0,0,0);p1=__builtin_amdgcn_mfma_f32_32x32x16_bf16(b1,qr[0],negm,0,0,0);}
    else{p0=__builtin_amdgcn_mfma_f32_32x32x16_bf16(b0,qr[d0],p0,0,0,0);p1=__builtin_amdgcn_mfma_f32_32x32x16_bf16(b1,qr[d0],p1,0,0,0);}}
}
typedef __attribute__((address_space(3))) const char* lds_cptr;
typedef short v4i16_t __attribute__((ext_vector_type(4)));
__device__ __forceinline__ void kload8(bf16x8*kf,lds_cptr kp){
  kf[0]=*(const __attribute__((address_space(3))) bf16x8*)(kp);      kf[1]=*(const __attribute__((address_space(3))) bf16x8*)(kp+512);
  kf[2]=*(const __attribute__((address_space(3))) bf16x8*)(kp+2048); kf[3]=*(const __attribute__((address_space(3))) bf16x8*)(kp+2560);
  kf[4]=*(const __attribute__((address_space(3))) bf16x8*)(kp+4096); kf[5]=*(const __attribute__((address_space(3))) bf16x8*)(kp+4608);
  kf[6]=*(const __attribute__((address_space(3))) bf16x8*)(kp+6144); kf[7]=*(const __attribute__((address_space(3))) bf16x8*)(kp+6656);
}
__device__ __forceinline__ void kload2(bf16x8*kf,lds_cptr kp,int j){ kf[2*j]=*(const __attribute__((address_space(3))) bf16x8*)(kp+j*2048); kf[2*j+1]=*(const __attribute__((address_space(3))) bf16x8*)(kp+j*2048+512); }
__device__ __forceinline__ s16x4 vtr(lds_cptr p){ return __builtin_bit_cast(s16x4,__builtin_amdgcn_ds_read_tr16_b64_v4i16((__attribute__((address_space(3))) v4i16_t*)p)); }
__device__ __forceinline__ float rowmax(const f32x16&p0,const f32x16&p1){
  float a=max3f(p0[0],p0[1],p1[0]),b=max3f(p0[2],p0[3],p1[1]);a=max3f(a,p1[2],p1[3]);
  #pragma unroll
  for(int r=4;r<16;r+=4){a=max3f(a,p0[r],p0[r+1]);b=max3f(b,p0[r+2],p0[r+3]);a=max3f(a,p1[r],p1[r+1]);b=max3f(b,p1[r+2],p1[r+3]);}
  const float m=max2f(a,b);
  auto rr=__builtin_amdgcn_permlane32_swap(__float_as_uint(m),__float_as_uint(m),false,false);
  return max2f(__uint_as_float(rr[0]),__uint_as_float(rr[1]));
}
__device__ __forceinline__ void pv(f32x16*o,int vb,bf16x8 pa0,bf16x8 pa1,bf16x8 pa2,bf16x8 pa3){
  #pragma unroll
  for(int d0=0;d0<2;++d0){s16x4 lo[4],hi[4];
    #pragma unroll
    for(int ks=0;ks<4;++ks){
      asm volatile("ds_read_b64_tr_b16 %0,%1 offset:%c2":"=&v"(lo[ks]):"v"(vb),"i"(d0*4096+ks*1024):"memory");
      asm volatile("ds_read_b64_tr_b16 %0,%1 offset:%c2":"=&v"(hi[ks]):"v"(vb),"i"(d0*4096+ks*1024+512):"memory");}
    asm volatile("s_waitcnt lgkmcnt(0)":::"memory");SBAR();
    #define PK(k) (bf16x8){lo[k][0],lo[k][1],lo[k][2],lo[k][3],hi[k][0],hi[k][1],hi[k][2],hi[k][3]}
    o[d0]=__builtin_amdgcn_mfma_f32_32x32x16_bf16(pa0,PK(0),o[d0],0,0,0);
    o[d0]=__builtin_amdgcn_mfma_f32_32x32x16_bf16(pa1,PK(1),o[d0],0,0,0);
    o[d0]=__builtin_amdgcn_mfma_f32_32x32x16_bf16(pa2,PK(2),o[d0],0,0,0);
    o[d0]=__builtin_amdgcn_mfma_f32_32x32x16_bf16(pa3,PK(3),o[d0],0,0,0);
    #undef PK
  }
}
typedef float f32x4_t __attribute__((ext_vector_type(4)));

#ifndef ATTN_STORE16
#define ATTN_STORE16(p,v) (*(u32x4*)(p)=(v))
#endif
constexpr int FCH=64;
constexpr int F2_CK=LDS_BYTES, FOX2_LDS_BYTES=F2_CK+FCH*64*4;
template<int THRL> __device__ __forceinline__ void fox_unit2(int h,int qb,int jc,float kn,const bf16*Q,const bf16*__restrict__ K,const bf16*__restrict__ V,bf16*O,float*ML,const float*__restrict__ c2h,char*shm,float*qmx){
  int tid=threadIdx.x; asm volatile("":"+v"(tid)); const int lane=tid&63,r32=lane&31,hi=lane>>5; const int wid=__builtin_amdgcn_readfirstlane(tid>>6);
  const long rowbase=0; const int q0=qb*QB;
  const bf16*Qw=Q+(rowbase+q0+wid*QBLK)*DM+h*D;
  const bf16*Kh=K+rowbase*DM+h*D,*Vh=V+rowbase*DM+h*D;
  const unsigned lds0=(unsigned)(uintptr_t)shm;
  float*wsf=(float*)(shm+LDS_WS)+wid*64;
  float*ckl=(float*)(shm+F2_CK);
  const int NTg=(q0+QB)/KVBLK;
  bf16x8 qr[4];
  #pragma unroll
  for(int d0=0;d0<4;++d0)qr[d0]=*reinterpret_cast<const bf16x8*>(&Qw[(long)r32*DM+d0*16+hi*8]);
  bf16x8 kd[4];
  { const bf16*Kd=K+(long)(q0+wid*QBLK+r32)*DM+h*D;
    #pragma unroll
    for(int d0=0;d0<4;++d0)kd[d0]=*reinterpret_cast<const bf16x8*>(&Kd[d0*16+hi*8]); }
  int ts;
  const float cq0_=c2h[q0], cte_=(tid<NTg-4)?c2h[64*tid+63]:0.f;
  { float qs=0.f,dg=0.f;
    #pragma unroll
    for(int d0=0;d0<4;++d0)
      #pragma unroll
      for(int e=0;e<8;++e){ const float v=__builtin_bit_cast(float,(unsigned)(unsigned short)qr[d0][e]<<16); qs+=v*v; dg+=v*__builtin_bit_cast(float,(unsigned)(unsigned short)kd[d0][e]<<16); }
    { auto rr=__builtin_amdgcn_permlane32_swap(__float_as_uint(qs),__float_as_uint(qs),false,false); qs=__uint_as_float(rr[0])+__uint_as_float(rr[1]); }
    { auto rr=__builtin_amdgcn_permlane32_swap(__float_as_uint(dg),__float_as_uint(dg),false,false); dg=__uint_as_float(rr[0])+__uint_as_float(rr[1]); }
    #pragma unroll
    for(int o_=1;o_<32;o_<<=1){ qs=__builtin_fmaxf(qs,__shfl_xor(qs,o_)); dg=__builtin_fminf(dg,__shfl_xor(dg,o_)); }
    if(lane==0){qmx[wid]=qs;qmx[wid-20]=dg;}
    __syncthreads();
    float q2=qmx[0];
    #pragma unroll
    for(int w_=1;w_<8;++w_)q2=__builtin_fmaxf(q2,qmx[w_]);
    float dmin=qmx[-20];
    #pragma unroll
    for(int w_=1;w_<8;++w_)dmin=__builtin_fminf(dmin,qmx[w_-20]);
    const float lim=cq0_+152.05f+sqrtf(q2)*kn-dmin;
    ts=__syncthreads_count((tid<NTg-4)&&(cte_>lim)); ts&=~3; }
  const int t1=NTg-FCH*jc; int t0=t1-FCH; t0=t0<0?0:t0; t0=t0<ts?ts:t0;
  if(t0>=t1){ if(hi==0){ float*mlp=ML+((long)(q0+wid*QBLK+r32)*NHEAD+h)*2; mlp[0]=-1.0e30f; mlp[1]=0.f; } return; }
  const int NT=t1-t0;
  const int NTm=(jc==0)?NT:(1<<20);
  const bf16*ksrc=Kh+(long)(t0*KVBLK+lane)*DM+wid*8;
  const bf16*vsrc=Vh+(long)(t0*KVBLK+16*(wid&3)+(lane>>2))*DM+(wid>>2)*32+(lane&3)*8;
  const unsigned kdst=lds0+LDS_K+wid*1024, vdst=lds0+LDS_V+wid*1024;
  #define DMA_K(t,slot) glds16(ksrc+(long)(t)*KVBLK*DM,(unsigned)__builtin_amdgcn_readfirstlane(kdst+(slot)))
  #define DMA_V(t,slot) glds16(vsrc+(long)(t)*KVBLK*DM,(unsigned)__builtin_amdgcn_readfirstlane(vdst+(slot)))
  const int vb0=(int)(lds0+LDS_V)+((lane>>4)&1)*32+(lane&3)*8+(4*hi+((lane&15)>>2))*64;
  const char*Kbase=shm+LDS_K; bf16x8 kf[8];
  const lds_cptr shm3=(lds_cptr)shm; const lds_cptr kp0=shm3+LDS_K+hi*1024+r32*16; const lds_cptr vp0=shm3+LDS_V+((lane>>4)&1)*32+(lane&3)*8+(4*hi+((lane&15)>>2))*64;
  DMA_K(0,0);DMA_V(0,0);DMA_K(1,SLOTB);
  { const float cref=cq0_; const int nck=NT*64;
    for(int i=tid*4;i<nck;i+=2048){ f32x4_t v=*(const f32x4_t*)(c2h+t0*64+i); v=v-cref; *(f32x4_t*)(ckl+i)=v; } }
  float mhat=0.f,l_reg=0.f;f32x16 o[2];o[0]=f32x16{};o[1]=f32x16{};const f32x16 zc16=f32x16{};
  const int qrel=wid*QBLK+r32;
  #define CMASK(P0,P1,t) do{int jb_=(t)-(NTm-4); if(jb_>=0)cmask(P0,P1,jb_,qrel,hi);}while(0)
  #define BIAS(P0,P1,t) do{ const float*cb_=ckl+(t)*64+4*hi; _Pragma("unroll") for(int g_=0;g_<4;++g_){ const f32x4_t a_=*(const f32x4_t*)(cb_+8*g_), b_=*(const f32x4_t*)(cb_+32+8*g_); _Pragma("unroll") for(int e_=0;e_<4;++e_){P0[4*g_+e_]-=a_[e_];P1[4*g_+e_]-=b_[e_];} SBAR(); } }while(0)
  bool resc=false;
  #define START(P0,P1) do{ const float rm=rowmax(P0,P1); resc=false; \
    { const float dl=rm; mhat=fadd_s(mhat,dl); \
      _Pragma("unroll") for(int r=0;r<16;++r){P0[r]=fsub_s(P0[r],dl);P1[r]=fsub_s(P1[r],dl);} \
      } \
    _Pragma("unroll") for(int r=0;r<16;++r)P0[r]=__builtin_amdgcn_exp2f(P0[r]); }while(0)
  #define RESC() do{ if(resc){ asm volatile("s_waitcnt lgkmcnt(0)":::"memory"); \
      _Pragma("unroll") for(int d_=0;d_<2;++d_) _Pragma("unroll") for(int r=0;r<16;++r)o[d_][r]*=wsf[crow(r,hi)]; } }while(0)
  f32x16 pA0,pA1,pB0,pB1;
  int sl_prev=0,sl_cur=0,sl_next=SLOTB;
  #define ROT() do{sl_prev=sl_cur;sl_cur=sl_next;sl_next=(sl_next==(NSLOT-1)*SLOTB)?0:sl_next+SLOTB;}while(0)
  DMA_K(2,2*SLOTB);
  WAIT_BAR(3);
  qkt(pA0,pA1,Kbase,qr,zc16,r32,hi);asm volatile("s_nop 15\n\ts_nop 7":"+v"(pA0),"+v"(pA1));BIAS(pA0,pA1,0);CMASK(pA0,pA1,0);
  START(pA0,pA1);
  _Pragma("unroll") for(int r=0;r<16;++r)pA1[r]=__builtin_amdgcn_exp2f(pA1[r]);
  #define PFG(X0,X1,tn,k) do{ const f32x4_t a_=*(const f32x4_t*)(ckl+(tn)*64+4*hi+(((k)<4)?8*(k):32+8*((k)-4))); const float nm_=-mhat; \
      if((k)<4){ X0[4*(k)]=nm_-a_[0]; X0[4*(k)+1]=nm_-a_[1]; X0[4*(k)+2]=nm_-a_[2]; X0[4*(k)+3]=nm_-a_[3]; } \
      else { X1[4*((k)-4)]=nm_-a_[0]; X1[4*((k)-4)+1]=nm_-a_[1]; X1[4*((k)-4)+2]=nm_-a_[2]; X1[4*((k)-4)+3]=nm_-a_[3]; } }while(0)
  { PFG(pB0,pB1,1,0);PFG(pB0,pB1,1,1);PFG(pB0,pB1,1,2);PFG(pB0,pB1,1,3);PFG(pB0,pB1,1,4);PFG(pB0,pB1,1,5);PFG(pB0,pB1,1,6);PFG(pB0,pB1,1,7); }
  WAIT_BAR(0);
  DMA_K(3,0);DMA_V(1,SLOTB);
  ROT();
  kload8(kf,kp0+sl_cur);
  WAIT_BAR(2);
  s16x4 vlo[8],vhi[8]; u32x4 pw0,pw1,pw2,pw3;
  #define PKW(P,B) cvtpk_s(P[B],P[B+1])
  #define PAF(k) __builtin_bit_cast(bf16x8,pw##k)
  #define VFR(i) (bf16x8){vlo[i][0],vlo[i][1],vlo[i][2],vlo[i][3],vhi[i][0],vhi[i][1],vhi[i][2],vhi[i][3]}
  #define PIN(x) asm volatile("":"+v"(x))
  #define MX3(a,b,c) __builtin_fmaxf(__builtin_fmaxf((a),(b)),(c))
  #define GAPA(MF,A0,A1,A2,A3,W0,W1,PW) do{ MF; sacc+=A0; sacc+=A1; sacc+=A2; sacc+=A3; PIN(sacc); W0; W1; PIN(PW); SBAR(); }while(0)
  #define EX(v) __builtin_amdgcn_exp2f(v)
  #define GAPB(MF,X,B,PF) do{ MF; PF; X[B]=EX(X[B]); X[B+1]=EX(X[B+1]); X[B+2]=EX(X[B+2]); X[B+3]=EX(X[B+3]); PIN(X); SBAR(); }while(0)
  #define PFN(G,X0,X1,tt,k) do{ if(G){ PFG(X0,X1,(tt)+1,k); } }while(0)
  #define VRD(i) do{ vlo[i]=vtr(vp_+(((i)>>2)*4096+((i)&3)*1024)); vhi[i]=vtr(vp_+(((i)>>2)*4096+((i)&3)*1024+512)); }while(0)
  #define KRD(G,j) do{ if(G){ kload2(kf,kp0+sl_next,j); SBAR(); } }while(0)
  #define STEP(C0,C1,P0,P1,t,GK,GV,GL) do{ SBAR(); \
    const lds_cptr vp_=vp0+sl_prev; \
    VRD(0); SBAR(); float sacc=(P0[0]+P0[1]); \
    GAPA(C0=__builtin_amdgcn_mfma_f32_32x32x16_bf16(kf[0],qr[0],C0,0,0,0), P0[2],P0[3],P0[4],P0[5],     pw0[0]=PKW(P0,0), pw0[1]=PKW(P0,2), pw0); \
    VRD(4); SBAR(); GAPA(C1=__builtin_amdgcn_mfma_f32_32x32x16_bf16(kf[1],qr[0],C1,0,0,0), P0[6],P0[7],P0[8],P0[9],     pw0[2]=PKW(P0,4), pw0[3]=PKW(P0,6), pw0); \
    VRD(1); SBAR(); GAPA(C0=__builtin_amdgcn_mfma_f32_32x32x16_bf16(kf[2],qr[1],C0,0,0,0),   P0[10],P0[11],P0[12],P0[13], pw1[0]=PKW(P0,8), pw1[1]=PKW(P0,10), pw1); \
    VRD(5); SBAR(); GAPA(C1=__builtin_amdgcn_mfma_f32_32x32x16_bf16(kf[3],qr[1],C1,0,0,0),   P0[14],P0[15],P1[0],P1[1],   pw1[2]=PKW(P0,12),pw1[3]=PKW(P0,14), pw1); \
    VRD(2); SBAR(); GAPA(C0=__builtin_amdgcn_mfma_f32_32x32x16_bf16(kf[4],qr[2],C0,0,0,0),   P1[2],P1[3],P1[4],P1[5],     pw2[0]=PKW(P1,0), pw2[1]=PKW(P1,2), pw2); \
    VRD(6); SBAR(); GAPA(C1=__builtin_amdgcn_mfma_f32_32x32x16_bf16(kf[5],qr[2],C1,0,0,0),   P1[6],P1[7],P1[8],P1[9],     pw2[2]=PKW(P1,4), pw2[3]=PKW(P1,6), pw2); \
    VRD(3); SBAR(); GAPA(C0=__builtin_amdgcn_mfma_f32_32x32x16_bf16(kf[6],qr[3],C0,0,0,0),   P1[10],P1[11],P1[12],P1[13], pw3[0]=PKW(P1,8), pw3[1]=PKW(P1,10), pw3); \
    VRD(7); SBAR(); GAPA(C1=__builtin_amdgcn_mfma_f32_32x32x16_bf16(kf[7],qr[3],C1,0,0,0),   P1[14],P1[15],0.f,0.f,       pw3[2]=PKW(P1,12),pw3[3]=PKW(P1,14), pw3); \
    l_reg+=sacc; \
    if(GK){DMA_K((t)+3,sl_cur);} if(GV){DMA_V((t)+1,sl_next);} \
    CMASK(C0,C1,t); \
    { float a=MX3(C0[0],C0[1],C1[0]),b=MX3(C0[2],C0[3],C1[1]); a=MX3(a,C1[2],C1[3]); \
      _Pragma("unroll") for(int r=4;r<16;r+=4){a=MX3(a,C0[r],C0[r+1]);b=MX3(b,C0[r+2],C0[r+3]);a=MX3(a,C1[r],C1[r+1]);b=MX3(b,C1[r+2],C1[r+3]);} \
      float rm=__builtin_fmaxf(a,b); { auto rr=__builtin_amdgcn_permlane32_swap(__float_as_uint(rm),__float_as_uint(rm),false,false); rm=__builtin_fmaxf(__uint_as_float(rr[0]),__uint_as_float(rr[1])); } \
      resc=false; \
      if(__builtin_expect(__any(rm>(float)THRL),0)){ const float dl=__builtin_fmaxf(rm,0.f); mhat+=dl; \
        _Pragma("unroll") for(int r=0;r<16;++r){C0[r]-=dl;C1[r]-=dl;} \
        const float f=__builtin_amdgcn_exp2f(-dl); l_reg*=f; if(hi==0)wsf[r32]=f; resc=true; } } \
    SBAR(); \
    GAPB(o[0]=__builtin_amdgcn_mfma_f32_32x32x16_bf16(PAF(0),VFR(0),o[0],0,0,0), C0,0, PFN(GL,P0,P1,t,0)); \
    GAPB(o[1]=__builtin_amdgcn_mfma_f32_32x32x16_bf16(PAF(0),VFR(4),o[1],0,0,0), C0,4, PFN(GL,P0,P1,t,1)); \
    KRD(GL,0); GAPB(o[0]=__builtin_amdgcn_mfma_f32_32x32x16_bf16(PAF(1),VFR(1),o[0],0,0,0), C0,8, PFN(GL,P0,P1,t,2)); \
    KRD(GL,1); GAPB(o[1]=__builtin_amdgcn_mfma_f32_32x32x16_bf16(PAF(1),VFR(5),o[1],0,0,0), C0,12, PFN(GL,P0,P1,t,3)); \
    KRD(GL,2); GAPB(o[0]=__builtin_amdgcn_mfma_f32_32x32x16_bf16(PAF(2),VFR(2),o[0],0,0,0), C1,0, PFN(GL,P0,P1,t,4)); \
    KRD(GL,3); GAPB(o[1]=__builtin_amdgcn_mfma_f32_32x32x16_bf16(PAF(2),VFR(6),o[1],0,0,0), C1,4, PFN(GL,P0,P1,t,5)); \
    GAPB(o[0]=__builtin_amdgcn_mfma_f32_32x32x16_bf16(PAF(3),VFR(3),o[0],0,0,0), C1,8, PFN(GL,P0,P1,t,6)); \
    GAPB(o[1]=__builtin_amdgcn_mfma_f32_32x32x16_bf16(PAF(3),VFR(7),o[1],0,0,0), C1,12, PFN(GL,P0,P1,t,7)); \
    }while(0)
  int t=1;
  #undef CMASK
  #define CMASK(P0,P1,t) do{}while(0)
  for(;t+5<NT;t+=2){
    STEP(pB0,pB1,pA0,pA1,t,true,true,true);     WAIT_BAR(2); RESC(); ROT();
    STEP(pA0,pA1,pB0,pB1,t+1,true,true,true);   WAIT_BAR(2); RESC(); ROT();
  }
  #undef CMASK
  #define CMASK(P0,P1,t) do{int jb_=(t)-(NTm-4); if(jb_>=0)cmask(P0,P1,jb_,qrel,hi);}while(0)
  #define ENDW(tt) do{ if((tt)+3<NT){WAIT_BAR(2);} else if((tt)+2<NT){WAIT_BAR(1);} else {WAIT_BAR(0);} }while(0)
  for(;t+1<NT;t+=2){
    STEP(pB0,pB1,pA0,pA1,t,(t+3<NT),(t+1<NT),(t+1<NT));       ENDW(t);   RESC(); ROT();
    STEP(pA0,pA1,pB0,pB1,t+1,(t+4<NT),(t+2<NT),(t+2<NT));     ENDW(t+1); RESC(); ROT();
  }
  STEP(pB0,pB1,pA0,pA1,NT-1,false,false,false); RESC();
  { float sacc=pB0[0]+pB0[1]; _Pragma("unroll") for(int r=2;r<16;++r)sacc+=pB0[r]; _Pragma("unroll") for(int r=0;r<16;++r)sacc+=pB1[r]; l_reg+=sacc;
    pw0=(u32x4){PKW(pB0,0),PKW(pB0,2),PKW(pB0,4),PKW(pB0,6)};pw1=(u32x4){PKW(pB0,8),PKW(pB0,10),PKW(pB0,12),PKW(pB0,14)};pw2=(u32x4){PKW(pB1,0),PKW(pB1,2),PKW(pB1,4),PKW(pB1,6)};pw3=(u32x4){PKW(pB1,8),PKW(pB1,10),PKW(pB1,12),PKW(pB1,14)};
    SBAR(); pv(o,vb0+sl_cur,PAF(0),PAF(1),PAF(2),PAF(3)); }
  #undef PKW
  #undef PAF
  #undef VFR
  #undef PIN
  #undef MX3
  #undef GAPA
  #undef GAPB
  #undef PFN
  #undef PFG
  #undef EX
  #undef VRD
  #undef KRD
  #undef STEP
  #undef ENDW
  {auto rr=__builtin_amdgcn_permlane32_swap(__float_as_uint(l_reg),__float_as_uint(l_reg),false,false);l_reg=__uint_as_float(rr[0])+__uint_as_float(rr[1]);}
  if(hi==0){ wsf[32+r32]=l_reg; float*mlp=ML+((long)(q0+wid*QBLK+r32)*NHEAD+h)*2; mlp[0]=mhat; mlp[1]=l_reg; } asm volatile("s_waitcnt lgkmcnt(0)":::"memory");
  float rli[16];
  #pragma unroll
  for(int r=0;r<16;++r)rli[r]=__builtin_amdgcn_rcpf(wsf[32+crow(r,hi)]);
  bf16*Ow=O+(rowbase+q0+wid*QBLK)*DM+h*D;
  { bf16*stg=(bf16*)(shm+LDS_OST)+wid*2048;
    #pragma unroll
    for(int r=0;r<16;++r){const int orow=crow(r,hi);
      #pragma unroll
      for(int d0=0;d0<2;++d0)stg[orow*64+d0*32+r32]=__float2bfloat16(o[d0][r]*rli[r]);}
    asm volatile("s_waitcnt lgkmcnt(0)":::"memory");
    #pragma unroll
    for(int i=0;i<4;++i){const int row=i*8+(lane>>3),ch=lane&7; const u32x4 v=*(const u32x4*)(stg+row*64+ch*8); ATTN_STORE16(Ow+(long)row*DM+ch*8,v);} }
  asm volatile("s_waitcnt lgkmcnt(0)\n\ts_barrier":::"memory");
  #undef DMA_K
  #undef DMA_V
  #undef CMASK
  #undef BIAS
  #undef START
  #undef RESC
  #undef ROT
}

#undef SBAR
#undef WAIT_BAR
}
namespace cg = cooperative_groups;
constexpr int S_ = 16384, DMOD = 1024, NL = 4, DIN = 2568, NIN = 2816, DFF = 2816, NGU = 5632, NHD = 8;
constexpr float EPSN = 1e-6f;
constexpr size_t MiB = 1u << 20;
constexpr size_t WS_CTL = 0, CTL_BYTES = 65536;
constexpr size_t WS_WIN = 2 * MiB;
constexpr size_t WS_WOUT = 24 * MiB;
constexpr size_t WS_WGU = 32 * MiB;
constexpr size_t WS_WD = 76 * MiB;
constexpr size_t WS_XB = 98 * MiB;
constexpr size_t WS_RSSM = 130 * MiB;
constexpr size_t WS_RSSF = 130 * MiB + 128 * 1024;
constexpr size_t WS_LOGF = 130 * MiB + 256 * 1024;
constexpr size_t WS_C2 = 131 * MiB;
constexpr size_t WS_QKVZ = 132 * MiB;
constexpr size_t WS_O = 212 * MiB;
constexpr size_t WS_MG = 228 * MiB;
constexpr size_t WS_H = 132 * MiB;
constexpr size_t WS_OP = 260 * MiB;
constexpr size_t WS_ML = 308 * MiB;
constexpr size_t WS_END = 312 * MiB;
static_assert(WS_H + (size_t)S_ * DFF * 2 <= WS_MG, "h overlay");
constexpr int LDS_BYTES = 147456;
constexpr int CW_KMAX = 8192, CW_BAR = 9216, CW_SGUQ = 13312, CW_TS = 14336, CW_FCNT = 14400;
constexpr int NPHASE = 2 + 6 * NL;

#define LAS __attribute__((address_space(3)))
typedef unsigned short bf16r;
typedef unsigned v4u __attribute__((ext_vector_type(4)));
typedef float f32x4 __attribute__((ext_vector_type(4)));
typedef float f32x16 __attribute__((ext_vector_type(16)));
typedef short bf16x8 __attribute__((ext_vector_type(8)));
#define LDS_WAIT() asm volatile("s_waitcnt lgkmcnt(0)" ::: "memory")
__device__ __forceinline__ unsigned f2bf(float f) { unsigned u = __builtin_bit_cast(unsigned, f); return (u + 0x7fffu + ((u >> 16) & 1u)) >> 16; }
__device__ __forceinline__ unsigned pk2(float lo, float hi) { return f2bf(lo) | (f2bf(hi) << 16); }
__device__ __forceinline__ float bflo(unsigned w) { return __builtin_bit_cast(float, w << 16); }
__device__ __forceinline__ float bfhi(unsigned w) { return __builtin_bit_cast(float, w & 0xffff0000u); }
__device__ __forceinline__ float bf1(bf16r w) { return __builtin_bit_cast(float, (unsigned)w << 16); }
#define DPPF(v, ctrl) __builtin_bit_cast(float, __builtin_amdgcn_update_dpp(0, __builtin_bit_cast(int, (v)), (ctrl), 0xf, 0xf, true))
__device__ __forceinline__ float row16_sum(float v) {
    v += DPPF(v, 0xB1); v += DPPF(v, 0x4E); v += DPPF(v, 0x141); v += DPPF(v, 0x140); return v;
}
__device__ __forceinline__ float wave_sum(float v) {
    v += DPPF(v, 0xB1); v += DPPF(v, 0x4E); v += DPPF(v, 0x141); v += DPPF(v, 0x140);
    const int iv = __builtin_bit_cast(int, v);
    const float s0 = __builtin_bit_cast(float, __builtin_amdgcn_readlane(iv, 0)), s1 = __builtin_bit_cast(float, __builtin_amdgcn_readlane(iv, 16)),
                s2 = __builtin_bit_cast(float, __builtin_amdgcn_readlane(iv, 32)), s3 = __builtin_bit_cast(float, __builtin_amdgcn_readlane(iv, 48));
    return (s0 + s1) + (s2 + s3);
}
constexpr int PREP_P = 132;
__device__ __forceinline__ void prep_item(const float* W, int ldw, int srccol, const float* gs, bf16r* WT, int K, int dstrow, int k0, LAS float* scr, int lane) {
#pragma unroll 8
    for (int i = 0; i < 16; ++i) { const int kk = 2 * i + (lane >> 5); f32x4 w = *(const f32x4*)(W + (size_t)(k0 + kk) * ldw + srccol + 4 * (lane & 31)); if (gs) w = w * gs[k0 + kk];
        *(LAS f32x4*)(scr + kk * PREP_P + 4 * (lane & 31)) = w; }
    LDS_WAIT(); asm volatile("" ::: "memory");
    const int c = lane & 3;
#pragma unroll
    for (int j = 0; j < 8; ++j) { const int n = (lane >> 2) + 16 * j; const LAS float* s = scr + (8 * c) * PREP_P + n;
        v4u o; o.x = pk2(s[0 * PREP_P], s[1 * PREP_P]); o.y = pk2(s[2 * PREP_P], s[3 * PREP_P]); o.z = pk2(s[4 * PREP_P], s[5 * PREP_P]); o.w = pk2(s[6 * PREP_P], s[7 * PREP_P]);
        *(v4u*)(WT + (size_t)(dstrow + n) * K + k0 + 8 * c) = o; }
    LDS_WAIT(); asm volatile("" ::: "memory");
}
template <int OFF> __device__ __forceinline__ unsigned long long ldk() {
    unsigned long long v; auto ka = __builtin_amdgcn_kernarg_segment_ptr();
    asm volatile("s_load_dwordx2 %0, %1, %2\n\ts_waitcnt lgkmcnt(0)" : "=s"(v) : "s"(ka), "i"(OFF) : "memory");
    return v;
}
struct Ptrs {
    const float *x, *mixg, *w_in, *b_f, *lng, *lnb, *w_s, *b_s, *outg, *w_out, *ffng, *w_gu, *w_d, *fing;
    float* out; unsigned char* ws;
};
__device__ __forceinline__ void phase_prep(const Ptrs& P, LAS unsigned char* lds, int l0, int l1, int gw, int NGW, int wave, int lane) {
    LAS float* scr = (LAS float*)(lds + wave * (32 * PREP_P * 4));
    bf16r* WinT = (bf16r*)(P.ws + WS_WIN); bf16r* WoutT = (bf16r*)(P.ws + WS_WOUT); bf16r* WguT = (bf16r*)(P.ws + WS_WGU); bf16r* WdT = (bf16r*)(P.ws + WS_WD);
    constexpr int I_IN = 32 * 20, I_OUT = 32 * 8, I_GU = 32 * 44, I_D = 88 * 8, I_L = I_IN + I_OUT + I_GU + I_D;
    for (int it = l0 * I_L + gw; it < l1 * I_L; it += NGW) {
        const int l = it / I_L; int r = it % I_L;
        if (r < I_IN) { const int kb = r / 20, nb = r % 20, n0 = 128 * nb, src = n0 < 1536 ? n0 : n0 + 8;
            prep_item(P.w_in + (size_t)l * DMOD * DIN, DIN, src, P.mixg + l * DMOD, WinT + (size_t)l * NIN * DMOD, DMOD, n0, 32 * kb, scr, lane); continue; }
        r -= I_IN;
        if (r < I_OUT) { const int kb = r / 8, nb = r % 8;
            prep_item(P.w_out + (size_t)l * DMOD * DMOD, DMOD, 128 * nb, P.outg + l * DMOD, WoutT + (size_t)l * DMOD * DMOD, DMOD, 128 * nb, 32 * kb, scr, lane); continue; }
        r -= I_OUT;
        if (r < I_GU) { const int kb = r / 44, nb = r % 44, n0 = 128 * nb, pn = n0 >> 8, src = (n0 & 255) == 0 ? 128 * pn : DFF + 128 * pn;
            prep_item(P.w_gu + (size_t)l * DMOD * NGU, NGU, src, P.ffng + l * DMOD, WguT + (size_t)l * NGU * DMOD, DMOD, n0, 32 * kb, scr, lane); continue; }
        r -= I_GU;
        { const int kb = r / 8, nb = r % 8;
            prep_item(P.w_d + (size_t)l * DFF * DMOD, DMOD, 128 * nb, nullptr, WdT + (size_t)l * DMOD * DFF, DFF, 128 * nb, 32 * kb, scr, lane); }
    }
    for (int idx = l0 * 262144 + gw * 64 + lane; idx < l1 * 262144; idx += NGW * 64) { const int l = idx >> 18, rr = (idx >> 10) & 255, k = idx & 1023; unsigned v = 0u;
        if ((rr & 127) < 8) { const float w = P.w_in[((size_t)l * DMOD + k) * DIN + 1536 + (rr & 7)] * P.mixg[l * DMOD + k]; const unsigned hb = f2bf(w);
            v = rr < 128 ? hb : f2bf(w - __builtin_bit_cast(float, hb << 16)); }
        WinT[((size_t)l * NIN + 2560 + rr) * DMOD + k] = (bf16r)v; }
}
template <int MODE>
__device__ __forceinline__ void phase_rowstats(const float* xin, bf16r* xb, unsigned long long* rss_out, const float* gfin, float* outp, int gw, int NGW, int lane, float tdelta = 0.f) {
#pragma unroll 2
    for (int m = gw; m < S_; m += NGW) {
        const f32x4* xr = (const f32x4*)(xin + (size_t)m * DMOD) + lane;
        f32x4 v[4]; float s = 0.f;
#pragma unroll
        for (int j = 0; j < 4; ++j) { v[j] = xr[64 * j]; s += (v[j].x * v[j].x + v[j].y * v[j].y) + (v[j].z * v[j].z + v[j].w * v[j].w); }
        const float tot = wave_sum(s);
        if (MODE == 2) {
            const float rs = 1.0f / sqrtf(tot * (1.0f / DMOD) + EPSN);
            f32x4* orow = (f32x4*)(outp + (size_t)m * DMOD) + lane; const f32x4* gr = (const f32x4*)gfin + lane;
#pragma unroll
            for (int j = 0; j < 4; ++j) orow[64 * j] = v[j] * rs * gr[64 * j] + (m < 1024 ? tdelta : 0.f);
        } else {
            unsigned long long* o8 = (unsigned long long*)(xb + (size_t)m * DMOD) + lane;
#pragma unroll
            for (int j = 0; j < 4; ++j) o8[64 * j] = (unsigned long long)pk2(v[j].x, v[j].y) | ((unsigned long long)pk2(v[j].z, v[j].w) << 32);
            if (lane == 0) rss_out[m] = (unsigned long long)__float2ull_rn(tot * 16777216.0f);
        }
    }
}
__device__ __forceinline__ void final_norm(const bf16r* xb, const unsigned long long* rss, const float* g, float* outp, int gw, int NGW, int lane) {
#pragma unroll 2
    for (int m = gw; m < S_; m += NGW) {
        const v4u a = *(const v4u*)(xb + (size_t)m * DMOD + 8 * lane), b = *(const v4u*)(xb + (size_t)m * DMOD + 512 + 8 * lane);
        const float rs = 1.0f / sqrtf((float)rss[m] * (1.0f / (1024.0f * 16777216.0f)) + EPSN);
        const f32x4* gr = (const f32x4*)g; f32x4* orow = (f32x4*)(outp + (size_t)m * DMOD);
        const f32x4 g0 = gr[2 * lane], g1 = gr[2 * lane + 1], g2 = gr[128 + 2 * lane], g3 = gr[128 + 2 * lane + 1];
        orow[2 * lane] = (f32x4){bflo(a.x), bfhi(a.x), bflo(a.y), bfhi(a.y)} * rs * g0; orow[2 * lane + 1] = (f32x4){bflo(a.z), bfhi(a.z), bflo(a.w), bfhi(a.w)} * rs * g1;
        orow[128 + 2 * lane] = (f32x4){bflo(b.x), bfhi(b.x), bflo(b.y), bfhi(b.y)} * rs * g2; orow[128 + 2 * lane + 1] = (f32x4){bflo(b.z), bfhi(b.z), bflo(b.w), bfhi(b.w)} * rs * g3;
    }
}
__device__ __forceinline__ void cumsum_head(const float* logf, float* c2, int h, LAS unsigned char* lds, int tid) {
    LAS double* scr = (LAS double*)lds;
    const f32x4* src = (const f32x4*)(logf + (size_t)h * S_ + tid * 32);
    f32x4 v[8]; double sum = 0.0;
#pragma unroll
    for (int e = 0; e < 8; ++e) { v[e] = src[e]; sum += ((double)v[e].x + (double)v[e].y) + ((double)v[e].z + (double)v[e].w); }
    scr[tid] = sum; __syncthreads();
    double pre = 0.0; for (int i = 0; i < tid; ++i) pre += scr[i];
    f32x4* dst = (f32x4*)(c2 + (size_t)h * S_ + tid * 32);
#pragma unroll
    for (int e = 0; e < 8; ++e) { f32x4 o; pre += (double)v[e].x; o.x = (float)(pre * 1.4426950408889634); pre += (double)v[e].y; o.y = (float)(pre * 1.4426950408889634);
        pre += (double)v[e].z; o.z = (float)(pre * 1.4426950408889634); pre += (double)v[e].w; o.w = (float)(pre * 1.4426950408889634); dst[e] = o; }
    __syncthreads();
}
__device__ __forceinline__ void sgu_item(int c, const bf16r* ZU, const bf16r* ZV, bf16r* MG, const float* lng, const float* lnb, const float* wsl, const float* bsl,
                                         LAS unsigned char* lds, int wid, int lane) {
    LAS float* bsb = (LAS float*)lds;
    LAS bf16r* zt = (LAS bf16r*)(lds + 4096);
    const int r32 = lane & 31, hi = lane >> 5, g = wid, tid = wid * 64 + lane;
    bsb[tid] = bsl[tid]; bsb[tid + 512] = bsl[tid + 512];
    const int rs4 = lane >> 4, l16 = lane & 15;
#pragma unroll 2
    for (int it = 0; it < 4; ++it) { const int i = 16 * wid + 4 * it + rs4; const size_t row = (size_t)c * 128 + i;
        v4u zr[4];
#pragma unroll
        for (int j = 0; j < 4; ++j) zr[j] = *(const v4u*)(ZV + row * 512 + 128 * j + 8 * l16);
        float z[32]; float s = 0.f;
#pragma unroll
        for (int j = 0; j < 4; ++j) { z[8 * j] = bflo(zr[j].x); z[8 * j + 1] = bfhi(zr[j].x); z[8 * j + 2] = bflo(zr[j].y); z[8 * j + 3] = bfhi(zr[j].y); z[8 * j + 4] = bflo(zr[j].z); z[8 * j + 5] = bfhi(zr[j].z); z[8 * j + 6] = bflo(zr[j].w); z[8 * j + 7] = bfhi(zr[j].w); }
#pragma unroll
        for (int e = 0; e < 32; ++e) s += z[e];
        const float mean = row16_sum(s) * (1.0f / 512.0f); float q = 0.f;
#pragma unroll
        for (int e = 0; e < 32; ++e) { z[e] -= mean; q += z[e] * z[e]; }
        const float rstd = 1.0f / sqrtf(row16_sum(q) * (1.0f / 512.0f) + EPSN);
#pragma unroll
        for (int j = 0; j < 4; ++j) { const f32x4 g0 = *(const f32x4*)(lng + 128 * j + 8 * l16), g1 = *(const f32x4*)(lng + 128 * j + 8 * l16 + 4), b0 = *(const f32x4*)(lnb + 128 * j + 8 * l16), b1 = *(const f32x4*)(lnb + 128 * j + 8 * l16 + 4);
            v4u zw; zw.x = pk2(z[8 * j] * rstd * g0.x + b0.x, z[8 * j + 1] * rstd * g0.y + b0.y); zw.y = pk2(z[8 * j + 2] * rstd * g0.z + b0.z, z[8 * j + 3] * rstd * g0.w + b0.w);
            zw.z = pk2(z[8 * j + 4] * rstd * g1.x + b1.x, z[8 * j + 5] * rstd * g1.y + b1.y); zw.w = pk2(z[8 * j + 6] * rstd * g1.z + b1.z, z[8 * j + 7] * rstd * g1.w + b1.w);
            *(LAS v4u*)(zt + i * 512 + 128 * j + 8 * l16) = zw; }
    }
    LDS_WAIT(); __syncthreads();
#pragma unroll 1
    for (int ni = 0; ni < 2; ++ni) {
        const int d = 64 * g + 32 * ni + r32;
        bf16x8 bfr[8];
#pragma unroll
        for (int ks = 0; ks < 8; ++ks) { const LAS bf16r* zp = zt + (16 * ks + 8 * hi) * 512 + d;
            v4u w; w.x = (unsigned)zp[0] | ((unsigned)zp[512] << 16); w.y = (unsigned)zp[1024] | ((unsigned)zp[1536] << 16); w.z = (unsigned)zp[2048] | ((unsigned)zp[2560] << 16); w.w = (unsigned)zp[3072] | ((unsigned)zp[3584] << 16);
            bfr[ks] = __builtin_bit_cast(bf16x8, w); }
        LDS_WAIT(); asm volatile("" ::: "memory");
        f32x16 acc[4];
#pragma unroll
        for (int mi = 0; mi < 4; ++mi) { acc[mi] = f32x16{};
#pragma unroll
            for (int ks = 0; ks < 8; ++ks) { if (mi < 2 && ks >= 4) continue;
                const float* wp = wsl + ((size_t)g * 128 + 32 * mi + r32) * 128 + 16 * ks + 8 * hi; const f32x4 a0 = *(const f32x4*)wp, a1 = *(const f32x4*)(wp + 4);
                v4u w; w.x = pk2(a0.x, a0.y); w.y = pk2(a0.z, a0.w); w.z = pk2(a1.x, a1.y); w.w = pk2(a1.z, a1.w);
                acc[mi] = __builtin_amdgcn_mfma_f32_32x32x16_bf16(__builtin_bit_cast(bf16x8, w), bfr[ks], acc[mi], 0, 0, 0); }
            asm volatile("" ::: "memory"); }
#pragma unroll
        for (int mi = 0; mi < 4; ++mi)
#pragma unroll
            for (int r = 0; r < 16; ++r) { const int i = 32 * mi + (r & 3) + 8 * (r >> 2) + 4 * hi;
                zt[i * 512 + d] = (bf16r)f2bf(acc[mi][r] + bsb[g * 128 + i]); }
        LDS_WAIT(); asm volatile("" ::: "memory");
    }
    __syncthreads();
#pragma unroll 2
    for (int it = 0; it < 4; ++it) { const int i = 16 * wid + 4 * it + rs4; const size_t row = (size_t)c * 128 + i;
        float a[32]; float ss = 0.f;
#pragma unroll
        for (int j = 0; j < 4; ++j) { const v4u tr = *(const LAS v4u*)(zt + i * 512 + 128 * j + 8 * l16); const v4u ur = *(const v4u*)(ZU + row * 512 + 128 * j + 8 * l16);
            a[8 * j] = bflo(tr.x) * bflo(ur.x); a[8 * j + 1] = bfhi(tr.x) * bfhi(ur.x); a[8 * j + 2] = bflo(tr.y) * bflo(ur.y); a[8 * j + 3] = bfhi(tr.y) * bfhi(ur.y);
            a[8 * j + 4] = bflo(tr.z) * bflo(ur.z); a[8 * j + 5] = bfhi(tr.z) * bfhi(ur.z); a[8 * j + 6] = bflo(tr.w) * bflo(ur.w); a[8 * j + 7] = bfhi(tr.w) * bfhi(ur.w); }
#pragma unroll
        for (int e = 0; e < 32; ++e) ss += a[e] * a[e];
        const float ra = 1.0f / sqrtf(row16_sum(ss) * (1.0f / 512.0f) + EPSN);
#pragma unroll
        for (int j = 0; j < 4; ++j) { v4u w; w.x = pk2(a[8 * j] * ra, a[8 * j + 1] * ra); w.y = pk2(a[8 * j + 2] * ra, a[8 * j + 3] * ra); w.z = pk2(a[8 * j + 4] * ra, a[8 * j + 5] * ra); w.w = pk2(a[8 * j + 6] * ra, a[8 * j + 7] * ra);
            *(v4u*)(MG + row * 1024 + 512 + 128 * j + 8 * l16) = w; }
    }
    LDS_WAIT(); __syncthreads();
}
__device__ __forceinline__ void combine_item(int c, const bf16r* O, const bf16r* OP1, const float* ML, bf16r* MG, int wid, int lane) {
    const int rs4 = lane >> 4, l16 = lane & 15;
#pragma unroll
    for (int it = 0; it < 2; ++it) { const size_t row = (size_t)c * 64 + 8 * wid + 4 * it + rs4; const int nch = ((int)(row >> 12)) + 1;
        float a[32]; float ss = 0.f;
#pragma unroll
        for (int j = 0; j < 4; ++j) { const int hh = 2 * j + (l16 >> 3); float Mj[4], lj[4]; v4u oj[4];
#pragma unroll
            for (int q = 0; q < 4; ++q) { if (q < nch) { const float* mlp = ML + (size_t)q * S_ * 16 + (row * 8 + hh) * 2; Mj[q] = mlp[0]; lj[q] = mlp[1];
                    oj[q] = (q == 0 || lj[q] > 0.f) ? *(const v4u*)((q == 0 ? O : OP1 + (size_t)(q - 1) * S_ * 512) + row * 512 + 128 * j + 8 * l16) : (v4u){0u, 0u, 0u, 0u}; } else { Mj[q] = -1.0e30f; lj[q] = 0.f; oj[q] = (v4u){0u, 0u, 0u, 0u}; } }
            const float Mmax = fmaxf(fmaxf(Mj[0], Mj[1]), fmaxf(Mj[2], Mj[3])); float wsum = 0.f; float t[8] = {0.f, 0.f, 0.f, 0.f, 0.f, 0.f, 0.f, 0.f};
#pragma unroll
            for (int q = 0; q < 4; ++q) { const float w = lj[q] > 0.f ? lj[q] * __builtin_amdgcn_exp2f(Mj[q] - Mmax) : 0.f; wsum += w;
                if (w > 0.f) { t[0] += w * bflo(oj[q].x); t[1] += w * bfhi(oj[q].x); t[2] += w * bflo(oj[q].y); t[3] += w * bfhi(oj[q].y); t[4] += w * bflo(oj[q].z); t[5] += w * bfhi(oj[q].z); t[6] += w * bflo(oj[q].w); t[7] += w * bfhi(oj[q].w); } }
            const float iw = 1.0f / wsum;
#pragma unroll
            for (int e = 0; e < 8; ++e) { a[8 * j + e] = t[e] * iw; ss += a[8 * j + e] * a[8 * j + e]; } }
        const float ra = 1.0f / sqrtf(row16_sum(ss) * (1.0f / 512.0f) + EPSN);
#pragma unroll
        for (int j = 0; j < 4; ++j) { v4u w; w.x = pk2(a[8 * j] * ra, a[8 * j + 1] * ra); w.y = pk2(a[8 * j + 2] * ra, a[8 * j + 3] * ra); w.z = pk2(a[8 * j + 4] * ra, a[8 * j + 5] * ra); w.w = pk2(a[8 * j + 6] * ra, a[8 * j + 7] * ra);
            *(v4u*)(MG + row * 1024 + 128 * j + 8 * l16) = w; }
    }
}
#define XB_TMO      128
#define XB_XCNT(j)  (256  + 64 * (j))
#define XB_XSUB(j)  (1280 + 64 * (j))
#define XB_XGEN(j)  (2304 + 64 * (j))
#define XB_TOP      3328
#define XB_TOPGEN   3392
#define XCD_BAR_WORDS 3456
#define XB_SPIN_CAP (1u << 18)

__device__ __forceinline__ unsigned xb_ld(unsigned* p)              { return __hip_atomic_load(p, __ATOMIC_RELAXED, __HIP_MEMORY_SCOPE_AGENT); }
__device__ __forceinline__ unsigned xb_add(unsigned* p, unsigned v) { return __hip_atomic_fetch_add(p, v, __ATOMIC_RELAXED, __HIP_MEMORY_SCOPE_AGENT); }
__device__ __forceinline__ unsigned xb_xcc_id() { return (unsigned)__builtin_amdgcn_s_getreg((3 << 11) | 20) & 0xFu; }
#define XB_SPIN(cond, bar) do { unsigned _sp = 0; while (cond) { __builtin_amdgcn_s_sleep(1); \
    if ((++_sp & 255u) == 0u) { if (xb_ld(&(bar)[XB_TMO])) break; if (_sp > XB_SPIN_CAP) { atomicAdd(&(bar)[XB_TMO], 1u); break; } } } } while (0)

struct XcdBarrier {
    unsigned* bar; unsigned x;
    volatile LAS unsigned* st;
};

__device__ __forceinline__ XcdBarrier xcd_barrier_post(unsigned* bar, volatile LAS unsigned* st) {
    XcdBarrier b; b.bar = bar; b.x = xb_xcc_id(); b.st = st;
    if (threadIdx.x == 0) (void)xb_add(&bar[XB_XCNT(b.x)], 1u);
    return b;
}
__device__ __forceinline__ void xcd_barrier_complete(unsigned* bar, unsigned x, unsigned& nloc, unsigned& nx) {
    const unsigned G = gridDim.x * gridDim.y * gridDim.z;
    unsigned sum, cnt, mine, sp = 0u;
    for (;;) {
        sum = 0u; cnt = 0u; mine = 0u;
#pragma unroll
        for (unsigned j = 0; j < 16; ++j) { const unsigned c = xb_ld(&bar[XB_XCNT(j)]); sum += c; cnt += (c > 0u) ? 1u : 0u; mine = (j == x) ? c : mine; }
        if (sum == G) break;
        __builtin_amdgcn_s_sleep(1);
        if ((++sp & 255u) == 0u) { if (xb_ld(&bar[XB_TMO])) break; if (sp > XB_SPIN_CAP) { atomicAdd(&bar[XB_TMO], 1u); break; } }
    }
    nloc = mine > 0u ? mine : 1u; nx = cnt > 0u ? cnt : 1u;
}

__device__ __forceinline__ void xcd_barrier(const XcdBarrier& b) {
    asm volatile("s_waitcnt vmcnt(0)" ::: "memory");
    __syncthreads();
    if (threadIdx.x == 0) {
        unsigned* bar = b.bar;
        __builtin_amdgcn_s_waitcnt(0);
        unsigned nloc = b.st[0], nx = b.st[1];
        if (nloc == 0u) { xcd_barrier_complete(bar, b.x, nloc, nx); b.st[0] = nloc; b.st[1] = nx; }
        const unsigned old = xb_add(&bar[XB_XSUB(b.x)], 1u);
        const unsigned gen = old / nloc;
        if (old + 1u == (gen + 1u) * nloc) {
            __builtin_amdgcn_fence(__ATOMIC_RELEASE, "agent");
            asm volatile("s_waitcnt vmcnt(0)" ::: "memory");
            const unsigned og = xb_add(&bar[XB_TOP], 1u);
            const unsigned tg = og / nx;
            if (og + 1u == (tg + 1u) * nx) xb_add(&bar[XB_TOPGEN], 1u);
            else XB_SPIN(xb_ld(&bar[XB_TOPGEN]) == tg, bar);
            __builtin_amdgcn_fence(__ATOMIC_ACQUIRE, "agent");
            xb_add(&bar[XB_XGEN(b.x)], 1u);
            asm volatile("s_waitcnt vmcnt(0)" ::: "memory");
        } else {
            XB_SPIN(xb_ld(&bar[XB_XGEN(b.x)]) == gen, bar);
            __builtin_amdgcn_fence(__ATOMIC_ACQUIRE, "agent");
            asm volatile("s_waitcnt vmcnt(0)" ::: "memory");
        }
    }
    __syncthreads();
}
#ifndef MK_MULTI
#define MK_MULTI 0
#endif
struct Args { const float* in[14]; float* out; unsigned char* ws; int ph_lo, ph_hi; };
__global__ void __launch_bounds__(512, 2) fox_fwd(Args args) {
    extern __shared__ __attribute__((aligned(16))) unsigned char lds[];
    cg::grid_group grid = cg::this_grid();
    LAS unsigned char* L = (LAS unsigned char*)lds;
    const int G = gridDim.x, bx = blockIdx.x;
    const int vcu = (G % 8 == 0) ? (bx % 8) * (G / 8) + bx / 8 : bx;
    const int NGW = G * 8;
#define IDS() int tid = threadIdx.x; asm volatile("" : "+v"(tid)); const int lane = tid & 63, wave = __builtin_amdgcn_readfirstlane(tid >> 6), gw = vcu * 8 + wave; (void)lane; (void)gw
#define KIN(k) ((const float*)(const __attribute__((address_space(1))) float*)ldk<8 * (k)>())
#define WSB() ((unsigned char*)(__attribute__((address_space(1))) unsigned char*)ldk<120>())
#define P_OUT ((float*)(__attribute__((address_space(1))) float*)ldk<112>())
#define ctl ((unsigned*)(WSB() + WS_CTL))
#define WinT ((bf16r*)(WSB() + WS_WIN))
#define WoutT ((bf16r*)(WSB() + WS_WOUT))
#define WguT ((bf16r*)(WSB() + WS_WGU))
#define WdT ((bf16r*)(WSB() + WS_WD))
#define XB ((bf16r*)(WSB() + WS_XB))
#define RSSM ((unsigned long long*)(WSB() + WS_RSSM))
#define RSSF ((unsigned long long*)(WSB() + WS_RSSF))
#define LOGF ((float*)(WSB() + WS_LOGF))
#define C2A ((float*)(WSB() + WS_C2))
#define QKVZ ((bf16r*)(WSB() + WS_QKVZ))
#define OB ((bf16r*)(WSB() + WS_O))
#define MG ((bf16r*)(WSB() + WS_MG))
#define HB ((bf16r*)(WSB() + WS_H))
#define OP1 ((bf16r*)(WSB() + WS_OP))
#define MLB ((float*)(WSB() + WS_ML))
#define MKP() Ptrs P; P.x = KIN(0); P.mixg = KIN(1); P.w_in = KIN(2); P.b_f = KIN(3); P.lng = KIN(4); P.lnb = KIN(5); P.w_s = KIN(6); P.b_s = KIN(7); \
    P.outg = KIN(8); P.w_out = KIN(9); P.ffng = KIN(10); P.w_gu = KIN(11); P.w_d = KIN(12); P.fing = KIN(13); P.out = P_OUT; P.ws = WSB()
    constexpr size_t QS = (size_t)S_ * 512;
    const int lo = args.ph_lo, hi = args.ph_hi;
    { LAS unsigned* misc = (LAS unsigned*)(L + 147456 - 8); if (threadIdx.x < 2) misc[threadIdx.x] = 0u; __syncthreads(); }
    XcdBarrier xbar = xcd_barrier_post((unsigned*)(WSB() + WS_CTL) + CW_BAR, (volatile LAS unsigned*)(L + 147456 - 8));
    int ph = 0;
#ifdef PROBE_T
    unsigned long long tacc_ = 0ull, tst_ = 0ull;
#define TCLS() ((ph == 0) ? 0 : (ph <= 7 * NL ? ((ph - 1) % 7) + 1 : 8))
#define TBEG() do { if (TCLS() == PROBE_T) tst_ = __builtin_amdgcn_s_memrealtime(); } while (0)
#define TEND() do { if (TCLS() == PROBE_T) tacc_ += __builtin_amdgcn_s_memrealtime() - tst_; } while (0)
#else
#define TBEG() do {} while (0)
#define TEND() do {} while (0)
#endif
#define RUN() (ph >= lo && ph < hi)
#ifdef PROBE_SYNC
#define SEAM() do { ++ph; if (ph > lo && ph < hi) { if (ph == 1) { grid.sync(); grid.sync(); } else { xcd_barrier(xbar); xcd_barrier(xbar); } } } while (0)
#else
#define SEAM() do { ++ph; if (ph > lo && ph < hi) { if (lo < 0) grid.sync(); xcd_barrier(xbar); } --ph; TEND(); ++ph; TBEG(); } while (0)
#endif
#ifdef PROBE_SMALL
#define REPS 2
#else
#define REPS 1
#endif
#ifndef FH_TABLE
#define FH_TABLE 0x76545677u
#endif
#ifndef SGU_AT
#define SGU_AT 1
#endif
#ifdef PROBE_GEMM
#define REPG 2
#else
#define REPG 1
#endif
#ifdef PROBE_ATTN
#define REPA 2
#else
#define REPA 1
#endif

#ifndef NO_P0
    if (RUN()) { IDS(); MKP(); for (int rp = 0; rp < REPS; ++rp) { phase_prep(P, L, 0, 1, gw, NGW, wave, lane); phase_rowstats<1>(P.x, (bf16r*)(P.ws + WS_XB), (unsigned long long*)(P.ws + WS_RSSM), nullptr, nullptr, gw, NGW, lane); } }
#endif
    SEAM();
    for (int l = 0; l < NL; ++l) {
#ifndef NO_INPROJ
        if (RUN()) {
            { IDS(); unsigned long long* rz = RSSF; if (bx < 256 && tid < 64) { unsigned zlo = 0u; asm volatile("" : "+v"(zlo)); rz[bx * 64 + tid] = (unsigned long long)zlo; }     }
            pg8::Gemm g{XB, WinT + (size_t)l * NIN * DMOD, S_, NIN, DMOD}; pg8::StaticOrder So; So.init(S_, NIN, G, bx); So.rot = NIN / 256 - 1;
            pg8::EpiInProj E{QKVZ, QS, RSSM, ctl + CW_KMAX + l * 16, KIN(3) + l * 8, LOGF, ctl + CW_FCNT + l * 64};
            for (int rg = 0; rg < REPG; ++rg) pg8::gemm_phase<pg8::EpiInProj, pg8::StaticOrder, true, true>(L, g, So, E);
            if (bx >= G - NHD) {
                IDS(); unsigned* const fc = ctl + CW_FCNT + l * 64;
                if (tid == 0) { unsigned sp = 0; while (__hip_atomic_load(fc, __ATOMIC_RELAXED, __HIP_MEMORY_SCOPE_AGENT) < 64u * REPG) { __builtin_amdgcn_s_sleep(8); if (++sp > (1u << 20)) break; }
                    __builtin_amdgcn_fence(__ATOMIC_ACQUIRE, "agent"); }
                __syncthreads();
                cumsum_head(LOGF, C2A, bx - (G - NHD), L, tid);
            }
        }
#endif
        SEAM();
#ifndef NO_ATTN
        if (RUN()) {
            IDS(); LAS unsigned* bc = (LAS unsigned*)(L + 147456 - 64);
            unsigned* const ctlp = ctl; unsigned char* const wsp = WSB();
            const int fh = (int)((FH_TABLE >> (4 * (bx & 7))) & 7u);
            for (int rp = 0; rp < REPA; ++rp)
            for (int qi = 0; qi <= NHD; ++qi) { const int h = (qi == 0) ? fh : (NHD - qi); if (qi > 0 && h == fh) continue;
                if (qi == SGU_AT && rp == 0) {
            for (;;) {
                if (tid == 0) bc[0] = atomicAdd(ctlp + CW_SGUQ + (l) * 64, 1u);
                __syncthreads(); const unsigned u = bc[0]; __syncthreads();
                if (u >= (unsigned)(S_ / 128)) break;
                bf16r* const qkvz = (bf16r*)(wsp + WS_QKVZ);
                sgu_item((int)u, qkvz + 3 * QS, qkvz + 4 * QS, (bf16r*)(wsp + WS_MG), KIN(4) + l * 512, KIN(5) + l * 512, KIN(6) + (size_t)l * 8 * 128 * 128, KIN(7) + l * 8 * 128, L, wave, lane);
            }
                }
                const float kn = sqrtf((__uint_as_float(ctlp[CW_KMAX + l * 16 + 2 * h]) + __uint_as_float(ctlp[CW_KMAX + l * 16 + 2 * h + 1])) * 1.02f);
                for (;;) {
                    if (tid == 0) bc[0] = atomicAdd(ctlp + ((rp * NL + l) * NHD + h) * 64, 1u);
                    __syncthreads(); const unsigned u = bc[0]; __syncthreads();
                    if (u >= 160u) break;
                    int qb, jc;
                    if (u < 64u) { qb = 63 - (int)(u >> 2); jc = (int)(u & 3u); } else if (u < 112u) { const int v = (int)u - 64; qb = 47 - v / 3; jc = v % 3; }
                    else if (u < 144u) { const int v = (int)u - 112; qb = 31 - (v >> 1); jc = v & 1; } else { qb = 15 - ((int)u - 144); jc = 0; }
                    bf16r* const qkvz = (bf16r*)(wsp + WS_QKVZ);
                    attn_body::fox_unit2<8>(h, qb, jc, kn, (const attn_body::bf16*)qkvz, (const attn_body::bf16*)(qkvz + QS), (const attn_body::bf16*)(qkvz + 2 * QS),
                                            (attn_body::bf16*)(jc == 0 ? (bf16r*)(wsp + WS_O) : (bf16r*)(wsp + WS_OP) + (size_t)(jc - 1) * QS), (float*)(wsp + WS_ML) + (size_t)jc * S_ * 16, (float*)(wsp + WS_C2) + (size_t)h * S_, (char*)lds, (float*)(lds + 147456 - 48));
                } }
        }
#endif
        SEAM();
#ifndef NO_MERGE
        if (RUN()) { IDS(); for (int rp = 0; rp < REPS; ++rp) for (int it = vcu; it < S_ / 64; it += G) combine_item(it, OB, OP1, MLB, MG, wave, lane); }
#endif
        SEAM();
#ifndef NO_OUTPROJ
        if (RUN()) {
            { IDS(); unsigned long long* rz = RSSM; if (bx < 256 && tid < 64) { unsigned zlo = 0u; asm volatile("" : "+v"(zlo)); rz[bx * 64 + tid] = (unsigned long long)zlo; }     }
            pg8::Gemm g{MG, WoutT + (size_t)l * DMOD * DMOD, S_, DMOD, DMOD}; pg8::StaticOrder So; So.init(S_, DMOD, G, bx);
            pg8::EpiResid E{XB, RSSF};
            pg8::gemm_phase<pg8::EpiResid, pg8::StaticOrder, true, true>(L, g, So, E);
        }
#endif
        SEAM();
#ifndef NO_GU
        if (RUN()) {
            pg8::Gemm g{XB, WguT + (size_t)l * NGU * DMOD, S_, NGU, DMOD}; pg8::StaticOrder So; So.init(S_, NGU, G, bx);
            pg8::EpiSwiGLU E{HB, RSSF};
            for (int rg = 0; rg < REPG; ++rg) pg8::gemm_phase<pg8::EpiSwiGLU, pg8::StaticOrder, true, true>(L, g, So, E);
            if (l + 1 < NL) { IDS(); MKP(); if (G == 256) { if (bx >= 128) phase_prep(P, L, l + 1, l + 2, (bx - 128) * 8 + wave, 1024, wave, lane); } else phase_prep(P, L, l + 1, l + 2, gw, NGW, wave, lane); }
        }
#endif
        SEAM();
#ifndef NO_DOWN
        if (RUN()) {
            pg8::Gemm g{HB, WdT + (size_t)l * DMOD * DFF, S_, DMOD, DFF}; pg8::StaticOrder So; So.init(S_, DMOD, G, bx);
            pg8::EpiResid E{XB, RSSM};
            pg8::gemm_phase<pg8::EpiResid, pg8::StaticOrder, true, true>(L, g, So, E);
        }
#endif
        SEAM();
    }
#ifndef NO_RSN
#ifdef PROBE_T
    { if (blockIdx.x == 0 && threadIdx.x == 0) { ((unsigned*)(WSB() + WS_CTL))[CW_TS] = (unsigned)tacc_; __threadfence(); } xcd_barrier(xbar); }
    const float tdelta = (PROBE_T == 99) ? 0.1f : (float)__hip_atomic_load((unsigned*)(WSB() + WS_CTL) + CW_TS, __ATOMIC_RELAXED, __HIP_MEMORY_SCOPE_AGENT) * 2.0e-7f;
#else
    const float tdelta = 0.f;
#endif
    if (RUN()) { IDS(); final_norm(XB, RSSM, KIN(13), P_OUT, gw, NGW, lane); }
#endif
    SEAM();
#undef RUN
#undef SEAM
}

extern "C" void kernel_launch(void* const* d_in, const int* in_sizes, int n_in, void* d_out, int out_size, void* d_ws, size_t ws_size, hipStream_t stream) {
    static int grid = 0;
    if (grid == 0) {
        if (n_in != 14 || out_size != S_ * DMOD || ws_size < WS_END) { fprintf(stderr, "kernel_launch: unexpected shapes (n_in %d out %d ws %zu)\n", n_in, out_size, ws_size); grid = -1; return; }
        int dev = 0, cus = 0, per_cu = 0;
        hipGetDevice(&dev); hipDeviceGetAttribute(&cus, hipDeviceAttributeMultiprocessorCount, dev);
        if (hipFuncSetAttribute((const void*)fox_fwd, hipFuncAttributeMaxDynamicSharedMemorySize, LDS_BYTES) != hipSuccess) { fprintf(stderr, "kernel_launch: hipFuncSetAttribute failed\n"); grid = -1; return; }
        if (hipOccupancyMaxActiveBlocksPerMultiprocessor(&per_cu, (const void*)fox_fwd, 512, LDS_BYTES) != hipSuccess || per_cu < 1) { fprintf(stderr, "kernel_launch: occupancy query says %d\n", per_cu); per_cu = 1; }
        (void)hipGetLastError();
        grid = cus * per_cu;
        if (grid < 256) { fprintf(stderr, "kernel_launch: this kernel needs a resident grid of at least 256 workgroups, got %d\n", grid); grid = -1; return; }
        fprintf(stderr, "kernel_launch: grid %d (cus %d x %d)\n", grid, cus, per_cu);
    }
    if (grid < 0) return;
    hipMemsetAsync((char*)d_ws + WS_CTL, 0, CTL_BYTES, stream);
    Args a{};
    for (int i = 0; i < 14; ++i) a.in[i] = (const float*)d_in[i];
    a.out = (float*)d_out; a.ws = (unsigned char*)d_ws;
#if MK_MULTI
    for (int p = 0; p < NPHASE; ++p) { a.ph_lo = p; a.ph_hi = p + 1; hipLaunchKernelGGL(fox_fwd, dim3(grid), dim3(512), LDS_BYTES, stream, a); }
#else
    a.ph_lo = 0; a.ph_hi = NPHASE;
    void* kargs[] = {&a};
    hipError_t e = hipLaunchCooperativeKernel((const void*)fox_fwd, dim3(grid), dim3(512), kargs, LDS_BYTES, stream);
    if (e != hipSuccess) fprintf(stderr, "kernel_launch: cooperative launch failed: %s (grid %d)\n", hipGetErrorString(e), grid);
#endif
}
```

```cpp
#define MK_MULTI 0
#define FOX_THRL 32
#include <hip/hip_runtime.h>
#include <hip/hip_cooperative_groups.h>
#include <cstdio>
#include <cstdint>
namespace pg8 {
#define PG8_LAS __attribute__((address_space(3)))
typedef unsigned short bf16_t;
typedef short bf16x8 __attribute__((ext_vector_type(8)));
typedef float f32x4 __attribute__((ext_vector_type(4)));
typedef unsigned u32x4 __attribute__((ext_vector_type(4)));
constexpr int BM = 256, BK = 64, HALF = 128, HTB = HALF * BK * 2  , STAGE_BYTES = 8 * HTB, NXCD = 8, WGM = 8;

__host__ __device__ __forceinline__ int lds_byte(int r, int c) { const int st = (r >> 4) * 2 + (c >> 5), rr = r & 15, cc = c & 31, ob = rr * 64 + cc * 2; return st * 1024 + (ob ^ (((ob >> 9) & 1) << 5)); }
__host__ __device__ __forceinline__ void stage_rc(int b, int& R, int& C) { const int st = b / 1024, sb = b % 1024, swz = sb ^ (((sb >> 9) & 1) << 5); R = (st >> 1) * 16 + swz / 64; C = (st & 1) * 32 + (swz % 64) / 2; }
__host__ __device__ __forceinline__ int perm32(int rho) { const int n = rho >> 4, i = rho & 15; return 8 * (i >> 2) + 4 * n + (i & 3); }

struct Unit { int pm, pn; };
struct Gemm { const bf16_t* A; const bf16_t* Bt; int M, N, K; };

struct StaticOrder {
    int nM, nN, nwg, G, c, rot;
    __host__ __device__ void init(int M, int N, int G_, int c_) { nM = M / BM; nN = N / BM; nwg = nM * nN; G = G_; c = c_; rot = 0; }
    __host__ __device__ __forceinline__ bool next(int i, Unit& u) const {
        const long L = (long)i * G + c; if (L >= nwg) return false;
        int wgid = (int)L; { const int q = nwg / NXCD, r = nwg % NXCD, xcd = wgid % NXCD, off = wgid / NXCD; wgid = (xcd < r ? xcd * (q + 1) : r * (q + 1) + (xcd - r) * q) + off; }
        const int nig = WGM * nN, gid = wgid / nig, fm = gid * WGM, gsz = (nM - fm) < WGM ? (nM - fm) : WGM;
        u.pm = fm + ((wgid % nig) % gsz); u.pn = (wgid % nig) / gsz + rot; if (u.pn >= nN) u.pn -= nN; return true;
    }
    __device__ __forceinline__ void a_ready(const Unit&) const {}
    __device__ __forceinline__ void done(const Unit&) const {}
};

__device__ __forceinline__ unsigned cvt_pk_bf16(float lo, float hi) { unsigned r; asm volatile("v_cvt_pk_bf16_f32 %0, %1, %2" : "=v"(r) : "v"(lo), "v"(hi)); return r; }
typedef float f32x2 __attribute__((ext_vector_type(2)));
__device__ __forceinline__ f32x2 gelu_pk(f32x2 v) {
    const f32x2 av = __builtin_elementwise_abs(v), d = av * 0.2316418882f + 1.0f;
    f32x2 t; t.x = __builtin_amdgcn_rcpf(d.x); t.y = __builtin_amdgcn_rcpf(d.y);
    f32x2 q = t * 0.5307027145f + (-0.7265760135f); q = q * t + 0.7107068705f; q = q * t + (-0.142248368f); q = q * t + 0.127414796f; q = q * t;
    const f32x2 s = (v * v) * (-0.72134752044f);
    f32x2 e; e.x = __builtin_amdgcn_exp2f(s.x); e.y = __builtin_amdgcn_exp2f(s.y);
    const f32x2 m = v * (q * e), r = v - m;
    f32x2 o; o.x = v.x < 0.f ? m.x : r.x; o.y = v.y < 0.f ? m.y : r.y; return o;
}
constexpr float C2Q = 0.125f * 1.4426950408889634f;
constexpr float RSS_INV = 1.0f / (1024.0f * 16777216.0f);
struct EpiInProj {
    static constexpr bool PERM = true, AFTER_DRAIN = false;
    bf16_t* O; size_t split_stride; const unsigned long long* rss; unsigned* kmax; const float* bfv; float* logf; unsigned* fcnt;
    __device__ __forceinline__ void operator()(const f32x4 (&acc)[2][2][4][2], const Unit& u, int wr, int wc, int fr, int fq) const {
        if (u.pn == 10) {
            if (wc == 0 && fq == 0) {
#pragma unroll
                for (int ai = 0; ai < 2; ++ai)
#pragma unroll
                    for (int m = 0; m < 4; ++m) { const int row = u.pm * BM + wr * 64 + fr + ai * HALF + m * 16; const float rs = __builtin_amdgcn_rsqf((float)rss[row] * RSS_INV + 1e-6f);
#pragma unroll
                        for (int n = 0; n < 2; ++n)
#pragma unroll
                            for (int e = 0; e < 4; ++e) { const float z = (acc[ai][0][m][n][e] + acc[ai][1][m][n][e]) * rs + bfv[4 * n + e];
                                const float lf = fminf(z, 0.f) - 0.6931471805599453f * __builtin_amdgcn_logf(1.0f + __builtin_amdgcn_exp2f(-1.4426950408889634f * fabsf(z)));
                                __hip_atomic_store((unsigned*)(logf + (size_t)(4 * n + e) * 16384 + row), __float_as_uint(lf), __ATOMIC_RELAXED, __HIP_MEMORY_SCOPE_AGENT); } } }
            asm volatile("s_waitcnt vmcnt(0)" ::: "memory"); __builtin_amdgcn_s_barrier();
            if (wr == 0 && wc == 0 && fr == 0 && fq == 0) __hip_atomic_fetch_add(fcnt, 1u, __ATOMIC_RELAXED, __HIP_MEMORY_SCOPE_AGENT);
            return; }
        const int t = u.pn >> 1; float kmx[2] = {0.f, 0.f}; bf16_t* base = O + (size_t)t * split_stride;
        const int row0 = u.pm * BM + wr * 64 + fr, col0 = (u.pn & 1) * 256 + wc * 32 + 8 * fq;
        const float s0 = (t == 0) ? C2Q : 1.0f;
#pragma unroll
        for (int ai = 0; ai < 2; ++ai)
#pragma unroll
            for (int m = 0; m < 4; ++m) { const int row = row0 + ai * HALF + m * 16; const float rs = __builtin_amdgcn_rsqf((float)rss[row] * RSS_INV + 1e-6f) * s0; bf16_t* rowp = base + (size_t)row * 512 + col0;
#pragma unroll
                for (int bj = 0; bj < 2; ++bj) { f32x4 v0 = acc[ai][bj][m][0] * rs, v1 = acc[ai][bj][m][1] * rs;
                    if (t == 1) { const f32x4 q0 = v0 * v0, q1 = v1 * v1; float sq = ((q0[0] + q0[1]) + (q0[2] + q0[3])) + ((q1[0] + q1[1]) + (q1[2] + q1[3])); sq += __shfl_xor(sq, 16); sq += __shfl_xor(sq, 32); kmx[bj] = fmaxf(kmx[bj], sq); }
                    if (t >= 3) { f32x2 a = gelu_pk((f32x2){v0[0], v0[1]}), b = gelu_pk((f32x2){v0[2], v0[3]}), c = gelu_pk((f32x2){v1[0], v1[1]}), d = gelu_pk((f32x2){v1[2], v1[3]});
                        v0 = (f32x4){a.x, a.y, b.x, b.y}; v1 = (f32x4){c.x, c.y, d.x, d.y}; }
                    u32x4 w; w.x = cvt_pk_bf16(v0[0], v0[1]); w.y = cvt_pk_bf16(v0[2], v0[3]); w.z = cvt_pk_bf16(v1[0], v1[1]); w.w = cvt_pk_bf16(v1[2], v1[3]);
                    *(u32x4*)(rowp + bj * HALF) = w; } }
        if (t == 1) {
#pragma unroll
            for (int bj = 0; bj < 2; ++bj) { float v = kmx[bj]; v = fmaxf(v, __shfl_xor(v, 1)); v = fmaxf(v, __shfl_xor(v, 2)); v = fmaxf(v, __shfl_xor(v, 4)); v = fmaxf(v, __shfl_xor(v, 8));
                if (fr == 0 && fq == 0) atomicMax(kmax + ((u.pn & 1) * 4 + bj * 2 + (wc >> 1)) * 2 + (wc & 1), __float_as_uint(v)); } }
    }
};
struct EpiResid {
    static constexpr bool PERM = true, AFTER_DRAIN = false;
    bf16_t* xb; unsigned long long* rss;
    __device__ __forceinline__ void operator()(const f32x4 (&acc)[2][2][4][2], const Unit& u, int wr, int wc, int fr, int fq) const {
        const int col0 = u.pn * BM + wc * 32 + 8 * fq;
#pragma unroll
        for (int ai = 0; ai < 2; ++ai)
#pragma unroll
            for (int m = 0; m < 4; ++m) { const int row = u.pm * BM + ai * HALF + wr * 64 + m * 16 + fr; const size_t off = (size_t)row * 1024 + col0; float sq = 0.f;
#pragma unroll
                for (int bj = 0; bj < 2; ++bj) { const u32x4 bw = *(const u32x4*)(xb + off + bj * HALF);
                    const f32x4 b0 = (f32x4){__builtin_bit_cast(float, bw.x << 16), __builtin_bit_cast(float, bw.x & 0xffff0000u), __builtin_bit_cast(float, bw.y << 16), __builtin_bit_cast(float, bw.y & 0xffff0000u)};
                    const f32x4 b1 = (f32x4){__builtin_bit_cast(float, bw.z << 16), __builtin_bit_cast(float, bw.z & 0xffff0000u), __builtin_bit_cast(float, bw.w << 16), __builtin_bit_cast(float, bw.w & 0xffff0000u)};
                    const f32x4 o0 = b0 + acc[ai][bj][m][0], o1 = b1 + acc[ai][bj][m][1];
                    u32x4 w; w.x = cvt_pk_bf16(o0[0], o0[1]); w.y = cvt_pk_bf16(o0[2], o0[3]); w.z = cvt_pk_bf16(o1[0], o1[1]); w.w = cvt_pk_bf16(o1[2], o1[3]);
                    *(u32x4*)(xb + off + bj * HALF) = w;
                    sq += ((o0[0] * o0[0] + o0[1] * o0[1]) + (o0[2] * o0[2] + o0[3] * o0[3])) + ((o1[0] * o1[0] + o1[1] * o1[1]) + (o1[2] * o1[2] + o1[3] * o1[3])); }
                sq += __shfl_xor(sq, 16); sq += __shfl_xor(sq, 32);
                if (fq == 0) atomicAdd(rss + row, (unsigned long long)__float2ull_rn(sq * 16777216.0f)); }
    }
};
struct EpiSwiGLU {
    static constexpr bool PERM = true, AFTER_DRAIN = false;
    bf16_t* H; const unsigned long long* rss;
    __device__ __forceinline__ void operator()(const f32x4 (&acc)[2][2][4][2], const Unit& u, int wr, int wc, int fr, int fq) const {
        const int row0 = u.pm * BM + wr * 64 + fr, col0 = u.pn * 128 + wc * 32 + 8 * fq;
#pragma unroll
        for (int ai = 0; ai < 2; ++ai)
#pragma unroll
            for (int m = 0; m < 4; ++m) { const int row = row0 + ai * HALF + m * 16; const float rs = __builtin_amdgcn_rsqf((float)rss[row] * RSS_INV + 1e-6f);
                float hv[8];
#pragma unroll
                for (int n = 0; n < 2; ++n)
#pragma unroll
                    for (int e = 0; e < 4; ++e) { const float g = acc[ai][0][m][n][e] * rs, up = acc[ai][1][m][n][e] * rs;
                        const float sg = __builtin_amdgcn_rcpf(1.0f + __builtin_amdgcn_exp2f(-1.4426950408889634f * g)); hv[n * 4 + e] = g * sg * up; }
                u32x4 w; w.x = cvt_pk_bf16(hv[0], hv[1]); w.y = cvt_pk_bf16(hv[2], hv[3]); w.z = cvt_pk_bf16(hv[4], hv[5]); w.w = cvt_pk_bf16(hv[6], hv[7]);
                *(u32x4*)(H + (size_t)row * 2816 + col0) = w; }
    }
};
template <class Epi, class Sched, bool ALIGN_EPI = false, bool SP2 = false>
__device__ __forceinline__ void gemm_phase(PG8_LAS unsigned char* lds, const Gemm g, const Sched& S, const Epi& E) {
    int tid = threadIdx.x; asm volatile("" : "+v"(tid));
    const int wid = __builtin_amdgcn_readfirstlane(tid >> 6), lane = tid & 63, wr = wid >> 2, wc = wid & 3, fr = lane & 15, fq = lane >> 4;
    const int K = g.K, nt = K / BK;
    unsigned voffA[2], voffB[2];
#pragma unroll
    for (int i = 0; i < 2; ++i) { int R, C; stage_rc(tid * 16 + i * 8192, R, C); const int Rb = Epi::PERM ? ((R & ~31) + perm32(R & 31)) : R;
        voffA[i] = (unsigned)(R * K + C) * 2u; voffB[i] = (unsigned)(Rb * K + C) * 2u; }
    const size_t kstep = (size_t)(BK * 2);
    const size_t hstep = (size_t)HALF * K * 2;
    const size_t tstep = 2 * hstep;
    const unsigned ldsw = (unsigned)wid * 1024u;
    const int aoff = lds_byte(wr * 64 + fr, fq * 8), boff = lds_byte(wc * 32 + fr, fq * 8);
#define PG8_SA(b, h) (((b) * 2 + (h)) * HTB)
#define PG8_SB(b, h) ((4 + (b) * 2 + (h)) * HTB)
#define PG8_STAGE(bufoff, gbase, voff) do { _Pragma("unroll") for (int _i = 0; _i < 2; ++_i) \
        __builtin_amdgcn_global_load_lds((const unsigned*)((const char*)(gbase) + (voff)[_i]), (PG8_LAS unsigned*)(lds + (bufoff) + ldsw + _i * 8192), 16, 0, 0); } while (0)
#define PG8_LDA(dst, b, h) do { _Pragma("unroll") for (int m = 0; m < 4; ++m) _Pragma("unroll") for (int k = 0; k < 2; ++k) dst[m][k] = *(const PG8_LAS bf16x8*)(lds + PG8_SA(b, h) + aoff + m * 2048 + k * 1024); } while (0)
#define PG8_LDB(dst, b, h) do { _Pragma("unroll") for (int n = 0; n < 2; ++n) _Pragma("unroll") for (int k = 0; k < 2; ++k) dst[n][k] = *(const PG8_LAS bf16x8*)(lds + PG8_SB(b, h) + boff + n * 2048 + k * 1024); } while (0)
#define PG8_MMA(ai, bj, At, Bt) do { __builtin_amdgcn_s_setprio(1); _Pragma("unroll") for (int m = 0; m < 4; ++m) _Pragma("unroll") for (int n = 0; n < 2; ++n) _Pragma("unroll") for (int k = 0; k < 2; ++k) \
        acc[ai][bj][m][n] = __builtin_amdgcn_mfma_f32_16x16x32_bf16(Bt[n][k], At[m][k], acc[ai][bj][m][n], 0, 0, 0); __builtin_amdgcn_s_setprio(0); } while (0)
#define PG8_WAIT_V(n) asm volatile("s_waitcnt vmcnt(" #n ")" ::: "memory")
#define PG8_WAIT_L(n) asm volatile("s_waitcnt lgkmcnt(" #n ")" ::: "memory")
#define PG8_BAR __builtin_amdgcn_s_barrier()
#define PG8_SCHED __builtin_amdgcn_sched_barrier(0)
    Unit cur, nxt; int ui = 0;
    if (!S.next(0, cur)) return;
    f32x4 acc[2][2][4][2];
#pragma unroll
    for (int a = 0; a < 2; ++a)
#pragma unroll
        for (int b = 0; b < 2; ++b)
#pragma unroll
            for (int m = 0; m < 4; ++m)
#pragma unroll
                for (int n = 0; n < 2; ++n) acc[a][b][m][n] = (f32x4){0.f, 0.f, 0.f, 0.f};
    bf16x8 At[4][2], B0[2][2], B1[2][2];
    const char* cA = (const char*)g.A + (size_t)cur.pm * tstep; const char* cB = (const char*)g.Bt + (size_t)cur.pn * tstep;
    S.a_ready(cur);
    if constexpr (SP2) {
        PG8_STAGE(PG8_SB(0, 0), cB, voffB); PG8_STAGE(PG8_SB(0, 1), cB + hstep, voffB); PG8_STAGE(PG8_SA(0, 0), cA, voffA); PG8_STAGE(PG8_SA(0, 1), cA + hstep, voffA);
        if (wr == 1) PG8_BAR;
        PG8_WAIT_V(2); PG8_BAR;
        PG8_STAGE(PG8_SB(1, 0), cB + kstep, voffB); PG8_STAGE(PG8_SA(1, 0), cA + kstep, voffA); PG8_STAGE(PG8_SB(1, 1), cB + hstep + kstep, voffB);
        PG8_WAIT_V(6); PG8_BAR;
    } else {
        PG8_STAGE(PG8_SB(0, 0), cB, voffB); PG8_STAGE(PG8_SA(0, 0), cA, voffA); PG8_STAGE(PG8_SB(0, 1), cB + hstep, voffB); PG8_STAGE(PG8_SA(0, 1), cA + hstep, voffA);
        if (wr == 1) PG8_BAR;
        PG8_WAIT_V(4); PG8_BAR;
        PG8_STAGE(PG8_SB(1, 0), cB + kstep, voffB); PG8_STAGE(PG8_SA(1, 0), cA + kstep, voffA); PG8_STAGE(PG8_SB(1, 1), cB + hstep + kstep, voffB);
        PG8_WAIT_V(6); PG8_BAR;
    }
    for (;;) {
        const bool has_next = S.next(ui + 1, nxt);
        const char* nA = has_next ? (const char*)g.A + (size_t)nxt.pm * tstep : cA; const char* nB = has_next ? (const char*)g.Bt + (size_t)nxt.pn * tstep : cB;
        for (int t = 0; t < nt; t += 2) {
            const bool last = (t == nt - 2);
            const char* a1 = cA + (size_t)(t + 1) * kstep;
            const char* a2 = last ? nA : cA + (size_t)(t + 2) * kstep; const char* b2 = last ? nB : cB + (size_t)(t + 2) * kstep;
            const char* a3 = a2 + kstep; const char* b3 = b2 + kstep;
            if (last && has_next) S.a_ready(nxt);
            if constexpr (SP2) {
            PG8_LDB(B0, 0, 0); PG8_LDB(B1, 0, 1); PG8_SCHED; PG8_LDA(At, 0, 0); PG8_STAGE(PG8_SA(1, 1), a1 + hstep, voffA);
            PG8_WAIT_V(8); PG8_WAIT_L(0); PG8_BAR; PG8_MMA(0, 0, At, B0); PG8_MMA(0, 1, At, B1); PG8_BAR; PG8_SCHED;
            PG8_LDA(At, 0, 1); PG8_STAGE(PG8_SB(0, 0), b2, voffB); PG8_STAGE(PG8_SB(0, 1), b2 + hstep, voffB); PG8_STAGE(PG8_SA(0, 0), a2, voffA);
            PG8_WAIT_V(8); PG8_WAIT_L(0); PG8_BAR; PG8_MMA(1, 0, At, B0); PG8_MMA(1, 1, At, B1); PG8_BAR; PG8_SCHED;
            PG8_LDB(B0, 1, 0); PG8_LDB(B1, 1, 1); PG8_SCHED; PG8_LDA(At, 1, 0); PG8_STAGE(PG8_SA(0, 1), a2 + hstep, voffA);
            PG8_WAIT_V(8); PG8_WAIT_L(0); PG8_BAR; PG8_MMA(0, 0, At, B0); PG8_MMA(0, 1, At, B1); PG8_BAR; PG8_SCHED;
            PG8_LDA(At, 1, 1); PG8_STAGE(PG8_SB(1, 0), b3, voffB); PG8_STAGE(PG8_SB(1, 1), b3 + hstep, voffB); PG8_STAGE(PG8_SA(1, 0), a3, voffA);
            PG8_WAIT_V(8); PG8_WAIT_L(0); PG8_BAR; PG8_MMA(1, 0, At, B0); PG8_MMA(1, 1, At, B1); PG8_BAR; PG8_SCHED;
            } else {
            PG8_LDB(B0, 0, 0); PG8_SCHED; PG8_LDA(At, 0, 0); PG8_STAGE(PG8_SA(1, 1), a1 + hstep, voffA);
            PG8_WAIT_L(8); PG8_BAR; PG8_WAIT_L(0); PG8_MMA(0, 0, At, B0); PG8_BAR; PG8_SCHED;
            PG8_LDB(B1, 0, 1); PG8_STAGE(PG8_SB(0, 0), b2, voffB);
            PG8_BAR; PG8_WAIT_L(0); PG8_MMA(0, 1, At, B1); PG8_BAR;
            PG8_LDA(At, 0, 1); PG8_STAGE(PG8_SA(0, 0), a2, voffA);
            PG8_BAR; PG8_WAIT_L(0); PG8_MMA(1, 0, At, B0); PG8_BAR; PG8_SCHED;
            PG8_STAGE(PG8_SB(0, 1), b2 + hstep, voffB);
            PG8_WAIT_V(6); PG8_BAR; PG8_MMA(1, 1, At, B1); PG8_BAR;
            PG8_LDB(B0, 1, 0); PG8_SCHED; PG8_LDA(At, 1, 0); PG8_STAGE(PG8_SA(0, 1), a2 + hstep, voffA);
            PG8_WAIT_L(8); PG8_BAR; PG8_WAIT_L(0); PG8_MMA(0, 0, At, B0); PG8_BAR; PG8_SCHED;
            PG8_LDB(B1, 1, 1); PG8_STAGE(PG8_SB(1, 0), b3, voffB);
            PG8_BAR; PG8_WAIT_L(0); PG8_MMA(0, 1, At, B1); PG8_BAR;
            PG8_LDA(At, 1, 1); PG8_STAGE(PG8_SA(1, 0), a3, voffA);
            PG8_BAR; PG8_WAIT_L(0); PG8_MMA(1, 0, At, B0); PG8_BAR; PG8_SCHED;
            PG8_STAGE(PG8_SB(1, 1), b3 + hstep, voffB);
            PG8_WAIT_V(6); PG8_BAR; PG8_MMA(1, 1, At, B1); PG8_BAR;
            }
        }
        if constexpr (ALIGN_EPI) { if (wr == 0) PG8_BAR; }
        if constexpr (!Epi::AFTER_DRAIN) { E(acc, cur, wr, wc, fr, fq); S.done(cur); }
        if (!has_next) break;
#pragma unroll
        for (int a = 0; a < 2; ++a)
#pragma unroll
            for (int b = 0; b < 2; ++b)
#pragma unroll
                for (int m = 0; m < 4; ++m)
#pragma unroll
                    for (int n = 0; n < 2; ++n) acc[a][b][m][n] = (f32x4){0.f, 0.f, 0.f, 0.f};
        cur = nxt; cA = nA; cB = nB; ++ui;
        if constexpr (ALIGN_EPI) { if (wr == 1) PG8_BAR; }
    }
    PG8_WAIT_V(0);
    if constexpr (!ALIGN_EPI) { if (wr == 0) PG8_BAR; }
    PG8_BAR;
    if constexpr (Epi::AFTER_DRAIN) { E.fused(acc, cur, wr, wc, fr, fq, lds, wid, lane); S.done(cur); }
#undef PG8_SA
#undef PG8_SB
#undef PG8_STAGE
#undef PG8_LDA
#undef PG8_LDB
#undef PG8_MMA
#undef PG8_WAIT_V
#undef PG8_WAIT_L
#undef PG8_BAR
#undef PG8_SCHED
}
}
#include <hip/hip_bf16.h>
#include <cmath>
namespace attn_body {
using bf16=__hip_bfloat16;
using bf16x8=__attribute__((ext_vector_type(8)))short;
using s16x4=__attribute__((ext_vector_type(4)))short;
using f32x16=__attribute__((ext_vector_type(16)))float;
using u32x4=__attribute__((ext_vector_type(4)))unsigned;
constexpr int BATCH=1,NHEAD=8,SEQ=16384,D=64,DM=NHEAD*D;
constexpr int NW=8,QBLK=32,QB=QBLK*NW,KVBLK=64,NQB=SEQ/QB;
constexpr int ATTN_PITCH=DM, ATTN_UNIT_ROWS=QB;
__device__ __forceinline__ int crow(int r,int hi){return (r&3)+8*(r>>2)+4*hi;}
#define SBAR() __builtin_amdgcn_sched_barrier(0)
__device__ __forceinline__ void cmask(f32x16&p0,f32x16&p1,int jb,int qrel,int hi){
  const float NEG=-INFINITY; int kb=64*jb+4*hi;
  #pragma unroll
  for(int r=0;r<16;++r){int kv=kb+(r&3)+8*(r>>2); if(kv>qrel)p0[r]=NEG; if(kv+32>qrel)p1[r]=NEG;}
}

constexpr int NSLOT=3, SLOTB=8192;
constexpr int LDS_K=0, LDS_V=NSLOT*SLOTB, LDS_WS=2*NSLOT*SLOTB, LDS_OST=LDS_WS+NW*64*4, LDS_BYTES=LDS_OST+NW*4096;
constexpr float C2=0.125f*1.4426950408889634f;
__device__ __forceinline__ void glds16(const void*gsrc,unsigned lds_dst){unsigned keep;
  asm volatile("s_mov_b32 %0, m0\n\ts_mov_b32 m0, %2\n\ts_nop 0\n\tglobal_load_lds_dwordx4 %1, off\n\ts_mov_b32 m0, %0":"=&s"(keep):"v"(gsrc),"s"(lds_dst):"memory");}
__device__ __forceinline__ float max3f(float a,float b,float c){float r;asm("v_max3_f32 %0, %1, %2, %3":"=v"(r):"v"(a),"v"(b),"v"(c));return r;}
__device__ __forceinline__ float max2f(float a,float b){float r;asm("v_max_f32_e32 %0, %1, %2":"=v"(r):"v"(a),"v"(b));return r;}
__device__ __forceinline__ float fadd_s(float a,float b){float r;asm("v_add_f32_e32 %0, %1, %2":"=v"(r):"v"(a),"v"(b));return r;}
__device__ __forceinline__ float fsub_s(float a,float b){float r;asm("v_sub_f32_e32 %0, %1, %2":"=v"(r):"v"(a),"v"(b));return r;}
typedef float f32x2_t __attribute__((ext_vector_type(2))); typedef __bf16 bf16x2_t __attribute__((ext_vector_type(2)));
__device__ __forceinline__ unsigned cvtpk_s(float lo,float hi){f32x2_t v={lo,hi};bf16x2_t b=__builtin_convertvector(v,bf16x2_t);return __builtin_bit_cast(unsigned,b);}
#define WAIT_BAR(N) asm volatile("s_waitcnt vmcnt(" #N ") lgkmcnt(0)\n\ts_barrier":::"memory")

__device__ __forceinline__ void qkt(f32x16&p0,f32x16&p1,const char*Kslot,const bf16x8*qr,const f32x16&negm,int r32,int hi){
  const char*kb=Kslot+hi*1024+r32*16;
  #pragma unroll
  for(int d0=0;d0<4;++d0){
    const bf16x8 b0=*reinterpret_cast<const bf16x8*>(kb+d0*2048);
    const bf16x8 b1=*reinterpret_cast<const bf16x8*>(kb+d0*2048+512);
    if(d0==0){p0=__builtin_amdgcn_mfma_f32_32x32x16_bf16(b0,qr[0],negm,0,0,0);p1=__builtin_amdgcn_mfma_f32_32x32x16_bf16(b1,qr[0],negm,0,0,0);}
    else{p0=__builtin_amdgcn_mfma_f32_32x32x16_bf16(b0,qr[d0],p0,0,0,0);p1=__builtin_amdgcn_mfma_f32_32x32x16_bf16(b1,qr[d0],p1,0,0,0);}}
}
typedef __attribute__((address_space(3))) const char* lds_cptr;
typedef short v4i16_t __attribute__((ext_vector_type(4)));
__device__ __forceinline__ void kload8(bf16x8*kf,lds_cptr kp){
  kf[0]=*(const __attribute__((address_space(3))) bf16x8*)(kp);      kf[1]=*(const __attribute__((address_space(3))) bf16x8*)(kp+512);
  kf[2]=*(const __attribute__((address_space(3))) bf16x8*)(kp+2048); kf[3]=*(const __attribute__((address_space(3))) bf16x8*)(kp+2560);
  kf[4]=*(const __attribute__((address_space(3))) bf16x8*)(kp+4096); kf[5]=*(const __attribute__((address_space(3))) bf16x8*)(kp+4608);
  kf[6]=*(const __attribute__((address_space(3))) bf16x8*)(kp+6144); kf[7]=*(const __attribute__((address_space(3))) bf16x8*)(kp+6656);
}
__device__ __forceinline__ void kload2(bf16x8*kf,lds_cptr kp,int j){ kf[2*j]=*(const __attribute__((address_space(3))) bf16x8*)(kp+j*2048); kf[2*j+1]=*(const __attribute__((address_space(3))) bf16x8*)(kp+j*2048+512); }
__device__ __forceinline__ s16x4 vtr(lds_cptr p){ return __builtin_bit_cast(s16x4,__builtin_amdgcn_ds_read_tr16_b64_v4i16((__attribute__((address_space(3))) v4i16_t*)p)); }
__device__ __forceinline__ float rowmax(const f32x16&p0,const f32x16&p1){
  float a=max3f(p0[0],p0[1],p1[0]),b=max3f(p0[2],p0[3],p1[1]);a=max3f(a,p1[2],p1[3]);
  #pragma unroll
  for(int r=4;r<16;r+=4){a=max3f(a,p0[r],p0[r+1]);b=max3f(b,p0[r+2],p0[r+3]);a=max3f(a,p1[r],p1[r+1]);b=max3f(b,p1[r+2],p1[r+3]);}
  const float m=max2f(a,b);
  auto rr=__builtin_amdgcn_permlane32_swap(__float_as_uint(m),__float_as_uint(m),false,false);
  return max2f(__uint_as_float(rr[0]),__uint_as_float(rr[1]));
}
__device__ __forceinline__ void pv(f32x16*o,int vb,bf16x8 pa0,bf16x8 pa1,bf16x8 pa2,bf16x8 pa3){
  #pragma unroll
  for(int d0=0;d0<2;++d0){s16x4 lo[4],hi[4];
    #pragma unroll
    for(int ks=0;ks<4;++ks){
      asm volatile("ds_read_b64_tr_b16 %0,%1 offset:%c2":"=&v"(lo[ks]):"v"(vb),"i"(d0*4096+ks*1024):"memory");
      asm volatile("ds_read_b64_tr_b16 %0,%1 offset:%c2":"=&v"(hi[ks]):"v"(vb),"i"(d0*4096+ks*1024+512):"memory");}
    asm volatile("s_waitcnt lgkmcnt(0)":::"memory");SBAR();
    #define PK(k) (bf16x8){lo[k][0],lo[k][1],lo[k][2],lo[k][3],hi[k][0],hi[k][1],hi[k][2],hi[k][3]}
    o[d0]=__builtin_amdgcn_mfma_f32_32x32x16_bf16(pa0,PK(0),o[d0],0,0,0);
    o[d0]=__builtin_amdgcn_mfma_f32_32x32x16_bf16(pa1,PK(1),o[d0],0,0,0);
    o[d0]=__builtin_amdgcn_mfma_f32_32x32x16_bf16(pa2,PK(2),o[d0],0,0,0);
    o[d0]=__builtin_amdgcn_mfma_f32_32x32x16_bf16(pa3,PK(3),o[d0],0,0,0);
    #undef PK
  }
}
typedef float f32x4_t __attribute__((ext_vector_type(4)));

#ifndef ATTN_STORE16
#define ATTN_STORE16(p,v) (*(u32x4*)(p)=(v))
#endif
constexpr int FCH=64;
constexpr int F2_CK=LDS_BYTES, FOX2_LDS_BYTES=F2_CK+FCH*64*4;
template<int THRL> __device__ __forceinline__ void fox_unit2(int h,int qb,int jc,float kn,const bf16*Q,const bf16*__restrict__ K,const bf16*__restrict__ V,bf16*O,float*ML,const float*__restrict__ c2h,char*shm,float*qmx){
  int tid=threadIdx.x; asm volatile("":"+v"(tid)); const int lane=tid&63,r32=lane&31,hi=lane>>5; const int wid=__builtin_amdgcn_readfirstlane(tid>>6);
  const long rowbase=0; const int q0=qb*QB;
  const bf16*Qw=Q+(rowbase+q0+wid*QBLK)*DM+h*D;
  const bf16*Kh=K+rowbase*DM+h*D,*Vh=V+rowbase*DM+h*D;
  const unsigned lds0=(unsigned)(uintptr_t)shm;
  float*wsf=(float*)(shm+LDS_WS)+wid*64;
  float*ckl=(float*)(shm+F2_CK);
  const int NTg=(q0+QB)/KVBLK;
  bf16x8 qr[4];
  #pragma unroll
  for(int d0=0;d0<4;++d0)qr[d0]=*reinterpret_cast<const bf16x8*>(&Qw[(long)r32*DM+d0*16+hi*8]);
  bf16x8 kd[4];
  { const bf16*Kd=K+(long)(q0+wid*QBLK+r32)*DM+h*D;
    #pragma unroll
    for(int d0=0;d0<4;++d0)kd[d0]=*reinterpret_cast<const bf16x8*>(&Kd[d0*16+hi*8]); }
  int ts;
  const float cq0_=c2h[q0], cte_=(tid<NTg-4)?c2h[64*tid+63]:0.f;
  { float qs=0.f,dg=0.f;
    #pragma unroll
    for(int d0=0;d0<4;++d0)
      #pragma unroll
      for(int e=0;e<8;++e){ const float v=__builtin_bit_cast(float,(unsigned)(unsigned short)qr[d0][e]<<16); qs+=v*v; dg+=v*__builtin_bit_cast(float,(unsigned)(unsigned short)kd[d0][e]<<16); }
    { auto rr=__builtin_amdgcn_permlane32_swap(__float_as_uint(qs),__float_as_uint(qs),false,false); qs=__uint_as_float(rr[0])+__uint_as_float(rr[1]); }
    { auto rr=__builtin_amdgcn_permlane32_swap(__float_as_uint(dg),__float_as_uint(dg),false,false); dg=__uint_as_float(rr[0])+__uint_as_float(rr[1]); }
    #pragma unroll
    for(int o_=1;o_<32;o_<<=1){ qs=__builtin_fmaxf(qs,__shfl_xor(qs,o_)); dg=__builtin_fminf(dg,__shfl_xor(dg,o_)); }
    if(lane==0){qmx[wid]=qs;qmx[wid-20]=dg;}
    __syncthreads();
    float q2=qmx[0];
    #pragma unroll
    for(int w_=1;w_<8;++w_)q2=__builtin_fmaxf(q2,qmx[w_]);
    float dmin=qmx[-20];
    #pragma unroll
    for(int w_=1;w_<8;++w_)dmin=__builtin_fminf(dmin,qmx[w_-20]);
    const float lim=cq0_+152.05f+sqrtf(q2)*kn-dmin;
    ts=__syncthreads_count((tid<NTg-4)&&(cte_>lim)); ts&=~3; }
  const int t1=NTg-FCH*jc; int t0=t1-FCH; t0=t0<0?0:t0; t0=t0<ts?ts:t0;
  if(t0>=t1){ if(hi==0){ float*mlp=ML+((long)(q0+wid*QBLK+r32)*NHEAD+h)*2; mlp[0]=-1.0e30f; mlp[1]=0.f; } return; }
  const int NT=t1-t0;
  const int NTm=(jc==0)?NT:(1<<20);
  const bf16*ksrc=Kh+(long)(t0*KVBLK+lane)*DM+wid*8;
  const bf16*vsrc=Vh+(long)(t0*KVBLK+16*(wid&3)+(lane>>2))*DM+(wid>>2)*32+(lane&3)*8;
  const unsigned kdst=lds0+LDS_K+wid*1024, vdst=lds0+LDS_V+wid*1024;
  #define DMA_K(t,slot) glds16(ksrc+(long)(t)*KVBLK*DM,(unsigned)__builtin_amdgcn_readfirstlane(kdst+(slot)))
  #define DMA_V(t,slot) glds16(vsrc+(long)(t)*KVBLK*DM,(unsigned)__builtin_amdgcn_readfirstlane(vdst+(slot)))
  const int vb0=(int)(lds0+LDS_V)+((lane>>4)&1)*32+(lane&3)*8+(4*hi+((lane&15)>>2))*64;
  const char*Kbase=shm+LDS_K; bf16x8 kf[8];
  const lds_cptr shm3=(lds_cptr)shm; const lds_cptr kp0=shm3+LDS_K+hi*1024+r32*16; const lds_cptr vp0=shm3+LDS_V+((lane>>4)&1)*32+(lane&3)*8+(4*hi+((lane&15)>>2))*64;
  DMA_K(0,0);DMA_V(0,0);DMA_K(1,SLOTB);
  { const float cref=cq0_; const int nck=NT*64;
    for(int i=tid*4;i<nck;i+=2048){ f32x4_t v=*(const f32x4_t*)(c2h+t0*64+i); v=v-cref; *(f32x4_t*)(ckl+i)=v; } }
  float mhat=0.f,l_reg=0.f;f32x16 o[2];o[0]=f32x16{};o[1]=f32x16{};const f32x16 zc16=f32x16{};
  const int qrel=wid*QBLK+r32;
  #define CMASK(P0,P1,t) do{int jb_=(t)-(NTm-4); if(jb_>=0)cmask(P0,P1,jb_,qrel,hi);}while(0)
  #define BIAS(P0,P1,t) do{ const float*cb_=ckl+(t)*64+4*hi; _Pragma("unroll") for(int g_=0;g_<4;++g_){ const f32x4_t a_=*(const f32x4_t*)(cb_+8*g_), b_=*(const f32x4_t*)(cb_+32+8*g_); _Pragma("unroll") for(int e_=0;e_<4;++e_){P0[4*g_+e_]-=a_[e_];P1[4*g_+e_]-=b_[e_];} SBAR(); } }while(0)
  bool resc=false;
  #define START(P0,P1) do{ const float rm=rowmax(P0,P1); resc=false; \
    { const float dl=rm; mhat=fadd_s(mhat,dl); \
      _Pragma("unroll") for(int r=0;r<16;++r){P0[r]=fsub_s(P0[r],dl);P1[r]=fsub_s(P1[r],dl);} \
      } \
    _Pragma("unroll") for(int r=0;r<16;++r)P0[r]=__builtin_amdgcn_exp2f(P0[r]); }while(0)
  #define RESC() do{ if(resc){ asm volatile("s_waitcnt lgkmcnt(0)":::"memory"); \
      _Pragma("unroll") for(int d_=0;d_<2;++d_) _Pragma("unroll") for(int r=0;r<16;++r)o[d_][r]*=wsf[crow(r,hi)]; } }while(0)
  f32x16 pA0,pA1,pB0,pB1;
  int sl_prev=0,sl_cur=0,sl_next=SLOTB;
  #define ROT() do{sl_prev=sl_cur;sl_cur=sl_next;sl_next=(sl_next==(NSLOT-1)*SLOTB)?0:sl_next+SLOTB;}while(0)
  DMA_K(2,2*SLOTB);
  WAIT_BAR(3);
  qkt(pA0,pA1,Kbase,qr,zc16,r32,hi);asm volatile("s_nop 15\n\ts_nop 7":"+v"(pA0),"+v"(pA1));BIAS(pA0,pA1,0);CMASK(pA0,pA1,0);
  START(pA0,pA1);
  _Pragma("unroll") for(int r=0;r<16;++r)pA1[r]=__builtin_amdgcn_exp2f(pA1[r]);
  #define PFG(X0,X1,tn,k) do{ const f32x4_t a_=*(const f32x4_t*)(ckl+(tn)*64+4*hi+(((k)<4)?8*(k):32+8*((k)-4))); const float nm_=-mhat; \
      if((k)<4){ X0[4*(k)]=nm_-a_[0]; X0[4*(k)+1]=nm_-a_[1]; X0[4*(k)+2]=nm_-a_[2]; X0[4*(k)+3]=nm_-a_[3]; } \
      else { X1[4*((k)-4)]=nm_-a_[0]; X1[4*((k)-4)+1]=nm_-a_[1]; X1[4*((k)-4)+2]=nm_-a_[2]; X1[4*((k)-4)+3]=nm_-a_[3]; } }while(0)
  { PFG(pB0,pB1,1,0);PFG(pB0,pB1,1,1);PFG(pB0,pB1,1,2);PFG(pB0,pB1,1,3);PFG(pB0,pB1,1,4);PFG(pB0,pB1,1,5);PFG(pB0,pB1,1,6);PFG(pB0,pB1,1,7); }
  WAIT_BAR(0);
  DMA_K(3,0);DMA_V(1,SLOTB);
  ROT();
  kload8(kf,kp0+sl_cur);
  WAIT_BAR(2);
  s16x4 vlo[8],vhi[8]; u32x4 pw0,pw1,pw2,pw3;
  #define PKW(P,B) cvtpk_s(P[B],P[B+1])
  #define PAF(k) __builtin_bit_cast(bf16x8,pw##k)
  #define VFR(i) (bf16x8){vlo[i][0],vlo[i][1],vlo[i][2],vlo[i][3],vhi[i][0],vhi[i][1],vhi[i][2],vhi[i][3]}
  #define PIN(x) asm volatile("":"+v"(x))
  #define MX3(a,b,c) __builtin_fmaxf(__builtin_fmaxf((a),(b)),(c))
  #define GAPA(MF,A0,A1,A2,A3,W0,W1,PW) do{ MF; sacc+=A0; sacc+=A1; sacc+=A2; sacc+=A3; PIN(sacc); W0; W1; PIN(PW); SBAR(); }while(0)
  #define EX(v) __builtin_amdgcn_exp2f(v)
  #define GAPB(MF,X,B,PF) do{ MF; PF; X[B]=EX(X[B]); X[B+1]=EX(X[B+1]); X[B+2]=EX(X[B+2]); X[B+3]=EX(X[B+3]); PIN(X); SBAR(); }while(0)
  #define PFN(G,X0,X1,tt,k) do{ if(G){ PFG(X0,X1,(tt)+1,k); } }while(0)
  #define VRD(i) do{ vlo[i]=vtr(vp_+(((i)>>2)*4096+((i)&3)*1024)); vhi[i]=vtr(vp_+(((i)>>2)*4096+((i)&3)*1024+512)); }while(0)
  #define KRD(G,j) do{ if(G){ kload2(kf,kp0+sl_next,j); SBAR(); } }while(0)
  #define STEP(C0,C1,P0,P1,t,GK,GV,GL) do{ SBAR(); \
    const lds_cptr vp_=vp0+sl_prev; \
    VRD(0); SBAR(); float sacc=(P0[0]+P0[1]); \
    GAPA(C0=__builtin_amdgcn_mfma_f32_32x32x16_bf16(kf[0],qr[0],C0,0,0,0), P0[2],P0[3],P0[4],P0[5],     pw0[0]=PKW(P0,0), pw0[1]=PKW(P0,2), pw0); \
    VRD(4); SBAR(); GAPA(C1=__builtin_amdgcn_mfma_f32_32x32x16_bf16(kf[1],qr[0],C1,0,0,0), P0[6],P0[7],P0[8],P0[9],     pw0[2]=PKW(P0,4), pw0[3]=PKW(P0,6), pw0); \
    VRD(1); SBAR(); GAPA(C0=__builtin_amdgcn_mfma_f32_32x32x16_bf16(kf[2],qr[1],C0,0,0,0),   P0[10],P0[11],P0[12],P0[13], pw1[0]=PKW(P0,8), pw1[1]=PKW(P0,10), pw1); \
    VRD(5); SBAR(); GAPA(C1=__builtin_amdgcn_mfma_f32_32x32x16_bf16(kf[3],qr[1],C1,0,0,0),   P0[14],P0[15],P1[0],P1[1],   pw1[2]=PKW(P0,12),pw1[3]=PKW(P0,14), pw1); \
    VRD(2); SBAR(); GAPA(C0=__builtin_amdgcn_mfma_f32_32x32x16_bf16(kf[4],qr[2],C0,0,0,0),   P1[2],P1[3],P1[4],P1[5],     pw2[0]=PKW(P1,0), pw2[1]=PKW(P1,2), pw2); \
    VRD(6); SBAR(); GAPA(C1=__builtin_amdgcn_mfma_f32_32x32x16_bf16(kf[5],qr[2],C1,0,0,0),   P1[6],P1[7],P1[8],P1[9],     pw2[2]=PKW(P1,4), pw2[3]=PKW(P1,6), pw2); \
    VRD(3); SBAR(); GAPA(C0=__builtin_amdgcn_mfma_f32_32x32x16_bf16(kf[6],qr[3],C0,0,0,0),   P1[10],P1[11],P1[12],P1[13], pw3[0]=PKW(P1,8), pw3[1]=PKW(P1,10), pw3); \
    VRD(7); SBAR(); GAPA(C1=__builtin_amdgcn_mfma_f32_32x32x16_bf16(kf[7],qr[3],C1,0,0,0),   P1[14],P1[15],0.f,0.f,       pw3[2]=PKW(P1,12),pw3[3]=PKW(P1,14), pw3); \
    l_reg+=sacc; \
    if(GK){DMA_K((t)+3,sl_cur);} if(GV){DMA_V((t)+1,sl_next);} \
    CMASK(C0,C1,t); \
    { float a=MX3(C0[0],C0[1],C1[0]),b=MX3(C0[2],C0[3],C1[1]); a=MX3(a,C1[2],C1[3]); \
      _Pragma("unroll") for(int r=4;r<16;r+=4){a=MX3(a,C0[r],C0[r+1]);b=MX3(b,C0[r+2],C0[r+3]);a=MX3(a,C1[r],C1[r+1]);b=MX3(b,C1[r+2],C1[r+3]);} \
      float rm=__builtin_fmaxf(a,b); { auto rr=__builtin_amdgcn_permlane32_swap(__float_as_uint(rm),__float_as_uint(rm),false,false); rm=__builtin_fmaxf(__uint_as_float(rr[0]),__uint_as_float(rr[1])); } \
      resc=false; \
      if(__builtin_expect(__any(rm>(float)THRL),0)){ const float dl=__builtin_fmaxf(rm,0.f); mhat+=dl; \
        _Pragma("unroll") for(int r=0;r<16;++r){C0[r]-=dl;C1[r]-=dl;} \
        const float f=__builtin_amdgcn_exp2f(-dl); l_reg*=f; if(hi==0)wsf[r32]=f; resc=true; } } \
    SBAR(); \
    GAPB(o[0]=__builtin_amdgcn_mfma_f32_32x32x16_bf16(PAF(0),VFR(0),o[0],0,0,0), C0,0, PFN(GL,P0,P1,t,0)); \
    GAPB(o[1]=__builtin_amdgcn_mfma_f32_32x32x16_bf16(PAF(0),VFR(4),o[1],0,0,0), C0,4, PFN(GL,P0,P1,t,1)); \
    KRD(GL,0); GAPB(o[0]=__builtin_amdgcn_mfma_f32_32x32x16_bf16(PAF(1),VFR(1),o[0],0,0,0), C0,8, PFN(GL,P0,P1,t,2)); \
    KRD(GL,1); GAPB(o[1]=__builtin_amdgcn_mfma_f32_32x32x16_bf16(PAF(1),VFR(5),o[1],0,0,0), C0,12, PFN(GL,P0,P1,t,3)); \
    KRD(GL,2); GAPB(o[0]=__builtin_amdgcn_mfma_f32_32x32x16_bf16(PAF(2),VFR(2),o[0],0,0,0), C1,0, PFN(GL,P0,P1,t,4)); \
    KRD(GL,3); GAPB(o[1]=__builtin_amdgcn_mfma_f32_32x32x16_bf16(PAF(2),VFR(6),o[1],0,0,0), C1,4, PFN(GL,P0,P1,t,5)); \
    GAPB(o[0]=__builtin_amdgcn_mfma_f32_32x32x16_bf16(PAF(3),VFR(3),o[0],0,0,0), C1,8, PFN(GL,P0,P1,t,6)); \
    GAPB(o[1]=__builtin_amdgcn_mfma_f32_32x32x16_bf16(PAF(3),VFR(7),o[1],0,0,0), C1,12, PFN(GL,P0,P1,t,7)); \
    }while(0)
  int t=1;
  #undef CMASK
  #define CMASK(P0,P1,t) do{}while(0)
  for(;t+5<NT;t+=2){
    STEP(pB0,pB1,pA0,pA1,t,true,true,true);     WAIT_BAR(2); RESC(); ROT();
    STEP(pA0,pA1,pB0,pB1,t+1,true,true,true);   WAIT_BAR(2); RESC(); ROT();
  }
  #undef CMASK
  #define CMASK(P0,P1,t) do{int jb_=(t)-(NTm-4); if(jb_>=0)cmask(P0,P1,jb_,qrel,hi);}while(0)
  #define ENDW(tt) do{ if((tt)+3<NT){WAIT_BAR(2);} else if((tt)+2<NT){WAIT_BAR(1);} else {WAIT_BAR(0);} }while(0)
  for(;t+1<NT;t+=2){
    STEP(pB0,pB1,pA0,pA1,t,(t+3<NT),(t+1<NT),(t+1<NT));       ENDW(t);   RESC(); ROT();
    STEP(pA0,pA1,pB0,pB1,t+1,(t+4<NT),(t+2<NT),(t+2<NT));     ENDW(t+1); RESC(); ROT();
  }
  STEP(pB0,pB1,pA0,pA1,NT-1,false,false,false); RESC();
  { float sacc=pB0[0]+pB0[1]; _Pragma("unroll") for(int r=2;r<16;++r)sacc+=pB0[r]; _Pragma("unroll") for(int r=0;r<16;++r)sacc+=pB1[r]; l_reg+=sacc;
    pw0=(u32x4){PKW(pB0,0),PKW(pB0,2),PKW(pB0,4),PKW(pB0,6)};pw1=(u32x4){PKW(pB0,8),PKW(pB0,10),PKW(pB0,12),PKW(pB0,14)};pw2=(u32x4){PKW(pB1,0),PKW(pB1,2),PKW(pB1,4),PKW(pB1,6)};pw3=(u32x4){PKW(pB1,8),PKW(pB1,10),PKW(pB1,12),PKW(pB1,14)};
    SBAR(); pv(o,vb0+sl_cur,PAF(0),PAF(1),PAF(2),PAF(3)); }
  #undef PKW
  #undef PAF
  #undef VFR
  #undef PIN
  #undef MX3
  #undef GAPA
  #undef GAPB
  #undef PFN
  #undef PFG
  #undef EX
  #undef VRD
  #undef KRD
  #undef STEP
  #undef ENDW
  {auto rr=__builtin_amdgcn_permlane32_swap(__float_as_uint(l_reg),__float_as_uint(l_reg),false,false);l_reg=__uint_as_float(rr[0])+__uint_as_float(rr[1]);}
  if(hi==0){ wsf[32+r32]=l_reg; float*mlp=ML+((long)(q0+wid*QBLK+r32)*NHEAD+h)*2; mlp[0]=mhat; mlp[1]=l_reg; } asm volatile("s_waitcnt lgkmcnt(0)":::"memory");
  float rli[16];
  #pragma unroll
  for(int r=0;r<16;++r)rli[r]=__builtin_amdgcn_rcpf(wsf[32+crow(r,hi)]);
  bf16*Ow=O+(rowbase+q0+wid*QBLK)*DM+h*D;
  { bf16*stg=(bf16*)(shm+LDS_OST)+wid*2048;
    #pragma unroll
    for(int r=0;r<16;++r){const int orow=crow(r,hi);
      #pragma unroll
      for(int d0=0;d0<2;++d0)stg[orow*64+d0*32+r32]=__float2bfloat16(o[d0][r]*rli[r]);}
    asm volatile("s_waitcnt lgkmcnt(0)":::"memory");
    #pragma unroll
    for(int i=0;i<4;++i){const int row=i*8+(lane>>3),ch=lane&7; const u32x4 v=*(const u32x4*)(stg+row*64+ch*8); ATTN_STORE16(Ow+(long)row*DM+ch*8,v);} }
  asm volatile("s_waitcnt lgkmcnt(0)\n\ts_barrier":::"memory");
  #undef DMA_K
  #undef DMA_V
  #undef CMASK
  #undef BIAS
  #undef START
  #undef RESC
  #undef ROT
}

#undef SBAR
#undef WAIT_BAR
}
namespace cg = cooperative_groups;
constexpr int S_ = 16384, DMOD = 1024, NL = 4, DIN = 2568, NIN = 2816, DFF = 2816, NGU = 5632, NHD = 8;
constexpr float EPSN = 1e-6f;
constexpr size_t MiB = 1u << 20;
constexpr size_t WS_CTL = 0, CTL_BYTES = 65536;
constexpr size_t WS_WIN = 2 * MiB;
constexpr size_t WS_WOUT = 24 * MiB;
constexpr size_t WS_WGU = 32 * MiB;
constexpr size_t WS_WD = 76 * MiB;
constexpr size_t WS_XB = 98 * MiB;
constexpr size_t WS_RSSM = 130 * MiB;
constexpr size_t WS_RSSF = 130 * MiB + 128 * 1024;
constexpr size_t WS_LOGF = 130 * MiB + 256 * 1024;
constexpr size_t WS_C2 = 131 * MiB;
constexpr size_t WS_QKVZ = 132 * MiB;
constexpr size_t WS_O = 212 * MiB;
constexpr size_t WS_MG = 228 * MiB;
constexpr size_t WS_H = 132 * MiB;
constexpr size_t WS_OP = 260 * MiB;
constexpr size_t WS_ML = 308 * MiB;
constexpr size_t WS_END = 312 * MiB;
static_assert(WS_H + (size_t)S_ * DFF * 2 <= WS_MG, "h overlay");
constexpr int LDS_BYTES = 147456;
constexpr int CW_KMAX = 8192, CW_BAR = 9216, CW_SGUQ = 13312, CW_TS = 14336, CW_FCNT = 14400;
constexpr int NPHASE = 2 + 6 * NL;

#define LAS __attribute__((address_space(3)))
typedef unsigned short bf16r;
typedef unsigned v4u __attribute__((ext_vector_type(4)));
typedef float f32x4 __attribute__((ext_vector_type(4)));
typedef float f32x16 __attribute__((ext_vector_type(16)));
typedef short bf16x8 __attribute__((ext_vector_type(8)));
#define LDS_WAIT() asm volatile("s_waitcnt lgkmcnt(0)" ::: "memory")
__device__ __forceinline__ unsigned f2bf(float f) { unsigned u = __builtin_bit_cast(unsigned, f); return (u + 0x7fffu + ((u >> 16) & 1u)) >> 16; }
__device__ __forceinline__ unsigned pk2(float lo, float hi) { return f2bf(lo) | (f2bf(hi) << 16); }
__device__ __forceinline__ float bflo(unsigned w) { return __builtin_bit_cast(float, w << 16); }
__device__ __forceinline__ float bfhi(unsigned w) { return __builtin_bit_cast(float, w & 0xffff0000u); }
__device__ __forceinline__ float bf1(bf16r w) { return __builtin_bit_cast(float, (unsigned)w << 16); }
#define DPPF(v, ctrl) __builtin_bit_cast(float, __builtin_amdgcn_update_dpp(0, __builtin_bit_cast(int, (v)), (ctrl), 0xf, 0xf, true))
__device__ __forceinline__ float row16_sum(float v) {
    v += DPPF(v, 0xB1); v += DPPF(v, 0x4E); v += DPPF(v, 0x141); v += DPPF(v, 0x140); return v;
}
__device__ __forceinline__ float wave_sum(float v) {
    v += DPPF(v, 0xB1); v += DPPF(v, 0x4E); v += DPPF(v, 0x141); v += DPPF(v, 0x140);
    const int iv = __builtin_bit_cast(int, v);
    const float s0 = __builtin_bit_cast(float, __builtin_amdgcn_readlane(iv, 0)), s1 = __builtin_bit_cast(float, __builtin_amdgcn_readlane(iv, 16)),
                s2 = __builtin_bit_cast(float, __builtin_amdgcn_readlane(iv, 32)), s3 = __builtin_bit_cast(float, __builtin_amdgcn_readlane(iv, 48));
    return (s0 + s1) + (s2 + s3);
}
constexpr int PREP_P = 132;
__device__ __forceinline__ void prep_item(const float* W, int ldw, int srccol, const float* gs, bf16r* WT, int K, int dstrow, int k0, LAS float* scr, int lane) {
#pragma unroll 8
    for (int i = 0; i < 16; ++i) { const int kk = 2 * i + (lane >> 5); f32x4 w = *(const f32x4*)(W + (size_t)(k0 + kk) * ldw + srccol + 4 * (lane & 31)); if (gs) w = w * gs[k0 + kk];
        *(LAS f32x4*)(scr + kk * PREP_P + 4 * (lane & 31)) = w; }
    LDS_WAIT(); asm volatile("" ::: "memory");
    const int c = lane & 3;
#pragma unroll
    for (int j = 0; j < 8; ++j) { const int n = (lane >> 2) + 16 * j; const LAS float* s = scr + (8 * c) * PREP_P + n;
        v4u o; o.x = pk2(s[0 * PREP_P], s[1 * PREP_P]); o.y = pk2(s[2 * PREP_P], s[3 * PREP_P]); o.z = pk2(s[4 * PREP_P], s[5 * PREP_P]); o.w = pk2(s[6 * PREP_P], s[7 * PREP_P]);
        *(v4u*)(WT + (size_t)(dstrow + n) * K + k0 + 8 * c) = o; }
    LDS_WAIT(); asm volatile("" ::: "memory");
}
template <int OFF> __device__ __forceinline__ unsigned long long ldk() {
    unsigned long long v; auto ka = __builtin_amdgcn_kernarg_segment_ptr();
    asm volatile("s_load_dwordx2 %0, %1, %2\n\ts_waitcnt lgkmcnt(0)" : "=s"(v) : "s"(ka), "i"(OFF) : "memory");
    return v;
}
struct Ptrs {
    const float *x, *mixg, *w_in, *b_f, *lng, *lnb, *w_s, *b_s, *outg, *w_out, *ffng, *w_gu, *w_d, *fing;
    float* out; unsigned char* ws;
};
__device__ __forceinline__ void phase_prep(const Ptrs& P, LAS unsigned char* lds, int l0, int l1, int gw, int NGW, int wave, int lane) {
    LAS float* scr = (LAS float*)(lds + wave * (32 * PREP_P * 4));
    bf16r* WinT = (bf16r*)(P.ws + WS_WIN); bf16r* WoutT = (bf16r*)(P.ws + WS_WOUT); bf16r* WguT = (bf16r*)(P.ws + WS_WGU); bf16r* WdT = (bf16r*)(P.ws + WS_WD);
    constexpr int I_IN = 32 * 20, I_OUT = 32 * 8, I_GU = 32 * 44, I_D = 88 * 8, I_L = I_IN + I_OUT + I_GU + I_D;
    for (int it = l0 * I_L + gw; it < l1 * I_L; it += NGW) {
        const int l = it / I_L; int r = it % I_L;
        if (r < I_IN) { const int kb = r / 20, nb = r % 20, n0 = 128 * nb, src = n0 < 1536 ? n0 : n0 + 8;
            prep_item(P.w_in + (size_t)l * DMOD * DIN, DIN, src, P.mixg + l * DMOD, WinT + (size_t)l * NIN * DMOD, DMOD, n0, 32 * kb, scr, lane); continue; }
        r -= I_IN;
        if (r < I_OUT) { const int kb = r / 8, nb = r % 8;
            prep_item(P.w_out + (size_t)l * DMOD * DMOD, DMOD, 128 * nb, P.outg + l * DMOD, WoutT + (size_t)l * DMOD * DMOD, DMOD, 128 * nb, 32 * kb, scr, lane); continue; }
        r -= I_OUT;
        if (r < I_GU) { const int kb = r / 44, nb = r % 44, n0 = 128 * nb, pn = n0 >> 8, src = (n0 & 255) == 0 ? 128 * pn : DFF + 128 * pn;
            prep_item(P.w_gu + (size_t)l * DMOD * NGU, NGU, src, P.ffng + l * DMOD, WguT + (size_t)l * NGU * DMOD, DMOD, n0, 32 * kb, scr, lane); continue; }
        r -= I_GU;
        { const int kb = r / 8, nb = r % 8;
            prep_item(P.w_d + (size_t)l * DFF * DMOD, DMOD, 128 * nb, nullptr, WdT + (size_t)l * DMOD * DFF, DFF, 128 * nb, 32 * kb, scr, lane); }
    }
    for (int idx = l0 * 262144 + gw * 64 + lane; idx < l1 * 262144; idx += NGW * 64) { const int l = idx >> 18, rr = (idx >> 10) & 255, k = idx & 1023; unsigned v = 0u;
        if ((rr & 127) < 8) { const float w = P.w_in[((size_t)l * DMOD + k) * DIN + 1536 + (rr & 7)] * P.mixg[l * DMOD + k]; const unsigned hb = f2bf(w);
            v = rr < 128 ? hb : f2bf(w - __builtin_bit_cast(float, hb << 16)); }
        WinT[((size_t)l * NIN + 2560 + rr) * DMOD + k] = (bf16r)v; }
}
template <int MODE>
__device__ __forceinline__ void phase_rowstats(const float* xin, bf16r* xb, unsigned long long* rss_out, const float* gfin, float* outp, int gw, int NGW, int lane, float tdelta = 0.f) {
#pragma unroll 2
    for (int m = gw; m < S_; m += NGW) {
        const f32x4* xr = (const f32x4*)(xin + (size_t)m * DMOD) + lane;
        f32x4 v[4]; float s = 0.f;
#pragma unroll
        for (int j = 0; j < 4; ++j) { v[j] = xr[64 * j]; s += (v[j].x * v[j].x + v[j].y * v[j].y) + (v[j].z * v[j].z + v[j].w * v[j].w); }
        const float tot = wave_sum(s);
        if (MODE == 2) {
            const float rs = 1.0f / sqrtf(tot * (1.0f / DMOD) + EPSN);
            f32x4* orow = (f32x4*)(outp + (size_t)m * DMOD) + lane; const f32x4* gr = (const f32x4*)gfin + lane;
#pragma unroll
            for (int j = 0; j < 4; ++j) orow[64 * j] = v[j] * rs * gr[64 * j] + (m < 1024 ? tdelta : 0.f);
        } else {
            unsigned long long* o8 = (unsigned long long*)(xb + (size_t)m * DMOD) + lane;
#pragma unroll
            for (int j = 0; j < 4; ++j) o8[64 * j] = (unsigned long long)pk2(v[j].x, v[j].y) | ((unsigned long long)pk2(v[j].z, v[j].w) << 32);
            if (lane == 0) rss_out[m] = (unsigned long long)__float2ull_rn(tot * 16777216.0f);
        }
    }
}
__device__ __forceinline__ void final_norm(const bf16r* xb, const unsigned long long* rss, const float* g, float* outp, int gw, int NGW, int lane) {
#pragma unroll 2
    for (int m = gw; m < S_; m += NGW) {
        const v4u a = *(const v4u*)(xb + (size_t)m * DMOD + 8 * lane), b = *(const v4u*)(xb + (size_t)m * DMOD + 512 + 8 * lane);
        const float rs = 1.0f / sqrtf((float)rss[m] * (1.0f / (1024.0f * 16777216.0f)) + EPSN);
        const f32x4* gr = (const f32x4*)g; f32x4* orow = (f32x4*)(outp + (size_t)m * DMOD);
        const f32x4 g0 = gr[2 * lane], g1 = gr[2 * lane + 1], g2 = gr[128 + 2 * lane], g3 = gr[128 + 2 * lane + 1];
        orow[2 * lane] = (f32x4){bflo(a.x), bfhi(a.x), bflo(a.y), bfhi(a.y)} * rs * g0; orow[2 * lane + 1] = (f32x4){bflo(a.z), bfhi(a.z), bflo(a.w), bfhi(a.w)} * rs * g1;
        orow[128 + 2 * lane] = (f32x4){bflo(b.x), bfhi(b.x), bflo(b.y), bfhi(b.y)} * rs * g2; orow[128 + 2 * lane + 1] = (f32x4){bflo(b.z), bfhi(b.z), bflo(b.w), bfhi(b.w)} * rs * g3;
    }
}
__device__ __forceinline__ void cumsum_head(const float* logf, float* c2, int h, LAS unsigned char* lds, int tid) {
    LAS double* scr = (LAS double*)lds;
    const f32x4* src = (const f32x4*)(logf + (size_t)h * S_ + tid * 32);
    f32x4 v[8]; double sum = 0.0;
#pragma unroll
    for (int e = 0; e < 8; ++e) { v[e] = src[e]; sum += ((double)v[e].x + (double)v[e].y) + ((double)v[e].z + (double)v[e].w); }
    scr[tid] = sum; __syncthreads();
    double pre = 0.0; for (int i = 0; i < tid; ++i) pre += scr[i];
    f32x4* dst = (f32x4*)(c2 + (size_t)h * S_ + tid * 32);
#pragma unroll
    for (int e = 0; e < 8; ++e) { f32x4 o; pre += (double)v[e].x; o.x = (float)(pre * 1.4426950408889634); pre += (double)v[e].y; o.y = (float)(pre * 1.4426950408889634);
        pre += (double)v[e].z; o.z = (float)(pre * 1.4426950408889634); pre += (double)v[e].w; o.w = (float)(pre * 1.4426950408889634); dst[e] = o; }
    __syncthreads();
}
__device__ __forceinline__ void sgu_item(int c, const bf16r* ZU, const bf16r* ZV, bf16r* MG, const float* lng, const float* lnb, const float* wsl, const float* bsl,
                                         LAS unsigned char* lds, int wid, int lane) {
    LAS float* bsb = (LAS float*)lds;
    LAS bf16r* zt = (LAS bf16r*)(lds + 4096);
    const int r32 = lane & 31, hi = lane >> 5, g = wid, tid = wid * 64 + lane;
    bsb[tid] = bsl[tid]; bsb[tid + 512] = bsl[tid + 512];
    const int rs4 = lane >> 4, l16 = lane & 15;
#pragma unroll 2
    for (int it = 0; it < 4; ++it) { const int i = 16 * wid + 4 * it + rs4; const size_t row = (size_t)c * 128 + i;
        v4u zr[4];
#pragma unroll
        for (int j = 0; j < 4; ++j) zr[j] = *(const v4u*)(ZV + row * 512 + 128 * j + 8 * l16);
        float z[32]; float s = 0.f;
#pragma unroll
        for (int j = 0; j < 4; ++j) { z[8 * j] = bflo(zr[j].x); z[8 * j + 1] = bfhi(zr[j].x); z[8 * j + 2] = bflo(zr[j].y); z[8 * j + 3] = bfhi(zr[j].y); z[8 * j + 4] = bflo(zr[j].z); z[8 * j + 5] = bfhi(zr[j].z); z[8 * j + 6] = bflo(zr[j].w); z[8 * j + 7] = bfhi(zr[j].w); }
#pragma unroll
        for (int e = 0; e < 32; ++e) s += z[e];
        const float mean = row16_sum(s) * (1.0f / 512.0f); float q = 0.f;
#pragma unroll
        for (int e = 0; e < 32; ++e) { z[e] -= mean; q += z[e] * z[e]; }
        const float rstd = 1.0f / sqrtf(row16_sum(q) * (1.0f / 512.0f) + EPSN);
#pragma unroll
        for (int j = 0; j < 4; ++j) { const f32x4 g0 = *(const f32x4*)(lng + 128 * j + 8 * l16), g1 = *(const f32x4*)(lng + 128 * j + 8 * l16 + 4), b0 = *(const f32x4*)(lnb + 128 * j + 8 * l16), b1 = *(const f32x4*)(lnb + 128 * j + 8 * l16 + 4);
            v4u zw; zw.x = pk2(z[8 * j] * rstd * g0.x + b0.x, z[8 * j + 1] * rstd * g0.y + b0.y); zw.y = pk2(z[8 * j + 2] * rstd * g0.z + b0.z, z[8 * j + 3] * rstd * g0.w + b0.w);
            zw.z = pk2(z[8 * j + 4] * rstd * g1.x + b1.x, z[8 * j + 5] * rstd * g1.y + b1.y); zw.w = pk2(z[8 * j + 6] * rstd * g1.z + b1.z, z[8 * j + 7] * rstd * g1.w + b1.w);
            *(LAS v4u*)(zt + i * 512 + 128 * j + 8 * l16) = zw; }
    }
    LDS_WAIT(); __syncthreads();
#pragma unroll 1
    for (int ni = 0; ni < 2; ++ni) {
        const int d = 64 * g + 32 * ni + r32;
        bf16x8 bfr[8];
#pragma unroll
        for (int ks = 0; ks < 8; ++ks) { const LAS bf16r* zp = zt + (16 * ks + 8 * hi) * 512 + d;
            v4u w; w.x = (unsigned)zp[0] | ((unsigned)zp[512] << 16); w.y = (unsigned)zp[1024] | ((unsigned)zp[1536] << 16); w.z = (unsigned)zp[2048] | ((unsigned)zp[2560] << 16); w.w = (unsigned)zp[3072] | ((unsigned)zp[3584] << 16);
            bfr[ks] = __builtin_bit_cast(bf16x8, w); }
        LDS_WAIT(); asm volatile("" ::: "memory");
        f32x16 acc[4];
#pragma unroll
        for (int mi = 0; mi < 4; ++mi) { acc[mi] = f32x16{};
#pragma unroll
            for (int ks = 0; ks < 8; ++ks) { if (mi < 2 && ks >= 4) continue;
                const float* wp = wsl + ((size_t)g * 128 + 32 * mi + r32) * 128 + 16 * ks + 8 * hi; const f32x4 a0 = *(const f32x4*)wp, a1 = *(const f32x4*)(wp + 4);
                v4u w; w.x = pk2(a0.x, a0.y); w.y = pk2(a0.z, a0.w); w.z = pk2(a1.x, a1.y); w.w = pk2(a1.z, a1.w);
                acc[mi] = __builtin_amdgcn_mfma_f32_32x32x16_bf16(__builtin_bit_cast(bf16x8, w), bfr[ks], acc[mi], 0, 0, 0); }
            asm volatile("" ::: "memory"); }
#pragma unroll
        for (int mi = 0; mi < 4; ++mi)
#pragma unroll
            for (int r = 0; r < 16; ++r) { const int i = 32 * mi + (r & 3) + 8 * (r >> 2) + 4 * hi;
                zt[i * 512 + d] = (bf16r)f2bf(acc[mi][r] + bsb[g * 128 + i]); }
        LDS_WAIT(); asm volatile("" ::: "memory");
    }
    __syncthreads();
#pragma unroll 2
    for (int it = 0; it < 4; ++it) { const int i = 16 * wid + 4 * it + rs4; const size_t row = (size_t)c * 128 + i;
        float a[32]; float ss = 0.f;
#pragma unroll
        for (int j = 0; j < 4; ++j) { const v4u tr = *(const LAS v4u*)(zt + i * 512 + 128 * j + 8 * l16); const v4u ur = *(const v4u*)(ZU + row * 512 + 128 * j + 8 * l16);
            a[8 * j] = bflo(tr.x) * bflo(ur.x); a[8 * j + 1] = bfhi(tr.x) * bfhi(ur.x); a[8 * j + 2] = bflo(tr.y) * bflo(ur.y); a[8 * j + 3] = bfhi(tr.y) * bfhi(ur.y);
            a[8 * j + 4] = bflo(tr.z) * bflo(ur.z); a[8 * j + 5] = bfhi(tr.z) * bfhi(ur.z); a[8 * j + 6] = bflo(tr.w) * bflo(ur.w); a[8 * j + 7] = bfhi(tr.w) * bfhi(ur.w); }
#pragma unroll
        for (int e = 0; e < 32; ++e) ss += a[e] * a[e];
        const float ra = 1.0f / sqrtf(row16_sum(ss) * (1.0f / 512.0f) + EPSN);
#pragma unroll
        for (int j = 0; j < 4; ++j) { v4u w; w.x = pk2(a[8 * j] * ra, a[8 * j + 1] * ra); w.y = pk2(a[8 * j + 2] * ra, a[8 * j + 3] * ra); w.z = pk2(a[8 * j + 4] * ra, a[8 * j + 5] * ra); w.w = pk2(a[8 * j + 6] * ra, a[8 * j + 7] * ra);
            *(v4u*)(MG + row * 1024 + 512 + 128 * j + 8 * l16) = w; }
    }
    LDS_WAIT(); __syncthreads();
}
__device__ __forceinline__ void combine_item(int c, const bf16r* O, const bf16r* OP1, const float* ML, bf16r* MG, int wid, int lane) {
    const int rs4 = lane >> 4, l16 = lane & 15;
#pragma unroll
    for (int it = 0; it < 2; ++it) { const size_t row = (size_t)c * 64 + 8 * wid + 4 * it + rs4; const int nch = ((int)(row >> 12)) + 1;
        float a[32]; float ss = 0.f;
#pragma unroll
        for (int j = 0; j < 4; ++j) { const int hh = 2 * j + (l16 >> 3); float Mj[4], lj[4]; v4u oj[4];
#pragma unroll
            for (int q = 0; q < 4; ++q) { if (q < nch) { const float* mlp = ML + (size_t)q * S_ * 16 + (row * 8 + hh) * 2; Mj[q] = mlp[0]; lj[q] = mlp[1];
                    oj[q] = (q == 0 || lj[q] > 0.f) ? *(const v4u*)((q == 0 ? O : OP1 + (size_t)(q - 1) * S_ * 512) + row * 512 + 128 * j + 8 * l16) : (v4u){0u, 0u, 0u, 0u}; } else { Mj[q] = -1.0e30f; lj[q] = 0.f; oj[q] = (v4u){0u, 0u, 0u, 0u}; } }
            const float Mmax = fmaxf(fmaxf(Mj[0], Mj[1]), fmaxf(Mj[2], Mj[3])); float wsum = 0.f; float t[8] = {0.f, 0.f, 0.f, 0.f, 0.f, 0.f, 0.f, 0.f};
#pragma unroll
            for (int q = 0; q < 4; ++q) { const float w = lj[q] > 0.f ? lj[q] * __builtin_amdgcn_exp2f(Mj[q] - Mmax) : 0.f; wsum += w;
                if (w > 0.f) { t[0] += w * bflo(oj[q].x); t[1] += w * bfhi(oj[q].x); t[2] += w * bflo(oj[q].y); t[3] += w * bfhi(oj[q].y); t[4] += w * bflo(oj[q].z); t[5] += w * bfhi(oj[q].z); t[6] += w * bflo(oj[q].w); t[7] += w * bfhi(oj[q].w); } }
            const float iw = 1.0f / wsum;
#pragma unroll
            for (int e = 0; e < 8; ++e) { a[8 * j + e] = t[e] * iw; ss += a[8 * j + e] * a[8 * j + e]; } }
        const float ra = 1.0f / sqrtf(row16_sum(ss) * (1.0f / 512.0f) + EPSN);
#pragma unroll
        for (int j = 0; j < 4; ++j) { v4u w; w.x = pk2(a[8 * j] * ra, a[8 * j + 1] * ra); w.y = pk2(a[8 * j + 2] * ra, a[8 * j + 3] * ra); w.z = pk2(a[8 * j + 4] * ra, a[8 * j + 5] * ra); w.w = pk2(a[8 * j + 6] * ra, a[8 * j + 7] * ra);
            *(v4u*)(MG + row * 1024 + 128 * j + 8 * l16) = w; }
    }
}
#define XB_TMO      128
#define XB_XCNT(j)  (256  + 64 * (j))
#define XB_XSUB(j)  (1280 + 64 * (j))
#define XB_XGEN(j)  (2304 + 64 * (j))
#define XB_TOP      3328
#define XB_TOPGEN   3392
#define XCD_BAR_WORDS 3456
#define XB_SPIN_CAP (1u << 18)

__device__ __forceinline__ unsigned xb_ld(unsigned* p)              { return __hip_atomic_load(p, __ATOMIC_RELAXED, __HIP_MEMORY_SCOPE_AGENT); }
__device__ __forceinline__ unsigned xb_add(unsigned* p, unsigned v) { return __hip_atomic_fetch_add(p, v, __ATOMIC_RELAXED, __HIP_MEMORY_SCOPE_AGENT); }
__device__ __forceinline__ unsigned xb_xcc_id() { return (unsigned)__builtin_amdgcn_s_getreg((3 << 11) | 20) & 0xFu; }
#define XB_SPIN(cond, bar) do { unsigned _sp = 0; while (cond) { __builtin_amdgcn_s_sleep(1); \
    if ((++_sp & 255u) == 0u) { if (xb_ld(&(bar)[XB_TMO])) break; if (_sp > XB_SPIN_CAP) { atomicAdd(&(bar)[XB_TMO], 1u); break; } } } } while (0)

struct XcdBarrier {
    unsigned* bar; unsigned x;
    volatile LAS unsigned* st;
};

__device__ __forceinline__ XcdBarrier xcd_barrier_post(unsigned* bar, volatile LAS unsigned* st) {
    XcdBarrier b; b.bar = bar; b.x = xb_xcc_id(); b.st = st;
    if (threadIdx.x == 0) (void)xb_add(&bar[XB_XCNT(b.x)], 1u);
    return b;
}
__device__ __forceinline__ void xcd_barrier_complete(unsigned* bar, unsigned x, unsigned& nloc, unsigned& nx) {
    const unsigned G = gridDim.x * gridDim.y * gridDim.z;
    unsigned sum, cnt, mine, sp = 0u;
    for (;;) {
        sum = 0u; cnt = 0u; mine = 0u;
#pragma unroll
        for (unsigned j = 0; j < 16; ++j) { const unsigned c = xb_ld(&bar[XB_XCNT(j)]); sum += c; cnt += (c > 0u) ? 1u : 0u; mine = (j == x) ? c : mine; }
        if (sum == G) break;
        __builtin_amdgcn_s_sleep(1);
        if ((++sp & 255u) == 0u) { if (xb_ld(&bar[XB_TMO])) break; if (sp > XB_SPIN_CAP) { atomicAdd(&bar[XB_TMO], 1u); break; } }
    }
    nloc = mine > 0u ? mine : 1u; nx = cnt > 0u ? cnt : 1u;
}

__device__ __forceinline__ void xcd_barrier(const XcdBarrier& b) {
    asm volatile("s_waitcnt vmcnt(0)" ::: "memory");
    __syncthreads();
    if (threadIdx.x == 0) {
        unsigned* bar = b.bar;
        __builtin_amdgcn_s_waitcnt(0);
        unsigned nloc = b.st[0], nx = b.st[1];
        if (nloc == 0u) { xcd_barrier_complete(bar, b.x, nloc, nx); b.st[0] = nloc; b.st[1] = nx; }
        const unsigned old = xb_add(&bar[XB_XSUB(b.x)], 1u);
        const unsigned gen = old / nloc;
        if (old + 1u == (gen + 1u) * nloc) {
            __builtin_amdgcn_fence(__ATOMIC_RELEASE, "agent");
            asm volatile("s_waitcnt vmcnt(0)" ::: "memory");
            const unsigned og = xb_add(&bar[XB_TOP], 1u);
            const unsigned tg = og / nx;
            if (og + 1u == (tg + 1u) * nx) xb_add(&bar[XB_TOPGEN], 1u);
            else XB_SPIN(xb_ld(&bar[XB_TOPGEN]) == tg, bar);
            __builtin_amdgcn_fence(__ATOMIC_ACQUIRE, "agent");
            xb_add(&bar[XB_XGEN(b.x)], 1u);
            asm volatile("s_waitcnt vmcnt(0)" ::: "memory");
        } else {
            XB_SPIN(xb_ld(&bar[XB_XGEN(b.x)]) == gen, bar);
            __builtin_amdgcn_fence(__ATOMIC_ACQUIRE, "agent");
            asm volatile("s_waitcnt vmcnt(0)" ::: "memory");
        }
    }
    __syncthreads();
}
#ifndef MK_MULTI
#define MK_MULTI 0
#endif
struct Args { const float* in[14]; float* out; unsigned char* ws; int ph_lo, ph_hi; };
__global__ void __launch_bounds__(512, 2) fox_fwd(Args args) {
    extern __shared__ __attribute__((aligned(16))) unsigned char lds[];
    cg::grid_group grid = cg::this_grid();
    LAS unsigned char* L = (LAS unsigned char*)lds;
    const int G = gridDim.x, bx = blockIdx.x;
    const int vcu = (G % 8 == 0) ? (bx % 8) * (G / 8) + bx / 8 : bx;
    const int NGW = G * 8;
#define IDS() int tid = threadIdx.x; asm volatile("" : "+v"(tid)); const int lane = tid & 63, wave = __builtin_amdgcn_readfirstlane(tid >> 6), gw = vcu * 8 + wave; (void)lane; (void)gw
#define KIN(k) ((const float*)(const __attribute__((address_space(1))) float*)ldk<8 * (k)>())
#define WSB() ((unsigned char*)(__attribute__((address_space(1))) unsigned char*)ldk<120>())
#define P_OUT ((float*)(__attribute__((address_space(1))) float*)ldk<112>())
#define ctl ((unsigned*)(WSB() + WS_CTL))
#define WinT ((bf16r*)(WSB() + WS_WIN))
#define WoutT ((bf16r*)(WSB() + WS_WOUT))
#define WguT ((bf16r*)(WSB() + WS_WGU))
#define WdT ((bf16r*)(WSB() + WS_WD))
#define XB ((bf16r*)(WSB() + WS_XB))
#define RSSM ((unsigned long long*)(WSB() + WS_RSSM))
#define RSSF ((unsigned long long*)(WSB() + WS_RSSF))
#define LOGF ((float*)(WSB() + WS_LOGF))
#define C2A ((float*)(WSB() + WS_C2))
#define QKVZ ((bf16r*)(WSB() + WS_QKVZ))
#define OB ((bf16r*)(WSB() + WS_O))
#define MG ((bf16r*)(WSB() + WS_MG))
#define HB ((bf16r*)(WSB() + WS_H))
#define OP1 ((bf16r*)(WSB() + WS_OP))
#define MLB ((float*)(WSB() + WS_ML))
#define MKP() Ptrs P; P.x = KIN(0); P.mixg = KIN(1); P.w_in = KIN(2); P.b_f = KIN(3); P.lng = KIN(4); P.lnb = KIN(5); P.w_s = KIN(6); P.b_s = KIN(7); \
    P.outg = KIN(8); P.w_out = KIN(9); P.ffng = KIN(10); P.w_gu = KIN(11); P.w_d = KIN(12); P.fing = KIN(13); P.out = P_OUT; P.ws = WSB()
    constexpr size_t QS = (size_t)S_ * 512;
    const int lo = args.ph_lo, hi = args.ph_hi;
    { LAS unsigned* misc = (LAS unsigned*)(L + 147456 - 8); if (threadIdx.x < 2) misc[threadIdx.x] = 0u; __syncthreads(); }
    XcdBarrier xbar = xcd_barrier_post((unsigned*)(WSB() + WS_CTL) + CW_BAR, (volatile LAS unsigned*)(L + 147456 - 8));
    int ph = 0;
#ifdef PROBE_T
    unsigned long long tacc_ = 0ull, tst_ = 0ull;
#define TCLS() ((ph == 0) ? 0 : (ph <= 7 * NL ? ((ph - 1) % 7) + 1 : 8))
#define TBEG() do { if (TCLS() == PROBE_T) tst_ = __builtin_amdgcn_s_memrealtime(); } while (0)
#define TEND() do { if (TCLS() == PROBE_T) tacc_ += __builtin_amdgcn_s_memrealtime() - tst_; } while (0)
#else
#define TBEG() do {} while (0)
#define TEND() do {} while (0)
#endif
#define RUN() (ph >= lo && ph < hi)
#ifdef PROBE_SYNC
#define SEAM() do { ++ph; if (ph > lo && ph < hi) { if (ph == 1) { grid.sync(); grid.sync(); } else { xcd_barrier(xbar); xcd_barrier(xbar); } } } while (0)
#else
#define SEAM() do { ++ph; if (ph > lo && ph < hi) { if (lo < 0) grid.sync(); xcd_barrier(xbar); } --ph; TEND(); ++ph; TBEG(); } while (0)
#endif
#ifdef PROBE_SMALL
#define REPS 2
#else
#define REPS 1
#endif
#ifndef FH_TABLE
#define FH_TABLE 0x76545677u
#endif
#ifndef FOX_THRL
#define FOX_THRL 8
#endif
#ifndef SGU_AT
#define SGU_AT 1
#endif
#ifdef PROBE_GEMM
#define REPG 2
#else
#define REPG 1
#endif
#ifdef PROBE_ATTN
#define REPA 2
#else
#define REPA 1
#endif

#ifndef NO_P0
    if (RUN()) { IDS(); MKP(); for (int rp = 0; rp < REPS; ++rp) { phase_prep(P, L, 0, 1, gw, NGW, wave, lane); phase_rowstats<1>(P.x, (bf16r*)(P.ws + WS_XB), (unsigned long long*)(P.ws + WS_RSSM), nullptr, nullptr, gw, NGW, lane); } }
#endif
    SEAM();
    for (int l = 0; l < NL; ++l) {
#ifndef NO_INPROJ
        if (RUN()) {
            { IDS(); unsigned long long* rz = RSSF; if (bx < 256 && tid < 64) { unsigned zlo = 0u; asm volatile("" : "+v"(zlo)); rz[bx * 64 + tid] = (unsigned long long)zlo; }     }
            pg8::Gemm g{XB, WinT + (size_t)l * NIN * DMOD, S_, NIN, DMOD}; pg8::StaticOrder So; So.init(S_, NIN, G, bx); So.rot = NIN / 256 - 1;
            pg8::EpiInProj E{QKVZ, QS, RSSM, ctl + CW_KMAX + l * 16, KIN(3) + l * 8, LOGF, ctl + CW_FCNT + l * 64};
            for (int rg = 0; rg < REPG; ++rg) pg8::gemm_phase<pg8::EpiInProj, pg8::StaticOrder, true, true>(L, g, So, E);
            if (bx >= G - NHD) {
                IDS(); unsigned* const fc = ctl + CW_FCNT + l * 64;
                if (tid == 0) { unsigned sp = 0; while (__hip_atomic_load(fc, __ATOMIC_RELAXED, __HIP_MEMORY_SCOPE_AGENT) < 64u * REPG) { __builtin_amdgcn_s_sleep(8); if (++sp > (1u << 20)) break; }
                    __builtin_amdgcn_fence(__ATOMIC_ACQUIRE, "agent"); }
                __syncthreads();
                cumsum_head(LOGF, C2A, bx - (G - NHD), L, tid);
            }
        }
#endif
        SEAM();
#ifndef NO_ATTN
        if (RUN()) {
            IDS(); LAS unsigned* bc = (LAS unsigned*)(L + 147456 - 64);
            unsigned* const ctlp = ctl; unsigned char* const wsp = WSB();
            const int fh = (int)((FH_TABLE >> (4 * (bx & 7))) & 7u);
            for (int rp = 0; rp < REPA; ++rp)
            for (int qi = 0; qi <= NHD; ++qi) { const int h = (qi == 0) ? fh : (NHD - qi); if (qi > 0 && h == fh) continue;
                if (qi == SGU_AT && rp == 0) {
            for (;;) {
                if (tid == 0) bc[0] = atomicAdd(ctlp + CW_SGUQ + (l) * 64, 1u);
                __syncthreads(); const unsigned u = bc[0]; __syncthreads();
                if (u >= (unsigned)(S_ / 128)) break;
                bf16r* const qkvz = (bf16r*)(wsp + WS_QKVZ);
                sgu_item((int)u, qkvz + 3 * QS, qkvz + 4 * QS, (bf16r*)(wsp + WS_MG), KIN(4) + l * 512, KIN(5) + l * 512, KIN(6) + (size_t)l * 8 * 128 * 128, KIN(7) + l * 8 * 128, L, wave, lane);
            }
                }
                const float kn = sqrtf((__uint_as_float(ctlp[CW_KMAX + l * 16 + 2 * h]) + __uint_as_float(ctlp[CW_KMAX + l * 16 + 2 * h + 1])) * 1.02f);
                for (;;) {
                    if (tid == 0) bc[0] = atomicAdd(ctlp + ((rp * NL + l) * NHD + h) * 64, 1u);
                    __syncthreads(); const unsigned u = bc[0]; __syncthreads();
                    if (u >= 160u) break;
                    int qb, jc;
                    if (u < 64u) { qb = 63 - (int)(u >> 2); jc = (int)(u & 3u); } else if (u < 112u) { const int v = (int)u - 64; qb = 47 - v / 3; jc = v % 3; }
                    else if (u < 144u) { const int v = (int)u - 112; qb = 31 - (v >> 1); jc = v & 1; } else { qb = 15 - ((int)u - 144); jc = 0; }
                    bf16r* const qkvz = (bf16r*)(wsp + WS_QKVZ);
                    attn_body::fox_unit2<FOX_THRL>(h, qb, jc, kn, (const attn_body::bf16*)qkvz, (const attn_body::bf16*)(qkvz + QS), (const attn_body::bf16*)(qkvz + 2 * QS),
                                            (attn_body::bf16*)(jc == 0 ? (bf16r*)(wsp + WS_O) : (bf16r*)(wsp + WS_OP) + (size_t)(jc - 1) * QS), (float*)(wsp + WS_ML) + (size_t)jc * S_ * 16, (float*)(wsp + WS_C2) + (size_t)h * S_, (char*)lds, (float*)(lds + 147456 - 48));
                } }
        }
#endif
        SEAM();
#ifndef NO_MERGE
        if (RUN()) { IDS(); for (int rp = 0; rp < REPS; ++rp) for (int it = vcu; it < S_ / 64; it += G) combine_item(it, OB, OP1, MLB, MG, wave, lane); }
#endif
        SEAM();
#ifndef NO_OUTPROJ
        if (RUN()) {
            { IDS(); unsigned long long* rz = RSSM; if (bx < 256 && tid < 64) { unsigned zlo = 0u; asm volatile("" : "+v"(zlo)); rz[bx * 64 + tid] = (unsigned long long)zlo; }     }
            pg8::Gemm g{MG, WoutT + (size_t)l * DMOD * DMOD, S_, DMOD, DMOD}; pg8::StaticOrder So; So.init(S_, DMOD, G, bx);
            pg8::EpiResid E{XB, RSSF};
            pg8::gemm_phase<pg8::EpiResid, pg8::StaticOrder, true, true>(L, g, So, E);
        }
#endif
        SEAM();
#ifndef NO_GU
        if (RUN()) {
            pg8::Gemm g{XB, WguT + (size_t)l * NGU * DMOD, S_, NGU, DMOD}; pg8::StaticOrder So; So.init(S_, NGU, G, bx);
            pg8::EpiSwiGLU E{HB, RSSF};
            for (int rg = 0; rg < REPG; ++rg) pg8::gemm_phase<pg8::EpiSwiGLU, pg8::StaticOrder, true, true>(L, g, So, E);
            if (l + 1 < NL) { IDS(); MKP(); if (G == 256) { if (bx >= 128) phase_prep(P, L, l + 1, l + 2, (bx - 128) * 8 + wave, 1024, wave, lane); } else phase_prep(P, L, l + 1, l + 2, gw, NGW, wave, lane); }
        }
#endif
        SEAM();
#ifndef NO_DOWN
        if (RUN()) {
            pg8::Gemm g{HB, WdT + (size_t)l * DMOD * DFF, S_, DMOD, DFF}; pg8::StaticOrder So; So.init(S_, DMOD, G, bx);
            pg8::EpiResid E{XB, RSSM};
            pg8::gemm_phase<pg8::EpiResid, pg8::StaticOrder, true, true>(L, g, So, E);
        }
#endif
        SEAM();
    }
#ifndef NO_RSN
#ifdef PROBE_T
    { if (blockIdx.x == 0 && threadIdx.x == 0) { ((unsigned*)(WSB() + WS_CTL))[CW_TS] = (unsigned)tacc_; __threadfence(); } xcd_barrier(xbar); }
    const float tdelta = (PROBE_T == 99) ? 0.1f : (float)__hip_atomic_load((unsigned*)(WSB() + WS_CTL) + CW_TS, __ATOMIC_RELAXED, __HIP_MEMORY_SCOPE_AGENT) * 2.0e-7f;
#else
    const float tdelta = 0.f;
#endif
    if (RUN()) { IDS(); final_norm(XB, RSSM, KIN(13), P_OUT, gw, NGW, lane); }
#endif
    SEAM();
#undef RUN
#undef SEAM
}

extern "C" void kernel_launch(void* const* d_in, const int* in_sizes, int n_in, void* d_out, int out_size, void* d_ws, size_t ws_size, hipStream_t stream) {
    static int grid = 0;
    if (grid == 0) {
        if (n_in != 14 || out_size != S_ * DMOD || ws_size < WS_END) { fprintf(stderr, "kernel_launch: unexpected shapes (n_in %d out %d ws %zu)\n", n_in, out_size, ws_size); grid = -1; return; }
        int dev = 0, cus = 0, per_cu = 0;
        hipGetDevice(&dev); hipDeviceGetAttribute(&cus, hipDeviceAttributeMultiprocessorCount, dev);
        if (hipFuncSetAttribute((const void*)fox_fwd, hipFuncAttributeMaxDynamicSharedMemorySize, LDS_BYTES) != hipSuccess) { fprintf(stderr, "kernel_launch: hipFuncSetAttribute failed\n"); grid = -1; return; }
        if (hipOccupancyMaxActiveBlocksPerMultiprocessor(&per_cu, (const void*)fox_fwd, 512, LDS_BYTES) != hipSuccess || per_cu < 1) { fprintf(stderr, "kernel_launch: occupancy query says %d\n", per_cu); per_cu = 1; }
        (void)hipGetLastError();
        grid = cus * per_cu;
        if (grid < 256) { fprintf(stderr, "kernel_launch: this kernel needs a resident grid of at least 256 workgroups, got %d\n", grid); grid = -1; return; }
        fprintf(stderr, "kernel_launch: grid %d (cus %d x %d)\n", grid, cus, per_cu);
    }
    if (grid < 0) return;
    hipMemsetAsync((char*)d_ws + WS_CTL, 0, CTL_BYTES, stream);
    Args a{};
    for (int i = 0; i < 14; ++i) a.in[i] = (const float*)d_in[i];
    a.out = (float*)d_out; a.ws = (unsigned char*)d_ws;
#if MK_MULTI
    for (int p = 0; p < NPHASE; ++p) { a.ph_lo = p; a.ph_hi = p + 1; hipLaunchKernelGGL(fox_fwd, dim3(grid), dim3(512), LDS_BYTES, stream, a); }
#else
    a.ph_lo = 0; a.ph_hi = NPHASE;
    void* kargs[] = {&a};
    hipError_t e = hipLaunchCooperativeKernel((const void*)fox_fwd, dim3(grid), dim3(512), kargs, LDS_BYTES, stream);
    if (e != hipSuccess) fprintf(stderr, "kernel_launch: cooperative launch failed: %s (grid %d)\n", hipGetErrorString(e), grid);
#endif
}
```

```cpp
#define MK_MULTI 0
#define FOX_THRL 64
#include <hip/hip_runtime.h>
#include <hip/hip_cooperative_groups.h>
#include <cstdio>
#include <cstdint>
namespace pg8 {
#define PG8_LAS __attribute__((address_space(3)))
typedef unsigned short bf16_t;
typedef short bf16x8 __attribute__((ext_vector_type(8)));
typedef float f32x4 __attribute__((ext_vector_type(4)));
typedef unsigned u32x4 __attribute__((ext_vector_type(4)));
constexpr int BM = 256, BK = 64, HALF = 128, HTB = HALF * BK * 2  , STAGE_BYTES = 8 * HTB, NXCD = 8, WGM = 8;

__host__ __device__ __forceinline__ int lds_byte(int r, int c) { const int st = (r >> 4) * 2 + (c >> 5), rr = r & 15, cc = c & 31, ob = rr * 64 + cc * 2; return st * 1024 + (ob ^ (((ob >> 9) & 1) << 5)); }
__host__ __device__ __forceinline__ void stage_rc(int b, int& R, int& C) { const int st = b / 1024, sb = b % 1024, swz = sb ^ (((sb >> 9) & 1) << 5); R = (st >> 1) * 16 + swz / 64; C = (st & 1) * 32 + (swz % 64) / 2; }
__host__ __device__ __forceinline__ int perm32(int rho) { const int n = rho >> 4, i = rho & 15; return 8 * (i >> 2) + 4 * n + (i & 3); }

struct Unit { int pm, pn; };
struct Gemm { const bf16_t* A; const bf16_t* Bt; int M, N, K; };

struct StaticOrder {
    int nM, nN, nwg, G, c, rot;
    __host__ __device__ void init(int M, int N, int G_, int c_) { nM = M / BM; nN = N / BM; nwg = nM * nN; G = G_; c = c_; rot = 0; }
    __host__ __device__ __forceinline__ bool next(int i, Unit& u) const {
        const long L = (long)i * G + c; if (L >= nwg) return false;
        int wgid = (int)L; { const int q = nwg / NXCD, r = nwg % NXCD, xcd = wgid % NXCD, off = wgid / NXCD; wgid = (xcd < r ? xcd * (q + 1) : r * (q + 1) + (xcd - r) * q) + off; }
        const int nig = WGM * nN, gid = wgid / nig, fm = gid * WGM, gsz = (nM - fm) < WGM ? (nM - fm) : WGM;
        u.pm = fm + ((wgid % nig) % gsz); u.pn = (wgid % nig) / gsz + rot; if (u.pn >= nN) u.pn -= nN; return true;
    }
    __device__ __forceinline__ void a_ready(const Unit&) const {}
    __device__ __forceinline__ void done(const Unit&) const {}
};

__device__ __forceinline__ unsigned cvt_pk_bf16(float lo, float hi) { unsigned r; asm volatile("v_cvt_pk_bf16_f32 %0, %1, %2" : "=v"(r) : "v"(lo), "v"(hi)); return r; }
typedef float f32x2 __attribute__((ext_vector_type(2)));
__device__ __forceinline__ f32x2 gelu_pk(f32x2 v) {
    const f32x2 av = __builtin_elementwise_abs(v), d = av * 0.2316418882f + 1.0f;
    f32x2 t; t.x = __builtin_amdgcn_rcpf(d.x); t.y = __builtin_amdgcn_rcpf(d.y);
    f32x2 q = t * 0.5307027145f + (-0.7265760135f); q = q * t + 0.7107068705f; q = q * t + (-0.142248368f); q = q * t + 0.127414796f; q = q * t;
    const f32x2 s = (v * v) * (-0.72134752044f);
    f32x2 e; e.x = __builtin_amdgcn_exp2f(s.x); e.y = __builtin_amdgcn_exp2f(s.y);
    const f32x2 m = v * (q * e), r = v - m;
    f32x2 o; o.x = v.x < 0.f ? m.x : r.x; o.y = v.y < 0.f ? m.y : r.y; return o;
}
constexpr float C2Q = 0.125f * 1.4426950408889634f;
constexpr float RSS_INV = 1.0f / (1024.0f * 16777216.0f);
struct EpiInProj {
    static constexpr bool PERM = true, AFTER_DRAIN = false;
    bf16_t* O; size_t split_stride; const unsigned long long* rss; unsigned* kmax; const float* bfv; float* logf; unsigned* fcnt;
    __device__ __forceinline__ void operator()(const f32x4 (&acc)[2][2][4][2], const Unit& u, int wr, int wc, int fr, int fq) const {
        if (u.pn == 10) {
            if (wc == 0 && fq == 0) {
#pragma unroll
                for (int ai = 0; ai < 2; ++ai)
#pragma unroll
                    for (int m = 0; m < 4; ++m) { const int row = u.pm * BM + wr * 64 + fr + ai * HALF + m * 16; const float rs = __builtin_amdgcn_rsqf((float)rss[row] * RSS_INV + 1e-6f);
#pragma unroll
                        for (int n = 0; n < 2; ++n)
#pragma unroll
                            for (int e = 0; e < 4; ++e) { const float z = (acc[ai][0][m][n][e] + acc[ai][1][m][n][e]) * rs + bfv[4 * n + e];
                                const float lf = fminf(z, 0.f) - 0.6931471805599453f * __builtin_amdgcn_logf(1.0f + __builtin_amdgcn_exp2f(-1.4426950408889634f * fabsf(z)));
                                __hip_atomic_store((unsigned*)(logf + (size_t)(4 * n + e) * 16384 + row), __float_as_uint(lf), __ATOMIC_RELAXED, __HIP_MEMORY_SCOPE_AGENT); } } }
            asm volatile("s_waitcnt vmcnt(0)" ::: "memory"); __builtin_amdgcn_s_barrier();
            if (wr == 0 && wc == 0 && fr == 0 && fq == 0) __hip_atomic_fetch_add(fcnt, 1u, __ATOMIC_RELAXED, __HIP_MEMORY_SCOPE_AGENT);
            return; }
        const int t = u.pn >> 1; float kmx[2] = {0.f, 0.f}; bf16_t* base = O + (size_t)t * split_stride;
        const int row0 = u.pm * BM + wr * 64 + fr, col0 = (u.pn & 1) * 256 + wc * 32 + 8 * fq;
        const float s0 = (t == 0) ? C2Q : 1.0f;
#pragma unroll
        for (int ai = 0; ai < 2; ++ai)
#pragma unroll
            for (int m = 0; m < 4; ++m) { const int row = row0 + ai * HALF + m * 16; const float rs = __builtin_amdgcn_rsqf((float)rss[row] * RSS_INV + 1e-6f) * s0; bf16_t* rowp = base + (size_t)row * 512 + col0;
#pragma unroll
                for (int bj = 0; bj < 2; ++bj) { f32x4 v0 = acc[ai][bj][m][0] * rs, v1 = acc[ai][bj][m][1] * rs;
                    if (t == 1) { const f32x4 q0 = v0 * v0, q1 = v1 * v1; float sq = ((q0[0] + q0[1]) + (q0[2] + q0[3])) + ((q1[0] + q1[1]) + (q1[2] + q1[3])); sq += __shfl_xor(sq, 16); sq += __shfl_xor(sq, 32); kmx[bj] = fmaxf(kmx[bj], sq); }
                    if (t >= 3) { f32x2 a = gelu_pk((f32x2){v0[0], v0[1]}), b = gelu_pk((f32x2){v0[2], v0[3]}), c = gelu_pk((f32x2){v1[0], v1[1]}), d = gelu_pk((f32x2){v1[2], v1[3]});
                        v0 = (f32x4){a.x, a.y, b.x, b.y}; v1 = (f32x4){c.x, c.y, d.x, d.y}; }
                    u32x4 w; w.x = cvt_pk_bf16(v0[0], v0[1]); w.y = cvt_pk_bf16(v0[2], v0[3]); w.z = cvt_pk_bf16(v1[0], v1[1]); w.w = cvt_pk_bf16(v1[2], v1[3]);
                    *(u32x4*)(rowp + bj * HALF) = w; } }
        if (t == 1) {
#pragma unroll
            for (int bj = 0; bj < 2; ++bj) { float v = kmx[bj]; v = fmaxf(v, __shfl_xor(v, 1)); v = fmaxf(v, __shfl_xor(v, 2)); v = fmaxf(v, __shfl_xor(v, 4)); v = fmaxf(v, __shfl_xor(v, 8));
                if (fr == 0 && fq == 0) atomicMax(kmax + ((u.pn & 1) * 4 + bj * 2 + (wc >> 1)) * 2 + (wc & 1), __float_as_uint(v)); } }
    }
};
struct EpiResid {
    static constexpr bool PERM = true, AFTER_DRAIN = false;
    bf16_t* xb; unsigned long long* rss;
    __device__ __forceinline__ void operator()(const f32x4 (&acc)[2][2][4][2], const Unit& u, int wr, int wc, int fr, int fq) const {
        const int col0 = u.pn * BM + wc * 32 + 8 * fq;
#pragma unroll
        for (int ai = 0; ai < 2; ++ai)
#pragma unroll
            for (int m = 0; m < 4; ++m) { const int row = u.pm * BM + ai * HALF + wr * 64 + m * 16 + fr; const size_t off = (size_t)row * 1024 + col0; float sq = 0.f;
#pragma unroll
                for (int bj = 0; bj < 2; ++bj) { const u32x4 bw = *(const u32x4*)(xb + off + bj * HALF);
                    const f32x4 b0 = (f32x4){__builtin_bit_cast(float, bw.x << 16), __builtin_bit_cast(float, bw.x & 0xffff0000u), __builtin_bit_cast(float, bw.y << 16), __builtin_bit_cast(float, bw.y & 0xffff0000u)};
                    const f32x4 b1 = (f32x4){__builtin_bit_cast(float, bw.z << 16), __builtin_bit_cast(float, bw.z & 0xffff0000u), __builtin_bit_cast(float, bw.w << 16), __builtin_bit_cast(float, bw.w & 0xffff0000u)};
                    const f32x4 o0 = b0 + acc[ai][bj][m][0], o1 = b1 + acc[ai][bj][m][1];
                    u32x4 w; w.x = cvt_pk_bf16(o0[0], o0[1]); w.y = cvt_pk_bf16(o0[2], o0[3]); w.z = cvt_pk_bf16(o1[0], o1[1]); w.w = cvt_pk_bf16(o1[2], o1[3]);
                    *(u32x4*)(xb + off + bj * HALF) = w;
                    sq += ((o0[0] * o0[0] + o0[1] * o0[1]) + (o0[2] * o0[2] + o0[3] * o0[3])) + ((o1[0] * o1[0] + o1[1] * o1[1]) + (o1[2] * o1[2] + o1[3] * o1[3])); }
                sq += __shfl_xor(sq, 16); sq += __shfl_xor(sq, 32);
                if (fq == 0) atomicAdd(rss + row, (unsigned long long)__float2ull_rn(sq * 16777216.0f)); }
    }
};
struct EpiSwiGLU {
    static constexpr bool PERM = true, AFTER_DRAIN = false;
    bf16_t* H; const unsigned long long* rss;
    __device__ __forceinline__ void operator()(const f32x4 (&acc)[2][2][4][2], const Unit& u, int wr, int wc, int fr, int fq) const {
        const int row0 = u.pm * BM + wr * 64 + fr, col0 = u.pn * 128 + wc * 32 + 8 * fq;
#pragma unroll
        for (int ai = 0; ai < 2; ++ai)
#pragma unroll
            for (int m = 0; m < 4; ++m) { const int row = row0 + ai * HALF + m * 16; const float rs = __builtin_amdgcn_rsqf((float)rss[row] * RSS_INV + 1e-6f);
                float hv[8];
#pragma unroll
                for (int n = 0; n < 2; ++n)
#pragma unroll
                    for (int e = 0; e < 4; ++e) { const float g = acc[ai][0][m][n][e] * rs, up = acc[ai][1][m][n][e] * rs;
                        const float sg = __builtin_amdgcn_rcpf(1.0f + __builtin_amdgcn_exp2f(-1.4426950408889634f * g)); hv[n * 4 + e] = g * sg * up; }
                u32x4 w; w.x = cvt_pk_bf16(hv[0], hv[1]); w.y = cvt_pk_bf16(hv[2], hv[3]); w.z = cvt_pk_bf16(hv[4], hv[5]); w.w = cvt_pk_bf16(hv[6], hv[7]);
                *(u32x4*)(H + (size_t)row * 2816 + col0) = w; }
    }
};
template <class Epi, class Sched, bool ALIGN_EPI = false, bool SP2 = false>
__device__ __forceinline__ void gemm_phase(PG8_LAS unsigned char* lds, const Gemm g, const Sched& S, const Epi& E) {
    int tid = threadIdx.x; asm volatile("" : "+v"(tid));
    const int wid = __builtin_amdgcn_readfirstlane(tid >> 6), lane = tid & 63, wr = wid >> 2, wc = wid & 3, fr = lane & 15, fq = lane >> 4;
    const int K = g.K, nt = K / BK;
    unsigned voffA[2], voffB[2];
#pragma unroll
    for (int i = 0; i < 2; ++i) { int R, C; stage_rc(tid * 16 + i * 8192, R, C); const int Rb = Epi::PERM ? ((R & ~31) + perm32(R & 31)) : R;
        voffA[i] = (unsigned)(R * K + C) * 2u; voffB[i] = (unsigned)(Rb * K + C) * 2u; }
    const size_t kstep = (size_t)(BK * 2);
    const size_t hstep = (size_t)HALF * K * 2;
    const size_t tstep = 2 * hstep;
    const unsigned ldsw = (unsigned)wid * 1024u;
    const int aoff = lds_byte(wr * 64 + fr, fq * 8), boff = lds_byte(wc * 32 + fr, fq * 8);
#define PG8_SA(b, h) (((b) * 2 + (h)) * HTB)
#define PG8_SB(b, h) ((4 + (b) * 2 + (h)) * HTB)
#define PG8_STAGE(bufoff, gbase, voff) do { _Pragma("unroll") for (int _i = 0; _i < 2; ++_i) \
        __builtin_amdgcn_global_load_lds((const unsigned*)((const char*)(gbase) + (voff)[_i]), (PG8_LAS unsigned*)(lds + (bufoff) + ldsw + _i * 8192), 16, 0, 0); } while (0)
#define PG8_LDA(dst, b, h) do { _Pragma("unroll") for (int m = 0; m < 4; ++m) _Pragma("unroll") for (int k = 0; k < 2; ++k) dst[m][k] = *(const PG8_LAS bf16x8*)(lds + PG8_SA(b, h) + aoff + m * 2048 + k * 1024); } while (0)
#define PG8_LDB(dst, b, h) do { _Pragma("unroll") for (int n = 0; n < 2; ++n) _Pragma("unroll") for (int k = 0; k < 2; ++k) dst[n][k] = *(const PG8_LAS bf16x8*)(lds + PG8_SB(b, h) + boff + n * 2048 + k * 1024); } while (0)
#define PG8_MMA(ai, bj, At, Bt) do { __builtin_amdgcn_s_setprio(1); _Pragma("unroll") for (int m = 0; m < 4; ++m) _Pragma("unroll") for (int n = 0; n < 2; ++n) _Pragma("unroll") for (int k = 0; k < 2; ++k) \
        acc[ai][bj][m][n] = __builtin_amdgcn_mfma_f32_16x16x32_bf16(Bt[n][k], At[m][k], acc[ai][bj][m][n], 0, 0, 0); __builtin_amdgcn_s_setprio(0); } while (0)
#define PG8_WAIT_V(n) asm volatile("s_waitcnt vmcnt(" #n ")" ::: "memory")
#define PG8_WAIT_L(n) asm volatile("s_waitcnt lgkmcnt(" #n ")" ::: "memory")
#define PG8_BAR __builtin_amdgcn_s_barrier()
#define PG8_SCHED __builtin_amdgcn_sched_barrier(0)
    Unit cur, nxt; int ui = 0;
    if (!S.next(0, cur)) return;
    f32x4 acc[2][2][4][2];
#pragma unroll
    for (int a = 0; a < 2; ++a)
#pragma unroll
        for (int b = 0; b < 2; ++b)
#pragma unroll
            for (int m = 0; m < 4; ++m)
#pragma unroll
                for (int n = 0; n < 2; ++n) acc[a][b][m][n] = (f32x4){0.f, 0.f, 0.f, 0.f};
    bf16x8 At[4][2], B0[2][2], B1[2][2];
    const char* cA = (const char*)g.A + (size_t)cur.pm * tstep; const char* cB = (const char*)g.Bt + (size_t)cur.pn * tstep;
    S.a_ready(cur);
    if constexpr (SP2) {
        PG8_STAGE(PG8_SB(0, 0), cB, voffB); PG8_STAGE(PG8_SB(0, 1), cB + hstep, voffB); PG8_STAGE(PG8_SA(0, 0), cA, voffA); PG8_STAGE(PG8_SA(0, 1), cA + hstep, voffA);
        if (wr == 1) PG8_BAR;
        PG8_WAIT_V(2); PG8_BAR;
        PG8_STAGE(PG8_SB(1, 0), cB + kstep, voffB); PG8_STAGE(PG8_SA(1, 0), cA + kstep, voffA); PG8_STAGE(PG8_SB(1, 1), cB + hstep + kstep, voffB);
        PG8_WAIT_V(6); PG8_BAR;
    } else {
        PG8_STAGE(PG8_SB(0, 0), cB, voffB); PG8_STAGE(PG8_SA(0, 0), cA, voffA); PG8_STAGE(PG8_SB(0, 1), cB + hstep, voffB); PG8_STAGE(PG8_SA(0, 1), cA + hstep, voffA);
        if (wr == 1) PG8_BAR;
        PG8_WAIT_V(4); PG8_BAR;
        PG8_STAGE(PG8_SB(1, 0), cB + kstep, voffB); PG8_STAGE(PG8_SA(1, 0), cA + kstep, voffA); PG8_STAGE(PG8_SB(1, 1), cB + hstep + kstep, voffB);
        PG8_WAIT_V(6); PG8_BAR;
    }
    for (;;) {
        const bool has_next = S.next(ui + 1, nxt);
        const char* nA = has_next ? (const char*)g.A + (size_t)nxt.pm * tstep : cA; const char* nB = has_next ? (const char*)g.Bt + (size_t)nxt.pn * tstep : cB;
        for (int t = 0; t < nt; t += 2) {
            const bool last = (t == nt - 2);
            const char* a1 = cA + (size_t)(t + 1) * kstep;
            const char* a2 = last ? nA : cA + (size_t)(t + 2) * kstep; const char* b2 = last ? nB : cB + (size_t)(t + 2) * kstep;
            const char* a3 = a2 + kstep; const char* b3 = b2 + kstep;
            if (last && has_next) S.a_ready(nxt);
            if constexpr (SP2) {
            PG8_LDB(B0, 0, 0); PG8_LDB(B1, 0, 1); PG8_SCHED; PG8_LDA(At, 0, 0); PG8_STAGE(PG8_SA(1, 1), a1 + hstep, voffA);
            PG8_WAIT_V(8); PG8_WAIT_L(0); PG8_BAR; PG8_MMA(0, 0, At, B0); PG8_MMA(0, 1, At, B1); PG8_BAR; PG8_SCHED;
            PG8_LDA(At, 0, 1); PG8_STAGE(PG8_SB(0, 0), b2, voffB); PG8_STAGE(PG8_SB(0, 1), b2 + hstep, voffB); PG8_STAGE(PG8_SA(0, 0), a2, voffA);
            PG8_WAIT_V(8); PG8_WAIT_L(0); PG8_BAR; PG8_MMA(1, 0, At, B0); PG8_MMA(1, 1, At, B1); PG8_BAR; PG8_SCHED;
            PG8_LDB(B0, 1, 0); PG8_LDB(B1, 1, 1); PG8_SCHED; PG8_LDA(At, 1, 0); PG8_STAGE(PG8_SA(0, 1), a2 + hstep, voffA);
            PG8_WAIT_V(8); PG8_WAIT_L(0); PG8_BAR; PG8_MMA(0, 0, At, B0); PG8_MMA(0, 1, At, B1); PG8_BAR; PG8_SCHED;
            PG8_LDA(At, 1, 1); PG8_STAGE(PG8_SB(1, 0), b3, voffB); PG8_STAGE(PG8_SB(1, 1), b3 + hstep, voffB); PG8_STAGE(PG8_SA(1, 0), a3, voffA);
            PG8_WAIT_V(8); PG8_WAIT_L(0); PG8_BAR; PG8_MMA(1, 0, At, B0); PG8_MMA(1, 1, At, B1); PG8_BAR; PG8_SCHED;
            } else {
            PG8_LDB(B0, 0, 0); PG8_SCHED; PG8_LDA(At, 0, 0); PG8_STAGE(PG8_SA(1, 1), a1 + hstep, voffA);
            PG8_WAIT_L(8); PG8_BAR; PG8_WAIT_L(0); PG8_MMA(0, 0, At, B0); PG8_BAR; PG8_SCHED;
            PG8_LDB(B1, 0, 1); PG8_STAGE(PG8_SB(0, 0), b2, voffB);
            PG8_BAR; PG8_WAIT_L(0); PG8_MMA(0, 1, At, B1); PG8_BAR;
            PG8_LDA(At, 0, 1); PG8_STAGE(PG8_SA(0, 0), a2, voffA);
            PG8_BAR; PG8_WAIT_L(0); PG8_MMA(1, 0, At, B0); PG8_BAR; PG8_SCHED;
            PG8_STAGE(PG8_SB(0, 1), b2 + hstep, voffB);
            PG8_WAIT_V(6); PG8_BAR; PG8_MMA(1, 1, At, B1); PG8_BAR;
            PG8_LDB(B0, 1, 0); PG8_SCHED; PG8_LDA(At, 1, 0); PG8_STAGE(PG8_SA(0, 1), a2 + hstep, voffA);
            PG8_WAIT_L(8); PG8_BAR; PG8_WAIT_L(0); PG8_MMA(0, 0, At, B0); PG8_BAR; PG8_SCHED;
            PG8_LDB(B1, 1, 1); PG8_STAGE(PG8_SB(1, 0), b3, voffB);
            PG8_BAR; PG8_WAIT_L(0); PG8_MMA(0, 1, At, B1); PG8_BAR;
            PG8_LDA(At, 1, 1); PG8_STAGE(PG8_SA(1, 0), a3, voffA);
            PG8_BAR; PG8_WAIT_L(0); PG8_MMA(1, 0, At, B0); PG8_BAR; PG8_SCHED;
            PG8_STAGE(PG8_SB(1, 1), b3 + hstep, voffB);
            PG8_WAIT_V(6); PG8_BAR; PG8_MMA(1, 1, At, B1); PG8_BAR;
            }
        }
        if constexpr (ALIGN_EPI) { if (wr == 0) PG8_BAR; }
        if constexpr (!Epi::AFTER_DRAIN) { E(acc, cur, wr, wc, fr, fq); S.done(cur); }
        if (!has_next) break;
#pragma unroll
        for (int a = 0; a < 2; ++a)
#pragma unroll
            for (int b = 0; b < 2; ++b)
#pragma unroll
                for (int m = 0; m < 4; ++m)
#pragma unroll
                    for (int n = 0; n < 2; ++n) acc[a][b][m][n] = (f32x4){0.f, 0.f, 0.f, 0.f};
        cur = nxt; cA = nA; cB = nB; ++ui;
        if constexpr (ALIGN_EPI) { if (wr == 1) PG8_BAR; }
    }
    PG8_WAIT_V(0);
    if constexpr (!ALIGN_EPI) { if (wr == 0) PG8_BAR; }
    PG8_BAR;
    if constexpr (Epi::AFTER_DRAIN) { E.fused(acc, cur, wr, wc, fr, fq, lds, wid, lane); S.done(cur); }
#undef PG8_SA
#undef PG8_SB
#undef PG8_STAGE
#undef PG8_LDA
#undef PG8_LDB
#undef PG8_MMA
#undef PG8_WAIT_V
#undef PG8_WAIT_L
#undef PG8_BAR
#undef PG8_SCHED
}
}
#include <hip/hip_bf16.h>
#include <cmath>
namespace attn_body {
using bf16=__hip_bfloat16;
using bf16x8=__attribute__((ext_vector_type(8)))short;
using s16x4=__attribute__((ext_vector_type(4)))short;
using f32x16=__attribute__((ext_vector_type(16)))float;
using u32x4=__attribute__((ext_vector_type(4)))unsigned;
constexpr int BATCH=1,NHEAD=8,SEQ=16384,D=64,DM=NHEAD*D;
constexpr int NW=8,QBLK=32,QB=QBLK*NW,KVBLK=64,NQB=SEQ/QB;
constexpr int ATTN_PITCH=DM, ATTN_UNIT_ROWS=QB;
__device__ __forceinline__ int crow(int r,int hi){return (r&3)+8*(r>>2)+4*hi;}
#define SBAR() __builtin_amdgcn_sched_barrier(0)
__device__ __forceinline__ void cmask(f32x16&p0,f32x16&p1,int jb,int qrel,int hi){
  const float NEG=-INFINITY; int kb=64*jb+4*hi;
  #pragma unroll
  for(int r=0;r<16;++r){int kv=kb+(r&3)+8*(r>>2); if(kv>qrel)p0[r]=NEG; if(kv+32>qrel)p1[r]=NEG;}
}

constexpr int NSLOT=3, SLOTB=8192;
constexpr int LDS_K=0, LDS_V=NSLOT*SLOTB, LDS_WS=2*NSLOT*SLOTB, LDS_OST=LDS_WS+NW*64*4, LDS_BYTES=LDS_OST+NW*4096;
constexpr float C2=0.125f*1.4426950408889634f;
__device__ __forceinline__ void glds16(const void*gsrc,unsigned lds_dst){unsigned keep;
  asm volatile("s_mov_b32 %0, m0\n\ts_mov_b32 m0, %2\n\ts_nop 0\n\tglobal_load_lds_dwordx4 %1, off\n\ts_mov_b32 m0, %0":"=&s"(keep):"v"(gsrc),"s"(lds_dst):"memory");}
__device__ __forceinline__ float max3f(float a,float b,float c){float r;asm("v_max3_f32 %0, %1, %2, %3":"=v"(r):"v"(a),"v"(b),"v"(c));return r;}
__device__ __forceinline__ float max2f(float a,float b){float r;asm("v_max_f32_e32 %0, %1, %2":"=v"(r):"v"(a),"v"(b));return r;}
__device__ __forceinline__ float fadd_s(float a,float b){float r;asm("v_add_f32_e32 %0, %1, %2":"=v"(r):"v"(a),"v"(b));return r;}
__device__ __forceinline__ float fsub_s(float a,float b){float r;asm("v_sub_f32_e32 %0, %1, %2":"=v"(r):"v"(a),"v"(b));return r;}
typedef float f32x2_t __attribute__((ext_vector_type(2))); typedef __bf16 bf16x2_t __attribute__((ext_vector_type(2)));
__device__ __forceinline__ unsigned cvtpk_s(float lo,float hi){f32x2_t v={lo,hi};bf16x2_t b=__builtin_convertvector(v,bf16x2_t);return __builtin_bit_cast(unsigned,b);}
#define WAIT_BAR(N) asm volatile("s_waitcnt vmcnt(" #N ") lgkmcnt(0)\n\ts_barrier":::"memory")

__device__ __forceinline__ void qkt(f32x16&p0,f32x16&p1,const char*Kslot,const bf16x8*qr,const f32x16&negm,int r32,int hi){
  const char*kb=Kslot+hi*1024+r32*16;
  #pragma unroll
  for(int d0=0;d0<4;++d0){
    const bf16x8 b0=*reinterpret_cast<const bf16x8*>(kb+d0*2048);
    const bf16x8 b1=*reinterpret_cast<const bf16x8*>(kb+d0*2048+512);
    if(d0==0){p0=__builtin_amdgcn_mfma_f32_32x32x16_bf16(b0,qr[0],negm,0,0,0);p1=__builtin_amdgcn_mfma_f32_32x32x16_bf16(b1,qr[0],negm,0,0,0);}
    else{p0=__builtin_amdgcn_mfma_f32_32x32x16_bf16(b0,qr[d0],p0,0,0,0);p1=__builtin_amdgcn_mfma_f32_32x32x16_bf16(b1,qr[d0],p1,0,0,0);}}
}
typedef __attribute__((address_space(3))) const char* lds_cptr;
typedef short v4i16_t __attribute__((ext_vector_type(4)));
__device__ __forceinline__ void kload8(bf16x8*kf,lds_cptr kp){
  kf[0]=*(const __attribute__((address_space(3))) bf16x8*)(kp);      kf[1]=*(const __attribute__((address_space(3))) bf16x8*)(kp+512);
  kf[2]=*(const __attribute__((address_space(3))) bf16x8*)(kp+2048); kf[3]=*(const __attribute__((address_space(3))) bf16x8*)(kp+2560);
  kf[4]=*(const __attribute__((address_space(3))) bf16x8*)(kp+4096); kf[5]=*(const __attribute__((address_space(3))) bf16x8*)(kp+4608);
  kf[6]=*(const __attribute__((address_space(3))) bf16x8*)(kp+6144); kf[7]=*(const __attribute__((address_space(3))) bf16x8*)(kp+6656);
}
__device__ __forceinline__ void kload2(bf16x8*kf,lds_cptr kp,int j){ kf[2*j]=*(const __attribute__((address_space(3))) bf16x8*)(kp+j*2048); kf[2*j+1]=*(const __attribute__((address_space(3))) bf16x8*)(kp+j*2048+512); }
__device__ __forceinline__ s16x4 vtr(lds_cptr p){ return __builtin_bit_cast(s16x4,__builtin_amdgcn_ds_read_tr16_b64_v4i16((__attribute__((address_space(3))) v4i16_t*)p)); }
__device__ __forceinline__ float rowmax(const f32x16&p0,const f32x16&p1){
  float a=max3f(p0[0],p0[1],p1[0]),b=max3f(p0[2],p0[3],p1[1]);a=max3f(a,p1[2],p1[3]);
  #pragma unroll
  for(int r=4;r<16;r+=4){a=max3f(a,p0[r],p0[r+1]);b=max3f(b,p0[r+2],p0[r+3]);a=max3f(a,p1[r],p1[r+1]);b=max3f(b,p1[r+2],p1[r+3]);}
  const float m=max2f(a,b);
  auto rr=__builtin_amdgcn_permlane32_swap(__float_as_uint(m),__float_as_uint(m),false,false);
  return max2f(__uint_as_float(rr[0]),__uint_as_float(rr[1]));
}
__device__ __forceinline__ void pv(f32x16*o,int vb,bf16x8 pa0,bf16x8 pa1,bf16x8 pa2,bf16x8 pa3){
  #pragma unroll
  for(int d0=0;d0<2;++d0){s16x4 lo[4],hi[4];
    #pragma unroll
    for(int ks=0;ks<4;++ks){
      asm volatile("ds_read_b64_tr_b16 %0,%1 offset:%c2":"=&v"(lo[ks]):"v"(vb),"i"(d0*4096+ks*1024):"memory");
      asm volatile("ds_read_b64_tr_b16 %0,%1 offset:%c2":"=&v"(hi[ks]):"v"(vb),"i"(d0*4096+ks*1024+512):"memory");}
    asm volatile("s_waitcnt lgkmcnt(0)":::"memory");SBAR();
    #define PK(k) (bf16x8){lo[k][0],lo[k][1],lo[k][2],lo[k][3],hi[k][0],hi[k][1],hi[k][2],hi[k][3]}
    o[d0]=__builtin_amdgcn_mfma_f32_32x32x16_bf16(pa0,PK(0),o[d0],0,0,0);
    o[d0]=__builtin_amdgcn_mfma_f32_32x32x16_bf16(pa1,PK(1),o[d0],0,0,0);
    o[d0]=__builtin_amdgcn_mfma_f32_32x32x16_bf16(pa2,PK(2),o[d0],0,0,0);
    o[d0]=__builtin_amdgcn_mfma_f32_32x32x16_bf16(pa3,PK(3),o[d0],0,0,0);
    #undef PK
  }
}
typedef float f32x4_t __attribute__((ext_vector_type(4)));

#ifndef ATTN_STORE16
#define ATTN_STORE16(p,v) (*(u32x4*)(p)=(v))
#endif
constexpr int FCH=64;
constexpr int F2_CK=LDS_BYTES, FOX2_LDS_BYTES=F2_CK+FCH*64*4;
template<int THRL> __device__ __forceinline__ void fox_unit2(int h,int qb,int jc,float kn,const bf16*Q,const bf16*__restrict__ K,const bf16*__restrict__ V,bf16*O,float*ML,const float*__restrict__ c2h,char*shm,float*qmx){
  int tid=threadIdx.x; asm volatile("":"+v"(tid)); const int lane=tid&63,r32=lane&31,hi=lane>>5; const int wid=__builtin_amdgcn_readfirstlane(tid>>6);
  const long rowbase=0; const int q0=qb*QB;
  const bf16*Qw=Q+(rowbase+q0+wid*QBLK)*DM+h*D;
  const bf16*Kh=K+rowbase*DM+h*D,*Vh=V+rowbase*DM+h*D;
  const unsigned lds0=(unsigned)(uintptr_t)shm;
  float*wsf=(float*)(shm+LDS_WS)+wid*64;
  float*ckl=(float*)(shm+F2_CK);
  const int NTg=(q0+QB)/KVBLK;
  bf16x8 qr[4];
  #pragma unroll
  for(int d0=0;d0<4;++d0)qr[d0]=*reinterpret_cast<const bf16x8*>(&Qw[(long)r32*DM+d0*16+hi*8]);
  bf16x8 kd[4];
  { const bf16*Kd=K+(long)(q0+wid*QBLK+r32)*DM+h*D;
    #pragma unroll
    for(int d0=0;d0<4;++d0)kd[d0]=*reinterpret_cast<const bf16x8*>(&Kd[d0*16+hi*8]); }
  int ts;
  const float cq0_=c2h[q0], cte_=(tid<NTg-4)?c2h[64*tid+63]:0.f;
  { float qs=0.f,dg=0.f;
    #pragma unroll
    for(int d0=0;d0<4;++d0)
      #pragma unroll
      for(int e=0;e<8;++e){ const float v=__builtin_bit_cast(float,(unsigned)(unsigned short)qr[d0][e]<<16); qs+=v*v; dg+=v*__builtin_bit_cast(float,(unsigned)(unsigned short)kd[d0][e]<<16); }
    { auto rr=__builtin_amdgcn_permlane32_swap(__float_as_uint(qs),__float_as_uint(qs),false,false); qs=__uint_as_float(rr[0])+__uint_as_float(rr[1]); }
    { auto rr=__builtin_amdgcn_permlane32_swap(__float_as_uint(dg),__float_as_uint(dg),false,false); dg=__uint_as_float(rr[0])+__uint_as_float(rr[1]); }
    #pragma unroll
    for(int o_=1;o_<32;o_<<=1){ qs=__builtin_fmaxf(qs,__shfl_xor(qs,o_)); dg=__builtin_fminf(dg,__shfl_xor(dg,o_)); }
    if(lane==0){qmx[wid]=qs;qmx[wid-20]=dg;}
    __syncthreads();
    float q2=qmx[0];
    #pragma unroll
    for(int w_=1;w_<8;++w_)q2=__builtin_fmaxf(q2,qmx[w_]);
    float dmin=qmx[-20];
    #pragma unroll
    for(int w_=1;w_<8;++w_)dmin=__builtin_fminf(dmin,qmx[w_-20]);
    const float lim=cq0_+152.05f+sqrtf(q2)*kn-dmin;
    ts=__syncthreads_count((tid<NTg-4)&&(cte_>lim)); ts&=~3; }
  const int t1=NTg-FCH*jc; int t0=t1-FCH; t0=t0<0?0:t0; t0=t0<ts?ts:t0;
  if(t0>=t1){ if(hi==0){ float*mlp=ML+((long)(q0+wid*QBLK+r32)*NHEAD+h)*2; mlp[0]=-1.0e30f; mlp[1]=0.f; } return; }
  const int NT=t1-t0;
  const int NTm=(jc==0)?NT:(1<<20);
  const bf16*ksrc=Kh+(long)(t0*KVBLK+lane)*DM+wid*8;
  const bf16*vsrc=Vh+(long)(t0*KVBLK+16*(wid&3)+(lane>>2))*DM+(wid>>2)*32+(lane&3)*8;
  const unsigned kdst=lds0+LDS_K+wid*1024, vdst=lds0+LDS_V+wid*1024;
  #define DMA_K(t,slot) glds16(ksrc+(long)(t)*KVBLK*DM,(unsigned)__builtin_amdgcn_readfirstlane(kdst+(slot)))
  #define DMA_V(t,slot) glds16(vsrc+(long)(t)*KVBLK*DM,(unsigned)__builtin_amdgcn_readfirstlane(vdst+(slot)))
  const int vb0=(int)(lds0+LDS_V)+((lane>>4)&1)*32+(lane&3)*8+(4*hi+((lane&15)>>2))*64;
  const char*Kbase=shm+LDS_K; bf16x8 kf[8];
  const lds_cptr shm3=(lds_cptr)shm; const lds_cptr kp0=shm3+LDS_K+hi*1024+r32*16; const lds_cptr vp0=shm3+LDS_V+((lane>>4)&1)*32+(lane&3)*8+(4*hi+((lane&15)>>2))*64;
  DMA_K(0,0);DMA_V(0,0);DMA_K(1,SLOTB);
  { const float cref=cq0_; const int nck=NT*64;
    for(int i=tid*4;i<nck;i+=2048){ f32x4_t v=*(const f32x4_t*)(c2h+t0*64+i); v=v-cref; *(f32x4_t*)(ckl+i)=v; } }
  float mhat=0.f,l_reg=0.f;f32x16 o[2];o[0]=f32x16{};o[1]=f32x16{};const f32x16 zc16=f32x16{};
  const int qrel=wid*QBLK+r32;
  #define CMASK(P0,P1,t) do{int jb_=(t)-(NTm-4); if(jb_>=0)cmask(P0,P1,jb_,qrel,hi);}while(0)
  #define BIAS(P0,P1,t) do{ const float*cb_=ckl+(t)*64+4*hi; _Pragma("unroll") for(int g_=0;g_<4;++g_){ const f32x4_t a_=*(const f32x4_t*)(cb_+8*g_), b_=*(const f32x4_t*)(cb_+32+8*g_); _Pragma("unroll") for(int e_=0;e_<4;++e_){P0[4*g_+e_]-=a_[e_];P1[4*g_+e_]-=b_[e_];} SBAR(); } }while(0)
  bool resc=false;
  #define START(P0,P1) do{ const float rm=rowmax(P0,P1); resc=false; \
    { const float dl=rm; mhat=fadd_s(mhat,dl); \
      _Pragma("unroll") for(int r=0;r<16;++r){P0[r]=fsub_s(P0[r],dl);P1[r]=fsub_s(P1[r],dl);} \
      } \
    _Pragma("unroll") for(int r=0;r<16;++r)P0[r]=__builtin_amdgcn_exp2f(P0[r]); }while(0)
  #define RESC() do{ if(resc){ asm volatile("s_waitcnt lgkmcnt(0)":::"memory"); \
      _Pragma("unroll") for(int d_=0;d_<2;++d_) _Pragma("unroll") for(int r=0;r<16;++r)o[d_][r]*=wsf[crow(r,hi)]; } }while(0)
  f32x16 pA0,pA1,pB0,pB1;
  int sl_prev=0,sl_cur=0,sl_next=SLOTB;
  #define ROT() do{sl_prev=sl_cur;sl_cur=sl_next;sl_next=(sl_next==(NSLOT-1)*SLOTB)?0:sl_next+SLOTB;}while(0)
  DMA_K(2,2*SLOTB);
  WAIT_BAR(3);
  qkt(pA0,pA1,Kbase,qr,zc16,r32,hi);asm volatile("s_nop 15\n\ts_nop 7":"+v"(pA0),"+v"(pA1));BIAS(pA0,pA1,0);CMASK(pA0,pA1,0);
  START(pA0,pA1);
  _Pragma("unroll") for(int r=0;r<16;++r)pA1[r]=__builtin_amdgcn_exp2f(pA1[r]);
  #define PFG(X0,X1,tn,k) do{ const f32x4_t a_=*(const f32x4_t*)(ckl+(tn)*64+4*hi+(((k)<4)?8*(k):32+8*((k)-4))); const float nm_=-mhat; \
      if((k)<4){ X0[4*(k)]=nm_-a_[0]; X0[4*(k)+1]=nm_-a_[1]; X0[4*(k)+2]=nm_-a_[2]; X0[4*(k)+3]=nm_-a_[3]; } \
      else { X1[4*((k)-4)]=nm_-a_[0]; X1[4*((k)-4)+1]=nm_-a_[1]; X1[4*((k)-4)+2]=nm_-a_[2]; X1[4*((k)-4)+3]=nm_-a_[3]; } }while(0)
  { PFG(pB0,pB1,1,0);PFG(pB0,pB1,1,1);PFG(pB0,pB1,1,2);PFG(pB0,pB1,1,3);PFG(pB0,pB1,1,4);PFG(pB0,pB1,1,5);PFG(pB0,pB1,1,6);PFG(pB0,pB1,1,7); }
  WAIT_BAR(0);
  DMA_K(3,0);DMA_V(1,SLOTB);
  ROT();
  kload8(kf,kp0+sl_cur);
  WAIT_BAR(2);
  s16x4 vlo[8],vhi[8]; u32x4 pw0,pw1,pw2,pw3;
  #define PKW(P,B) cvtpk_s(P[B],P[B+1])
  #define PAF(k) __builtin_bit_cast(bf16x8,pw##k)
  #define VFR(i) (bf16x8){vlo[i][0],vlo[i][1],vlo[i][2],vlo[i][3],vhi[i][0],vhi[i][1],vhi[i][2],vhi[i][3]}
  #define PIN(x) asm volatile("":"+v"(x))
  #define MX3(a,b,c) __builtin_fmaxf(__builtin_fmaxf((a),(b)),(c))
  #define GAPA(MF,A0,A1,A2,A3,W0,W1,PW) do{ MF; sacc+=A0; sacc+=A1; sacc+=A2; sacc+=A3; PIN(sacc); W0; W1; PIN(PW); SBAR(); }while(0)
  #define EX(v) __builtin_amdgcn_exp2f(v)
  #define GAPB(MF,X,B,PF) do{ MF; PF; X[B]=EX(X[B]); X[B+1]=EX(X[B+1]); X[B+2]=EX(X[B+2]); X[B+3]=EX(X[B+3]); PIN(X); SBAR(); }while(0)
  #define PFN(G,X0,X1,tt,k) do{ if(G){ PFG(X0,X1,(tt)+1,k); } }while(0)
  #define VRD(i) do{ vlo[i]=vtr(vp_+(((i)>>2)*4096+((i)&3)*1024)); vhi[i]=vtr(vp_+(((i)>>2)*4096+((i)&3)*1024+512)); }while(0)
  #define KRD(G,j) do{ if(G){ kload2(kf,kp0+sl_next,j); SBAR(); } }while(0)
  #define STEP(C0,C1,P0,P1,t,GK,GV,GL) do{ SBAR(); \
    const lds_cptr vp_=vp0+sl_prev; \
    VRD(0); SBAR(); float sacc=(P0[0]+P0[1]); \
    GAPA(C0=__builtin_amdgcn_mfma_f32_32x32x16_bf16(kf[0],qr[0],C0,0,0,0), P0[2],P0[3],P0[4],P0[5],     pw0[0]=PKW(P0,0), pw0[1]=PKW(P0,2), pw0); \
    VRD(4); SBAR(); GAPA(C1=__builtin_amdgcn_mfma_f32_32x32x16_bf16(kf[1],qr[0],C1,0,0,0), P0[6],P0[7],P0[8],P0[9],     pw0[2]=PKW(P0,4), pw0[3]=PKW(P0,6), pw0); \
    VRD(1); SBAR(); GAPA(C0=__builtin_amdgcn_mfma_f32_32x32x16_bf16(kf[2],qr[1],C0,0,0,0),   P0[10],P0[11],P0[12],P0[13], pw1[0]=PKW(P0,8), pw1[1]=PKW(P0,10), pw1); \
    VRD(5); SBAR(); GAPA(C1=__builtin_amdgcn_mfma_f32_32x32x16_bf16(kf[3],qr[1],C1,0,0,0),   P0[14],P0[15],P1[0],P1[1],   pw1[2]=PKW(P0,12),pw1[3]=PKW(P0,14), pw1); \
    VRD(2); SBAR(); GAPA(C0=__builtin_amdgcn_mfma_f32_32x32x16_bf16(kf[4],qr[2],C0,0,0,0),   P1[2],P1[3],P1[4],P1[5],     pw2[0]=PKW(P1,0), pw2[1]=PKW(P1,2), pw2); \
    VRD(6); SBAR(); GAPA(C1=__builtin_amdgcn_mfma_f32_32x32x16_bf16(kf[5],qr[2],C1,0,0,0),   P1[6],P1[7],P1[8],P1[9],     pw2[2]=PKW(P1,4), pw2[3]=PKW(P1,6), pw2); \
    VRD(3); SBAR(); GAPA(C0=__builtin_amdgcn_mfma_f32_32x32x16_bf16(kf[6],qr[3],C0,0,0,0),   P1[10],P1[11],P1[12],P1[13], pw3[0]=PKW(P1,8), pw3[1]=PKW(P1,10), pw3); \
    VRD(7); SBAR(); GAPA(C1=__builtin_amdgcn_mfma_f32_32x32x16_bf16(kf[7],qr[3],C1,0,0,0),   P1[14],P1[15],0.f,0.f,       pw3[2]=PKW(P1,12),pw3[3]=PKW(P1,14), pw3); \
    l_reg+=sacc; \
    if(GK){DMA_K((t)+3,sl_cur);} if(GV){DMA_V((t)+1,sl_next);} \
    CMASK(C0,C1,t); \
    { float a=MX3(C0[0],C0[1],C1[0]),b=MX3(C0[2],C0[3],C1[1]); a=MX3(a,C1[2],C1[3]); \
      _Pragma("unroll") for(int r=4;r<16;r+=4){a=MX3(a,C0[r],C0[r+1]);b=MX3(b,C0[r+2],C0[r+3]);a=MX3(a,C1[r],C1[r+1]);b=MX3(b,C1[r+2],C1[r+3]);} \
      float rm=__builtin_fmaxf(a,b); { auto rr=__builtin_amdgcn_permlane32_swap(__float_as_uint(rm),__float_as_uint(rm),false,false); rm=__builtin_fmaxf(__uint_as_float(rr[0]),__uint_as_float(rr[1])); } \
      resc=false; \
      if(__builtin_expect(__any(rm>(float)THRL),0)){ const float dl=__builtin_fmaxf(rm,0.f); mhat+=dl; \
        _Pragma("unroll") for(int r=0;r<16;++r){C0[r]-=dl;C1[r]-=dl;} \
        const float f=__builtin_amdgcn_exp2f(-dl); l_reg*=f; if(hi==0)wsf[r32]=f; resc=true; } } \
    SBAR(); \
    GAPB(o[0]=__builtin_amdgcn_mfma_f32_32x32x16_bf16(PAF(0),VFR(0),o[0],0,0,0), C0,0, PFN(GL,P0,P1,t,0)); \
    GAPB(o[1]=__builtin_amdgcn_mfma_f32_32x32x16_bf16(PAF(0),VFR(4),o[1],0,0,0), C0,4, PFN(GL,P0,P1,t,1)); \
    KRD(GL,0); GAPB(o[0]=__builtin_amdgcn_mfma_f32_32x32x16_bf16(PAF(1),VFR(1),o[0],0,0,0), C0,8, PFN(GL,P0,P1,t,2)); \
    KRD(GL,1); GAPB(o[1]=__builtin_amdgcn_mfma_f32_32x32x16_bf16(PAF(1),VFR(5),o[1],0,0,0), C0,12, PFN(GL,P0,P1,t,3)); \
    KRD(GL,2); GAPB(o[0]=__builtin_amdgcn_mfma_f32_32x32x16_bf16(PAF(2),VFR(2),o[0],0,0,0), C1,0, PFN(GL,P0,P1,t,4)); \
    KRD(GL,3); GAPB(o[1]=__builtin_amdgcn_mfma_f32_32x32x16_bf16(PAF(2),VFR(6),o[1],0,0,0), C1,4, PFN(GL,P0,P1,t,5)); \
    GAPB(o[0]=__builtin_amdgcn_mfma_f32_32x32x16_bf16(PAF(3),VFR(3),o[0],0,0,0), C1,8, PFN(GL,P0,P1,t,6)); \
    GAPB(o[1]=__builtin_amdgcn_mfma_f32_32x32x16_bf16(PAF(3),VFR(7),o[1],0,0,0), C1,12, PFN(GL,P0,P1,t,7)); \
    }while(0)
  int t=1;
  #undef CMASK
  #define CMASK(P0,P1,t) do{}while(0)
  for(;t+5<NT;t+=2){
    STEP(pB0,pB1,pA0,pA1,t,true,true,true);     WAIT_BAR(2); RESC(); ROT();
    STEP(pA0,pA1,pB0,pB1,t+1,true,true,true);   WAIT_BAR(2); RESC(); ROT();
  }
  #undef CMASK
  #define CMASK(P0,P1,t) do{int jb_=(t)-(NTm-4); if(jb_>=0)cmask(P0,P1,jb_,qrel,hi);}while(0)
  #define ENDW(tt) do{ if((tt)+3<NT){WAIT_BAR(2);} else if((tt)+2<NT){WAIT_BAR(1);} else {WAIT_BAR(0);} }while(0)
  for(;t+1<NT;t+=2){
    STEP(pB0,pB1,pA0,pA1,t,(t+3<NT),(t+1<NT),(t+1<NT));       ENDW(t);   RESC(); ROT();
    STEP(pA0,pA1,pB0,pB1,t+1,(t+4<NT),(t+2<NT),(t+2<NT));     ENDW(t+1); RESC(); ROT();
  }
  STEP(pB0,pB1,pA0,pA1,NT-1,false,false,false); RESC();
  { float sacc=pB0[0]+pB0[1]; _Pragma("unroll") for(int r=2;r<16;++r)sacc+=pB0[r]; _Pragma("unroll") for(int r=0;r<16;++r)sacc+=pB1[r]; l_reg+=sacc;
    pw0=(u32x4){PKW(pB0,0),PKW(pB0,2),PKW(pB0,4),PKW(pB0,6)};pw1=(u32x4){PKW(pB0,8),PKW(pB0,10),PKW(pB0,12),PKW(pB0,14)};pw2=(u32x4){PKW(pB1,0),PKW(pB1,2),PKW(pB1,4),PKW(pB1,6)};pw3=(u32x4){PKW(pB1,8),PKW(pB1,10),PKW(pB1,12),PKW(pB1,14)};
    SBAR(); pv(o,vb0+sl_cur,PAF(0),PAF(1),PAF(2),PAF(3)); }
  #undef PKW
  #undef PAF
  #undef VFR
  #undef PIN
  #undef MX3
  #undef GAPA
  #undef GAPB
  #undef PFN
  #undef PFG
  #undef EX
  #undef VRD
  #undef KRD
  #undef STEP
  #undef ENDW
  {auto rr=__builtin_amdgcn_permlane32_swap(__float_as_uint(l_reg),__float_as_uint(l_reg),false,false);l_reg=__uint_as_float(rr[0])+__uint_as_float(rr[1]);}
  if(hi==0){ wsf[32+r32]=l_reg; float*mlp=ML+((long)(q0+wid*QBLK+r32)*NHEAD+h)*2; mlp[0]=mhat; mlp[1]=l_reg; } asm volatile("s_waitcnt lgkmcnt(0)":::"memory");
  float rli[16];
  #pragma unroll
  for(int r=0;r<16;++r)rli[r]=__builtin_amdgcn_rcpf(wsf[32+crow(r,hi)]);
  bf16*Ow=O+(rowbase+q0+wid*QBLK)*DM+h*D;
  { bf16*stg=(bf16*)(shm+LDS_OST)+wid*2048;
    #pragma unroll
    for(int r=0;r<16;++r){const int orow=crow(r,hi);
      #pragma unroll
      for(int d0=0;d0<2;++d0)stg[orow*64+d0*32+r32]=__float2bfloat16(o[d0][r]*rli[r]);}
    asm volatile("s_waitcnt lgkmcnt(0)":::"memory");
    #pragma unroll
    for(int i=0;i<4;++i){const int row=i*8+(lane>>3),ch=lane&7; const u32x4 v=*(const u32x4*)(stg+row*64+ch*8); ATTN_STORE16(Ow+(long)row*DM+ch*8,v);} }
  asm volatile("s_waitcnt lgkmcnt(0)\n\ts_barrier":::"memory");
  #undef DMA_K
  #undef DMA_V
  #undef CMASK
  #undef BIAS
  #undef START
  #undef RESC
  #undef ROT
}

#undef SBAR
#undef WAIT_BAR
}
namespace cg = cooperative_groups;
constexpr int S_ = 16384, DMOD = 1024, NL = 4, DIN = 2568, NIN = 2816, DFF = 2816, NGU = 5632, NHD = 8;
constexpr float EPSN = 1e-6f;
constexpr size_t MiB = 1u << 20;
constexpr size_t WS_CTL = 0, CTL_BYTES = 65536;
constexpr size_t WS_WIN = 2 * MiB;
constexpr size_t WS_WOUT = 24 * MiB;
constexpr size_t WS_WGU = 32 * MiB;
constexpr size_t WS_WD = 76 * MiB;
constexpr size_t WS_XB = 98 * MiB;
constexpr size_t WS_RSSM = 130 * MiB;
constexpr size_t WS_RSSF = 130 * MiB + 128 * 1024;
constexpr size_t WS_LOGF = 130 * MiB + 256 * 1024;
constexpr size_t WS_C2 = 131 * MiB;
constexpr size_t WS_QKVZ = 132 * MiB;
constexpr size_t WS_O = 212 * MiB;
constexpr size_t WS_MG = 228 * MiB;
constexpr size_t WS_H = 132 * MiB;
constexpr size_t WS_OP = 260 * MiB;
constexpr size_t WS_ML = 308 * MiB;
constexpr size_t WS_END = 312 * MiB;
static_assert(WS_H + (size_t)S_ * DFF * 2 <= WS_MG, "h overlay");
constexpr int LDS_BYTES = 147456;
constexpr int CW_KMAX = 8192, CW_BAR = 9216, CW_SGUQ = 13312, CW_TS = 14336, CW_FCNT = 14400;
constexpr int NPHASE = 2 + 6 * NL;

#define LAS __attribute__((address_space(3)))
typedef unsigned short bf16r;
typedef unsigned v4u __attribute__((ext_vector_type(4)));
typedef float f32x4 __attribute__((ext_vector_type(4)));
typedef float f32x16 __attribute__((ext_vector_type(16)));
typedef short bf16x8 __attribute__((ext_vector_type(8)));
#define LDS_WAIT() asm volatile("s_waitcnt lgkmcnt(0)" ::: "memory")
__device__ __forceinline__ unsigned f2bf(float f) { unsigned u = __builtin_bit_cast(unsigned, f); return (u + 0x7fffu + ((u >> 16) & 1u)) >> 16; }
__device__ __forceinline__ unsigned pk2(float lo, float hi) { return f2bf(lo) | (f2bf(hi) << 16); }
__device__ __forceinline__ float bflo(unsigned w) { return __builtin_bit_cast(float, w << 16); }
__device__ __forceinline__ float bfhi(unsigned w) { return __builtin_bit_cast(float, w & 0xffff0000u); }
__device__ __forceinline__ float bf1(bf16r w) { return __builtin_bit_cast(float, (unsigned)w << 16); }
#define DPPF(v, ctrl) __builtin_bit_cast(float, __builtin_amdgcn_update_dpp(0, __builtin_bit_cast(int, (v)), (ctrl), 0xf, 0xf, true))
__device__ __forceinline__ float row16_sum(float v) {
    v += DPPF(v, 0xB1); v += DPPF(v, 0x4E); v += DPPF(v, 0x141); v += DPPF(v, 0x140); return v;
}
__device__ __forceinline__ float wave_sum(float v) {
    v += DPPF(v, 0xB1); v += DPPF(v, 0x4E); v += DPPF(v, 0x141); v += DPPF(v, 0x140);
    const int iv = __builtin_bit_cast(int, v);
    const float s0 = __builtin_bit_cast(float, __builtin_amdgcn_readlane(iv, 0)), s1 = __builtin_bit_cast(float, __builtin_amdgcn_readlane(iv, 16)),
                s2 = __builtin_bit_cast(float, __builtin_amdgcn_readlane(iv, 32)), s3 = __builtin_bit_cast(float, __builtin_amdgcn_readlane(iv, 48));
    return (s0 + s1) + (s2 + s3);
}
constexpr int PREP_P = 132;
__device__ __forceinline__ void prep_item(const float* W, int ldw, int srccol, const float* gs, bf16r* WT, int K, int dstrow, int k0, LAS float* scr, int lane) {
#pragma unroll 8
    for (int i = 0; i < 16; ++i) { const int kk = 2 * i + (lane >> 5); f32x4 w = *(const f32x4*)(W + (size_t)(k0 + kk) * ldw + srccol + 4 * (lane & 31)); if (gs) w = w * gs[k0 + kk];
        *(LAS f32x4*)(scr + kk * PREP_P + 4 * (lane & 31)) = w; }
    LDS_WAIT(); asm volatile("" ::: "memory");
    const int c = lane & 3;
#pragma unroll
    for (int j = 0; j < 8; ++j) { const int n = (lane >> 2) + 16 * j; const LAS float* s = scr + (8 * c) * PREP_P + n;
        v4u o; o.x = pk2(s[0 * PREP_P], s[1 * PREP_P]); o.y = pk2(s[2 * PREP_P], s[3 * PREP_P]); o.z = pk2(s[4 * PREP_P], s[5 * PREP_P]); o.w = pk2(s[6 * PREP_P], s[7 * PREP_P]);
        *(v4u*)(WT + (size_t)(dstrow + n) * K + k0 + 8 * c) = o; }
    LDS_WAIT(); asm volatile("" ::: "memory");
}
template <int OFF> __device__ __forceinline__ unsigned long long ldk() {
    unsigned long long v; auto ka = __builtin_amdgcn_kernarg_segment_ptr();
    asm volatile("s_load_dwordx2 %0, %1, %2\n\ts_waitcnt lgkmcnt(0)" : "=s"(v) : "s"(ka), "i"(OFF) : "memory");
    return v;
}
struct Ptrs {
    const float *x, *mixg, *w_in, *b_f, *lng, *lnb, *w_s, *b_s, *outg, *w_out, *ffng, *w_gu, *w_d, *fing;
    float* out; unsigned char* ws;
};
__device__ __forceinline__ void phase_prep(const Ptrs& P, LAS unsigned char* lds, int l0, int l1, int gw, int NGW, int wave, int lane) {
    LAS float* scr = (LAS float*)(lds + wave * (32 * PREP_P * 4));
    bf16r* WinT = (bf16r*)(P.ws + WS_WIN); bf16r* WoutT = (bf16r*)(P.ws + WS_WOUT); bf16r* WguT = (bf16r*)(P.ws + WS_WGU); bf16r* WdT = (bf16r*)(P.ws + WS_WD);
    constexpr int I_IN = 32 * 20, I_OUT = 32 * 8, I_GU = 32 * 44, I_D = 88 * 8, I_L = I_IN + I_OUT + I_GU + I_D;
    for (int it = l0 * I_L + gw; it < l1 * I_L; it += NGW) {
        const int l = it / I_L; int r = it % I_L;
        if (r < I_IN) { const int kb = r / 20, nb = r % 20, n0 = 128 * nb, src = n0 < 1536 ? n0 : n0 + 8;
            prep_item(P.w_in + (size_t)l * DMOD * DIN, DIN, src, P.mixg + l * DMOD, WinT + (size_t)l * NIN * DMOD, DMOD, n0, 32 * kb, scr, lane); continue; }
        r -= I_IN;
        if (r < I_OUT) { const int kb = r / 8, nb = r % 8;
            prep_item(P.w_out + (size_t)l * DMOD * DMOD, DMOD, 128 * nb, P.outg + l * DMOD, WoutT + (size_t)l * DMOD * DMOD, DMOD, 128 * nb, 32 * kb, scr, lane); continue; }
        r -= I_OUT;
        if (r < I_GU) { const int kb = r / 44, nb = r % 44, n0 = 128 * nb, pn = n0 >> 8, src = (n0 & 255) == 0 ? 128 * pn : DFF + 128 * pn;
            prep_item(P.w_gu + (size_t)l * DMOD * NGU, NGU, src, P.ffng + l * DMOD, WguT + (size_t)l * NGU * DMOD, DMOD, n0, 32 * kb, scr, lane); continue; }
        r -= I_GU;
        { const int kb = r / 8, nb = r % 8;
            prep_item(P.w_d + (size_t)l * DFF * DMOD, DMOD, 128 * nb, nullptr, WdT + (size_t)l * DMOD * DFF, DFF, 128 * nb, 32 * kb, scr, lane); }
    }
    for (int idx = l0 * 262144 + gw * 64 + lane; idx < l1 * 262144; idx += NGW * 64) { const int l = idx >> 18, rr = (idx >> 10) & 255, k = idx & 1023; unsigned v = 0u;
        if ((rr & 127) < 8) { const float w = P.w_in[((size_t)l * DMOD + k) * DIN + 1536 + (rr & 7)] * P.mixg[l * DMOD + k]; const unsigned hb = f2bf(w);
            v = rr < 128 ? hb : f2bf(w - __builtin_bit_cast(float, hb << 16)); }
        WinT[((size_t)l * NIN + 2560 + rr) * DMOD + k] = (bf16r)v; }
}
template <int MODE>
__device__ __forceinline__ void phase_rowstats(const float* xin, bf16r* xb, unsigned long long* rss_out, const float* gfin, float* outp, int gw, int NGW, int lane, float tdelta = 0.f) {
#pragma unroll 2
    for (int m = gw; m < S_; m += NGW) {
        const f32x4* xr = (const f32x4*)(xin + (size_t)m * DMOD) + lane;
        f32x4 v[4]; float s = 0.f;
#pragma unroll
        for (int j = 0; j < 4; ++j) { v[j] = xr[64 * j]; s += (v[j].x * v[j].x + v[j].y * v[j].y) + (v[j].z * v[j].z + v[j].w * v[j].w); }
        const float tot = wave_sum(s);
        if (MODE == 2) {
            const float rs = 1.0f / sqrtf(tot * (1.0f / DMOD) + EPSN);
            f32x4* orow = (f32x4*)(outp + (size_t)m * DMOD) + lane; const f32x4* gr = (const f32x4*)gfin + lane;
#pragma unroll
            for (int j = 0; j < 4; ++j) orow[64 * j] = v[j] * rs * gr[64 * j] + (m < 1024 ? tdelta : 0.f);
        } else {
            unsigned long long* o8 = (unsigned long long*)(xb + (size_t)m * DMOD) + lane;
#pragma unroll
            for (int j = 0; j < 4; ++j) o8[64 * j] = (unsigned long long)pk2(v[j].x, v[j].y) | ((unsigned long long)pk2(v[j].z, v[j].w) << 32);
            if (lane == 0) rss_out[m] = (unsigned long long)__float2ull_rn(tot * 16777216.0f);
        }
    }
}
__device__ __forceinline__ void final_norm(const bf16r* xb, const unsigned long long* rss, const float* g, float* outp, int gw, int NGW, int lane) {
#pragma unroll 2
    for (int m = gw; m < S_; m += NGW) {
        const v4u a = *(const v4u*)(xb + (size_t)m * DMOD + 8 * lane), b = *(const v4u*)(xb + (size_t)m * DMOD + 512 + 8 * lane);
        const float rs = 1.0f / sqrtf((float)rss[m] * (1.0f / (1024.0f * 16777216.0f)) + EPSN);
        const f32x4* gr = (const f32x4*)g; f32x4* orow = (f32x4*)(outp + (size_t)m * DMOD);
        const f32x4 g0 = gr[2 * lane], g1 = gr[2 * lane + 1], g2 = gr[128 + 2 * lane], g3 = gr[128 + 2 * lane + 1];
        orow[2 * lane] = (f32x4){bflo(a.x), bfhi(a.x), bflo(a.y), bfhi(a.y)} * rs * g0; orow[2 * lane + 1] = (f32x4){bflo(a.z), bfhi(a.z), bflo(a.w), bfhi(a.w)} * rs * g1;
        orow[128 + 2 * lane] = (f32x4){bflo(b.x), bfhi(b.x), bflo(b.y), bfhi(b.y)} * rs * g2; orow[128 + 2 * lane + 1] = (f32x4){bflo(b.z), bfhi(b.z), bflo(b.w), bfhi(b.w)} * rs * g3;
    }
}
__device__ __forceinline__ void cumsum_head(const float* logf, float* c2, int h, LAS unsigned char* lds, int tid) {
    LAS double* scr = (LAS double*)lds;
    const f32x4* src = (const f32x4*)(logf + (size_t)h * S_ + tid * 32);
    f32x4 v[8]; double sum = 0.0;
#pragma unroll
    for (int e = 0; e < 8; ++e) { v[e] = src[e]; sum += ((double)v[e].x + (double)v[e].y) + ((double)v[e].z + (double)v[e].w); }
    scr[tid] = sum; __syncthreads();
    double pre = 0.0; for (int i = 0; i < tid; ++i) pre += scr[i];
    f32x4* dst = (f32x4*)(c2 + (size_t)h * S_ + tid * 32);
#pragma unroll
    for (int e = 0; e < 8; ++e) { f32x4 o; pre += (double)v[e].x; o.x = (float)(pre * 1.4426950408889634); pre += (double)v[e].y; o.y = (float)(pre * 1.4426950408889634);
        pre += (double)v[e].z; o.z = (float)(pre * 1.4426950408889634); pre += (double)v[e].w; o.w = (float)(pre * 1.4426950408889634); dst[e] = o; }
    __syncthreads();
}
__device__ __forceinline__ void sgu_item(int c, const bf16r* ZU, const bf16r* ZV, bf16r* MG, const float* lng, const float* lnb, const float* wsl, const float* bsl,
                                         LAS unsigned char* lds, int wid, int lane) {
    LAS float* bsb = (LAS float*)lds;
    LAS bf16r* zt = (LAS bf16r*)(lds + 4096);
    const int r32 = lane & 31, hi = lane >> 5, g = wid, tid = wid * 64 + lane;
    bsb[tid] = bsl[tid]; bsb[tid + 512] = bsl[tid + 512];
    const int rs4 = lane >> 4, l16 = lane & 15;
#pragma unroll 2
    for (int it = 0; it < 4; ++it) { const int i = 16 * wid + 4 * it + rs4; const size_t row = (size_t)c * 128 + i;
        v4u zr[4];
#pragma unroll
        for (int j = 0; j < 4; ++j) zr[j] = *(const v4u*)(ZV + row * 512 + 128 * j + 8 * l16);
        float z[32]; float s = 0.f;
#pragma unroll
        for (int j = 0; j < 4; ++j) { z[8 * j] = bflo(zr[j].x); z[8 * j + 1] = bfhi(zr[j].x); z[8 * j + 2] = bflo(zr[j].y); z[8 * j + 3] = bfhi(zr[j].y); z[8 * j + 4] = bflo(zr[j].z); z[8 * j + 5] = bfhi(zr[j].z); z[8 * j + 6] = bflo(zr[j].w); z[8 * j + 7] = bfhi(zr[j].w); }
#pragma unroll
        for (int e = 0; e < 32; ++e) s += z[e];
        const float mean = row16_sum(s) * (1.0f / 512.0f); float q = 0.f;
#pragma unroll
        for (int e = 0; e < 32; ++e) { z[e] -= mean; q += z[e] * z[e]; }
        const float rstd = 1.0f / sqrtf(row16_sum(q) * (1.0f / 512.0f) + EPSN);
#pragma unroll
        for (int j = 0; j < 4; ++j) { const f32x4 g0 = *(const f32x4*)(lng + 128 * j + 8 * l16), g1 = *(const f32x4*)(lng + 128 * j + 8 * l16 + 4), b0 = *(const f32x4*)(lnb + 128 * j + 8 * l16), b1 = *(const f32x4*)(lnb + 128 * j + 8 * l16 + 4);
            v4u zw; zw.x = pk2(z[8 * j] * rstd * g0.x + b0.x, z[8 * j + 1] * rstd * g0.y + b0.y); zw.y = pk2(z[8 * j + 2] * rstd * g0.z + b0.z, z[8 * j + 3] * rstd * g0.w + b0.w);
            zw.z = pk2(z[8 * j + 4] * rstd * g1.x + b1.x, z[8 * j + 5] * rstd * g1.y + b1.y); zw.w = pk2(z[8 * j + 6] * rstd * g1.z + b1.z, z[8 * j + 7] * rstd * g1.w + b1.w);
            *(LAS v4u*)(zt + i * 512 + 128 * j + 8 * l16) = zw; }
    }
    LDS_WAIT(); __syncthreads();
#pragma unroll 1
    for (int ni = 0; ni < 2; ++ni) {
        const int d = 64 * g + 32 * ni + r32;
        bf16x8 bfr[8];
#pragma unroll
        for (int ks = 0; ks < 8; ++ks) { const LAS bf16r* zp = zt + (16 * ks + 8 * hi) * 512 + d;
            v4u w; w.x = (unsigned)zp[0] | ((unsigned)zp[512] << 16); w.y = (unsigned)zp[1024] | ((unsigned)zp[1536] << 16); w.z = (unsigned)zp[2048] | ((unsigned)zp[2560] << 16); w.w = (unsigned)zp[3072] | ((unsigned)zp[3584] << 16);
            bfr[ks] = __builtin_bit_cast(bf16x8, w); }
        LDS_WAIT(); asm volatile("" ::: "memory");
        f32x16 acc[4];
#pragma unroll
        for (int mi = 0; mi < 4; ++mi) { acc[mi] = f32x16{};
#pragma unroll
            for (int ks = 0; ks < 8; ++ks) { if (mi < 2 && ks >= 4) continue;
                const float* wp = wsl + ((size_t)g * 128 + 32 * mi + r32) * 128 + 16 * ks + 8 * hi; const f32x4 a0 = *(const f32x4*)wp, a1 = *(const f32x4*)(wp + 4);
                v4u w; w.x = pk2(a0.x, a0.y); w.y = pk2(a0.z, a0.w); w.z = pk2(a1.x, a1.y); w.w = pk2(a1.z, a1.w);
                acc[mi] = __builtin_amdgcn_mfma_f32_32x32x16_bf16(__builtin_bit_cast(bf16x8, w), bfr[ks], acc[mi], 0, 0, 0); }
            asm volatile("" ::: "memory"); }
#pragma unroll
        for (int mi = 0; mi < 4; ++mi)
#pragma unroll
            for (int r = 0; r < 16; ++r) { const int i = 32 * mi + (r & 3) + 8 * (r >> 2) + 4 * hi;
                zt[i * 512 + d] = (bf16r)f2bf(acc[mi][r] + bsb[g * 128 + i]); }
        LDS_WAIT(); asm volatile("" ::: "memory");
    }
    __syncthreads();
#pragma unroll 2
    for (int it = 0; it < 4; ++it) { const int i = 16 * wid + 4 * it + rs4; const size_t row = (size_t)c * 128 + i;
        float a[32]; float ss = 0.f;
#pragma unroll
        for (int j = 0; j < 4; ++j) { const v4u tr = *(const LAS v4u*)(zt + i * 512 + 128 * j + 8 * l16); const v4u ur = *(const v4u*)(ZU + row * 512 + 128 * j + 8 * l16);
            a[8 * j] = bflo(tr.x) * bflo(ur.x); a[8 * j + 1] = bfhi(tr.x) * bfhi(ur.x); a[8 * j + 2] = bflo(tr.y) * bflo(ur.y); a[8 * j + 3] = bfhi(tr.y) * bfhi(ur.y);
            a[8 * j + 4] = bflo(tr.z) * bflo(ur.z); a[8 * j + 5] = bfhi(tr.z) * bfhi(ur.z); a[8 * j + 6] = bflo(tr.w) * bflo(ur.w); a[8 * j + 7] = bfhi(tr.w) * bfhi(ur.w); }
#pragma unroll
        for (int e = 0; e < 32; ++e) ss += a[e] * a[e];
        const float ra = 1.0f / sqrtf(row16_sum(ss) * (1.0f / 512.0f) + EPSN);
#pragma unroll
        for (int j = 0; j < 4; ++j) { v4u w; w.x = pk2(a[8 * j] * ra, a[8 * j + 1] * ra); w.y = pk2(a[8 * j + 2] * ra, a[8 * j + 3] * ra); w.z = pk2(a[8 * j + 4] * ra, a[8 * j + 5] * ra); w.w = pk2(a[8 * j + 6] * ra, a[8 * j + 7] * ra);
            *(v4u*)(MG + row * 1024 + 512 + 128 * j + 8 * l16) = w; }
    }
    LDS_WAIT(); __syncthreads();
}
__device__ __forceinline__ void combine_item(int c, const bf16r* O, const bf16r* OP1, const float* ML, bf16r* MG, int wid, int lane) {
    const int rs4 = lane >> 4, l16 = lane & 15;
#pragma unroll
    for (int it = 0; it < 2; ++it) { const size_t row = (size_t)c * 64 + 8 * wid + 4 * it + rs4; const int nch = ((int)(row >> 12)) + 1;
        float a[32]; float ss = 0.f;
#pragma unroll
        for (int j = 0; j < 4; ++j) { const int hh = 2 * j + (l16 >> 3); float Mj[4], lj[4]; v4u oj[4];
#pragma unroll
            for (int q = 0; q < 4; ++q) { if (q < nch) { const float* mlp = ML + (size_t)q * S_ * 16 + (row * 8 + hh) * 2; Mj[q] = mlp[0]; lj[q] = mlp[1];
                    oj[q] = (q == 0 || lj[q] > 0.f) ? *(const v4u*)((q == 0 ? O : OP1 + (size_t)(q - 1) * S_ * 512) + row * 512 + 128 * j + 8 * l16) : (v4u){0u, 0u, 0u, 0u}; } else { Mj[q] = -1.0e30f; lj[q] = 0.f; oj[q] = (v4u){0u, 0u, 0u, 0u}; } }
            const float Mmax = fmaxf(fmaxf(Mj[0], Mj[1]), fmaxf(Mj[2], Mj[3])); float wsum = 0.f; float t[8] = {0.f, 0.f, 0.f, 0.f, 0.f, 0.f, 0.f, 0.f};
#pragma unroll
            for (int q = 0; q < 4; ++q) { const float w = lj[q] > 0.f ? lj[q] * __builtin_amdgcn_exp2f(Mj[q] - Mmax) : 0.f; wsum += w;
                if (w > 0.f) { t[0] += w * bflo(oj[q].x); t[1] += w * bfhi(oj[q].x); t[2] += w * bflo(oj[q].y); t[3] += w * bfhi(oj[q].y); t[4] += w * bflo(oj[q].z); t[5] += w * bfhi(oj[q].z); t[6] += w * bflo(oj[q].w); t[7] += w * bfhi(oj[q].w); } }
            const float iw = 1.0f / wsum;
#pragma unroll
            for (int e = 0; e < 8; ++e) { a[8 * j + e] = t[e] * iw; ss += a[8 * j + e] * a[8 * j + e]; } }
        const float ra = 1.0f / sqrtf(row16_sum(ss) * (1.0f / 512.0f) + EPSN);
#pragma unroll
        for (int j = 0; j < 4; ++j) { v4u w; w.x = pk2(a[8 * j] * ra, a[8 * j + 1] * ra); w.y = pk2(a[8 * j + 2] * ra, a[8 * j + 3] * ra); w.z = pk2(a[8 * j + 4] * ra, a[8 * j + 5] * ra); w.w = pk2(a[8 * j + 6] * ra, a[8 * j + 7] * ra);
            *(v4u*)(MG + row * 1024 + 128 * j + 8 * l16) = w; }
    }
}
#define XB_TMO      128
#define XB_XCNT(j)  (256  + 64 * (j))
#define XB_XSUB(j)  (1280 + 64 * (j))
#define XB_XGEN(j)  (2304 + 64 * (j))
#define XB_TOP      3328
#define XB_TOPGEN   3392
#define XCD_BAR_WORDS 3456
#define XB_SPIN_CAP (1u << 18)

__device__ __forceinline__ unsigned xb_ld(unsigned* p)              { return __hip_atomic_load(p, __ATOMIC_RELAXED, __HIP_MEMORY_SCOPE_AGENT); }
__device__ __forceinline__ unsigned xb_add(unsigned* p, unsigned v) { return __hip_atomic_fetch_add(p, v, __ATOMIC_RELAXED, __HIP_MEMORY_SCOPE_AGENT); }
__device__ __forceinline__ unsigned xb_xcc_id() { return (unsigned)__builtin_amdgcn_s_getreg((3 << 11) | 20) & 0xFu; }
#define XB_SPIN(cond, bar) do { unsigned _sp = 0; while (cond) { __builtin_amdgcn_s_sleep(1); \
    if ((++_sp & 255u) == 0u) { if (xb_ld(&(bar)[XB_TMO])) break; if (_sp > XB_SPIN_CAP) { atomicAdd(&(bar)[XB_TMO], 1u); break; } } } } while (0)

struct XcdBarrier {
    unsigned* bar; unsigned x;
    volatile LAS unsigned* st;
};

__device__ __forceinline__ XcdBarrier xcd_barrier_post(unsigned* bar, volatile LAS unsigned* st) {
    XcdBarrier b; b.bar = bar; b.x = xb_xcc_id(); b.st = st;
    if (threadIdx.x == 0) (void)xb_add(&bar[XB_XCNT(b.x)], 1u);
    return b;
}
__device__ __forceinline__ void xcd_barrier_complete(unsigned* bar, unsigned x, unsigned& nloc, unsigned& nx) {
    const unsigned G = gridDim.x * gridDim.y * gridDim.z;
    unsigned sum, cnt, mine, sp = 0u;
    for (;;) {
        sum = 0u; cnt = 0u; mine = 0u;
#pragma unroll
        for (unsigned j = 0; j < 16; ++j) { const unsigned c = xb_ld(&bar[XB_XCNT(j)]); sum += c; cnt += (c > 0u) ? 1u : 0u; mine = (j == x) ? c : mine; }
        if (sum == G) break;
        __builtin_amdgcn_s_sleep(1);
        if ((++sp & 255u) == 0u) { if (xb_ld(&bar[XB_TMO])) break; if (sp > XB_SPIN_CAP) { atomicAdd(&bar[XB_TMO], 1u); break; } }
    }
    nloc = mine > 0u ? mine : 1u; nx = cnt > 0u ? cnt : 1u;
}

__device__ __forceinline__ void xcd_barrier(const XcdBarrier& b) {
    asm volatile("s_waitcnt vmcnt(0)" ::: "memory");
    __syncthreads();
    if (threadIdx.x == 0) {
        unsigned* bar = b.bar;
        __builtin_amdgcn_s_waitcnt(0);
        unsigned nloc = b.st[0], nx = b.st[1];
        if (nloc == 0u) { xcd_barrier_complete(bar, b.x, nloc, nx); b.st[0] = nloc; b.st[1] = nx; }
        const unsigned old = xb_add(&bar[XB_XSUB(b.x)], 1u);
        const unsigned gen = old / nloc;
        if (old + 1u == (gen + 1u) * nloc) {
            __builtin_amdgcn_fence(__ATOMIC_RELEASE, "agent");
            asm volatile("s_waitcnt vmcnt(0)" ::: "memory");
            const unsigned og = xb_add(&bar[XB_TOP], 1u);
            const unsigned tg = og / nx;
            if (og + 1u == (tg + 1u) * nx) xb_add(&bar[XB_TOPGEN], 1u);
            else XB_SPIN(xb_ld(&bar[XB_TOPGEN]) == tg, bar);
            __builtin_amdgcn_fence(__ATOMIC_ACQUIRE, "agent");
            xb_add(&bar[XB_XGEN(b.x)], 1u);
            asm volatile("s_waitcnt vmcnt(0)" ::: "memory");
        } else {
            XB_SPIN(xb_ld(&bar[XB_XGEN(b.x)]) == gen, bar);
            __builtin_amdgcn_fence(__ATOMIC_ACQUIRE, "agent");
            asm volatile("s_waitcnt vmcnt(0)" ::: "memory");
        }
    }
    __syncthreads();
}
#ifndef MK_MULTI
#define MK_MULTI 0
#endif
struct Args { const float* in[14]; float* out; unsigned char* ws; int ph_lo, ph_hi; };
__global__ void __launch_bounds__(512, 2) fox_fwd(Args args) {
    extern __shared__ __attribute__((aligned(16))) unsigned char lds[];
    cg::grid_group grid = cg::this_grid();
    LAS unsigned char* L = (LAS unsigned char*)lds;
    const int G = gridDim.x, bx = blockIdx.x;
    const int vcu = (G % 8 == 0) ? (bx % 8) * (G / 8) + bx / 8 : bx;
    const int NGW = G * 8;
#define IDS() int tid = threadIdx.x; asm volatile("" : "+v"(tid)); const int lane = tid & 63, wave = __builtin_amdgcn_readfirstlane(tid >> 6), gw = vcu * 8 + wave; (void)lane; (void)gw
#define KIN(k) ((const float*)(const __attribute__((address_space(1))) float*)ldk<8 * (k)>())
#define WSB() ((unsigned char*)(__attribute__((address_space(1))) unsigned char*)ldk<120>())
#define P_OUT ((float*)(__attribute__((address_space(1))) float*)ldk<112>())
#define ctl ((unsigned*)(WSB() + WS_CTL))
#define WinT ((bf16r*)(WSB() + WS_WIN))
#define WoutT ((bf16r*)(WSB() + WS_WOUT))
#define WguT ((bf16r*)(WSB() + WS_WGU))
#define WdT ((bf16r*)(WSB() + WS_WD))
#define XB ((bf16r*)(WSB() + WS_XB))
#define RSSM ((unsigned long long*)(WSB() + WS_RSSM))
#define RSSF ((unsigned long long*)(WSB() + WS_RSSF))
#define LOGF ((float*)(WSB() + WS_LOGF))
#define C2A ((float*)(WSB() + WS_C2))
#define QKVZ ((bf16r*)(WSB() + WS_QKVZ))
#define OB ((bf16r*)(WSB() + WS_O))
#define MG ((bf16r*)(WSB() + WS_MG))
#define HB ((bf16r*)(WSB() + WS_H))
#define OP1 ((bf16r*)(WSB() + WS_OP))
#define MLB ((float*)(WSB() + WS_ML))
#define MKP() Ptrs P; P.x = KIN(0); P.mixg = KIN(1); P.w_in = KIN(2); P.b_f = KIN(3); P.lng = KIN(4); P.lnb = KIN(5); P.w_s = KIN(6); P.b_s = KIN(7); \
    P.outg = KIN(8); P.w_out = KIN(9); P.ffng = KIN(10); P.w_gu = KIN(11); P.w_d = KIN(12); P.fing = KIN(13); P.out = P_OUT; P.ws = WSB()
    constexpr size_t QS = (size_t)S_ * 512;
    const int lo = args.ph_lo, hi = args.ph_hi;
    { LAS unsigned* misc = (LAS unsigned*)(L + 147456 - 8); if (threadIdx.x < 2) misc[threadIdx.x] = 0u; __syncthreads(); }
    XcdBarrier xbar = xcd_barrier_post((unsigned*)(WSB() + WS_CTL) + CW_BAR, (volatile LAS unsigned*)(L + 147456 - 8));
    int ph = 0;
#ifdef PROBE_T
    unsigned long long tacc_ = 0ull, tst_ = 0ull;
#define TCLS() ((ph == 0) ? 0 : (ph <= 7 * NL ? ((ph - 1) % 7) + 1 : 8))
#define TBEG() do { if (TCLS() == PROBE_T) tst_ = __builtin_amdgcn_s_memrealtime(); } while (0)
#define TEND() do { if (TCLS() == PROBE_T) tacc_ += __builtin_amdgcn_s_memrealtime() - tst_; } while (0)
#else
#define TBEG() do {} while (0)
#define TEND() do {} while (0)
#endif
#define RUN() (ph >= lo && ph < hi)
#ifdef PROBE_SYNC
#define SEAM() do { ++ph; if (ph > lo && ph < hi) { if (ph == 1) { grid.sync(); grid.sync(); } else { xcd_barrier(xbar); xcd_barrier(xbar); } } } while (0)
#else
#define SEAM() do { ++ph; if (ph > lo && ph < hi) { if (lo < 0) grid.sync(); xcd_barrier(xbar); } --ph; TEND(); ++ph; TBEG(); } while (0)
#endif
#ifdef PROBE_SMALL
#define REPS 2
#else
#define REPS 1
#endif
#ifndef FH_TABLE
#define FH_TABLE 0x76545677u
#endif
#ifndef FOX_THRL
#define FOX_THRL 8
#endif
#ifndef SGU_AT
#define SGU_AT 1
#endif
#ifdef PROBE_GEMM
#define REPG 2
#else
#define REPG 1
#endif
#ifdef PROBE_ATTN
#define REPA 2
#else
#define REPA 1
#endif

#ifndef NO_P0
    if (RUN()) { IDS(); MKP(); for (int rp = 0; rp < REPS; ++rp) { phase_prep(P, L, 0, 1, gw, NGW, wave, lane); phase_rowstats<1>(P.x, (bf16r*)(P.ws + WS_XB), (unsigned long long*)(P.ws + WS_RSSM), nullptr, nullptr, gw, NGW, lane); } }
#endif
    SEAM();
    for (int l = 0; l < NL; ++l) {
#ifndef NO_INPROJ
        if (RUN()) {
            { IDS(); unsigned long long* rz = RSSF; if (bx < 256 && tid < 64) { unsigned zlo = 0u; asm volatile("" : "+v"(zlo)); rz[bx * 64 + tid] = (unsigned long long)zlo; }     }
            pg8::Gemm g{XB, WinT + (size_t)l * NIN * DMOD, S_, NIN, DMOD}; pg8::StaticOrder So; So.init(S_, NIN, G, bx); So.rot = NIN / 256 - 1;
            pg8::EpiInProj E{QKVZ, QS, RSSM, ctl + CW_KMAX + l * 16, KIN(3) + l * 8, LOGF, ctl + CW_FCNT + l * 64};
            for (int rg = 0; rg < REPG; ++rg) pg8::gemm_phase<pg8::EpiInProj, pg8::StaticOrder, true, true>(L, g, So, E);
            if (bx >= G - NHD) {
                IDS(); unsigned* const fc = ctl + CW_FCNT + l * 64;
                if (tid == 0) { unsigned sp = 0; while (__hip_atomic_load(fc, __ATOMIC_RELAXED, __HIP_MEMORY_SCOPE_AGENT) < 64u * REPG) { __builtin_amdgcn_s_sleep(8); if (++sp > (1u << 20)) break; }
                    __builtin_amdgcn_fence(__ATOMIC_ACQUIRE, "agent"); }
                __syncthreads();
                cumsum_head(LOGF, C2A, bx - (G - NHD), L, tid);
            }
        }
#endif
        SEAM();
#ifndef NO_ATTN
        if (RUN()) {
            IDS(); LAS unsigned* bc = (LAS unsigned*)(L + 147456 - 64);
            unsigned* const ctlp = ctl; unsigned char* const wsp = WSB();
            const int fh = (int)((FH_TABLE >> (4 * (bx & 7))) & 7u);
            for (int rp = 0; rp < REPA; ++rp)
            for (int qi = 0; qi <= NHD; ++qi) { const int h = (qi == 0) ? fh : (NHD - qi); if (qi > 0 && h == fh) continue;
                if (qi == SGU_AT && rp == 0) {
            for (;;) {
                if (tid == 0) bc[0] = atomicAdd(ctlp + CW_SGUQ + (l) * 64, 1u);
                __syncthreads(); const unsigned u = bc[0]; __syncthreads();
                if (u >= (unsigned)(S_ / 128)) break;
                bf16r* const qkvz = (bf16r*)(wsp + WS_QKVZ);
                sgu_item((int)u, qkvz + 3 * QS, qkvz + 4 * QS, (bf16r*)(wsp + WS_MG), KIN(4) + l * 512, KIN(5) + l * 512, KIN(6) + (size_t)l * 8 * 128 * 128, KIN(7) + l * 8 * 128, L, wave, lane);
            }
                }
                const float kn = sqrtf((__uint_as_float(ctlp[CW_KMAX + l * 16 + 2 * h]) + __uint_as_float(ctlp[CW_KMAX + l * 16 + 2 * h + 1])) * 1.02f);
                for (;;) {
                    if (tid == 0) bc[0] = atomicAdd(ctlp + ((rp * NL + l) * NHD + h) * 64, 1u);
                    __syncthreads(); const unsigned u = bc[0]; __syncthreads();
                    if (u >= 160u) break;
                    int qb, jc;
                    if (u < 64u) { qb = 63 - (int)(u >> 2); jc = (int)(u & 3u); } else if (u < 112u) { const int v = (int)u - 64; qb = 47 - v / 3; jc = v % 3; }
                    else if (u < 144u) { const int v = (int)u - 112; qb = 31 - (v >> 1); jc = v & 1; } else { qb = 15 - ((int)u - 144); jc = 0; }
                    bf16r* const qkvz = (bf16r*)(wsp + WS_QKVZ);
                    attn_body::fox_unit2<FOX_THRL>(h, qb, jc, kn, (const attn_body::bf16*)qkvz, (const attn_body::bf16*)(qkvz + QS), (const attn_body::bf16*)(qkvz + 2 * QS),
                                            (attn_body::bf16*)(jc == 0 ? (bf16r*)(wsp + WS_O) : (bf16r*)(wsp + WS_OP) + (size_t)(jc - 1) * QS), (float*)(wsp + WS_ML) + (size_t)jc * S_ * 16, (float*)(wsp + WS_C2) + (size_t)h * S_, (char*)lds, (float*)(lds + 147456 - 48));
                } }
        }
#endif
        SEAM();
#ifndef NO_MERGE
        if (RUN()) { IDS(); for (int rp = 0; rp < REPS; ++rp) for (int it = vcu; it < S_ / 64; it += G) combine_item(it, OB, OP1, MLB, MG, wave, lane); }
#endif
        SEAM();
#ifndef NO_OUTPROJ
        if (RUN()) {
            { IDS(); unsigned long long* rz = RSSM; if (bx < 256 && tid < 64) { unsigned zlo = 0u; asm volatile("" : "+v"(zlo)); rz[bx * 64 + tid] = (unsigned long long)zlo; }     }
            pg8::Gemm g{MG, WoutT + (size_t)l * DMOD * DMOD, S_, DMOD, DMOD}; pg8::StaticOrder So; So.init(S_, DMOD, G, bx);
            pg8::EpiResid E{XB, RSSF};
            pg8::gemm_phase<pg8::EpiResid, pg8::StaticOrder, true, true>(L, g, So, E);
        }
#endif
        SEAM();
#ifndef NO_GU
        if (RUN()) {
            pg8::Gemm g{XB, WguT + (size_t)l * NGU * DMOD, S_, NGU, DMOD}; pg8::StaticOrder So; So.init(S_, NGU, G, bx);
            pg8::EpiSwiGLU E{HB, RSSF};
            for (int rg = 0; rg < REPG; ++rg) pg8::gemm_phase<pg8::EpiSwiGLU, pg8::StaticOrder, true, true>(L, g, So, E);
            if (l + 1 < NL) { IDS(); MKP(); if (G == 256) { if (bx >= 128) phase_prep(P, L, l + 1, l + 2, (bx - 128) * 8 + wave, 1024, wave, lane); } else phase_prep(P, L, l + 1, l + 2, gw, NGW, wave, lane); }
        }
#endif
        SEAM();
#ifndef NO_DOWN
        if (RUN()) {
            pg8::Gemm g{HB, WdT + (size_t)l * DMOD * DFF, S_, DMOD, DFF}; pg8::StaticOrder So; So.init(S_, DMOD, G, bx);
            pg8::EpiResid E{XB, RSSM};
            pg8::gemm_phase<pg8::EpiResid, pg8::StaticOrder, true, true>(L, g, So, E);
        }
#endif
        SEAM();
    }
#ifndef NO_RSN
#ifdef PROBE_T
    { if (blockIdx.x == 0 && threadIdx.x == 0) { ((unsigned*)(WSB() + WS_CTL))[CW_TS] = (unsigned)tacc_; __threadfence(); } xcd_barrier(xbar); }
    const float tdelta = (PROBE_T == 99) ? 0.1f : (float)__hip_atomic_load((unsigned*)(WSB() + WS_CTL) + CW_TS, __ATOMIC_RELAXED, __HIP_MEMORY_SCOPE_AGENT) * 2.0e-7f;
#else
    const float tdelta = 0.f;
#endif
    if (RUN()) { IDS(); final_norm(XB, RSSM, KIN(13), P_OUT, gw, NGW, lane); }
#endif
    SEAM();
#undef RUN
#undef SEAM
}

extern "C" void kernel_launch(void* const* d_in, const int* in_sizes, int n_in, void* d_out, int out_size, void* d_ws, size_t ws_size, hipStream_t stream) {
    static int grid = 0;
    if (grid == 0) {
        if (n_in != 14 || out_size != S_ * DMOD || ws_size < WS_END) { fprintf(stderr, "kernel_launch: unexpected shapes (n_in %d out %d ws %zu)\n", n_in, out_size, ws_size); grid = -1; return; }
        int dev = 0, cus = 0, per_cu = 0;
        hipGetDevice(&dev); hipDeviceGetAttribute(&cus, hipDeviceAttributeMultiprocessorCount, dev);
        if (hipFuncSetAttribute((const void*)fox_fwd, hipFuncAttributeMaxDynamicSharedMemorySize, LDS_BYTES) != hipSuccess) { fprintf(stderr, "kernel_launch: hipFuncSetAttribute failed\n"); grid = -1; return; }
        if (hipOccupancyMaxActiveBlocksPerMultiprocessor(&per_cu, (const void*)fox_fwd, 512, LDS_BYTES) != hipSuccess || per_cu < 1) { fprintf(stderr, "kernel_launch: occupancy query says %d\n", per_cu); per_cu = 1; }
        (void)hipGetLastError();
        grid = cus * per_cu;
        if (grid < 256) { fprintf(stderr, "kernel_launch: this kernel needs a resident grid of at least 256 workgroups, got %d\n", grid); grid = -1; return; }
        fprintf(stderr, "kernel_launch: grid %d (cus %d x %d)\n", grid, cus, per_cu);
    }
    if (grid < 0) return;
    hipMemsetAsync((char*)d_ws + WS_CTL, 0, CTL_BYTES, stream);
    Args a{};
    for (int i = 0; i < 14; ++i) a.in[i] = (const float*)d_in[i];
    a.out = (float*)d_out; a.ws = (unsigned char*)d_ws;
#if MK_MULTI
    for (int p = 0; p < NPHASE; ++p) { a.ph_lo = p; a.ph_hi = p + 1; hipLaunchKernelGGL(fox_fwd, dim3(grid), dim3(512), LDS_BYTES, stream, a); }
#else
    a.ph_lo = 0; a.ph_hi = NPHASE;
    void* kargs[] = {&a};
    hipError_t e = hipLaunchCooperativeKernel((const void*)fox_fwd, dim3(grid), dim3(512), kargs, LDS_BYTES, stream);
    if (e != hipSuccess) fprintf(stderr, "kernel_launch: cooperative launch failed: %s (grid %d)\n", hipGetErrorString(e), grid);
#endif
}
```

```cpp
#define MK_MULTI 0
#define FOX_THRL 64
#include <hip/hip_runtime.h>
#include <hip/hip_cooperative_groups.h>
#include <cstdio>
#include <cstdint>
namespace pg8 {
#define PG8_LAS __attribute__((address_space(3)))
typedef unsigned short bf16_t;
typedef short bf16x8 __attribute__((ext_vector_type(8)));
typedef float f32x4 __attribute__((ext_vector_type(4)));
typedef unsigned u32x4 __attribute__((ext_vector_type(4)));
constexpr int BM = 256, BK = 64, HALF = 128, HTB = HALF * BK * 2  , STAGE_BYTES = 8 * HTB, NXCD = 8, WGM = 8;

__host__ __device__ __forceinline__ int lds_byte(int r, int c) { const int st = (r >> 4) * 2 + (c >> 5), rr = r & 15, cc = c & 31, ob = rr * 64 + cc * 2; return st * 1024 + (ob ^ (((ob >> 9) & 1) << 5)); }
__host__ __device__ __forceinline__ void stage_rc(int b, int& R, int& C) { const int st = b / 1024, sb = b % 1024, swz = sb ^ (((sb >> 9) & 1) << 5); R = (st >> 1) * 16 + swz / 64; C = (st & 1) * 32 + (swz % 64) / 2; }
__host__ __device__ __forceinline__ int perm32(int rho) { const int n = rho >> 4, i = rho & 15; return 8 * (i >> 2) + 4 * n + (i & 3); }

struct Unit { int pm, pn; };
struct Gemm { const bf16_t* A; const bf16_t* Bt; int M, N, K; };

struct StaticOrder {
    int nM, nN, nwg, G, c, rot;
    __host__ __device__ void init(int M, int N, int G_, int c_) { nM = M / BM; nN = N / BM; nwg = nM * nN; G = G_; c = c_; rot = 0; }
    __host__ __device__ __forceinline__ bool next(int i, Unit& u) const {
        const long L = (long)i * G + c; if (L >= nwg) return false;
        int wgid = (int)L; { const int q = nwg / NXCD, r = nwg % NXCD, xcd = wgid % NXCD, off = wgid / NXCD; wgid = (xcd < r ? xcd * (q + 1) : r * (q + 1) + (xcd - r) * q) + off; }
        const int nig = WGM * nN, gid = wgid / nig, fm = gid * WGM, gsz = (nM - fm) < WGM ? (nM - fm) : WGM;
        u.pm = fm + ((wgid % nig) % gsz); u.pn = (wgid % nig) / gsz + rot; if (u.pn >= nN) u.pn -= nN; return true;
    }
    __device__ __forceinline__ void a_ready(const Unit&) const {}
    __device__ __forceinline__ void done(const Unit&) const {}
};

__device__ __forceinline__ unsigned cvt_pk_bf16(float lo, float hi) { unsigned r; asm volatile("v_cvt_pk_bf16_f32 %0, %1, %2" : "=v"(r) : "v"(lo), "v"(hi)); return r; }
typedef float f32x2 __attribute__((ext_vector_type(2)));
__device__ __forceinline__ f32x2 gelu_pk(f32x2 v) {
    const f32x2 av = __builtin_elementwise_abs(v), d = av * 0.2316418882f + 1.0f;
    f32x2 t; t.x = __builtin_amdgcn_rcpf(d.x); t.y = __builtin_amdgcn_rcpf(d.y);
    f32x2 q = t * 0.5307027145f + (-0.7265760135f); q = q * t + 0.7107068705f; q = q * t + (-0.142248368f); q = q * t + 0.127414796f; q = q * t;
    const f32x2 s = (v * v) * (-0.72134752044f);
    f32x2 e; e.x = __builtin_amdgcn_exp2f(s.x); e.y = __builtin_amdgcn_exp2f(s.y);
    const f32x2 m = v * (q * e), r = v - m;
    f32x2 o; o.x = v.x < 0.f ? m.x : r.x; o.y = v.y < 0.f ? m.y : r.y; return o;
}
constexpr float C2Q = 0.125f * 1.4426950408889634f;
constexpr float RSS_INV = 1.0f / (1024.0f * 16777216.0f);
struct EpiInProj {
    static constexpr bool PERM = true, AFTER_DRAIN = false;
    bf16_t* O; size_t split_stride; const unsigned long long* rss; unsigned* kmax; const float* bfv; float* logf; unsigned* fcnt;
    __device__ __forceinline__ void operator()(const f32x4 (&acc)[2][2][4][2], const Unit& u, int wr, int wc, int fr, int fq) const {
        if (u.pn == 10) {
            if (wc == 0 && fq == 0) {
#pragma unroll
                for (int ai = 0; ai < 2; ++ai)
#pragma unroll
                    for (int m = 0; m < 4; ++m) { const int row = u.pm * BM + wr * 64 + fr + ai * HALF + m * 16; const float rs = __builtin_amdgcn_rsqf((float)rss[row] * RSS_INV + 1e-6f);
#pragma unroll
                        for (int n = 0; n < 2; ++n)
#pragma unroll
                            for (int e = 0; e < 4; ++e) { const float z = (acc[ai][0][m][n][e] + acc[ai][1][m][n][e]) * rs + bfv[4 * n + e];
                                const float lf = fminf(z, 0.f) - 0.6931471805599453f * __builtin_amdgcn_logf(1.0f + __builtin_amdgcn_exp2f(-1.4426950408889634f * fabsf(z)));
                                __hip_atomic_store((unsigned*)(logf + (size_t)(4 * n + e) * 16384 + row), __float_as_uint(lf), __ATOMIC_RELAXED, __HIP_MEMORY_SCOPE_AGENT); } } }
            asm volatile("s_waitcnt vmcnt(0)" ::: "memory"); __builtin_amdgcn_s_barrier();
            if (wr == 0 && wc == 0 && fr == 0 && fq == 0) __hip_atomic_fetch_add(fcnt, 1u, __ATOMIC_RELAXED, __HIP_MEMORY_SCOPE_AGENT);
            return; }
        const int t = u.pn >> 1; float kmx[2] = {0.f, 0.f}; bf16_t* base = O + (size_t)t * split_stride;
        const int row0 = u.pm * BM + wr * 64 + fr, col0 = (u.pn & 1) * 256 + wc * 32 + 8 * fq;
        const float s0 = (t == 0) ? C2Q : 1.0f;
#pragma unroll
        for (int ai = 0; ai < 2; ++ai)
#pragma unroll
            for (int m = 0; m < 4; ++m) { const int row = row0 + ai * HALF + m * 16; const float rs = __builtin_amdgcn_rsqf((float)rss[row] * RSS_INV + 1e-6f) * s0; bf16_t* rowp = base + (size_t)row * 512 + col0;
#pragma unroll
                for (int bj = 0; bj < 2; ++bj) { f32x4 v0 = acc[ai][bj][m][0] * rs, v1 = acc[ai][bj][m][1] * rs;
                    if (t == 1) { const f32x4 q0 = v0 * v0, q1 = v1 * v1; float sq = ((q0[0] + q0[1]) + (q0[2] + q0[3])) + ((q1[0] + q1[1]) + (q1[2] + q1[3])); sq += __shfl_xor(sq, 16); sq += __shfl_xor(sq, 32); kmx[bj] = fmaxf(kmx[bj], sq); }
                    if (t >= 3) { f32x2 a = gelu_pk((f32x2){v0[0], v0[1]}), b = gelu_pk((f32x2){v0[2], v0[3]}), c = gelu_pk((f32x2){v1[0], v1[1]}), d = gelu_pk((f32x2){v1[2], v1[3]});
                        v0 = (f32x4){a.x, a.y, b.x, b.y}; v1 = (f32x4){c.x, c.y, d.x, d.y}; }
                    u32x4 w; w.x = cvt_pk_bf16(v0[0], v0[1]); w.y = cvt_pk_bf16(v0[2], v0[3]); w.z = cvt_pk_bf16(v1[0], v1[1]); w.w = cvt_pk_bf16(v1[2], v1[3]);
                    *(u32x4*)(rowp + bj * HALF) = w; } }
        if (t == 1) {
#pragma unroll
            for (int bj = 0; bj < 2; ++bj) { float v = kmx[bj]; v = fmaxf(v, __shfl_xor(v, 1)); v = fmaxf(v, __shfl_xor(v, 2)); v = fmaxf(v, __shfl_xor(v, 4)); v = fmaxf(v, __shfl_xor(v, 8));
                if (fr == 0 && fq == 0) atomicMax(kmax + ((u.pn & 1) * 4 + bj * 2 + (wc >> 1)) * 2 + (wc & 1), __float_as_uint(v)); } }
    }
};
struct EpiResid {
    static constexpr bool PERM = true, AFTER_DRAIN = false;
    bf16_t* xb; unsigned long long* rss;
    __device__ __forceinline__ void operator()(const f32x4 (&acc)[2][2][4][2], const Unit& u, int wr, int wc, int fr, int fq) const {
        const int col0 = u.pn * BM + wc * 32 + 8 * fq;
#pragma unroll
        for (int ai = 0; ai < 2; ++ai)
#pragma unroll
            for (int m = 0; m < 4; ++m) { const int row = u.pm * BM + ai * HALF + wr * 64 + m * 16 + fr; const size_t off = (size_t)row * 1024 + col0; float sq = 0.f;
#pragma unroll
                for (int bj = 0; bj < 2; ++bj) { const u32x4 bw = *(const u32x4*)(xb + off + bj * HALF);
                    const f32x4 b0 = (f32x4){__builtin_bit_cast(float, bw.x << 16), __builtin_bit_cast(float, bw.x & 0xffff0000u), __builtin_bit_cast(float, bw.y << 16), __builtin_bit_cast(float, bw.y & 0xffff0000u)};
                    const f32x4 b1 = (f32x4){__builtin_bit_cast(float, bw.z << 16), __builtin_bit_cast(float, bw.z & 0xffff0000u), __builtin_bit_cast(float, bw.w << 16), __builtin_bit_cast(float, bw.w & 0xffff0000u)};
                    const f32x4 o0 = b0 + acc[ai][bj][m][0], o1 = b1 + acc[ai][bj][m][1];
                    u32x4 w; w.x = cvt_pk_bf16(o0[0], o0[1]); w.y = cvt_pk_bf16(o0[2], o0[3]); w.z = cvt_pk_bf16(o1[0], o1[1]); w.w = cvt_pk_bf16(o1[2], o1[3]);
                    *(u32x4*)(xb + off + bj * HALF) = w;
                    sq += ((o0[0] * o0[0] + o0[1] * o0[1]) + (o0[2] * o0[2] + o0[3] * o0[3])) + ((o1[0] * o1[0] + o1[1] * o1[1]) + (o1[2] * o1[2] + o1[3] * o1[3])); }
                sq += __shfl_xor(sq, 16); sq += __shfl_xor(sq, 32);
                if (fq == 0) atomicAdd(rss + row, (unsigned long long)__float2ull_rn(sq * 16777216.0f)); }
    }
};
struct EpiSwiGLU {
    static constexpr bool PERM = true, AFTER_DRAIN = false;
    bf16_t* H; const unsigned long long* rss;
    __device__ __forceinline__ void operator()(const f32x4 (&acc)[2][2][4][2], const Unit& u, int wr, int wc, int fr, int fq) const {
        const int row0 = u.pm * BM + wr * 64 + fr, col0 = u.pn * 128 + wc * 32 + 8 * fq;
#pragma unroll
        for (int ai = 0; ai < 2; ++ai)
#pragma unroll
            for (int m = 0; m < 4; ++m) { const int row = row0 + ai * HALF + m * 16; const float rs = __builtin_amdgcn_rsqf((float)rss[row] * RSS_INV + 1e-6f);
                float hv[8];
#pragma unroll
                for (int n = 0; n < 2; ++n)
#pragma unroll
                    for (int e = 0; e < 4; ++e) { const float g = acc[ai][0][m][n][e] * rs, up = acc[ai][1][m][n][e] * rs;
                        const float sg = __builtin_amdgcn_rcpf(1.0f + __builtin_amdgcn_exp2f(-1.4426950408889634f * g)); hv[n * 4 + e] = g * sg * up; }
                u32x4 w; w.x = cvt_pk_bf16(hv[0], hv[1]); w.y = cvt_pk_bf16(hv[2], hv[3]); w.z = cvt_pk_bf16(hv[4], hv[5]); w.w = cvt_pk_bf16(hv[6], hv[7]);
                *(u32x4*)(H + (size_t)row * 2816 + col0) = w; }
    }
};
template <class Epi, class Sched, bool ALIGN_EPI = false, bool SP2 = false>
__device__ __forceinline__ void gemm_phase(PG8_LAS unsigned char* lds, const Gemm g, const Sched& S, const Epi& E) {
    int tid = threadIdx.x; asm volatile("" : "+v"(tid));
    const int wid = __builtin_amdgcn_readfirstlane(tid >> 6), lane = tid & 63, wr = wid >> 2, wc = wid & 3, fr = lane & 15, fq = lane >> 4;
    const int K = g.K, nt = K / BK;
    unsigned voffA[2], voffB[2];
#pragma unroll
    for (int i = 0; i < 2; ++i) { int R, C; stage_rc(tid * 16 + i * 8192, R, C); const int Rb = Epi::PERM ? ((R & ~31) + perm32(R & 31)) : R;
        voffA[i] = (unsigned)(R * K + C) * 2u; voffB[i] = (unsigned)(Rb * K + C) * 2u; }
    const size_t kstep = (size_t)(BK * 2);
    const size_t hstep = (size_t)HALF * K * 2;
    const size_t tstep = 2 * hstep;
    const unsigned ldsw = (unsigned)wid * 1024u;
    const int aoff = lds_byte(wr * 64 + fr, fq * 8), boff = lds_byte(wc * 32 + fr, fq * 8);
#define PG8_SA(b, h) (((b) * 2 + (h)) * HTB)
#define PG8_SB(b, h) ((4 + (b) * 2 + (h)) * HTB)
#define PG8_STAGE(bufoff, gbase, voff) do { _Pragma("unroll") for (int _i = 0; _i < 2; ++_i) \
        __builtin_amdgcn_global_load_lds((const unsigned*)((const char*)(gbase) + (voff)[_i]), (PG8_LAS unsigned*)(lds + (bufoff) + ldsw + _i * 8192), 16, 0, 0); } while (0)
#define PG8_LDA(dst, b, h) do { _Pragma("unroll") for (int m = 0; m < 4; ++m) _Pragma("unroll") for (int k = 0; k < 2; ++k) dst[m][k] = *(const PG8_LAS bf16x8*)(lds + PG8_SA(b, h) + aoff + m * 2048 + k * 1024); } while (0)
#define PG8_LDB(dst, b, h) do { _Pragma("unroll") for (int n = 0; n < 2; ++n) _Pragma("unroll") for (int k = 0; k < 2; ++k) dst[n][k] = *(const PG8_LAS bf16x8*)(lds + PG8_SB(b, h) + boff + n * 2048 + k * 1024); } while (0)
#define PG8_MMA(ai, bj, At, Bt) do { __builtin_amdgcn_s_setprio(1); _Pragma("unroll") for (int m = 0; m < 4; ++m) _Pragma("unroll") for (int n = 0; n < 2; ++n) _Pragma("unroll") for (int k = 0; k < 2; ++k) \
        acc[ai][bj][m][n] = __builtin_amdgcn_mfma_f32_16x16x32_bf16(Bt[n][k], At[m][k], acc[ai][bj][m][n], 0, 0, 0); __builtin_amdgcn_s_setprio(0); } while (0)
#define PG8_WAIT_V(n) asm volatile("s_waitcnt vmcnt(" #n ")" ::: "memory")
#define PG8_WAIT_L(n) asm volatile("s_waitcnt lgkmcnt(" #n ")" ::: "memory")
#define PG8_BAR __builtin_amdgcn_s_barrier()
#define PG8_SCHED __builtin_amdgcn_sched_barrier(0)
    Unit cur, nxt; int ui = 0;
    if (!S.next(0, cur)) return;
    f32x4 acc[2][2][4][2];
#pragma unroll
    for (int a = 0; a < 2; ++a)
#pragma unroll
        for (int b = 0; b < 2; ++b)
#pragma unroll
            for (int m = 0; m < 4; ++m)
#pragma unroll
                for (int n = 0; n < 2; ++n) acc[a][b][m][n] = (f32x4){0.f, 0.f, 0.f, 0.f};
    bf16x8 At[4][2], B0[2][2], B1[2][2];
    const char* cA = (const char*)g.A + (size_t)cur.pm * tstep; const char* cB = (const char*)g.Bt + (size_t)cur.pn * tstep;
    S.a_ready(cur);
    if constexpr (SP2) {
        PG8_STAGE(PG8_SB(0, 0), cB, voffB); PG8_STAGE(PG8_SB(0, 1), cB + hstep, voffB); PG8_STAGE(PG8_SA(0, 0), cA, voffA); PG8_STAGE(PG8_SA(0, 1), cA + hstep, voffA);
        if (wr == 1) PG8_BAR;
        PG8_WAIT_V(2); PG8_BAR;
        PG8_STAGE(PG8_SB(1, 0), cB + kstep, voffB); PG8_STAGE(PG8_SA(1, 0), cA + kstep, voffA); PG8_STAGE(PG8_SB(1, 1), cB + hstep + kstep, voffB);
        PG8_WAIT_V(6); PG8_BAR;
    } else {
        PG8_STAGE(PG8_SB(0, 0), cB, voffB); PG8_STAGE(PG8_SA(0, 0), cA, voffA); PG8_STAGE(PG8_SB(0, 1), cB + hstep, voffB); PG8_STAGE(PG8_SA(0, 1), cA + hstep, voffA);
        if (wr == 1) PG8_BAR;
        PG8_WAIT_V(4); PG8_BAR;
        PG8_STAGE(PG8_SB(1, 0), cB + kstep, voffB); PG8_STAGE(PG8_SA(1, 0), cA + kstep, voffA); PG8_STAGE(PG8_SB(1, 1), cB + hstep + kstep, voffB);
        PG8_WAIT_V(6); PG8_BAR;
    }
    for (;;) {
        const bool has_next = S.next(ui + 1, nxt);
        const char* nA = has_next ? (const char*)g.A + (size_t)nxt.pm * tstep : cA; const char* nB = has_next ? (const char*)g.Bt + (size_t)nxt.pn * tstep : cB;
        for (int t = 0; t < nt; t += 2) {
            const bool last = (t == nt - 2);
            const char* a1 = cA + (size_t)(t + 1) * kstep;
            const char* a2 = last ? nA : cA + (size_t)(t + 2) * kstep; const char* b2 = last ? nB : cB + (size_t)(t + 2) * kstep;
            const char* a3 = a2 + kstep; const char* b3 = b2 + kstep;
            if (last && has_next) S.a_ready(nxt);
            if constexpr (SP2) {
            PG8_LDB(B0, 0, 0); PG8_LDB(B1, 0, 1); PG8_SCHED; PG8_LDA(At, 0, 0); PG8_STAGE(PG8_SA(1, 1), a1 + hstep, voffA);
            PG8_WAIT_V(8); PG8_WAIT_L(0); PG8_BAR; PG8_MMA(0, 0, At, B0); PG8_MMA(0, 1, At, B1); PG8_BAR; PG8_SCHED;
            PG8_LDA(At, 0, 1); PG8_STAGE(PG8_SB(0, 0), b2, voffB); PG8_STAGE(PG8_SB(0, 1), b2 + hstep, voffB); PG8_STAGE(PG8_SA(0, 0), a2, voffA);
            PG8_WAIT_V(8); PG8_WAIT_L(0); PG8_BAR; PG8_MMA(1, 0, At, B0); PG8_MMA(1, 1, At, B1); PG8_BAR; PG8_SCHED;
            PG8_LDB(B0, 1, 0); PG8_LDB(B1, 1, 1); PG8_SCHED; PG8_LDA(At, 1, 0); PG8_STAGE(PG8_SA(0, 1), a2 + hstep, voffA);
            PG8_WAIT_V(8); PG8_WAIT_L(0); PG8_BAR; PG8_MMA(0, 0, At, B0); PG8_MMA(0, 1, At, B1); PG8_BAR; PG8_SCHED;
            PG8_LDA(At, 1, 1); PG8_STAGE(PG8_SB(1, 0), b3, voffB); PG8_STAGE(PG8_SB(1, 1), b3 + hstep, voffB); PG8_STAGE(PG8_SA(1, 0), a3, voffA);
            PG8_WAIT_V(8); PG8_WAIT_L(0); PG8_BAR; PG8_MMA(1, 0, At, B0); PG8_MMA(1, 1, At, B1); PG8_BAR; PG8_SCHED;
            } else {
            PG8_LDB(B0, 0, 0); PG8_SCHED; PG8_LDA(At, 0, 0); PG8_STAGE(PG8_SA(1, 1), a1 + hstep, voffA);
            PG8_WAIT_L(8); PG8_BAR; PG8_WAIT_L(0); PG8_MMA(0, 0, At, B0); PG8_BAR; PG8_SCHED;
            PG8_LDB(B1, 0, 1); PG8_STAGE(PG8_SB(0, 0), b2, voffB);
            PG8_BAR; PG8_WAIT_L(0); PG8_MMA(0, 1, At, B1); PG8_BAR;
            PG8_LDA(At, 0, 1); PG8_STAGE(PG8_SA(0, 0), a2, voffA);
            PG8_BAR; PG8_WAIT_L(0); PG8_MMA(1, 0, At, B0); PG8_BAR; PG8_SCHED;
            PG8_STAGE(PG8_SB(0, 1), b2 + hstep, voffB);
            PG8_WAIT_V(6); PG8_BAR; PG8_MMA(1, 1, At, B1); PG8_BAR;
            PG8_LDB(B0, 1, 0); PG8_SCHED; PG8_LDA(At, 1, 0); PG8_STAGE(PG8_SA(0, 1), a2 + hstep, voffA);
            PG8_WAIT_L(8); PG8_BAR; PG8_WAIT_L(0); PG8_MMA(0, 0, At, B0); PG8_BAR; PG8_SCHED;
            PG8_LDB(B1, 1, 1); PG8_STAGE(PG8_SB(1, 0), b3, voffB);
            PG8_BAR; PG8_WAIT_L(0); PG8_MMA(0, 1, At, B1); PG8_BAR;
            PG8_LDA(At, 1, 1); PG8_STAGE(PG8_SA(1, 0), a3, voffA);
            PG8_BAR; PG8_WAIT_L(0); PG8_MMA(1, 0, At, B0); PG8_BAR; PG8_SCHED;
            PG8_STAGE(PG8_SB(1, 1), b3 + hstep, voffB);
            PG8_WAIT_V(6); PG8_BAR; PG8_MMA(1, 1, At, B1); PG8_BAR;
            }
        }
        if constexpr (ALIGN_EPI) { if (wr == 0) PG8_BAR; }
        if constexpr (!Epi::AFTER_DRAIN) { E(acc, cur, wr, wc, fr, fq); S.done(cur); }
        if (!has_next) break;
#pragma unroll
        for (int a = 0; a < 2; ++a)
#pragma unroll
            for (int b = 0; b < 2; ++b)
#pragma unroll
                for (int m = 0; m < 4; ++m)
#pragma unroll
                    for (int n = 0; n < 2; ++n) acc[a][b][m][n] = (f32x4){0.f, 0.f, 0.f, 0.f};
        cur = nxt; cA = nA; cB = nB; ++ui;
        if constexpr (ALIGN_EPI) { if (wr == 1) PG8_BAR; }
    }
    PG8_WAIT_V(0);
    if constexpr (!ALIGN_EPI) { if (wr == 0) PG8_BAR; }
    PG8_BAR;
    if constexpr (Epi::AFTER_DRAIN) { E.fused(acc, cur, wr, wc, fr, fq, lds, wid, lane); S.done(cur); }
#undef PG8_SA
#undef PG8_SB
#undef PG8_STAGE
#undef PG8_LDA
#undef PG8_LDB
#undef PG8_MMA
#undef PG8_WAIT_V
#undef PG8_WAIT_L
#undef PG8_BAR
#undef PG8_SCHED
}
}
#include <hip/hip_bf16.h>
#include <cmath>
namespace attn_body {
using bf16=__hip_bfloat16;
using bf16x8=__attribute__((ext_vector_type(8)))short;
using s16x4=__attribute__((ext_vector_type(4)))short;
using f32x16=__attribute__((ext_vector_type(16)))float;
using u32x4=__attribute__((ext_vector_type(4)))unsigned;
constexpr int BATCH=1,NHEAD=8,SEQ=16384,D=64,DM=NHEAD*D;
constexpr int NW=8,QBLK=32,QB=QBLK*NW,KVBLK=64,NQB=SEQ/QB;
constexpr int ATTN_PITCH=DM, ATTN_UNIT_ROWS=QB;
__device__ __forceinline__ int crow(int r,int hi){return (r&3)+8*(r>>2)+4*hi;}
#define SBAR() __builtin_amdgcn_sched_barrier(0)
__device__ __forceinline__ void cmask(f32x16&p0,f32x16&p1,int jb,int qrel,int hi){
  const float NEG=-INFINITY; int kb=64*jb+4*hi;
  #pragma unroll
  for(int r=0;r<16;++r){int kv=kb+(r&3)+8*(r>>2); if(kv>qrel)p0[r]=NEG; if(kv+32>qrel)p1[r]=NEG;}
}

constexpr int NSLOT=3, SLOTB=8192;
constexpr int LDS_K=0, LDS_V=NSLOT*SLOTB, LDS_WS=2*NSLOT*SLOTB, LDS_OST=LDS_WS+NW*64*4, LDS_BYTES=LDS_OST+NW*4096;
constexpr float C2=0.125f*1.4426950408889634f;
__device__ __forceinline__ void glds16(const void*gsrc,unsigned lds_dst){unsigned keep;
  asm volatile("s_mov_b32 %0, m0\n\ts_mov_b32 m0, %2\n\ts_nop 0\n\tglobal_load_lds_dwordx4 %1, off\n\ts_mov_b32 m0, %0":"=&s"(keep):"v"(gsrc),"s"(lds_dst):"memory");}
__device__ __forceinline__ float max3f(float a,float b,float c){float r;asm("v_max3_f32 %0, %1, %2, %3":"=v"(r):"v"(a),"v"(b),"v"(c));return r;}
__device__ __forceinline__ float max2f(float a,float b){float r;asm("v_max_f32_e32 %0, %1, %2":"=v"(r):"v"(a),"v"(b));return r;}
__device__ __forceinline__ float fadd_s(float a,float b){float r;asm("v_add_f32_e32 %0, %1, %2":"=v"(r):"v"(a),"v"(b));return r;}
__device__ __forceinline__ float fsub_s(float a,float b){float r;asm("v_sub_f32_e32 %0, %1, %2":"=v"(r):"v"(a),"v"(b));return r;}
typedef float f32x2_t __attribute__((ext_vector_type(2))); typedef __bf16 bf16x2_t __attribute__((ext_vector_type(2)));
__device__ __forceinline__ unsigned cvtpk_s(float lo,float hi){f32x2_t v={lo,hi};bf16x2_t b=__builtin_convertvector(v,bf16x2_t);return __builtin_bit_cast(unsigned,b);}
#define WAIT_BAR(N) asm volatile("s_waitcnt vmcnt(" #N ") lgkmcnt(0)\n\ts_barrier":::"memory")

__device__ __forceinline__ void qkt(f32x16&p0,f32x16&p1,const char*Kslot,const bf16x8*qr,const f32x16&negm,int r32,int hi){
  const char*kb=Kslot+hi*1024+r32*16;
  #pragma unroll
  for(int d0=0;d0<4;++d0){
    const bf16x8 b0=*reinterpret_cast<const bf16x8*>(kb+d0*2048);
    const bf16x8 b1=*reinterpret_cast<const bf16x8*>(kb+d0*2048+512);
    if(d0==0){p0=__builtin_amdgcn_mfma_f32_32x32x16_bf16(b0,qr[0],negm,0,0,0);p1=__builtin_amdgcn_mfma_f32_32x32x16_bf16(b1,qr[0],negm,0,0,0);}
    else{p0=__builtin_amdgcn_mfma_f32_32x32x16_bf16(b0,qr[d0],p0,0,0,0);p1=__builtin_amdgcn_mfma_f32_32x32x16_bf16(b1,qr[d0],p1,0,0,0);}}
}
typedef __attribute__((address_space(3))) const char* lds_cptr;
typedef short v4i16_t __attribute__((ext_vector_type(4)));
__device__ __forceinline__ void kload8(bf16x8*kf,lds_cptr kp){
  kf[0]=*(const __attribute__((address_space(3))) bf16x8*)(kp);      kf[1]=*(const __attribute__((address_space(3))) bf16x8*)(kp+512);
  kf[2]=*(const __attribute__((address_space(3))) bf16x8*)(kp+2048); kf[3]=*(const __attribute__((address_space(3))) bf16x8*)(kp+2560);
  kf[4]=*(const __attribute__((address_space(3))) bf16x8*)(kp+4096); kf[5]=*(const __attribute__((address_space(3))) bf16x8*)(kp+4608);
  kf[6]=*(const __attribute__((address_space(3))) bf16x8*)(kp+6144); kf[7]=*(const __attribute__((address_space(3))) bf16x8*)(kp+6656);
}
__device__ __forceinline__ void kload2(bf16x8*kf,lds_cptr kp,int j){ kf[2*j]=*(const __attribute__((address_space(3))) bf16x8*)(kp+j*2048); kf[2*j+1]=*(const __attribute__((address_space(3))) bf16x8*)(kp+j*2048+512); }
__device__ __forceinline__ s16x4 vtr(lds_cptr p){ return __builtin_bit_cast(s16x4,__builtin_amdgcn_ds_read_tr16_b64_v4i16((__attribute__((address_space(3))) v4i16_t*)p)); }
__device__ __forceinline__ float rowmax(const f32x16&p0,const f32x16&p1){
  float a=max3f(p0[0],p0[1],p1[0]),b=max3f(p0[2],p0[3],p1[1]);a=max3f(a,p1[2],p1[3]);
  #pragma unroll
  for(int r=4;r<16;r+=4){a=max3f(a,p0[r],p0[r+1]);b=max3f(b,p0[r+2],p0[r+3]);a=max3f(a,p1[r],p1[r+1]);b=max3f(b,p1[r+2],p1[r+3]);}
  const float m=max2f(a,b);
  auto rr=__builtin_amdgcn_permlane32_swap(__float_as_uint(m),__float_as_uint(m),false,false);
  return max2f(__uint_as_float(rr[0]),__uint_as_float(rr[1]));
}
__device__ __forceinline__ void pv(f32x16*o,int vb,bf16x8 pa0,bf16x8 pa1,bf16x8 pa2,bf16x8 pa3){
  #pragma unroll
  for(int d0=0;d0<2;++d0){s16x4 lo[4],hi[4];
    #pragma unroll
    for(int ks=0;ks<4;++ks){
      asm volatile("ds_read_b64_tr_b16 %0,%1 offset:%c2":"=&v"(lo[ks]):"v"(vb),"i"(d0*4096+ks*1024):"memory");
      asm volatile("ds_read_b64_tr_b16 %0,%1 offset:%c2":"=&v"(hi[ks]):"v"(vb),"i"(d0*4096+ks*1024+512):"memory");}
    asm volatile("s_waitcnt lgkmcnt(0)":::"memory");SBAR();
    #define PK(k) (bf16x8){lo[k][0],lo[k][1],lo[k][2],lo[k][3],hi[k][0],hi[k][1],hi[k][2],hi[k][3]}
    o[d0]=__builtin_amdgcn_mfma_f32_32x32x16_bf16(pa0,PK(0),o[d0],0,0,0);
    o[d0]=__builtin_amdgcn_mfma_f32_32x32x16_bf16(pa1,PK(1),o[d0],0,0,0);
    o[d0]=__builtin_amdgcn_mfma_f32_32x32x16_bf16(pa2,PK(2),o[d0],0,0,0);
    o[d0]=__builtin_amdgcn_mfma_f32_32x32x16_bf16(pa3,PK(3),o[d0],0,0,0);
    #undef PK
  }
}
typedef float f32x4_t __attribute__((ext_vector_type(4)));

#ifndef ATTN_STORE16
#define ATTN_STORE16(p,v) (*(u32x4*)(p)=(v))
#endif
constexpr int FCH=64;
constexpr int F2_CK=LDS_BYTES, FOX2_LDS_BYTES=F2_CK+FCH*64*4;
template<int THRL> __device__ __forceinline__ void fox_unit2(int h,int qb,int jc,float kn,const bf16*Q,const bf16*__restrict__ K,const bf16*__restrict__ V,bf16*O,float*ML,const float*__restrict__ c2h,char*shm,float*qmx){
  int tid=threadIdx.x; asm volatile("":"+v"(tid)); const int lane=tid&63,r32=lane&31,hi=lane>>5; const int wid=__builtin_amdgcn_readfirstlane(tid>>6);
  const long rowbase=0; const int q0=qb*QB;
  const bf16*Qw=Q+(rowbase+q0+wid*QBLK)*DM+h*D;
  const bf16*Kh=K+rowbase*DM+h*D,*Vh=V+rowbase*DM+h*D;
  const unsigned lds0=(unsigned)(uintptr_t)shm;
  float*wsf=(float*)(shm+LDS_WS)+wid*64;
  float*ckl=(float*)(shm+F2_CK);
  const int NTg=(q0+QB)/KVBLK;
  bf16x8 qr[4];
  #pragma unroll
  for(int d0=0;d0<4;++d0)qr[d0]=*reinterpret_cast<const bf16x8*>(&Qw[(long)r32*DM+d0*16+hi*8]);
  bf16x8 kd[4];
  { const bf16*Kd=K+(long)(q0+wid*QBLK+r32)*DM+h*D;
    #pragma unroll
    for(int d0=0;d0<4;++d0)kd[d0]=*reinterpret_cast<const bf16x8*>(&Kd[d0*16+hi*8]); }
  int ts; float qkb_;
  const float cq0_=c2h[q0], cte_=(tid<NTg-4)?c2h[64*tid+63]:0.f;
  { float qs=0.f,dg=0.f;
    #pragma unroll
    for(int d0=0;d0<4;++d0)
      #pragma unroll
      for(int e=0;e<8;++e){ const float v=__builtin_bit_cast(float,(unsigned)(unsigned short)qr[d0][e]<<16); qs+=v*v; dg+=v*__builtin_bit_cast(float,(unsigned)(unsigned short)kd[d0][e]<<16); }
    { auto rr=__builtin_amdgcn_permlane32_swap(__float_as_uint(qs),__float_as_uint(qs),false,false); qs=__uint_as_float(rr[0])+__uint_as_float(rr[1]); }
    { auto rr=__builtin_amdgcn_permlane32_swap(__float_as_uint(dg),__float_as_uint(dg),false,false); dg=__uint_as_float(rr[0])+__uint_as_float(rr[1]); }
    #pragma unroll
    for(int o_=1;o_<32;o_<<=1){ qs=__builtin_fmaxf(qs,__shfl_xor(qs,o_)); dg=__builtin_fminf(dg,__shfl_xor(dg,o_)); }
    if(lane==0){qmx[wid]=qs;qmx[wid-20]=dg;}
    __syncthreads();
    float q2=qmx[0];
    #pragma unroll
    for(int w_=1;w_<8;++w_)q2=__builtin_fmaxf(q2,qmx[w_]);
    float dmin=qmx[-20];
    #pragma unroll
    for(int w_=1;w_<8;++w_)dmin=__builtin_fminf(dmin,qmx[w_-20]);
    qkb_=sqrtf(q2)*kn+0.25f;
    const float lim=cq0_+152.05f+sqrtf(q2)*kn-dmin;
    ts=__syncthreads_count((tid<NTg-4)&&(cte_>lim)); ts&=~3; }
  const int t1=NTg-FCH*jc; int t0=t1-FCH; t0=t0<0?0:t0; t0=t0<ts?ts:t0;
  if(t0>=t1){ if(hi==0){ float*mlp=ML+((long)(q0+wid*QBLK+r32)*NHEAD+h)*2; mlp[0]=-1.0e30f; mlp[1]=0.f; } return; }
  const int NT=t1-t0;
  const int NTm=(jc==0)?NT:(1<<20);
  const bf16*ksrc=Kh+(long)(t0*KVBLK+lane)*DM+wid*8;
  const bf16*vsrc=Vh+(long)(t0*KVBLK+16*(wid&3)+(lane>>2))*DM+(wid>>2)*32+(lane&3)*8;
  const unsigned kdst=lds0+LDS_K+wid*1024, vdst=lds0+LDS_V+wid*1024;
  #define DMA_K(t,slot) glds16(ksrc+(long)(t)*KVBLK*DM,(unsigned)__builtin_amdgcn_readfirstlane(kdst+(slot)))
  #define DMA_V(t,slot) glds16(vsrc+(long)(t)*KVBLK*DM,(unsigned)__builtin_amdgcn_readfirstlane(vdst+(slot)))
  const int vb0=(int)(lds0+LDS_V)+((lane>>4)&1)*32+(lane&3)*8+(4*hi+((lane&15)>>2))*64;
  const char*Kbase=shm+LDS_K; bf16x8 kf[8];
  const lds_cptr shm3=(lds_cptr)shm; const lds_cptr kp0=shm3+LDS_K+hi*1024+r32*16; const lds_cptr vp0=shm3+LDS_V+((lane>>4)&1)*32+(lane&3)*8+(4*hi+((lane&15)>>2))*64;
  DMA_K(0,0);DMA_V(0,0);DMA_K(1,SLOTB);
  { const float cref=cq0_; const int nck=NT*64;
    for(int i=tid*4;i<nck;i+=2048){ f32x4_t v=*(const f32x4_t*)(c2h+t0*64+i); v=v-cref; *(f32x4_t*)(ckl+i)=v; } }
  float mhat=0.f,l_reg=0.f;f32x16 o[2];o[0]=f32x16{};o[1]=f32x16{};const f32x16 zc16=f32x16{};
  const int qrel=wid*QBLK+r32;
  #define CMASK(P0,P1,t) do{int jb_=(t)-(NTm-4); if(jb_>=0)cmask(P0,P1,jb_,qrel,hi);}while(0)
  #define BIAS(P0,P1,t) do{ const float*cb_=ckl+(t)*64+4*hi; _Pragma("unroll") for(int g_=0;g_<4;++g_){ const f32x4_t a_=*(const f32x4_t*)(cb_+8*g_), b_=*(const f32x4_t*)(cb_+32+8*g_); _Pragma("unroll") for(int e_=0;e_<4;++e_){P0[4*g_+e_]-=a_[e_];P1[4*g_+e_]-=b_[e_];} SBAR(); } }while(0)
  bool resc=false;
  #define START(P0,P1) do{ const float rm=rowmax(P0,P1); resc=false; \
    { const float dl=rm; mhat=fadd_s(mhat,dl); \
      _Pragma("unroll") for(int r=0;r<16;++r){P0[r]=fsub_s(P0[r],dl);P1[r]=fsub_s(P1[r],dl);} \
      } \
    _Pragma("unroll") for(int r=0;r<16;++r)P0[r]=__builtin_amdgcn_exp2f(P0[r]); }while(0)
  #define RESC() do{ if(resc){ asm volatile("s_waitcnt lgkmcnt(0)":::"memory"); \
      _Pragma("unroll") for(int d_=0;d_<2;++d_) _Pragma("unroll") for(int r=0;r<16;++r)o[d_][r]*=wsf[crow(r,hi)]; } }while(0)
  f32x16 pA0,pA1,pB0,pB1;
  int sl_prev=0,sl_cur=0,sl_next=SLOTB;
  #define ROT() do{sl_prev=sl_cur;sl_cur=sl_next;sl_next=(sl_next==(NSLOT-1)*SLOTB)?0:sl_next+SLOTB;}while(0)
  DMA_K(2,2*SLOTB);
  WAIT_BAR(3);
  qkt(pA0,pA1,Kbase,qr,zc16,r32,hi);asm volatile("s_nop 15\n\ts_nop 7":"+v"(pA0),"+v"(pA1));BIAS(pA0,pA1,0);CMASK(pA0,pA1,0);
  START(pA0,pA1);
  _Pragma("unroll") for(int r=0;r<16;++r)pA1[r]=__builtin_amdgcn_exp2f(pA1[r]);
  #define PFG(X0,X1,tn,k) do{ const f32x4_t a_=*(const f32x4_t*)(ckl+(tn)*64+4*hi+(((k)<4)?8*(k):32+8*((k)-4))); const float nm_=-mhat; \
      if((k)<4){ X0[4*(k)]=nm_-a_[0]; X0[4*(k)+1]=nm_-a_[1]; X0[4*(k)+2]=nm_-a_[2]; X0[4*(k)+3]=nm_-a_[3]; } \
      else { X1[4*((k)-4)]=nm_-a_[0]; X1[4*((k)-4)+1]=nm_-a_[1]; X1[4*((k)-4)+2]=nm_-a_[2]; X1[4*((k)-4)+3]=nm_-a_[3]; } }while(0)
  { PFG(pB0,pB1,1,0);PFG(pB0,pB1,1,1);PFG(pB0,pB1,1,2);PFG(pB0,pB1,1,3);PFG(pB0,pB1,1,4);PFG(pB0,pB1,1,5);PFG(pB0,pB1,1,6);PFG(pB0,pB1,1,7); }
  WAIT_BAR(0);
  DMA_K(3,0);DMA_V(1,SLOTB);
  ROT();
  kload8(kf,kp0+sl_cur);
  WAIT_BAR(2);
  s16x4 vlo[8],vhi[8]; u32x4 pw0,pw1,pw2,pw3;
  #define PKW(P,B) cvtpk_s(P[B],P[B+1])
  #define PAF(k) __builtin_bit_cast(bf16x8,pw##k)
  #define VFR(i) (bf16x8){vlo[i][0],vlo[i][1],vlo[i][2],vlo[i][3],vhi[i][0],vhi[i][1],vhi[i][2],vhi[i][3]}
  #define PIN(x) asm volatile("":"+v"(x))
  #define MX3(a,b,c) __builtin_fmaxf(__builtin_fmaxf((a),(b)),(c))
  #define GAPA(MF,A0,A1,A2,A3,W0,W1,PW) do{ MF; sacc+=A0; sacc+=A1; sacc+=A2; sacc+=A3; PIN(sacc); W0; W1; PIN(PW); SBAR(); }while(0)
  #define EX(v) __builtin_amdgcn_exp2f(v)
  #define GAPB(MF,X,B,PF) do{ MF; PF; X[B]=EX(X[B]); X[B+1]=EX(X[B+1]); X[B+2]=EX(X[B+2]); X[B+3]=EX(X[B+3]); PIN(X); SBAR(); }while(0)
  #define PFN(G,X0,X1,tt,k) do{ if(G){ PFG(X0,X1,(tt)+1,k); } }while(0)
  #define VRD(i) do{ vlo[i]=vtr(vp_+(((i)>>2)*4096+((i)&3)*1024)); vhi[i]=vtr(vp_+(((i)>>2)*4096+((i)&3)*1024+512)); }while(0)
  #define KRD(G,j) do{ if(G){ kload2(kf,kp0+sl_next,j); SBAR(); } }while(0)
  #define STEP(C0,C1,P0,P1,t,GK,GV,GL) do{ SBAR(); \
    const lds_cptr vp_=vp0+sl_prev; \
    VRD(0); SBAR(); float sacc=(P0[0]+P0[1]); \
    GAPA(C0=__builtin_amdgcn_mfma_f32_32x32x16_bf16(kf[0],qr[0],C0,0,0,0), P0[2],P0[3],P0[4],P0[5],     pw0[0]=PKW(P0,0), pw0[1]=PKW(P0,2), pw0); \
    VRD(4); SBAR(); GAPA(C1=__builtin_amdgcn_mfma_f32_32x32x16_bf16(kf[1],qr[0],C1,0,0,0), P0[6],P0[7],P0[8],P0[9],     pw0[2]=PKW(P0,4), pw0[3]=PKW(P0,6), pw0); \
    VRD(1); SBAR(); GAPA(C0=__builtin_amdgcn_mfma_f32_32x32x16_bf16(kf[2],qr[1],C0,0,0,0),   P0[10],P0[11],P0[12],P0[13], pw1[0]=PKW(P0,8), pw1[1]=PKW(P0,10), pw1); \
    VRD(5); SBAR(); GAPA(C1=__builtin_amdgcn_mfma_f32_32x32x16_bf16(kf[3],qr[1],C1,0,0,0),   P0[14],P0[15],P1[0],P1[1],   pw1[2]=PKW(P0,12),pw1[3]=PKW(P0,14), pw1); \
    VRD(2); SBAR(); GAPA(C0=__builtin_amdgcn_mfma_f32_32x32x16_bf16(kf[4],qr[2],C0,0,0,0),   P1[2],P1[3],P1[4],P1[5],     pw2[0]=PKW(P1,0), pw2[1]=PKW(P1,2), pw2); \
    VRD(6); SBAR(); GAPA(C1=__builtin_amdgcn_mfma_f32_32x32x16_bf16(kf[5],qr[2],C1,0,0,0),   P1[6],P1[7],P1[8],P1[9],     pw2[2]=PKW(P1,4), pw2[3]=PKW(P1,6), pw2); \
    VRD(3); SBAR(); GAPA(C0=__builtin_amdgcn_mfma_f32_32x32x16_bf16(kf[6],qr[3],C0,0,0,0),   P1[10],P1[11],P1[12],P1[13], pw3[0]=PKW(P1,8), pw3[1]=PKW(P1,10), pw3); \
    VRD(7); SBAR(); GAPA(C1=__builtin_amdgcn_mfma_f32_32x32x16_bf16(kf[7],qr[3],C1,0,0,0),   P1[14],P1[15],0.f,0.f,       pw3[2]=PKW(P1,12),pw3[3]=PKW(P1,14), pw3); \
    l_reg+=sacc; \
    if(GK){DMA_K((t)+3,sl_cur);} if(GV){DMA_V((t)+1,sl_next);} \
    CMASK(C0,C1,t); \
    { resc=false; \
      const float ub_=qkb_-mhat-ckl[(t)*64+63];     \
      if(__builtin_expect(__any(ub_>(float)THRL),0)){ \
        float a=MX3(C0[0],C0[1],C1[0]),b=MX3(C0[2],C0[3],C1[1]); a=MX3(a,C1[2],C1[3]); \
        _Pragma("unroll") for(int r=4;r<16;r+=4){a=MX3(a,C0[r],C0[r+1]);b=MX3(b,C0[r+2],C0[r+3]);a=MX3(a,C1[r],C1[r+1]);b=MX3(b,C1[r+2],C1[r+3]);} \
        float rm=__builtin_fmaxf(a,b); { auto rr=__builtin_amdgcn_permlane32_swap(__float_as_uint(rm),__float_as_uint(rm),false,false); rm=__builtin_fmaxf(__uint_as_float(rr[0]),__uint_as_float(rr[1])); } \
        const float dl=__builtin_fmaxf(rm,0.f); mhat+=dl; \
        _Pragma("unroll") for(int r=0;r<16;++r){C0[r]-=dl;C1[r]-=dl;} \
        const float f=__builtin_amdgcn_exp2f(-dl); l_reg*=f; if(hi==0)wsf[r32]=f; resc=true; } } \
    SBAR(); \
    GAPB(o[0]=__builtin_amdgcn_mfma_f32_32x32x16_bf16(PAF(0),VFR(0),o[0],0,0,0), C0,0, PFN(GL,P0,P1,t,0)); \
    GAPB(o[1]=__builtin_amdgcn_mfma_f32_32x32x16_bf16(PAF(0),VFR(4),o[1],0,0,0), C0,4, PFN(GL,P0,P1,t,1)); \
    KRD(GL,0); GAPB(o[0]=__builtin_amdgcn_mfma_f32_32x32x16_bf16(PAF(1),VFR(1),o[0],0,0,0), C0,8, PFN(GL,P0,P1,t,2)); \
    KRD(GL,1); GAPB(o[1]=__builtin_amdgcn_mfma_f32_32x32x16_bf16(PAF(1),VFR(5),o[1],0,0,0), C0,12, PFN(GL,P0,P1,t,3)); \
    KRD(GL,2); GAPB(o[0]=__builtin_amdgcn_mfma_f32_32x32x16_bf16(PAF(2),VFR(2),o[0],0,0,0), C1,0, PFN(GL,P0,P1,t,4)); \
    KRD(GL,3); GAPB(o[1]=__builtin_amdgcn_mfma_f32_32x32x16_bf16(PAF(2),VFR(6),o[1],0,0,0), C1,4, PFN(GL,P0,P1,t,5)); \
    GAPB(o[0]=__builtin_amdgcn_mfma_f32_32x32x16_bf16(PAF(3),VFR(3),o[0],0,0,0), C1,8, PFN(GL,P0,P1,t,6)); \
    GAPB(o[1]=__builtin_amdgcn_mfma_f32_32x32x16_bf16(PAF(3),VFR(7),o[1],0,0,0), C1,12, PFN(GL,P0,P1,t,7)); \
    }while(0)
  int t=1;
  #undef CMASK
  #define CMASK(P0,P1,t) do{}while(0)
  for(;t+5<NT;t+=2){
    STEP(pB0,pB1,pA0,pA1,t,true,true,true);     WAIT_BAR(2); RESC(); ROT();
    STEP(pA0,pA1,pB0,pB1,t+1,true,true,true);   WAIT_BAR(2); RESC(); ROT();
  }
  #undef CMASK
  #define CMASK(P0,P1,t) do{int jb_=(t)-(NTm-4); if(jb_>=0)cmask(P0,P1,jb_,qrel,hi);}while(0)
  #define ENDW(tt) do{ if((tt)+3<NT){WAIT_BAR(2);} else if((tt)+2<NT){WAIT_BAR(1);} else {WAIT_BAR(0);} }while(0)
  for(;t+1<NT;t+=2){
    STEP(pB0,pB1,pA0,pA1,t,(t+3<NT),(t+1<NT),(t+1<NT));       ENDW(t);   RESC(); ROT();
    STEP(pA0,pA1,pB0,pB1,t+1,(t+4<NT),(t+2<NT),(t+2<NT));     ENDW(t+1); RESC(); ROT();
  }
  STEP(pB0,pB1,pA0,pA1,NT-1,false,false,false); RESC();
  { float sacc=pB0[0]+pB0[1]; _Pragma("unroll") for(int r=2;r<16;++r)sacc+=pB0[r]; _Pragma("unroll") for(int r=0;r<16;++r)sacc+=pB1[r]; l_reg+=sacc;
    pw0=(u32x4){PKW(pB0,0),PKW(pB0,2),PKW(pB0,4),PKW(pB0,6)};pw1=(u32x4){PKW(pB0,8),PKW(pB0,10),PKW(pB0,12),PKW(pB0,14)};pw2=(u32x4){PKW(pB1,0),PKW(pB1,2),PKW(pB1,4),PKW(pB1,6)};pw3=(u32x4){PKW(pB1,8),PKW(pB1,10),PKW(pB1,12),PKW(pB1,14)};
    SBAR(); pv(o,vb0+sl_cur,PAF(0),PAF(1),PAF(2),PAF(3)); }
  #undef PKW
  #undef PAF
  #undef VFR
  #undef PIN
  #undef MX3
  #undef GAPA
  #undef GAPB
  #undef PFN
  #undef PFG
  #undef EX
  #undef VRD
  #undef KRD
  #undef STEP
  #undef ENDW
  {auto rr=__builtin_amdgcn_permlane32_swap(__float_as_uint(l_reg),__float_as_uint(l_reg),false,false);l_reg=__uint_as_float(rr[0])+__uint_as_float(rr[1]);}
  if(hi==0){ wsf[32+r32]=l_reg; float*mlp=ML+((long)(q0+wid*QBLK+r32)*NHEAD+h)*2; mlp[0]=mhat; mlp[1]=l_reg; } asm volatile("s_waitcnt lgkmcnt(0)":::"memory");
  float rli[16];
  #pragma unroll
  for(int r=0;r<16;++r)rli[r]=__builtin_amdgcn_rcpf(wsf[32+crow(r,hi)]);
  bf16*Ow=O+(rowbase+q0+wid*QBLK)*DM+h*D;
  { bf16*stg=(bf16*)(shm+LDS_OST)+wid*2048;
    #pragma unroll
    for(int r=0;r<16;++r){const int orow=crow(r,hi);
      #pragma unroll
      for(int d0=0;d0<2;++d0)stg[orow*64+d0*32+r32]=__float2bfloat16(o[d0][r]*rli[r]);}
    asm volatile("s_waitcnt lgkmcnt(0)":::"memory");
    #pragma unroll
    for(int i=0;i<4;++i){const int row=i*8+(lane>>3),ch=lane&7; const u32x4 v=*(const u32x4*)(stg+row*64+ch*8); ATTN_STORE16(Ow+(long)row*DM+ch*8,v);} }
  asm volatile("s_waitcnt lgkmcnt(0)\n\ts_barrier":::"memory");
  #undef DMA_K
  #undef DMA_V
  #undef CMASK
  #undef BIAS
  #undef START
  #undef RESC
  #undef ROT
}

#undef SBAR
#undef WAIT_BAR
}
namespace cg = cooperative_groups;
constexpr int S_ = 16384, DMOD = 1024, NL = 4, DIN = 2568, NIN = 2816, DFF = 2816, NGU = 5632, NHD = 8;
constexpr float EPSN = 1e-6f;
constexpr size_t MiB = 1u << 20;
constexpr size_t WS_CTL = 0, CTL_BYTES = 65536;
constexpr size_t WS_WIN = 2 * MiB;
constexpr size_t WS_WOUT = 24 * MiB;
constexpr size_t WS_WGU = 32 * MiB;
constexpr size_t WS_WD = 76 * MiB;
constexpr size_t WS_XB = 98 * MiB;
constexpr size_t WS_RSSM = 130 * MiB;
constexpr size_t WS_RSSF = 130 * MiB + 128 * 1024;
constexpr size_t WS_LOGF = 130 * MiB + 256 * 1024;
constexpr size_t WS_C2 = 131 * MiB;
constexpr size_t WS_QKVZ = 132 * MiB;
constexpr size_t WS_O = 212 * MiB;
constexpr size_t WS_MG = 228 * MiB;
constexpr size_t WS_H = 132 * MiB;
constexpr size_t WS_OP = 260 * MiB;
constexpr size_t WS_ML = 308 * MiB;
constexpr size_t WS_END = 312 * MiB;
static_assert(WS_H + (size_t)S_ * DFF * 2 <= WS_MG, "h overlay");
constexpr int LDS_BYTES = 147456;
constexpr int CW_KMAX = 8192, CW_BAR = 9216, CW_SGUQ = 13312, CW_TS = 14336, CW_FCNT = 14400;
constexpr int NPHASE = 2 + 6 * NL;

#define LAS __attribute__((address_space(3)))
typedef unsigned short bf16r;
typedef unsigned v4u __attribute__((ext_vector_type(4)));
typedef float f32x4 __attribute__((ext_vector_type(4)));
typedef float f32x16 __attribute__((ext_vector_type(16)));
typedef short bf16x8 __attribute__((ext_vector_type(8)));
#define LDS_WAIT() asm volatile("s_waitcnt lgkmcnt(0)" ::: "memory")
__device__ __forceinline__ unsigned f2bf(float f) { unsigned u = __builtin_bit_cast(unsigned, f); return (u + 0x7fffu + ((u >> 16) & 1u)) >> 16; }
__device__ __forceinline__ unsigned pk2(float lo, float hi) { return f2bf(lo) | (f2bf(hi) << 16); }
__device__ __forceinline__ float bflo(unsigned w) { return __builtin_bit_cast(float, w << 16); }
__device__ __forceinline__ float bfhi(unsigned w) { return __builtin_bit_cast(float, w & 0xffff0000u); }
__device__ __forceinline__ float bf1(bf16r w) { return __builtin_bit_cast(float, (unsigned)w << 16); }
#define DPPF(v, ctrl) __builtin_bit_cast(float, __builtin_amdgcn_update_dpp(0, __builtin_bit_cast(int, (v)), (ctrl), 0xf, 0xf, true))
__device__ __forceinline__ float row16_sum(float v) {
    v += DPPF(v, 0xB1); v += DPPF(v, 0x4E); v += DPPF(v, 0x141); v += DPPF(v, 0x140); return v;
}
__device__ __forceinline__ float wave_sum(float v) {
    v += DPPF(v, 0xB1); v += DPPF(v, 0x4E); v += DPPF(v, 0x141); v += DPPF(v, 0x140);
    const int iv = __builtin_bit_cast(int, v);
    const float s0 = __builtin_bit_cast(float, __builtin_amdgcn_readlane(iv, 0)), s1 = __builtin_bit_cast(float, __builtin_amdgcn_readlane(iv, 16)),
                s2 = __builtin_bit_cast(float, __builtin_amdgcn_readlane(iv, 32)), s3 = __builtin_bit_cast(float, __builtin_amdgcn_readlane(iv, 48));
    return (s0 + s1) + (s2 + s3);
}
constexpr int PREP_P = 132;
__device__ __forceinline__ void prep_item(const float* W, int ldw, int srccol, const float* gs, bf16r* WT, int K, int dstrow, int k0, LAS float* scr, int lane) {
#pragma unroll 8
    for (int i = 0; i < 16; ++i) { const int kk = 2 * i + (lane >> 5); f32x4 w = *(const f32x4*)(W + (size_t)(k0 + kk) * ldw + srccol + 4 * (lane & 31)); if (gs) w = w * gs[k0 + kk];
        *(LAS f32x4*)(scr + kk * PREP_P + 4 * (lane & 31)) = w; }
    LDS_WAIT(); asm volatile("" ::: "memory");
    const int c = lane & 3;
#pragma unroll
    for (int j = 0; j < 8; ++j) { const int n = (lane >> 2) + 16 * j; const LAS float* s = scr + (8 * c) * PREP_P + n;
        v4u o; o.x = pk2(s[0 * PREP_P], s[1 * PREP_P]); o.y = pk2(s[2 * PREP_P], s[3 * PREP_P]); o.z = pk2(s[4 * PREP_P], s[5 * PREP_P]); o.w = pk2(s[6 * PREP_P], s[7 * PREP_P]);
        *(v4u*)(WT + (size_t)(dstrow + n) * K + k0 + 8 * c) = o; }
    LDS_WAIT(); asm volatile("" ::: "memory");
}
template <int OFF> __device__ __forceinline__ unsigned long long ldk() {
    unsigned long long v; auto ka = __builtin_amdgcn_kernarg_segment_ptr();
    asm volatile("s_load_dwordx2 %0, %1, %2\n\ts_waitcnt lgkmcnt(0)" : "=s"(v) : "s"(ka), "i"(OFF) : "memory");
    return v;
}
struct Ptrs {
    const float *x, *mixg, *w_in, *b_f, *lng, *lnb, *w_s, *b_s, *outg, *w_out, *ffng, *w_gu, *w_d, *fing;
    float* out; unsigned char* ws;
};
__device__ __forceinline__ void phase_prep(const Ptrs& P, LAS unsigned char* lds, int l0, int l1, int gw, int NGW, int wave, int lane) {
    LAS float* scr = (LAS float*)(lds + wave * (32 * PREP_P * 4));
    bf16r* WinT = (bf16r*)(P.ws + WS_WIN); bf16r* WoutT = (bf16r*)(P.ws + WS_WOUT); bf16r* WguT = (bf16r*)(P.ws + WS_WGU); bf16r* WdT = (bf16r*)(P.ws + WS_WD);
    constexpr int I_IN = 32 * 20, I_OUT = 32 * 8, I_GU = 32 * 44, I_D = 88 * 8, I_L = I_IN + I_OUT + I_GU + I_D;
    for (int it = l0 * I_L + gw; it < l1 * I_L; it += NGW) {
        const int l = it / I_L; int r = it % I_L;
        if (r < I_IN) { const int kb = r / 20, nb = r % 20, n0 = 128 * nb, src = n0 < 1536 ? n0 : n0 + 8;
            prep_item(P.w_in + (size_t)l * DMOD * DIN, DIN, src, P.mixg + l * DMOD, WinT + (size_t)l * NIN * DMOD, DMOD, n0, 32 * kb, scr, lane); continue; }
        r -= I_IN;
        if (r < I_OUT) { const int kb = r / 8, nb = r % 8;
            prep_item(P.w_out + (size_t)l * DMOD * DMOD, DMOD, 128 * nb, P.outg + l * DMOD, WoutT + (size_t)l * DMOD * DMOD, DMOD, 128 * nb, 32 * kb, scr, lane); continue; }
        r -= I_OUT;
        if (r < I_GU) { const int kb = r / 44, nb = r % 44, n0 = 128 * nb, pn = n0 >> 8, src = (n0 & 255) == 0 ? 128 * pn : DFF + 128 * pn;
            prep_item(P.w_gu + (size_t)l * DMOD * NGU, NGU, src, P.ffng + l * DMOD, WguT + (size_t)l * NGU * DMOD, DMOD, n0, 32 * kb, scr, lane); continue; }
        r -= I_GU;
        { const int kb = r / 8, nb = r % 8;
            prep_item(P.w_d + (size_t)l * DFF * DMOD, DMOD, 128 * nb, nullptr, WdT + (size_t)l * DMOD * DFF, DFF, 128 * nb, 32 * kb, scr, lane); }
    }
    for (int idx = l0 * 262144 + gw * 64 + lane; idx < l1 * 262144; idx += NGW * 64) { const int l = idx >> 18, rr = (idx >> 10) & 255, k = idx & 1023; unsigned v = 0u;
        if ((rr & 127) < 8) { const float w = P.w_in[((size_t)l * DMOD + k) * DIN + 1536 + (rr & 7)] * P.mixg[l * DMOD + k]; const unsigned hb = f2bf(w);
            v = rr < 128 ? hb : f2bf(w - __builtin_bit_cast(float, hb << 16)); }
        WinT[((size_t)l * NIN + 2560 + rr) * DMOD + k] = (bf16r)v; }
}
template <int MODE>
__device__ __forceinline__ void phase_rowstats(const float* xin, bf16r* xb, unsigned long long* rss_out, const float* gfin, float* outp, int gw, int NGW, int lane, float tdelta = 0.f) {
#pragma unroll 2
    for (int m = gw; m < S_; m += NGW) {
        const f32x4* xr = (const f32x4*)(xin + (size_t)m * DMOD) + lane;
        f32x4 v[4]; float s = 0.f;
#pragma unroll
        for (int j = 0; j < 4; ++j) { v[j] = xr[64 * j]; s += (v[j].x * v[j].x + v[j].y * v[j].y) + (v[j].z * v[j].z + v[j].w * v[j].w); }
        const float tot = wave_sum(s);
        if (MODE == 2) {
            const float rs = 1.0f / sqrtf(tot * (1.0f / DMOD) + EPSN);
            f32x4* orow = (f32x4*)(outp + (size_t)m * DMOD) + lane; const f32x4* gr = (const f32x4*)gfin + lane;
#pragma unroll
            for (int j = 0; j < 4; ++j) orow[64 * j] = v[j] * rs * gr[64 * j] + (m < 1024 ? tdelta : 0.f);
        } else {
            unsigned long long* o8 = (unsigned long long*)(xb + (size_t)m * DMOD) + lane;
#pragma unroll
            for (int j = 0; j < 4; ++j) o8[64 * j] = (unsigned long long)pk2(v[j].x, v[j].y) | ((unsigned long long)pk2(v[j].z, v[j].w) << 32);
            if (lane == 0) rss_out[m] = (unsigned long long)__float2ull_rn(tot * 16777216.0f);
        }
    }
}
__device__ __forceinline__ void final_norm(const bf16r* xb, const unsigned long long* rss, const float* g, float* outp, int gw, int NGW, int lane) {
#pragma unroll 2
    for (int m = gw; m < S_; m += NGW) {
        const v4u a = *(const v4u*)(xb + (size_t)m * DMOD + 8 * lane), b = *(const v4u*)(xb + (size_t)m * DMOD + 512 + 8 * lane);
        const float rs = 1.0f / sqrtf((float)rss[m] * (1.0f / (1024.0f * 16777216.0f)) + EPSN);
        const f32x4* gr = (const f32x4*)g; f32x4* orow = (f32x4*)(outp + (size_t)m * DMOD);
        const f32x4 g0 = gr[2 * lane], g1 = gr[2 * lane + 1], g2 = gr[128 + 2 * lane], g3 = gr[128 + 2 * lane + 1];
        orow[2 * lane] = (f32x4){bflo(a.x), bfhi(a.x), bflo(a.y), bfhi(a.y)} * rs * g0; orow[2 * lane + 1] = (f32x4){bflo(a.z), bfhi(a.z), bflo(a.w), bfhi(a.w)} * rs * g1;
        orow[128 + 2 * lane] = (f32x4){bflo(b.x), bfhi(b.x), bflo(b.y), bfhi(b.y)} * rs * g2; orow[128 + 2 * lane + 1] = (f32x4){bflo(b.z), bfhi(b.z), bflo(b.w), bfhi(b.w)} * rs * g3;
    }
}
__device__ __forceinline__ void cumsum_head(const float* logf, float* c2, int h, LAS unsigned char* lds, int tid) {
    LAS double* scr = (LAS double*)lds;
    const f32x4* src = (const f32x4*)(logf + (size_t)h * S_ + tid * 32);
    f32x4 v[8]; double sum = 0.0;
#pragma unroll
    for (int e = 0; e < 8; ++e) { v[e] = src[e]; sum += ((double)v[e].x + (double)v[e].y) + ((double)v[e].z + (double)v[e].w); }
    scr[tid] = sum; __syncthreads();
    double pre = 0.0; for (int i = 0; i < tid; ++i) pre += scr[i];
    f32x4* dst = (f32x4*)(c2 + (size_t)h * S_ + tid * 32);
#pragma unroll
    for (int e = 0; e < 8; ++e) { f32x4 o; pre += (double)v[e].x; o.x = (float)(pre * 1.4426950408889634); pre += (double)v[e].y; o.y = (float)(pre * 1.4426950408889634);
        pre += (double)v[e].z; o.z = (float)(pre * 1.4426950408889634); pre += (double)v[e].w; o.w = (float)(pre * 1.4426950408889634); dst[e] = o; }
    __syncthreads();
}
__device__ __forceinline__ void sgu_item(int c, const bf16r* ZU, const bf16r* ZV, bf16r* MG, const float* lng, const float* lnb, const float* wsl, const float* bsl,
                                         LAS unsigned char* lds, int wid, int lane) {
    LAS float* bsb = (LAS float*)lds;
    LAS bf16r* zt = (LAS bf16r*)(lds + 4096);
    const int r32 = lane & 31, hi = lane >> 5, g = wid, tid = wid * 64 + lane;
    bsb[tid] = bsl[tid]; bsb[tid + 512] = bsl[tid + 512];
    const int rs4 = lane >> 4, l16 = lane & 15;
#pragma unroll 2
    for (int it = 0; it < 4; ++it) { const int i = 16 * wid + 4 * it + rs4; const size_t row = (size_t)c * 128 + i;
        v4u zr[4];
#pragma unroll
        for (int j = 0; j < 4; ++j) zr[j] = *(const v4u*)(ZV + row * 512 + 128 * j + 8 * l16);
        float z[32]; float s = 0.f;
#pragma unroll
        for (int j = 0; j < 4; ++j) { z[8 * j] = bflo(zr[j].x); z[8 * j + 1] = bfhi(zr[j].x); z[8 * j + 2] = bflo(zr[j].y); z[8 * j + 3] = bfhi(zr[j].y); z[8 * j + 4] = bflo(zr[j].z); z[8 * j + 5] = bfhi(zr[j].z); z[8 * j + 6] = bflo(zr[j].w); z[8 * j + 7] = bfhi(zr[j].w); }
#pragma unroll
        for (int e = 0; e < 32; ++e) s += z[e];
        const float mean = row16_sum(s) * (1.0f / 512.0f); float q = 0.f;
#pragma unroll
        for (int e = 0; e < 32; ++e) { z[e] -= mean; q += z[e] * z[e]; }
        const float rstd = 1.0f / sqrtf(row16_sum(q) * (1.0f / 512.0f) + EPSN);
#pragma unroll
        for (int j = 0; j < 4; ++j) { const f32x4 g0 = *(const f32x4*)(lng + 128 * j + 8 * l16), g1 = *(const f32x4*)(lng + 128 * j + 8 * l16 + 4), b0 = *(const f32x4*)(lnb + 128 * j + 8 * l16), b1 = *(const f32x4*)(lnb + 128 * j + 8 * l16 + 4);
            v4u zw; zw.x = pk2(z[8 * j] * rstd * g0.x + b0.x, z[8 * j + 1] * rstd * g0.y + b0.y); zw.y = pk2(z[8 * j + 2] * rstd * g0.z + b0.z, z[8 * j + 3] * rstd * g0.w + b0.w);
            zw.z = pk2(z[8 * j + 4] * rstd * g1.x + b1.x, z[8 * j + 5] * rstd * g1.y + b1.y); zw.w = pk2(z[8 * j + 6] * rstd * g1.z + b1.z, z[8 * j + 7] * rstd * g1.w + b1.w);
            *(LAS v4u*)(zt + i * 512 + 128 * j + 8 * l16) = zw; }
    }
    LDS_WAIT(); __syncthreads();
#pragma unroll 1
    for (int ni = 0; ni < 2; ++ni) {
        const int d = 64 * g + 32 * ni + r32;
        bf16x8 bfr[8];
#pragma unroll
        for (int ks = 0; ks < 8; ++ks) { const LAS bf16r* zp = zt + (16 * ks + 8 * hi) * 512 + d;
            v4u w; w.x = (unsigned)zp[0] | ((unsigned)zp[512] << 16); w.y = (unsigned)zp[1024] | ((unsigned)zp[1536] << 16); w.z = (unsigned)zp[2048] | ((unsigned)zp[2560] << 16); w.w = (unsigned)zp[3072] | ((unsigned)zp[3584] << 16);
            bfr[ks] = __builtin_bit_cast(bf16x8, w); }
        LDS_WAIT(); asm volatile("" ::: "memory");
        f32x16 acc[4];
#pragma unroll
        for (int mi = 0; mi < 4; ++mi) { acc[mi] = f32x16{};
#pragma unroll
            for (int ks = 0; ks < 8; ++ks) { if (mi < 2 && ks >= 4) continue;
                const float* wp = wsl + ((size_t)g * 128 + 32 * mi + r32) * 128 + 16 * ks + 8 * hi; const f32x4 a0 = *(const f32x4*)wp, a1 = *(const f32x4*)(wp + 4);
                v4u w; w.x = pk2(a0.x, a0.y); w.y = pk2(a0.z, a0.w); w.z = pk2(a1.x, a1.y); w.w = pk2(a1.z, a1.w);
                acc[mi] = __builtin_amdgcn_mfma_f32_32x32x16_bf16(__builtin_bit_cast(bf16x8, w), bfr[ks], acc[mi], 0, 0, 0); }
            asm volatile("" ::: "memory"); }
#pragma unroll
        for (int mi = 0; mi < 4; ++mi)
#pragma unroll
            for (int r = 0; r < 16; ++r) { const int i = 32 * mi + (r & 3) + 8 * (r >> 2) + 4 * hi;
                zt[i * 512 + d] = (bf16r)f2bf(acc[mi][r] + bsb[g * 128 + i]); }
        LDS_WAIT(); asm volatile("" ::: "memory");
    }
    __syncthreads();
#pragma unroll 2
    for (int it = 0; it < 4; ++it) { const int i = 16 * wid + 4 * it + rs4; const size_t row = (size_t)c * 128 + i;
        float a[32]; float ss = 0.f;
#pragma unroll
        for (int j = 0; j < 4; ++j) { const v4u tr = *(const LAS v4u*)(zt + i * 512 + 128 * j + 8 * l16); const v4u ur = *(const v4u*)(ZU + row * 512 + 128 * j + 8 * l16);
            a[8 * j] = bflo(tr.x) * bflo(ur.x); a[8 * j + 1] = bfhi(tr.x) * bfhi(ur.x); a[8 * j + 2] = bflo(tr.y) * bflo(ur.y); a[8 * j + 3] = bfhi(tr.y) * bfhi(ur.y);
            a[8 * j + 4] = bflo(tr.z) * bflo(ur.z); a[8 * j + 5] = bfhi(tr.z) * bfhi(ur.z); a[8 * j + 6] = bflo(tr.w) * bflo(ur.w); a[8 * j + 7] = bfhi(tr.w) * bfhi(ur.w); }
#pragma unroll
        for (int e = 0; e < 32; ++e) ss += a[e] * a[e];
        const float ra = 1.0f / sqrtf(row16_sum(ss) * (1.0f / 512.0f) + EPSN);
#pragma unroll
        for (int j = 0; j < 4; ++j) { v4u w; w.x = pk2(a[8 * j] * ra, a[8 * j + 1] * ra); w.y = pk2(a[8 * j + 2] * ra, a[8 * j + 3] * ra); w.z = pk2(a[8 * j + 4] * ra, a[8 * j + 5] * ra); w.w = pk2(a[8 * j + 6] * ra, a[8 * j + 7] * ra);
            *(v4u*)(MG + row * 1024 + 512 + 128 * j + 8 * l16) = w; }
    }
    LDS_WAIT(); __syncthreads();
}
__device__ __forceinline__ void combine_item(int c, const bf16r* O, const bf16r* OP1, const float* ML, bf16r* MG, int wid, int lane) {
    const int rs4 = lane >> 4, l16 = lane & 15;
#pragma unroll
    for (int it = 0; it < 2; ++it) { const size_t row = (size_t)c * 64 + 8 * wid + 4 * it + rs4; const int nch = ((int)(row >> 12)) + 1;
        float a[32]; float ss = 0.f;
#pragma unroll
        for (int j = 0; j < 4; ++j) { const int hh = 2 * j + (l16 >> 3); float Mj[4], lj[4]; v4u oj[4];
#pragma unroll
            for (int q = 0; q < 4; ++q) { if (q < nch) { const float* mlp = ML + (size_t)q * S_ * 16 + (row * 8 + hh) * 2; Mj[q] = mlp[0]; lj[q] = mlp[1];
                    oj[q] = (q == 0 || lj[q] > 0.f) ? *(const v4u*)((q == 0 ? O : OP1 + (size_t)(q - 1) * S_ * 512) + row * 512 + 128 * j + 8 * l16) : (v4u){0u, 0u, 0u, 0u}; } else { Mj[q] = -1.0e30f; lj[q] = 0.f; oj[q] = (v4u){0u, 0u, 0u, 0u}; } }
            const float Mmax = fmaxf(fmaxf(Mj[0], Mj[1]), fmaxf(Mj[2], Mj[3])); float wsum = 0.f; float t[8] = {0.f, 0.f, 0.f, 0.f, 0.f, 0.f, 0.f, 0.f};
#pragma unroll
            for (int q = 0; q < 4; ++q) { const float w = lj[q] > 0.f ? lj[q] * __builtin_amdgcn_exp2f(Mj[q] - Mmax) : 0.f; wsum += w;
                if (w > 0.f) { t[0] += w * bflo(oj[q].x); t[1] += w * bfhi(oj[q].x); t[2] += w * bflo(oj[q].y); t[3] += w * bfhi(oj[q].y); t[4] += w * bflo(oj[q].z); t[5] += w * bfhi(oj[q].z); t[6] += w * bflo(oj[q].w); t[7] += w * bfhi(oj[q].w); } }
            const float iw = 1.0f / wsum;
#pragma unroll
            for (int e = 0; e < 8; ++e) { a[8 * j + e] = t[e] * iw; ss += a[8 * j + e] * a[8 * j + e]; } }
        const float ra = 1.0f / sqrtf(row16_sum(ss) * (1.0f / 512.0f) + EPSN);
#pragma unroll
        for (int j = 0; j < 4; ++j) { v4u w; w.x = pk2(a[8 * j] * ra, a[8 * j + 1] * ra); w.y = pk2(a[8 * j + 2] * ra, a[8 * j + 3] * ra); w.z = pk2(a[8 * j + 4] * ra, a[8 * j + 5] * ra); w.w = pk2(a[8 * j + 6] * ra, a[8 * j + 7] * ra);
            *(v4u*)(MG + row * 1024 + 128 * j + 8 * l16) = w; }
    }
}
#define XB_TMO      128
#define XB_XCNT(j)  (256  + 64 * (j))
#define XB_XSUB(j)  (1280 + 64 * (j))
#define XB_XGEN(j)  (2304 + 64 * (j))
#define XB_TOP      3328
#define XB_TOPGEN   3392
#define XCD_BAR_WORDS 3456
#define XB_SPIN_CAP (1u << 18)

__device__ __forceinline__ unsigned xb_ld(unsigned* p)              { return __hip_atomic_load(p, __ATOMIC_RELAXED, __HIP_MEMORY_SCOPE_AGENT); }
__device__ __forceinline__ unsigned xb_add(unsigned* p, unsigned v) { return __hip_atomic_fetch_add(p, v, __ATOMIC_RELAXED, __HIP_MEMORY_SCOPE_AGENT); }
__device__ __forceinline__ unsigned xb_xcc_id() { return (unsigned)__builtin_amdgcn_s_getreg((3 << 11) | 20) & 0xFu; }
#define XB_SPIN(cond, bar) do { unsigned _sp = 0; while (cond) { __builtin_amdgcn_s_sleep(1); \
    if ((++_sp & 255u) == 0u) { if (xb_ld(&(bar)[XB_TMO])) break; if (_sp > XB_SPIN_CAP) { atomicAdd(&(bar)[XB_TMO], 1u); break; } } } } while (0)

struct XcdBarrier {
    unsigned* bar; unsigned x;
    volatile LAS unsigned* st;
};

__device__ __forceinline__ XcdBarrier xcd_barrier_post(unsigned* bar, volatile LAS unsigned* st) {
    XcdBarrier b; b.bar = bar; b.x = xb_xcc_id(); b.st = st;
    if (threadIdx.x == 0) (void)xb_add(&bar[XB_XCNT(b.x)], 1u);
    return b;
}
__device__ __forceinline__ void xcd_barrier_complete(unsigned* bar, unsigned x, unsigned& nloc, unsigned& nx) {
    const unsigned G = gridDim.x * gridDim.y * gridDim.z;
    unsigned sum, cnt, mine, sp = 0u;
    for (;;) {
        sum = 0u; cnt = 0u; mine = 0u;
#pragma unroll
        for (unsigned j = 0; j < 16; ++j) { const unsigned c = xb_ld(&bar[XB_XCNT(j)]); sum += c; cnt += (c > 0u) ? 1u : 0u; mine = (j == x) ? c : mine; }
        if (sum == G) break;
        __builtin_amdgcn_s_sleep(1);
        if ((++sp & 255u) == 0u) { if (xb_ld(&bar[XB_TMO])) break; if (sp > XB_SPIN_CAP) { atomicAdd(&bar[XB_TMO], 1u); break; } }
    }
    nloc = mine > 0u ? mine : 1u; nx = cnt > 0u ? cnt : 1u;
}

__device__ __forceinline__ void xcd_barrier(const XcdBarrier& b) {
    asm volatile("s_waitcnt vmcnt(0)" ::: "memory");
    __syncthreads();
    if (threadIdx.x == 0) {
        unsigned* bar = b.bar;
        __builtin_amdgcn_s_waitcnt(0);
        unsigned nloc = b.st[0], nx = b.st[1];
        if (nloc == 0u) { xcd_barrier_complete(bar, b.x, nloc, nx); b.st[0] = nloc; b.st[1] = nx; }
        const unsigned old = xb_add(&bar[XB_XSUB(b.x)], 1u);
        const unsigned gen = old / nloc;
        if (old + 1u == (gen + 1u) * nloc) {
            __builtin_amdgcn_fence(__ATOMIC_RELEASE, "agent");
            asm volatile("s_waitcnt vmcnt(0)" ::: "memory");
            const unsigned og = xb_add(&bar[XB_TOP], 1u);
            const unsigned tg = og / nx;
            if (og + 1u == (tg + 1u) * nx) xb_add(&bar[XB_TOPGEN], 1u);
            else XB_SPIN(xb_ld(&bar[XB_TOPGEN]) == tg, bar);
            __builtin_amdgcn_fence(__ATOMIC_ACQUIRE, "agent");
            xb_add(&bar[XB_XGEN(b.x)], 1u);
            asm volatile("s_waitcnt vmcnt(0)" ::: "memory");
        } else {
            XB_SPIN(xb_ld(&bar[XB_XGEN(b.x)]) == gen, bar);
            __builtin_amdgcn_fence(__ATOMIC_ACQUIRE, "agent");
            asm volatile("s_waitcnt vmcnt(0)" ::: "memory");
        }
    }
    __syncthreads();
}
#ifndef MK_MULTI
#define MK_MULTI 0
#endif
struct Args { const float* in[14]; float* out; unsigned char* ws; int ph_lo, ph_hi; };
__global__ void __launch_bounds__(512, 2) fox_fwd(Args args) {
    extern __shared__ __attribute__((aligned(16))) unsigned char lds[];
    cg::grid_group grid = cg::this_grid();
    LAS unsigned char* L = (LAS unsigned char*)lds;
    const int G = gridDim.x, bx = blockIdx.x;
    const int vcu = (G % 8 == 0) ? (bx % 8) * (G / 8) + bx / 8 : bx;
    const int NGW = G * 8;
#define IDS() int tid = threadIdx.x; asm volatile("" : "+v"(tid)); const int lane = tid & 63, wave = __builtin_amdgcn_readfirstlane(tid >> 6), gw = vcu * 8 + wave; (void)lane; (void)gw
#define KIN(k) ((const float*)(const __attribute__((address_space(1))) float*)ldk<8 * (k)>())
#define WSB() ((unsigned char*)(__attribute__((address_space(1))) unsigned char*)ldk<120>())
#define P_OUT ((float*)(__attribute__((address_space(1))) float*)ldk<112>())
#define ctl ((unsigned*)(WSB() + WS_CTL))
#define WinT ((bf16r*)(WSB() + WS_WIN))
#define WoutT ((bf16r*)(WSB() + WS_WOUT))
#define WguT ((bf16r*)(WSB() + WS_WGU))
#define WdT ((bf16r*)(WSB() + WS_WD))
#define XB ((bf16r*)(WSB() + WS_XB))
#define RSSM ((unsigned long long*)(WSB() + WS_RSSM))
#define RSSF ((unsigned long long*)(WSB() + WS_RSSF))
#define LOGF ((float*)(WSB() + WS_LOGF))
#define C2A ((float*)(WSB() + WS_C2))
#define QKVZ ((bf16r*)(WSB() + WS_QKVZ))
#define OB ((bf16r*)(WSB() + WS_O))
#define MG ((bf16r*)(WSB() + WS_MG))
#define HB ((bf16r*)(WSB() + WS_H))
#define OP1 ((bf16r*)(WSB() + WS_OP))
#define MLB ((float*)(WSB() + WS_ML))
#define MKP() Ptrs P; P.x = KIN(0); P.mixg = KIN(1); P.w_in = KIN(2); P.b_f = KIN(3); P.lng = KIN(4); P.lnb = KIN(5); P.w_s = KIN(6); P.b_s = KIN(7); \
    P.outg = KIN(8); P.w_out = KIN(9); P.ffng = KIN(10); P.w_gu = KIN(11); P.w_d = KIN(12); P.fing = KIN(13); P.out = P_OUT; P.ws = WSB()
    constexpr size_t QS = (size_t)S_ * 512;
    const int lo = args.ph_lo, hi = args.ph_hi;
    { LAS unsigned* misc = (LAS unsigned*)(L + 147456 - 8); if (threadIdx.x < 2) misc[threadIdx.x] = 0u; __syncthreads(); }
    XcdBarrier xbar = xcd_barrier_post((unsigned*)(WSB() + WS_CTL) + CW_BAR, (volatile LAS unsigned*)(L + 147456 - 8));
    int ph = 0;
#ifdef PROBE_T
    unsigned long long tacc_ = 0ull, tst_ = 0ull;
#define TCLS() ((ph == 0) ? 0 : (ph <= 7 * NL ? ((ph - 1) % 7) + 1 : 8))
#define TBEG() do { if (TCLS() == PROBE_T) tst_ = __builtin_amdgcn_s_memrealtime(); } while (0)
#define TEND() do { if (TCLS() == PROBE_T) tacc_ += __builtin_amdgcn_s_memrealtime() - tst_; } while (0)
#else
#define TBEG() do {} while (0)
#define TEND() do {} while (0)
#endif
#define RUN() (ph >= lo && ph < hi)
#ifdef PROBE_SYNC
#define SEAM() do { ++ph; if (ph > lo && ph < hi) { if (ph == 1) { grid.sync(); grid.sync(); } else { xcd_barrier(xbar); xcd_barrier(xbar); } } } while (0)
#else
#define SEAM() do { ++ph; if (ph > lo && ph < hi) { if (lo < 0) grid.sync(); xcd_barrier(xbar); } --ph; TEND(); ++ph; TBEG(); } while (0)
#endif
#ifdef PROBE_SMALL
#define REPS 2
#else
#define REPS 1
#endif
#ifndef FH_TABLE
#define FH_TABLE 0x76545677u
#endif
#ifndef FOX_THRL
#define FOX_THRL 8
#endif
#ifndef SGU_AT
#define SGU_AT 1
#endif
#ifdef PROBE_GEMM
#define REPG 2
#else
#define REPG 1
#endif
#ifdef PROBE_ATTN
#define REPA 2
#else
#define REPA 1
#endif

#ifndef NO_P0
    if (RUN()) { IDS(); MKP(); for (int rp = 0; rp < REPS; ++rp) { phase_prep(P, L, 0, 1, gw, NGW, wave, lane); phase_rowstats<1>(P.x, (bf16r*)(P.ws + WS_XB), (unsigned long long*)(P.ws + WS_RSSM), nullptr, nullptr, gw, NGW, lane); } }
#endif
    SEAM();
    for (int l = 0; l < NL; ++l) {
#ifndef NO_INPROJ
        if (RUN()) {
            { IDS(); unsigned long long* rz = RSSF; if (bx < 256 && tid < 64) { unsigned zlo = 0u; asm volatile("" : "+v"(zlo)); rz[bx * 64 + tid] = (unsigned long long)zlo; }     }
            pg8::Gemm g{XB, WinT + (size_t)l * NIN * DMOD, S_, NIN, DMOD}; pg8::StaticOrder So; So.init(S_, NIN, G, bx); So.rot = NIN / 256 - 1;
            pg8::EpiInProj E{QKVZ, QS, RSSM, ctl + CW_KMAX + l * 16, KIN(3) + l * 8, LOGF, ctl + CW_FCNT + l * 64};
            for (int rg = 0; rg < REPG; ++rg) pg8::gemm_phase<pg8::EpiInProj, pg8::StaticOrder, true, true>(L, g, So, E);
            if (bx >= G - NHD) {
                IDS(); unsigned* const fc = ctl + CW_FCNT + l * 64;
                if (tid == 0) { unsigned sp = 0; while (__hip_atomic_load(fc, __ATOMIC_RELAXED, __HIP_MEMORY_SCOPE_AGENT) < 64u * REPG) { __builtin_amdgcn_s_sleep(8); if (++sp > (1u << 20)) break; }
                    __builtin_amdgcn_fence(__ATOMIC_ACQUIRE, "agent"); }
                __syncthreads();
                cumsum_head(LOGF, C2A, bx - (G - NHD), L, tid);
            }
        }
#endif
        SEAM();
#ifndef NO_ATTN
        if (RUN()) {
            IDS(); LAS unsigned* bc = (LAS unsigned*)(L + 147456 - 64);
            unsigned* const ctlp = ctl; unsigned char* const wsp = WSB();
            const int fh = (int)((FH_TABLE >> (4 * (bx & 7))) & 7u);
            for (int rp = 0; rp < REPA; ++rp)
            for (int qi = 0; qi <= NHD; ++qi) { const int h = (qi == 0) ? fh : (NHD - qi); if (qi > 0 && h == fh) continue;
                if (qi == SGU_AT && rp == 0) {
            for (;;) {
                if (tid == 0) bc[0] = atomicAdd(ctlp + CW_SGUQ + (l) * 64, 1u);
                __syncthreads(); const unsigned u = bc[0]; __syncthreads();
                if (u >= (unsigned)(S_ / 128)) break;
                bf16r* const qkvz = (bf16r*)(wsp + WS_QKVZ);
                sgu_item((int)u, qkvz + 3 * QS, qkvz + 4 * QS, (bf16r*)(wsp + WS_MG), KIN(4) + l * 512, KIN(5) + l * 512, KIN(6) + (size_t)l * 8 * 128 * 128, KIN(7) + l * 8 * 128, L, wave, lane);
            }
                }
                const float kn = sqrtf((__uint_as_float(ctlp[CW_KMAX + l * 16 + 2 * h]) + __uint_as_float(ctlp[CW_KMAX + l * 16 + 2 * h + 1])) * 1.02f);
                for (;;) {
                    if (tid == 0) bc[0] = atomicAdd(ctlp + ((rp * NL + l) * NHD + h) * 64, 1u);
                    __syncthreads(); const unsigned u = bc[0]; __syncthreads();
                    if (u >= 160u) break;
                    int qb, jc;
                    if (u < 64u) { qb = 63 - (int)(u >> 2); jc = (int)(u & 3u); } else if (u < 112u) { const int v = (int)u - 64; qb = 47 - v / 3; jc = v % 3; }
                    else if (u < 144u) { const int v = (int)u - 112; qb = 31 - (v >> 1); jc = v & 1; } else { qb = 15 - ((int)u - 144); jc = 0; }
                    bf16r* const qkvz = (bf16r*)(wsp + WS_QKVZ);
                    attn_body::fox_unit2<FOX_THRL>(h, qb, jc, kn, (const attn_body::bf16*)qkvz, (const attn_body::bf16*)(qkvz + QS), (const attn_body::bf16*)(qkvz + 2 * QS),
                                            (attn_body::bf16*)(jc == 0 ? (bf16r*)(wsp + WS_O) : (bf16r*)(wsp + WS_OP) + (size_t)(jc - 1) * QS), (float*)(wsp + WS_ML) + (size_t)jc * S_ * 16, (float*)(wsp + WS_C2) + (size_t)h * S_, (char*)lds, (float*)(lds + 147456 - 48));
                } }
        }
#endif
        SEAM();
#ifndef NO_MERGE
        if (RUN()) { IDS(); for (int rp = 0; rp < REPS; ++rp) for (int it = vcu; it < S_ / 64; it += G) combine_item(it, OB, OP1, MLB, MG, wave, lane); }
#endif
        SEAM();
#ifndef NO_OUTPROJ
        if (RUN()) {
            { IDS(); unsigned long long* rz = RSSM; if (bx < 256 && tid < 64) { unsigned zlo = 0u; asm volatile("" : "+v"(zlo)); rz[bx * 64 + tid] = (unsigned long long)zlo; }     }
            pg8::Gemm g{MG, WoutT + (size_t)l * DMOD * DMOD, S_, DMOD, DMOD}; pg8::StaticOrder So; So.init(S_, DMOD, G, bx);
            pg8::EpiResid E{XB, RSSF};
            pg8::gemm_phase<pg8::EpiResid, pg8::StaticOrder, true, true>(L, g, So, E);
        }
#endif
        SEAM();
#ifndef NO_GU
        if (RUN()) {
            pg8::Gemm g{XB, WguT + (size_t)l * NGU * DMOD, S_, NGU, DMOD}; pg8::StaticOrder So; So.init(S_, NGU, G, bx);
            pg8::EpiSwiGLU E{HB, RSSF};
            for (int rg = 0; rg < REPG; ++rg) pg8::gemm_phase<pg8::EpiSwiGLU, pg8::StaticOrder, true, true>(L, g, So, E);
            if (l + 1 < NL) { IDS(); MKP(); if (G == 256) { if (bx >= 128) phase_prep(P, L, l + 1, l + 2, (bx - 128) * 8 + wave, 1024, wave, lane); } else phase_prep(P, L, l + 1, l + 2, gw, NGW, wave, lane); }
        }
#endif
        SEAM();
#ifndef NO_DOWN
        if (RUN()) {
            pg8::Gemm g{HB, WdT + (size_t)l * DMOD * DFF, S_, DMOD, DFF}; pg8::StaticOrder So; So.init(S_, DMOD, G, bx);
            pg8::EpiResid E{XB, RSSM};
            pg8::gemm_phase<pg8::EpiResid, pg8::StaticOrder, true, true>(L, g, So, E);
        }
#endif
        SEAM();
    }
#ifndef NO_RSN
#ifdef PROBE_T
    { if (blockIdx.x == 0 && threadIdx.x == 0) { ((unsigned*)(WSB() + WS_CTL))[CW_TS] = (unsigned)tacc_; __threadfence(); } xcd_barrier(xbar); }
    const float tdelta = (PROBE_T == 99) ? 0.1f : (float)__hip_atomic_load((unsigned*)(WSB() + WS_CTL) + CW_TS, __ATOMIC_RELAXED, __HIP_MEMORY_SCOPE_AGENT) * 2.0e-7f;
#else
    const float tdelta = 0.f;
#endif
    if (RUN()) { IDS(); final_norm(XB, RSSM, KIN(13), P_OUT, gw, NGW, lane); }
#endif
    SEAM();
#undef RUN
#undef SEAM
}

extern "C" void kernel_launch(void* const* d_in, const int* in_sizes, int n_in, void* d_out, int out_size, void* d_ws, size_t ws_size, hipStream_t stream) {
    static int grid = 0;
    if (grid == 0) {
        if (n_in != 14 || out_size != S_ * DMOD || ws_size < WS_END) { fprintf(stderr, "kernel_launch: unexpected shapes (n_in %d out %d ws %zu)\n", n_in, out_size, ws_size); grid = -1; return; }
        int dev = 0, cus = 0, per_cu = 0;
        hipGetDevice(&dev); hipDeviceGetAttribute(&cus, hipDeviceAttributeMultiprocessorCount, dev);
        if (hipFuncSetAttribute((const void*)fox_fwd, hipFuncAttributeMaxDynamicSharedMemorySize, LDS_BYTES) != hipSuccess) { fprintf(stderr, "kernel_launch: hipFuncSetAttribute failed\n"); grid = -1; return; }
        if (hipOccupancyMaxActiveBlocksPerMultiprocessor(&per_cu, (const void*)fox_fwd, 512, LDS_BYTES) != hipSuccess || per_cu < 1) { fprintf(stderr, "kernel_launch: occupancy query says %d\n", per_cu); per_cu = 1; }
        (void)hipGetLastError();
        grid = cus * per_cu;
        if (grid < 256) { fprintf(stderr, "kernel_launch: this kernel needs a resident grid of at least 256 workgroups, got %d\n", grid); grid = -1; return; }
        fprintf(stderr, "kernel_launch: grid %d (cus %d x %d)\n", grid, cus, per_cu);
    }
    if (grid < 0) return;
    hipMemsetAsync((char*)d_ws + WS_CTL, 0, CTL_BYTES, stream);
    Args a{};
    for (int i = 0; i < 14; ++i) a.in[i] = (const float*)d_in[i];
    a.out = (float*)d_out; a.ws = (unsigned char*)d_ws;
#if MK_MULTI
    for (int p = 0; p < NPHASE; ++p) { a.ph_lo = p; a.ph_hi = p + 1; hipLaunchKernelGGL(fox_fwd, dim3(grid), dim3(512), LDS_BYTES, stream, a); }
#else
    a.ph_lo = 0; a.ph_hi = NPHASE;
    void* kargs[] = {&a};
    hipError_t e = hipLaunchCooperativeKernel((const void*)fox_fwd, dim3(grid), dim3(512), kargs, LDS_BYTES, stream);
    if (e != hipSuccess) fprintf(stderr, "kernel_launch: cooperative launch failed: %s (grid %d)\n", hipGetErrorString(e), grid);
#endif
}
```
